# Optimizing an MI355X kernel written in HIP

```python
import jax, jax.numpy as jnp
from jax import lax
import numpy as np

D_MODEL = 1024
BATCH = 8
SEQ = 4096
DEPTH = 1

MEM_LEN = 256
EPS = 1e-6

POOL_WINDOWS = (2, 4, 8, 16)
POOL_GROUPS = len(POOL_WINDOWS)
POOL_GROUP_DIM = D_MODEL // 8
POOL_WIDTH = POOL_GROUPS * POOL_GROUP_DIM
MAX_WINDOW = max(POOL_WINDOWS)

SWA_HEAD_DIM = 64
SWA_HEADS = D_MODEL // SWA_HEAD_DIM
SWA_KV_HEADS = 2
SWA_GROUP = SWA_HEADS // SWA_KV_HEADS
SWA_WIDTH = SWA_HEADS * SWA_HEAD_DIM
SWA_KV_WIDTH = SWA_KV_HEADS * SWA_HEAD_DIM
WINDOW = 128
BLOCK = 128
ROPE_THETA = 10000.0

MEM_HEADS = 4
MEM_HEAD_DIM = D_MODEL // 8
MEM_WIDTH = MEM_HEADS * MEM_HEAD_DIM

N_BRANCHES = 3
IN_WIDTH = POOL_WIDTH + SWA_WIDTH + 2 * SWA_KV_WIDTH + MEM_WIDTH + N_BRANCHES * D_MODEL

PEER_HEADS = 8
N_KEYS = 128
N_EXPERTS = N_KEYS * N_KEYS
PEER_KEY_DIM = 256
PEER_HALF = PEER_KEY_DIM // 2
PEER_TOPK = 16
PEER_CHUNK = 128

NEG_INF = -1e30

kernel_name = "hybrid_pool_swa_mem_peer_block"


def rmsnorm(x, g):
    xf = x.astype(jnp.float32)
    y = xf * lax.rsqrt(jnp.mean(xf * xf, axis=-1, keepdims=True) + EPS)
    return (y * g.astype(jnp.float32)).astype(x.dtype)


def pool_mixer(u, w_pool, pool_scale):
    B, S, _ = u.shape
    uf = u.astype(jnp.float32)
    cs = jnp.pad(jnp.cumsum(uf, axis=1), ((0, 0), (MAX_WINDOW, 0), (0, 0)))
    t = jnp.arange(S)
    outs = []
    for gi, w in enumerate(POOL_WINDOWS):
        lo_c, hi_c = gi * POOL_GROUP_DIM, (gi + 1) * POOL_GROUP_DIM
        upper = cs[:, MAX_WINDOW:, lo_c:hi_c]
        lower = cs[:, MAX_WINDOW - w:MAX_WINDOW - w + S, lo_c:hi_c]
        cnt = jnp.minimum(t + 1, w).astype(jnp.float32)[None, :, None]
        outs.append((upper - lower) / cnt - uf[..., lo_c:hi_c])
    pooled = jnp.stack(outs, axis=2)
    mixed = jnp.einsum('bsgc,gcd->bsgd', pooled, w_pool.astype(jnp.float32))
    return (mixed.reshape(B, S, POOL_WIDTH) * pool_scale.astype(jnp.float32)).astype(u.dtype)


def rope(x, pos):
    half = x.shape[-1] // 2
    inv = ROPE_THETA ** (-jnp.arange(half, dtype=jnp.float32) / half)
    ang = pos.astype(jnp.float32)[..., None] * inv
    cos = jnp.cos(ang)[:, :, None, :]
    sin = jnp.sin(ang)[:, :, None, :]
    xf = x.astype(jnp.float32)
    x1, x2 = xf[..., :half], xf[..., half:]
    return jnp.concatenate([x1 * cos - x2 * sin, x2 * cos + x1 * sin], axis=-1).astype(x.dtype)


def swa_with_sinks(q, k, v, sinks):
    B, S = q.shape[0], q.shape[1]
    nb = S // BLOCK
    qb = q.reshape(B, nb, BLOCK, SWA_KV_HEADS, SWA_GROUP, SWA_HEAD_DIM)

    def band(a):
        ab = a.reshape(B, nb, BLOCK, SWA_KV_HEADS, SWA_HEAD_DIM)
        prev = jnp.pad(ab, ((0, 0), (1, 0), (0, 0), (0, 0), (0, 0)))[:, :-1]
        return jnp.concatenate([prev, ab], axis=2)

    kband, vband = band(k), band(v)
    s = jnp.einsum('bnqhgd,bnkhd->bnhgqk', qb.astype(jnp.float32), kband.astype(jnp.float32))
    s = s * (SWA_HEAD_DIM ** -0.5)
    qi = jnp.arange(BLOCK)[:, None] + BLOCK
    ki = jnp.arange(2 * BLOCK)[None, :]
    rel = qi - ki
    mask = (rel >= 0) & (rel < WINDOW)
    valid_prev = (jnp.arange(nb)[:, None, None] > 0) | (ki[None] >= BLOCK)
    mask = mask[None] & valid_prev
    s = jnp.where(mask[None, :, None, None], s, NEG_INF)
    sink = sinks.astype(jnp.float32).reshape(SWA_KV_HEADS, SWA_GROUP)[None, None, :, :, None, None]
    m = jnp.maximum(jnp.max(s, axis=-1, keepdims=True), sink)
    p = jnp.exp(s - m)
    p = p / (jnp.sum(p, axis=-1, keepdims=True) + jnp.exp(sink - m))
    o = jnp.einsum('bnhgqk,bnkhd->bnqhgd', p.astype(v.dtype), vband)
    return o.reshape(B, S, SWA_WIDTH)


def mem_attention(qm, mem_n, w_mem_kv):
    B, S, _ = qm.shape
    kv = mem_n @ w_mem_kv
    km, vm = jnp.split(kv, 2, axis=-1)
    M = mem_n.shape[1]
    q = qm.reshape(B, S, MEM_HEADS, MEM_HEAD_DIM)
    km = km.reshape(B, M, MEM_HEADS, MEM_HEAD_DIM)
    vm = vm.reshape(B, M, MEM_HEADS, MEM_HEAD_DIM)
    s = jnp.einsum('bshd,bmhd->bhsm', q.astype(jnp.float32), km.astype(jnp.float32))
    p = jax.nn.softmax(s * (MEM_HEAD_DIM ** -0.5), axis=-1)
    o = jnp.einsum('bhsm,bmhd->bshd', p.astype(vm.dtype), vm)
    return o.reshape(B, S, MEM_WIDTH)


def peer(h, w_q, sub_keys, expert_u, expert_v):
    B, S, D = h.shape
    T = B * S
    hf = h.reshape(T, D)
    q = (hf @ w_q).reshape(T, PEER_HEADS, 2, PEER_HALF)
    sc = jnp.einsum('thpc,hpnc->thpn', q.astype(jnp.float32), sub_keys.astype(jnp.float32))
    s_top, i_top = lax.top_k(sc, PEER_TOPK)
    cand = (s_top[:, :, 0, :, None] + s_top[:, :, 1, None, :]).reshape(T, PEER_HEADS, PEER_TOPK * PEER_TOPK)
    ids_cand = (i_top[:, :, 0, :, None] * N_KEYS + i_top[:, :, 1, None, :]).reshape(T, PEER_HEADS, PEER_TOPK * PEER_TOPK)
    s_fin, pos = lax.top_k(cand, PEER_TOPK)
    ids = jnp.take_along_axis(ids_cand, pos, axis=-1)
    gates = jax.nn.softmax(s_fin, axis=-1).astype(h.dtype)
    nc = T // PEER_CHUNK
    HK = PEER_HEADS * PEER_TOPK

    def expert_chunk(args):
        xc, idc, gc = args
        u = expert_u[idc]
        a = jax.nn.gelu(jnp.einsum('cd,ckd->ck', xc, u))
        vv = expert_v[idc]
        return jnp.einsum('ck,ckd->cd', gc * a, vv)

    y = lax.map(expert_chunk, (hf.reshape(nc, PEER_CHUNK, D),
                               ids.reshape(nc, PEER_CHUNK, HK),
                               gates.reshape(nc, PEER_CHUNK, HK)))
    return y.reshape(B, S, D)


def setup_inputs(seed: int = 0) -> dict:
    key = jax.random.key(seed)
    ks = jax.random.split(key, 24)
    L, D = DEPTH, D_MODEL
    nrm = jax.random.normal
    x = nrm(ks[0], (BATCH, SEQ, D), jnp.float32)
    mem = nrm(ks[1], (BATCH, MEM_LEN, D), jnp.float32)
    positions = (jnp.arange(SEQ, dtype=jnp.int32)[None, :]
                 + jax.random.randint(ks[2], (BATCH, 1), 0, 1024, dtype=jnp.int32))
    return {
        "x": x,
        "mem": mem,
        "positions": positions,
        "norm1_g": 1.0 + 0.05 * nrm(ks[3], (L, D), jnp.float32),
        "mem_norm_g": 1.0 + 0.05 * nrm(ks[4], (L, D), jnp.float32),
        "w_in": nrm(ks[5], (L, D, IN_WIDTH), jnp.float32) * D ** -0.5,
        "w_pool": nrm(ks[6], (L, POOL_GROUPS, POOL_GROUP_DIM, POOL_GROUP_DIM), jnp.float32) * POOL_GROUP_DIM ** -0.5,
        "pool_scale": 1.0 + 0.1 * nrm(ks[7], (L, POOL_WIDTH), jnp.float32),
        "attn_sinks": 0.5 * nrm(ks[8], (L, SWA_HEADS), jnp.float32),
        "w_mem_kv": nrm(ks[9], (L, D, 2 * MEM_WIDTH), jnp.float32) * D ** -0.5,
        "w_branch_pool": nrm(ks[10], (L, POOL_WIDTH, D), jnp.float32) * POOL_WIDTH ** -0.5,
        "w_branch_swa": nrm(ks[11], (L, SWA_WIDTH, D), jnp.float32) * SWA_WIDTH ** -0.5,
        "w_branch_mem": nrm(ks[12], (L, MEM_WIDTH, D), jnp.float32) * MEM_WIDTH ** -0.5,
        "w_out": nrm(ks[13], (L, D, D), jnp.float32) * D ** -0.5,
        "norm2_g": 1.0 + 0.05 * nrm(ks[14], (L, D), jnp.float32),
        "peer_w_q": nrm(ks[15], (L, D, PEER_HEADS * PEER_KEY_DIM), jnp.float32) * D ** -0.5,
        "peer_sub_keys": nrm(ks[16], (L, PEER_HEADS, 2, N_KEYS, PEER_HALF), jnp.float32) * PEER_HALF ** -0.5,
        "peer_u": nrm(ks[17], (L, N_EXPERTS, D), jnp.float32) * D ** -0.5,
        "peer_v": nrm(ks[18], (L, N_EXPERTS, D), jnp.float32) * 0.5,
        "final_norm_g": 1.0 + 0.05 * nrm(ks[19], (D,), jnp.float32),
    }


def reference(x, mem, positions, norm1_g, mem_norm_g, w_in, w_pool, pool_scale, attn_sinks,
              w_mem_kv, w_branch_pool, w_branch_swa, w_branch_mem, w_out, norm2_g,
              peer_w_q, peer_sub_keys, peer_u, peer_v, final_norm_g):
    B, S, D = x.shape
    splits = np.cumsum([POOL_WIDTH, SWA_WIDTH, SWA_KV_WIDTH, SWA_KV_WIDTH, MEM_WIDTH]).tolist()
    for l in range(DEPTH):
        h = rmsnorm(x, norm1_g[l])
        z = h @ w_in[l]
        u_pool, q, k, v, qm, gate_logits = jnp.split(z, splits, axis=-1)
        y_pool = pool_mixer(u_pool, w_pool[l], pool_scale[l])
        q = rope(q.reshape(B, S, SWA_HEADS, SWA_HEAD_DIM), positions)
        k = rope(k.reshape(B, S, SWA_KV_HEADS, SWA_HEAD_DIM), positions)
        v = v.reshape(B, S, SWA_KV_HEADS, SWA_HEAD_DIM)
        y_swa = swa_with_sinks(q, k, v, attn_sinks[l])
        y_mem = mem_attention(qm, rmsnorm(mem, mem_norm_g[l]), w_mem_kv[l])
        g = jax.nn.sigmoid(gate_logits.reshape(B, S, N_BRANCHES, D))
        merged = (g[:, :, 0] * (y_pool @ w_branch_pool[l])
                  + g[:, :, 1] * (y_swa @ w_branch_swa[l])
                  + g[:, :, 2] * (y_mem @ w_branch_mem[l]))
        x = x + merged @ w_out[l]
        h2 = rmsnorm(x, norm2_g[l])
        x = x + peer(h2, peer_w_q[l], peer_sub_keys[l], peer_u[l], peer_v[l])
    return rmsnorm(x, final_norm_g)
```

```cpp
#include <hip/hip_runtime.h>
#include <hip/hip_cooperative_groups.h>
#include <cstdio>
#include <cstdint>
namespace cg = cooperative_groups;

#define DI __device__ __forceinline__
typedef unsigned short bf16_t;
typedef _Float16 f16_t;
typedef short bf16x8 __attribute__((ext_vector_type(8)));
typedef float f32x4 __attribute__((ext_vector_type(4)));
typedef float f32x16 __attribute__((ext_vector_type(16)));
typedef unsigned u32x4 __attribute__((ext_vector_type(4)));
typedef unsigned u32x2 __attribute__((ext_vector_type(2)));
typedef _Float16 f16x4 __attribute__((ext_vector_type(4)));

constexpr int D = 1024, BATCH = 8, SEQ = 4096, T = BATCH * SEQ, MEML = 256, TMEM = BATCH * MEML;
constexpr int INW = 5376;
constexpr int NTHREADS = 512, NWAVES = 8;
constexpr int NEXP = 16384;
constexpr float EPS = 1e-6f;

constexpr size_t MiB = 1u << 20;
constexpr size_t WS_WIN = 1 * MiB;
constexpr size_t WS_WBR = 12 * MiB;
constexpr size_t WS_WOUT = 16 * MiB;
constexpr size_t WS_WQ = 18 * MiB;
constexpr size_t WS_KEYS = 22 * MiB;
constexpr size_t WS_WPOOL = 22 * MiB + 512 * 1024;
constexpr size_t WS_RSTD1 = 22 * MiB + 768 * 1024;
constexpr size_t WS_RSTD2 = 22 * MiB + 896 * 1024;
constexpr size_t WS_RSTDM = 23 * MiB;
constexpr size_t WS_WMKV = 24 * MiB;
constexpr size_t WS_MEMB = 26 * MiB;
constexpr size_t WS_KVM = 30 * MiB;
constexpr size_t WS_ROPE = 34 * MiB;
constexpr size_t WS_XB = 42 * MiB;
constexpr size_t WS_POOLED = 42 * MiB;
constexpr size_t WS_MERGED = 42 * MiB;
constexpr size_t WS_U16 = 106 * MiB;
constexpr size_t WS_V16 = 138 * MiB;
constexpr size_t WS_UPOOL = 170 * MiB;
constexpr size_t WS_QR = 202 * MiB;
constexpr size_t WS_KR = 266 * MiB;
constexpr size_t WS_VV = 274 * MiB;
constexpr size_t WS_QM = 282 * MiB;
constexpr size_t WS_GATES = 314 * MiB;
constexpr size_t WS_X1B = 170 * MiB;
constexpr size_t WS_QP = 314 * MiB;
constexpr size_t WS_IDS = 442 * MiB;
constexpr size_t WS_GTS = 458 * MiB;
constexpr size_t WS_END = 512 * MiB;

struct Params {
    const float* x; const float* mem; const int* pos; const float* norm1_g; const float* mem_norm_g; const float* w_in; const float* w_pool;
    const float* pool_scale; const float* sinks; const float* w_mem_kv; const float* w_bpool; const float* w_bswa; const float* w_bmem; const float* w_out;
    const float* norm2_g; const float* w_q; const float* sub_keys; const float* peer_u; const float* peer_v; const float* final_g;
    float* out; unsigned char* ws;
};

DI unsigned f2bf(float f) { unsigned u = __builtin_bit_cast(unsigned, f); return (u + 0x7fffu + ((u >> 16) & 1u)) >> 16; }
DI unsigned pk2(float lo, float hi) { return f2bf(lo) | (f2bf(hi) << 16); }
DI float bf2f(bf16_t b) { return __builtin_bit_cast(float, (unsigned)b << 16); }
DI float bflo(unsigned w) { return __builtin_bit_cast(float, w << 16); }
DI float bfhi(unsigned w) { return __builtin_bit_cast(float, w & 0xffff0000u); }
DI float wave_sum(float v) {
#pragma unroll
    for (int o = 1; o < 64; o <<= 1) v += __shfl_xor(v, o);
    return v;
}
DI float wave_max(float v) {
#pragma unroll
    for (int o = 1; o < 64; o <<= 1) v = fmaxf(v, __shfl_xor(v, o));
    return v;
}
DI float gelu_tanh(float x) {
    const float y = 0.7978845608028654f * (x + 0.044715f * x * x * x);
    const float e = __expf(2.f * y);
    const float th = 1.f - 2.f / (e + 1.f);
    return 0.5f * x * (1.f + th);
}
DI float sigmoidf(float x) { return 1.f / (1.f + __expf(-x)); }

DI void transpose_item(const float* W, int K, int N, bf16_t* WT, int ldt, int roff, int coff, const float* g, float* scr, int item, int lane) {
    const int nblk = N / 32, kb = item / nblk, nb = item % nblk, k0 = 64 * kb, n0 = 32 * nb;
#pragma unroll 8
    for (int i = 0; i < 32; ++i) { const int kk = 2 * i + (lane >> 5); float v = W[(size_t)(k0 + kk) * N + n0 + (lane & 31)]; if (g) v *= g[k0 + kk]; scr[kk * 33 + (lane & 31)] = v; }
    asm volatile("s_waitcnt lgkmcnt(0)" ::: "memory");
    const int c = lane & 7;
#pragma unroll
    for (int j = 0; j < 4; ++j) { const int n = (lane >> 3) + 8 * j; const float* s = scr + (8 * c) * 33 + n;
        u32x4 o; o.x = pk2(s[0 * 33], s[1 * 33]); o.y = pk2(s[2 * 33], s[3 * 33]); o.z = pk2(s[4 * 33], s[5 * 33]); o.w = pk2(s[6 * 33], s[7 * 33]);
        *(u32x4*)(WT + (size_t)(roff + n0 + n) * ldt + coff + k0 + 8 * c) = o; }
    asm volatile("s_waitcnt lgkmcnt(0)" ::: "memory");
}

DI void row_to_bf16_rstd(const float* xrow, bf16_t* orow, float* rstd_out, int lane) {
    const f32x4* xr = (const f32x4*)xrow + lane;
    f32x4 v[4]; float s = 0.f;
#pragma unroll
    for (int j = 0; j < 4; ++j) { v[j] = xr[64 * j]; s += (v[j].x * v[j].x + v[j].y * v[j].y) + (v[j].z * v[j].z + v[j].w * v[j].w); }
    s = wave_sum(s);
    if (lane == 0) *rstd_out = 1.f / sqrtf(s * (1.f / D) + EPS);
    u32x2* o8 = (u32x2*)orow + lane;
#pragma unroll
    for (int j = 0; j < 4; ++j) { u32x2 w; w.x = pk2(v[j].x, v[j].y); w.y = pk2(v[j].z, v[j].w); o8[64 * j] = w; }
}

DI void phase0(const Params& p, float* lds_f, int gw, int NGW, int wave, int lane) {
    unsigned char* ws = p.ws;
    float* scr = lds_f + wave * (64 * 33);
    bf16_t* WinT = (bf16_t*)(ws + WS_WIN); bf16_t* WbrT = (bf16_t*)(ws + WS_WBR); bf16_t* WoutT = (bf16_t*)(ws + WS_WOUT); bf16_t* WqT = (bf16_t*)(ws + WS_WQ);
    bf16_t* WmkvT = (bf16_t*)(ws + WS_WMKV); bf16_t* WpoolT = (bf16_t*)(ws + WS_WPOOL);
    constexpr int I_IN = (D / 64) * (INW / 32), I_BP = (512 / 64) * (D / 32), I_BS = (1024 / 64) * (D / 32), I_BM = I_BP, I_OUT = (D / 64) * (D / 32), I_Q = (D / 64) * (2048 / 32), I_MKV = (D / 64) * (D / 32), I_PL = (128 / 64) * (128 / 32);
    constexpr int NITEMS = I_IN + I_BP + I_BS + I_BM + I_OUT + I_Q + I_MKV + 4 * I_PL;
    for (int it = gw; it < NITEMS; it += NGW) {
        int r = it;
        if (r < I_IN) { transpose_item(p.w_in, D, INW, WinT, D, 0, 0, p.norm1_g, scr, r, lane); continue; } r -= I_IN;
        if (r < I_BP) { transpose_item(p.w_bpool, 512, D, WbrT, 2048, 0, 0, nullptr, scr, r, lane); continue; } r -= I_BP;
        if (r < I_BS) { transpose_item(p.w_bswa, 1024, D, WbrT, 2048, 0, 512, nullptr, scr, r, lane); continue; } r -= I_BS;
        if (r < I_BM) { transpose_item(p.w_bmem, 512, D, WbrT, 2048, 0, 1536, nullptr, scr, r, lane); continue; } r -= I_BM;
        if (r < I_OUT) { transpose_item(p.w_out, D, D, WoutT, D, 0, 0, nullptr, scr, r, lane); continue; } r -= I_OUT;
        if (r < I_Q) { transpose_item(p.w_q, D, 2048, WqT, D, 0, 0, p.norm2_g, scr, r, lane); continue; } r -= I_Q;
        if (r < I_MKV) { transpose_item(p.w_mem_kv, D, D, WmkvT, D, 0, 0, p.mem_norm_g, scr, r, lane); continue; } r -= I_MKV;
        { const int g = r / I_PL, rr = r % I_PL; transpose_item(p.w_pool + (size_t)g * 128 * 128, 128, 128, WpoolT + (size_t)g * 128 * 128, 128, 0, 0, nullptr, scr, rr, lane); }
    }
    bf16_t* xb = (bf16_t*)(ws + WS_XB); float* rstd1 = (float*)(ws + WS_RSTD1);
    for (int m = gw; m < T; m += NGW) row_to_bf16_rstd(p.x + (size_t)m * D, xb + (size_t)m * D, rstd1 + m, lane);
    bf16_t* memb = (bf16_t*)(ws + WS_MEMB); float* rstdm = (float*)(ws + WS_RSTDM);
    for (int m = gw; m < TMEM; m += NGW) row_to_bf16_rstd(p.mem + (size_t)m * D, memb + (size_t)m * D, rstdm + m, lane);
    const size_t gt = (size_t)gw * 64 + lane, NGT = (size_t)NGW * 64;
    bf16_t* keysb = (bf16_t*)(ws + WS_KEYS);
    for (size_t i = gt; i < (size_t)8 * 2 * 128 * 128 / 4; i += NGT) { const f32x4 v = ((const f32x4*)p.sub_keys)[i]; u32x2 w; w.x = pk2(v.x, v.y); w.y = pk2(v.z, v.w); ((u32x2*)keysb)[i] = w; }
    f16_t* u16 = (f16_t*)(ws + WS_U16); f16_t* v16 = (f16_t*)(ws + WS_V16);
    for (size_t i = gt; i < (size_t)NEXP * D / 4; i += NGT) {
        const f32x4 a = ((const f32x4*)p.peer_u)[i]; const f32x4 b = ((const f32x4*)p.peer_v)[i];
        f16x4 ha = {(f16_t)a.x, (f16_t)a.y, (f16_t)a.z, (f16_t)a.w}; f16x4 hb = {(f16_t)b.x, (f16_t)b.y, (f16_t)b.z, (f16_t)b.w};
        ((f16x4*)u16)[i] = ha; ((f16x4*)v16)[i] = hb;
    }
    float2* rope = (float2*)(ws + WS_ROPE);
    for (size_t i = gt; i < (size_t)T * 32; i += NGT) {
        const int t = (int)(i >> 5), d = (int)(i & 31);
        const float inv = exp2f(-(float)d * (13.287712379549449f / 32.f));
        const float ang = (float)p.pos[t] * inv;
        const double rev = (double)ang * 0.15915494309189535;
        const float fr = (float)(rev - floor(rev));
        rope[i] = make_float2(__builtin_amdgcn_cosf(fr), __builtin_amdgcn_sinf(fr));
    }
}

DI int crow(int i, int h) { return (i & 3) + 8 * (i >> 2) + 4 * h; }
constexpr int GS_LD = 40;

template <class Epi>
DI void gemm_simple(const bf16_t* A, int lda, const bf16_t* Bt, int ldb, int M, int N, int K, const Epi& E, bf16_t* lds, int tid) {
    const int lane = tid & 63, wave = tid >> 6, wm = wave >> 1, wn = wave & 1, r = lane & 31, h = lane >> 5;
    bf16_t* As = lds; bf16_t* Bs = lds + 128 * GS_LD;
    const int ntn = N / 128, ntiles = (M / 128) * ntn;
    const int lrow = tid >> 2, lkc = (tid & 3) * 8;
    for (int tile = blockIdx.x; tile < ntiles; tile += gridDim.x) {
        const int tm = tile / ntn, tn = tile % ntn;
        f32x16 acc0, acc1;
#pragma unroll
        for (int i = 0; i < 16; ++i) { acc0[i] = 0.f; acc1[i] = 0.f; }
        const bf16_t* ap = A + (size_t)(tm * 128 + lrow) * lda + lkc;
        const bf16_t* bp = Bt + (size_t)(tn * 128 + lrow) * ldb + lkc;
        for (int k0 = 0; k0 < K; k0 += 32) {
            const u32x4 av = *(const u32x4*)(ap + k0);
            const u32x4 bv = *(const u32x4*)(bp + k0);
            __syncthreads();
            *(u32x4*)(As + lrow * GS_LD + lkc) = av;
            *(u32x4*)(Bs + lrow * GS_LD + lkc) = bv;
            __syncthreads();
#pragma unroll
            for (int ks = 0; ks < 2; ++ks) {
                const bf16x8 a = *(const bf16x8*)(As + (wm * 32 + r) * GS_LD + ks * 16 + 8 * h);
                const bf16x8 b0 = *(const bf16x8*)(Bs + (wn * 64 + r) * GS_LD + ks * 16 + 8 * h);
                const bf16x8 b1 = *(const bf16x8*)(Bs + (wn * 64 + 32 + r) * GS_LD + ks * 16 + 8 * h);
                acc0 = __builtin_amdgcn_mfma_f32_32x32x16_bf16(a, b0, acc0, 0, 0, 0);
                acc1 = __builtin_amdgcn_mfma_f32_32x32x16_bf16(a, b1, acc1, 0, 0, 0);
            }
        }
        E(tm * 128 + wm * 32, tn * 128 + wn * 64, acc0, acc1, lane);
    }
}

DI void gemm_gated(const bf16_t* A, const bf16_t* Bt, const bf16_t* gates, bf16_t* merged, bf16_t* lds, int tid) {
    const int lane = tid & 63, wave = tid >> 6, wm = wave >> 1, wn = wave & 1, r = lane & 31, h = lane >> 5;
    bf16_t* As = lds; bf16_t* Bs = lds + 128 * GS_LD;
    constexpr int lda = 2048, ldb = 2048, N = 1024, K = 2048;
    const int ntn = N / 128, ntiles = (T / 128) * ntn;
    const int lrow = tid >> 2, lkc = (tid & 3) * 8;
    for (int tile = blockIdx.x; tile < ntiles; tile += gridDim.x) {
        const int tm = tile / ntn, tn = tile % ntn;
        f32x16 acc0, acc1, tot0, tot1;
#pragma unroll
        for (int i = 0; i < 16; ++i) { acc0[i] = 0.f; acc1[i] = 0.f; tot0[i] = 0.f; tot1[i] = 0.f; }
        const bf16_t* ap = A + (size_t)(tm * 128 + lrow) * lda + lkc;
        const bf16_t* bp = Bt + (size_t)(tn * 128 + lrow) * ldb + lkc;
        const int rb = tm * 128 + wm * 32, cb = tn * 128 + wn * 64 + r;
        for (int k0 = 0; k0 < K; k0 += 32) {
            const u32x4 av = *(const u32x4*)(ap + k0);
            const u32x4 bv = *(const u32x4*)(bp + k0);
            __syncthreads();
            *(u32x4*)(As + lrow * GS_LD + lkc) = av;
            *(u32x4*)(Bs + lrow * GS_LD + lkc) = bv;
            __syncthreads();
#pragma unroll
            for (int ks = 0; ks < 2; ++ks) {
                const bf16x8 a = *(const bf16x8*)(As + (wm * 32 + r) * GS_LD + ks * 16 + 8 * h);
                const bf16x8 b0 = *(const bf16x8*)(Bs + (wn * 64 + r) * GS_LD + ks * 16 + 8 * h);
                const bf16x8 b1 = *(const bf16x8*)(Bs + (wn * 64 + 32 + r) * GS_LD + ks * 16 + 8 * h);
                acc0 = __builtin_amdgcn_mfma_f32_32x32x16_bf16(a, b0, acc0, 0, 0, 0);
                acc1 = __builtin_amdgcn_mfma_f32_32x32x16_bf16(a, b1, acc1, 0, 0, 0);
            }
            const int kn = k0 + 32;
            if (kn == 512 || kn == 1536 || kn == 2048) {
                const int b = (kn == 512) ? 0 : (kn == 1536 ? 1 : 2);
#pragma unroll
                for (int i = 0; i < 16; ++i) {
                    const size_t row = (size_t)(rb + crow(i, h));
                    const float g0 = bf2f(gates[row * 3072 + b * 1024 + cb]), g1 = bf2f(gates[row * 3072 + b * 1024 + cb + 32]);
                    tot0[i] += g0 * acc0[i]; tot1[i] += g1 * acc1[i]; acc0[i] = 0.f; acc1[i] = 0.f;
                }
            }
        }
#pragma unroll
        for (int i = 0; i < 16; ++i) {
            const size_t row = (size_t)(rb + crow(i, h));
            merged[row * 1024 + cb] = (bf16_t)f2bf(tot0[i]); merged[row * 1024 + cb + 32] = (bf16_t)f2bf(tot1[i]);
        }
    }
}

struct EpiZ {
    const float* rstd1; const float2* rope; bf16_t *upool, *qr, *kr, *vv, *qm, *gates;
    DI void operator()(int rb, int cb, const f32x16& a0, const f32x16& a1, int lane) const {
        const int r = lane & 31, h = lane >> 5;
#pragma unroll
        for (int i = 0; i < 16; ++i) {
            const int row = rb + crow(i, h);
            const float rs = rstd1[row];
            float v0 = a0[i] * rs, v1 = a1[i] * rs;
            const int c0 = cb + r;
            if (cb < 512) { upool[(size_t)row * 512 + c0] = (bf16_t)f2bf(v0); upool[(size_t)row * 512 + c0 + 32] = (bf16_t)f2bf(v1); }
            else if (cb < 1536) {
                const float2 cs = rope[(size_t)row * 32 + r];
                const float o0 = (v0 * cs.x - v1 * cs.y) * 0.125f, o1 = (v1 * cs.x + v0 * cs.y) * 0.125f;
                qr[(size_t)row * 1024 + (c0 - 512)] = (bf16_t)f2bf(o0); qr[(size_t)row * 1024 + (c0 - 512) + 32] = (bf16_t)f2bf(o1);
            } else if (cb < 1664) {
                const float2 cs = rope[(size_t)row * 32 + r];
                const float o0 = v0 * cs.x - v1 * cs.y, o1 = v1 * cs.x + v0 * cs.y;
                kr[(size_t)row * 128 + (c0 - 1536)] = (bf16_t)f2bf(o0); kr[(size_t)row * 128 + (c0 - 1536) + 32] = (bf16_t)f2bf(o1);
            } else if (cb < 1792) { vv[(size_t)row * 128 + (c0 - 1664)] = (bf16_t)f2bf(v0); vv[(size_t)row * 128 + (c0 - 1664) + 32] = (bf16_t)f2bf(v1); }
            else if (cb < 2304) { qm[(size_t)row * 512 + (c0 - 1792)] = (bf16_t)f2bf(v0); qm[(size_t)row * 512 + (c0 - 1792) + 32] = (bf16_t)f2bf(v1); }
            else { gates[(size_t)row * 3072 + (c0 - 2304)] = (bf16_t)f2bf(sigmoidf(v0)); gates[(size_t)row * 3072 + (c0 - 2304) + 32] = (bf16_t)f2bf(sigmoidf(v1)); }
        }
    }
};
struct EpiRowScaleBf16 {
    const float* rs; bf16_t* O; int ldo;
    DI void operator()(int rb, int cb, const f32x16& a0, const f32x16& a1, int lane) const {
        const int r = lane & 31, h = lane >> 5;
#pragma unroll
        for (int i = 0; i < 16; ++i) { const int row = rb + crow(i, h); const float s = rs ? rs[row] : 1.f;
            O[(size_t)row * ldo + cb + r] = (bf16_t)f2bf(a0[i] * s); O[(size_t)row * ldo + cb + r + 32] = (bf16_t)f2bf(a1[i] * s); }
    }
};
struct EpiPool {
    const float* scale; bf16_t* ycat; int g;
    DI void operator()(int rb, int cb, const f32x16& a0, const f32x16& a1, int lane) const {
        const int r = lane & 31, h = lane >> 5; const int c0 = g * 128 + cb + r; const float s0 = scale[c0], s1 = scale[c0 + 32];
#pragma unroll
        for (int i = 0; i < 16; ++i) { const int row = rb + crow(i, h);
            ycat[(size_t)row * 2048 + c0] = (bf16_t)f2bf(a0[i] * s0); ycat[(size_t)row * 2048 + c0 + 32] = (bf16_t)f2bf(a1[i] * s1); }
    }
};
struct EpiOut {
    const float* x; float* x1; bf16_t* x1b;
    DI void operator()(int rb, int cb, const f32x16& a0, const f32x16& a1, int lane) const {
        const int r = lane & 31, h = lane >> 5;
#pragma unroll
        for (int i = 0; i < 16; ++i) { const size_t o = (size_t)(rb + crow(i, h)) * D + cb + r;
            const float v0 = x[o] + a0[i], v1 = x[o + 32] + a1[i];
            x1[o] = v0; x1[o + 32] = v1; x1b[o] = (bf16_t)f2bf(v0); x1b[o + 32] = (bf16_t)f2bf(v1); }
    }
};

DI void pooled_phase(const bf16_t* upool, bf16_t* pooled) {
    const size_t gt = (size_t)blockIdx.x * NTHREADS + threadIdx.x, NGT = (size_t)gridDim.x * NTHREADS;
    for (size_t i = gt; i < (size_t)T * 512; i += NGT) {
        const int t = (int)(i >> 9), c = (int)(i & 511), g = c >> 7, w = 2 << g, s = t & (SEQ - 1);
        const int cnt = (s + 1 < w) ? s + 1 : w;
        float sum = 0.f;
        for (int j = 0; j < cnt; ++j) sum += bf2f(upool[(size_t)(t - j) * 512 + c]);
        const float u = bf2f(upool[i]);
        pooled[i] = (bf16_t)f2bf(sum / (float)cnt - u);
    }
}
DI void swa_item(int item, const bf16_t* qr, const bf16_t* kr, const bf16_t* vv, const float* sinks, bf16_t* ycat, int lane) {
    const int t = item >> 4, hq = item & 15, kvh = hq >> 3, s = t & (SEQ - 1);
    const unsigned* qp = (const unsigned*)(qr + (size_t)t * 1024 + hq * 64);
    unsigned q[32];
#pragma unroll
    for (int i = 0; i < 32; ++i) q[i] = qp[i];
    float sc[2];
#pragma unroll
    for (int e = 0; e < 2; ++e) {
        const int rel = 127 - (lane + 64 * e);
        const int j = s - rel;
        float d = -1e30f;
        if (j >= 0) {
            const unsigned* kp = (const unsigned*)(kr + (size_t)(t - rel) * 128 + kvh * 64);
            float a = 0.f;
#pragma unroll
            for (int i = 0; i < 32; ++i) { const unsigned kw = kp[i]; a += bflo(q[i]) * bflo(kw) + bfhi(q[i]) * bfhi(kw); }
            d = a;
        }
        sc[e] = d;
    }
    const float sink = sinks[hq];
    const float m = fmaxf(wave_max(fmaxf(sc[0], sc[1])), sink);
    const float p0 = __expf(sc[0] - m), p1 = __expf(sc[1] - m);
    const float den = wave_sum(p0 + p1) + __expf(sink - m);
    const float inv = 1.f / den;
    float o = 0.f;
    for (int jj = 0; jj < 128; ++jj) {
        const float pj = (jj < 64) ? __shfl(p0, jj) : __shfl(p1, jj - 64);
        const int rel = 127 - jj;
        if (s - rel >= 0) o += pj * bf2f(vv[(size_t)(t - rel) * 128 + kvh * 64 + lane]);
    }
    ycat[(size_t)t * 2048 + 512 + hq * 64 + lane] = (bf16_t)f2bf(o * inv);
}
DI void mem_item(int item, const bf16_t* qm, const bf16_t* kvm, bf16_t* ycat, int lane) {
    const int t = item >> 2, hm = item & 3, b = t / SEQ;
    const unsigned* qp = (const unsigned*)(qm + (size_t)t * 512 + hm * 128);
    float sc[4];
#pragma unroll
    for (int e = 0; e < 4; ++e) {
        const int m = lane + 64 * e;
        const unsigned* kp = (const unsigned*)(kvm + (size_t)(b * MEML + m) * 1024 + hm * 128);
        float a = 0.f;
        for (int i = 0; i < 64; ++i) { const unsigned qw = qp[i], kw = kp[i]; a += bflo(qw) * bflo(kw) + bfhi(qw) * bfhi(kw); }
        sc[e] = a * 0.08838834764831845f;
    }
    const float mx = wave_max(fmaxf(fmaxf(sc[0], sc[1]), fmaxf(sc[2], sc[3])));
    float pe[4];
#pragma unroll
    for (int e = 0; e < 4; ++e) pe[e] = __expf(sc[e] - mx);
    const float inv = 1.f / wave_sum((pe[0] + pe[1]) + (pe[2] + pe[3]));
    float o0 = 0.f, o1 = 0.f;
#pragma unroll
    for (int e = 0; e < 4; ++e)
        for (int jj = 0; jj < 64; ++jj) {
            const float pj = __shfl(pe[e], jj);
            const bf16_t* vp = kvm + (size_t)(b * MEML + jj + 64 * e) * 1024 + 512 + hm * 128;
            o0 += pj * bf2f(vp[lane]); o1 += pj * bf2f(vp[lane + 64]);
        }
    bf16_t* yp = ycat + (size_t)t * 2048 + 1536 + hm * 128;
    yp[lane] = (bf16_t)f2bf(o0 * inv); yp[lane + 64] = (bf16_t)f2bf(o1 * inv);
}

DI void argmax_step(float& v, int& i) {
#pragma unroll
    for (int o = 1; o < 64; o <<= 1) { const float ov = __shfl_xor(v, o); const int oi = __shfl_xor(i, o); if (ov > v || (ov == v && oi < i)) { v = ov; i = oi; } }
}
DI void topk_item(int item, const bf16_t* qp, const bf16_t* keysb, const float* rstd2, int* ids, float* gts, int lane) {
    const int t = item >> 3, h = item & 7;
    const float rs = rstd2[t];
    float stop[2]; int itop[2];
#pragma unroll
    for (int p = 0; p < 2; ++p) {
        const unsigned* qv = (const unsigned*)(qp + (size_t)t * 2048 + h * 256 + p * 128);
        float s0 = 0.f, s1 = 0.f;
        const unsigned* k0 = (const unsigned*)(keysb + ((size_t)(h * 2 + p) * 128 + lane) * 128);
        const unsigned* k1 = k0 + 64 * 64;
        for (int i = 0; i < 64; ++i) { const unsigned qw = qv[i], a = k0[i], b = k1[i]; s0 += bflo(qw) * bflo(a) + bfhi(qw) * bfhi(a); s1 += bflo(qw) * bflo(b) + bfhi(qw) * bfhi(b); }
        s0 *= rs; s1 *= rs;
        float sv = 0.f; int si = 0;
        for (int k = 0; k < 16; ++k) {
            float v; int i;
            if (s0 >= s1) { v = s0; i = lane; } else { v = s1; i = lane + 64; }
            argmax_step(v, i);
            if (i == lane) s0 = -3e38f; if (i == lane + 64) s1 = -3e38f;
            if (lane == k) { sv = v; si = i; }
        }
        stop[p] = sv; itop[p] = si;
    }
    float cv[4]; int cid[4];
#pragma unroll
    for (int e = 0; e < 4; ++e) { const int ci = lane * 4 + e, a = ci >> 4, b = ci & 15;
        cv[e] = __shfl(stop[0], a) + __shfl(stop[1], b); cid[e] = __shfl(itop[0], a) * 128 + __shfl(itop[1], b); }
    float fv = 0.f; int fid = 0;
    for (int k = 0; k < 16; ++k) {
        float v = cv[0]; int i = lane * 4;
#pragma unroll
        for (int e = 1; e < 4; ++e) if (cv[e] > v) { v = cv[e]; i = lane * 4 + e; }
        argmax_step(v, i);
        const int owner = i >> 2, e = i & 3;
        int id = (e == 0) ? cid[0] : (e == 1) ? cid[1] : (e == 2) ? cid[2] : cid[3];
        id = __shfl(id, owner);
        if (lane == owner) { if (e == 0) cv[0] = -3e38f; else if (e == 1) cv[1] = -3e38f; else if (e == 2) cv[2] = -3e38f; else cv[3] = -3e38f; }
        if (lane == k) { fv = v; fid = id; }
    }
    const float mx = __shfl(fv, 0);
    float e = (lane < 16) ? __expf(fv - mx) : 0.f;
    const float den = wave_sum(e);
    if (lane < 16) { ids[(size_t)t * 128 + h * 16 + lane] = fid; gts[(size_t)t * 128 + h * 16 + lane] = e / den; }
}

DI void gather_item(int t, const float* x1, const float* g2, const float* gf, const f16_t* u16, const f16_t* v16, const int* ids, const float* gts, float* out, int lane) {
    const f32x4* xr = (const f32x4*)(x1 + (size_t)t * D) + lane;
    f32x4 xv[4], hv[4], acc[4]; float s = 0.f;
#pragma unroll
    for (int j = 0; j < 4; ++j) { xv[j] = xr[64 * j]; s += (xv[j].x * xv[j].x + xv[j].y * xv[j].y) + (xv[j].z * xv[j].z + xv[j].w * xv[j].w); acc[j] = (f32x4){0.f, 0.f, 0.f, 0.f}; }
    const float rs = 1.f / sqrtf(wave_sum(s) * (1.f / D) + EPS);
#pragma unroll
    for (int j = 0; j < 4; ++j) { const f32x4 g = ((const f32x4*)g2)[lane + 64 * j]; hv[j] = xv[j] * rs * g; }
    const int id0 = ids[(size_t)t * 128 + lane], id1 = ids[(size_t)t * 128 + 64 + lane];
    const float gt0 = gts[(size_t)t * 128 + lane], gt1 = gts[(size_t)t * 128 + 64 + lane];
    for (int k = 0; k < 128; ++k) {
        const int id = (k < 64) ? __shfl(id0, k) : __shfl(id1, k - 64);
        const float gate = (k < 64) ? __shfl(gt0, k) : __shfl(gt1, k - 64);
        const f16x4* ur = (const f16x4*)(u16 + (size_t)id * D) + lane;
        float d = 0.f;
#pragma unroll
        for (int j = 0; j < 4; ++j) { const f16x4 u = ur[64 * j]; d += (hv[j].x * (float)u.x + hv[j].y * (float)u.y) + (hv[j].z * (float)u.z + hv[j].w * (float)u.w); }
        d = wave_sum(d);
        const float coef = gate * gelu_tanh(d);
        const f16x4* vr = (const f16x4*)(v16 + (size_t)id * D) + lane;
#pragma unroll
        for (int j = 0; j < 4; ++j) { const f16x4 v = vr[64 * j]; acc[j].x += coef * (float)v.x; acc[j].y += coef * (float)v.y; acc[j].z += coef * (float)v.z; acc[j].w += coef * (float)v.w; }
    }
    float s2 = 0.f;
#pragma unroll
    for (int j = 0; j < 4; ++j) { xv[j] = xv[j] + acc[j]; s2 += (xv[j].x * xv[j].x + xv[j].y * xv[j].y) + (xv[j].z * xv[j].z + xv[j].w * xv[j].w); }
    const float rf = 1.f / sqrtf(wave_sum(s2) * (1.f / D) + EPS);
    f32x4* orow = (f32x4*)(out + (size_t)t * D) + lane;
#pragma unroll
    for (int j = 0; j < 4; ++j) { const f32x4 g = ((const f32x4*)gf)[lane + 64 * j]; orow[64 * j] = xv[j] * rf * g; }
}

constexpr int LDS_BYTES = NWAVES * 64 * 33 * 4;
__global__ void __launch_bounds__(NTHREADS) fwd_kernel(Params p) {
    __shared__ __attribute__((aligned(16))) unsigned char lds[LDS_BYTES];
    cg::grid_group grid = cg::this_grid();
    const int tid = threadIdx.x, lane = tid & 63, wave = tid >> 6;
    const int gw = blockIdx.x * NWAVES + wave, NGW = gridDim.x * NWAVES;
    unsigned char* ws = p.ws;
    bf16_t* ldsb = (bf16_t*)lds;
    bf16_t* ycat = (bf16_t*)p.out;

    phase0(p, (float*)lds, gw, NGW, wave, lane);
    grid.sync();
    {
        EpiZ E{(const float*)(ws + WS_RSTD1), (const float2*)(ws + WS_ROPE), (bf16_t*)(ws + WS_UPOOL), (bf16_t*)(ws + WS_QR), (bf16_t*)(ws + WS_KR), (bf16_t*)(ws + WS_VV), (bf16_t*)(ws + WS_QM), (bf16_t*)(ws + WS_GATES)};
        gemm_simple((const bf16_t*)(ws + WS_XB), D, (const bf16_t*)(ws + WS_WIN), D, T, INW, D, E, ldsb, tid);
        EpiRowScaleBf16 E2{(const float*)(ws + WS_RSTDM), (bf16_t*)(ws + WS_KVM), 1024};
        gemm_simple((const bf16_t*)(ws + WS_MEMB), D, (const bf16_t*)(ws + WS_WMKV), D, TMEM, 1024, D, E2, ldsb, tid);
    }
    grid.sync();
    pooled_phase((const bf16_t*)(ws + WS_UPOOL), (bf16_t*)(ws + WS_POOLED));
    for (int it = gw; it < T * 16; it += NGW) swa_item(it, (const bf16_t*)(ws + WS_QR), (const bf16_t*)(ws + WS_KR), (const bf16_t*)(ws + WS_VV), p.sinks, ycat, lane);
    for (int it = gw; it < T * 4; it += NGW) mem_item(it, (const bf16_t*)(ws + WS_QM), (const bf16_t*)(ws + WS_KVM), ycat, lane);
    grid.sync();
    for (int g = 0; g < 4; ++g) {
        EpiPool E{p.pool_scale, ycat, g};
        gemm_simple((const bf16_t*)(ws + WS_POOLED) + g * 128, 512, (const bf16_t*)(ws + WS_WPOOL) + (size_t)g * 128 * 128, 128, T, 128, 128, E, ldsb, tid);
    }
    grid.sync();
    gemm_gated(ycat, (const bf16_t*)(ws + WS_WBR), (const bf16_t*)(ws + WS_GATES), (bf16_t*)(ws + WS_MERGED), ldsb, tid);
    grid.sync();
    {
        EpiOut E{p.x, p.out, (bf16_t*)(ws + WS_X1B)};
        gemm_simple((const bf16_t*)(ws + WS_MERGED), D, (const bf16_t*)(ws + WS_WOUT), D, T, D, D, E, ldsb, tid);
    }
    grid.sync();
    {
        EpiRowScaleBf16 E{nullptr, (bf16_t*)(ws + WS_QP), 2048};
        gemm_simple((const bf16_t*)(ws + WS_X1B), D, (const bf16_t*)(ws + WS_WQ), D, T, 2048, D, E, ldsb, tid);
        float* rstd2 = (float*)(ws + WS_RSTD2);
        for (int m = gw; m < T; m += NGW) {
            const f32x4* xr = (const f32x4*)(p.out + (size_t)m * D) + lane; float s = 0.f;
#pragma unroll
            for (int j = 0; j < 4; ++j) { const f32x4 v = xr[64 * j]; s += (v.x * v.x + v.y * v.y) + (v.z * v.z + v.w * v.w); }
            s = wave_sum(s);
            if (lane == 0) rstd2[m] = 1.f / sqrtf(s * (1.f / D) + EPS);
        }
    }
    grid.sync();
    for (int it = gw; it < T * 8; it += NGW) topk_item(it, (const bf16_t*)(ws + WS_QP), (const bf16_t*)(ws + WS_KEYS), (const float*)(ws + WS_RSTD2), (int*)(ws + WS_IDS), (float*)(ws + WS_GTS), lane);
    grid.sync();
    for (int t = gw; t < T; t += NGW) gather_item(t, p.out, p.norm2_g, p.final_g, (const f16_t*)(ws + WS_U16), (const f16_t*)(ws + WS_V16), (const int*)(ws + WS_IDS), (const float*)(ws + WS_GTS), p.out, lane);
}

extern "C" void kernel_launch(void* const* d_in, const int* in_sizes, int n_in, void* d_out, int out_size, void* d_ws, size_t ws_size, hipStream_t stream) {
    static int grid_blocks = 0;
    if (grid_blocks == 0) {
        if (n_in != 20 || out_size != T * D || ws_size < WS_END) { fprintf(stderr, "kernel_launch: unexpected shapes: n_in %d out %d ws %zu\n", n_in, out_size, ws_size); grid_blocks = -1; return; }
        int dev = 0, cus = 0, per_cu = 0;
        hipGetDevice(&dev);
        hipDeviceGetAttribute(&cus, hipDeviceAttributeMultiprocessorCount, dev);
        hipOccupancyMaxActiveBlocksPerMultiprocessor(&per_cu, (const void*)fwd_kernel, NTHREADS, 0);
        if (per_cu < 1) { fprintf(stderr, "kernel_launch: occupancy query says %d blocks per CU\n", per_cu); grid_blocks = -1; return; }
        grid_blocks = cus * per_cu;
        fprintf(stderr, "kernel_launch: cus %d per_cu %d grid %d ws %zu\n", cus, per_cu, grid_blocks, ws_size);
    }
    if (grid_blocks < 0) return;
    Params p{};
    p.x = (const float*)d_in[0]; p.mem = (const float*)d_in[1]; p.pos = (const int*)d_in[2]; p.norm1_g = (const float*)d_in[3]; p.mem_norm_g = (const float*)d_in[4];
    p.w_in = (const float*)d_in[5]; p.w_pool = (const float*)d_in[6]; p.pool_scale = (const float*)d_in[7]; p.sinks = (const float*)d_in[8]; p.w_mem_kv = (const float*)d_in[9];
    p.w_bpool = (const float*)d_in[10]; p.w_bswa = (const float*)d_in[11]; p.w_bmem = (const float*)d_in[12]; p.w_out = (const float*)d_in[13]; p.norm2_g = (const float*)d_in[14];
    p.w_q = (const float*)d_in[15]; p.sub_keys = (const float*)d_in[16]; p.peer_u = (const float*)d_in[17]; p.peer_v = (const float*)d_in[18]; p.final_g = (const float*)d_in[19];
    p.out = (float*)d_out; p.ws = (unsigned char*)d_ws;
    void* args[] = {&p};
    hipError_t e = hipLaunchCooperativeKernel((const void*)fwd_kernel, dim3(grid_blocks), dim3(NTHREADS), args, 0, stream);
    if (e != hipSuccess) fprintf(stderr, "cooperative launch failed: %s (grid %d)\n", hipGetErrorString(e), grid_blocks);
}
```

```cpp
#include <hip/hip_runtime.h>
#include <hip/hip_cooperative_groups.h>
#include <cstdio>
#include <cstdint>
namespace cg = cooperative_groups;

#define DI __device__ __forceinline__
typedef unsigned short bf16_t;
typedef _Float16 f16_t;
typedef short bf16x8 __attribute__((ext_vector_type(8)));
typedef float f32x4 __attribute__((ext_vector_type(4)));
typedef float f32x16 __attribute__((ext_vector_type(16)));
typedef unsigned u32x4 __attribute__((ext_vector_type(4)));
typedef unsigned u32x2 __attribute__((ext_vector_type(2)));
typedef _Float16 f16x4 __attribute__((ext_vector_type(4)));

constexpr int D = 1024, BATCH = 8, SEQ = 4096, T = BATCH * SEQ, MEML = 256, TMEM = BATCH * MEML;
constexpr int INW = 5376;
constexpr int NTHREADS = 512, NWAVES = 8;
constexpr int NEXP = 16384;
constexpr float EPS = 1e-6f;

constexpr size_t MiB = 1u << 20;
constexpr size_t WS_WIN = 1 * MiB;
constexpr size_t WS_WBR = 12 * MiB;
constexpr size_t WS_WOUT = 16 * MiB;
constexpr size_t WS_WQ = 18 * MiB;
constexpr size_t WS_KEYS = 22 * MiB;
constexpr size_t WS_WPOOL = 22 * MiB + 512 * 1024;
constexpr size_t WS_RSTD1 = 22 * MiB + 768 * 1024;
constexpr size_t WS_RSTD2 = 22 * MiB + 896 * 1024;
constexpr size_t WS_RSTDM = 23 * MiB;
constexpr size_t WS_WMKV = 24 * MiB;
constexpr size_t WS_MEMB = 26 * MiB;
constexpr size_t WS_KVM = 30 * MiB;
constexpr size_t WS_ROPE = 34 * MiB;
constexpr size_t WS_XB = 42 * MiB;
constexpr size_t WS_POOLED = 42 * MiB;
constexpr size_t WS_MERGED = 42 * MiB;
constexpr size_t WS_U16 = 106 * MiB;
constexpr size_t WS_V16 = 138 * MiB;
constexpr size_t WS_UPOOL = 170 * MiB;
constexpr size_t WS_QR = 202 * MiB;
constexpr size_t WS_KR = 266 * MiB;
constexpr size_t WS_VV = 274 * MiB;
constexpr size_t WS_QM = 282 * MiB;
constexpr size_t WS_GATES = 314 * MiB;
constexpr size_t WS_X1B = 170 * MiB;
constexpr size_t WS_QP = 314 * MiB;
constexpr size_t WS_IDS = 442 * MiB;
constexpr size_t WS_GTS = 458 * MiB;
constexpr size_t WS_END = 512 * MiB;

struct Params {
    const float* x; const float* mem; const int* pos; const float* norm1_g; const float* mem_norm_g; const float* w_in; const float* w_pool;
    const float* pool_scale; const float* sinks; const float* w_mem_kv; const float* w_bpool; const float* w_bswa; const float* w_bmem; const float* w_out;
    const float* norm2_g; const float* w_q; const float* sub_keys; const float* peer_u; const float* peer_v; const float* final_g;
    float* out; unsigned char* ws;
};

DI unsigned f2bf(float f) { unsigned u = __builtin_bit_cast(unsigned, f); return (u + 0x7fffu + ((u >> 16) & 1u)) >> 16; }
DI unsigned pk2(float lo, float hi) { return f2bf(lo) | (f2bf(hi) << 16); }
DI float bf2f(bf16_t b) { return __builtin_bit_cast(float, (unsigned)b << 16); }
DI float bflo(unsigned w) { return __builtin_bit_cast(float, w << 16); }
DI float bfhi(unsigned w) { return __builtin_bit_cast(float, w & 0xffff0000u); }
DI float wave_sum(float v) {
#pragma unroll
    for (int o = 1; o < 64; o <<= 1) v += __shfl_xor(v, o);
    return v;
}
DI float wave_max(float v) {
#pragma unroll
    for (int o = 1; o < 64; o <<= 1) v = fmaxf(v, __shfl_xor(v, o));
    return v;
}
DI float gelu_tanh(float x) {
    const float y = 0.7978845608028654f * (x + 0.044715f * x * x * x);
    const float e = __expf(2.f * y);
    const float th = 1.f - 2.f / (e + 1.f);
    return 0.5f * x * (1.f + th);
}
DI float sigmoidf(float x) { return 1.f / (1.f + __expf(-x)); }

DI int zperm(int n) {
    if (n < 512 || n >= 1664) return n;
    const int d = (n - 512) & 63, hb = n - d; return hb + 8 * ((d & 31) >> 2) + (d & 3) + 4 * (d >> 5);
}
template <bool ZPERM>
DI void transpose_item(const float* W, int K, int N, bf16_t* WT, int ldt, int roff, int coff, const float* g, float* scr, int item, int lane) {
    const int nblk = N / 32, kb = item / nblk, nb = item % nblk, k0 = 64 * kb, n0 = 32 * nb;
#pragma unroll 8
    for (int i = 0; i < 32; ++i) { const int kk = 2 * i + (lane >> 5); float v = W[(size_t)(k0 + kk) * N + n0 + (lane & 31)]; if (g) v *= g[k0 + kk]; scr[kk * 33 + (lane & 31)] = v; }
    asm volatile("s_waitcnt lgkmcnt(0)" ::: "memory");
    const int c = lane & 7;
#pragma unroll
    for (int j = 0; j < 4; ++j) { const int n = (lane >> 3) + 8 * j; const float* s = scr + (8 * c) * 33 + n;
        u32x4 o; o.x = pk2(s[0 * 33], s[1 * 33]); o.y = pk2(s[2 * 33], s[3 * 33]); o.z = pk2(s[4 * 33], s[5 * 33]); o.w = pk2(s[6 * 33], s[7 * 33]);
        const int nd = ZPERM ? zperm(n0 + n) : n0 + n;
        *(u32x4*)(WT + (size_t)(roff + nd) * ldt + coff + k0 + 8 * c) = o; }
    asm volatile("s_waitcnt lgkmcnt(0)" ::: "memory");
}

DI void row_to_bf16_rstd(const float* xrow, bf16_t* orow, float* rstd_out, int lane) {
    const f32x4* xr = (const f32x4*)xrow + lane;
    f32x4 v[4]; float s = 0.f;
#pragma unroll
    for (int j = 0; j < 4; ++j) { v[j] = xr[64 * j]; s += (v[j].x * v[j].x + v[j].y * v[j].y) + (v[j].z * v[j].z + v[j].w * v[j].w); }
    s = wave_sum(s);
    if (lane == 0) *rstd_out = 1.f / sqrtf(s * (1.f / D) + EPS);
    u32x2* o8 = (u32x2*)orow + lane;
#pragma unroll
    for (int j = 0; j < 4; ++j) { u32x2 w; w.x = pk2(v[j].x, v[j].y); w.y = pk2(v[j].z, v[j].w); o8[64 * j] = w; }
}

DI void phase0(const Params& p, float* lds_f, int gw, int NGW, int wave, int lane) {
    unsigned char* ws = p.ws;
    float* scr = lds_f + wave * (64 * 33);
    bf16_t* WinT = (bf16_t*)(ws + WS_WIN); bf16_t* WbrT = (bf16_t*)(ws + WS_WBR); bf16_t* WoutT = (bf16_t*)(ws + WS_WOUT); bf16_t* WqT = (bf16_t*)(ws + WS_WQ);
    bf16_t* WmkvT = (bf16_t*)(ws + WS_WMKV);
    constexpr int I_IN = (D / 64) * (INW / 32), I_BS = (1024 / 64) * (D / 32), I_BM = (512 / 64) * (D / 32), I_OUT = (D / 64) * (D / 32), I_Q = (D / 64) * (2048 / 32), I_MKV = (D / 64) * (D / 32);
    constexpr int NITEMS = I_IN + I_BS + I_BM + I_OUT + I_Q + I_MKV;
    for (int it = gw; it < NITEMS; it += NGW) {
        int r = it;
        if (r < I_IN) { transpose_item<true>(p.w_in, D, INW, WinT, D, 0, 0, p.norm1_g, scr, r, lane); continue; } r -= I_IN;
        if (r < I_BS) { transpose_item<false>(p.w_bswa, 1024, D, WbrT, 2048, 0, 512, nullptr, scr, r, lane); continue; } r -= I_BS;
        if (r < I_BM) { transpose_item<false>(p.w_bmem, 512, D, WbrT, 2048, 0, 1536, nullptr, scr, r, lane); continue; } r -= I_BM;
        if (r < I_OUT) { transpose_item<false>(p.w_out, D, D, WoutT, D, 0, 0, nullptr, scr, r, lane); continue; } r -= I_OUT;
        if (r < I_Q) { transpose_item<false>(p.w_q, D, 2048, WqT, D, 0, 0, p.norm2_g, scr, r, lane); continue; } r -= I_Q;
        transpose_item<false>(p.w_mem_kv, D, D, WmkvT, D, 0, 0, p.mem_norm_g, scr, r, lane);
    }
    {
        const size_t gt0 = (size_t)gw * 64 + lane, NGT0 = (size_t)NGW * 64;
        for (size_t i = gt0; i < (size_t)512 * 1024; i += NGT0) {
            const int n = (int)(i & 1023), cp = (int)(i >> 10), g = cp >> 7;
            const float* wp = p.w_pool + (size_t)cp * 128; const float* sc = p.pool_scale + g * 128; const float* wb = p.w_bpool + (size_t)(g * 128) * 1024 + n;
            float a = 0.f;
            for (int d = 0; d < 128; ++d) a += wp[d] * sc[d] * wb[(size_t)d * 1024];
            WbrT[(size_t)n * 2048 + cp] = (bf16_t)f2bf(a);
        }
    }
    bf16_t* xb = (bf16_t*)(ws + WS_XB); float* rstd1 = (float*)(ws + WS_RSTD1);
    for (int m = gw; m < T; m += NGW) row_to_bf16_rstd(p.x + (size_t)m * D, xb + (size_t)m * D, rstd1 + m, lane);
    bf16_t* memb = (bf16_t*)(ws + WS_MEMB); float* rstdm = (float*)(ws + WS_RSTDM);
    for (int m = gw; m < TMEM; m += NGW) row_to_bf16_rstd(p.mem + (size_t)m * D, memb + (size_t)m * D, rstdm + m, lane);
    const size_t gt = (size_t)gw * 64 + lane, NGT = (size_t)NGW * 64;
    bf16_t* keysb = (bf16_t*)(ws + WS_KEYS);
    for (size_t i = gt; i < (size_t)8 * 2 * 128 * 128 / 4; i += NGT) { const f32x4 v = ((const f32x4*)p.sub_keys)[i]; u32x2 w; w.x = pk2(v.x, v.y); w.y = pk2(v.z, v.w); ((u32x2*)keysb)[i] = w; }
    f16_t* u16 = (f16_t*)(ws + WS_U16); f16_t* v16 = (f16_t*)(ws + WS_V16);
    for (size_t i = gt; i < (size_t)NEXP * D / 4; i += NGT) {
        const f32x4 a = ((const f32x4*)p.peer_u)[i]; const f32x4 b = ((const f32x4*)p.peer_v)[i];
        f16x4 ha = {(f16_t)a.x, (f16_t)a.y, (f16_t)a.z, (f16_t)a.w}; f16x4 hb = {(f16_t)b.x, (f16_t)b.y, (f16_t)b.z, (f16_t)b.w};
        ((f16x4*)u16)[i] = ha; ((f16x4*)v16)[i] = hb;
    }
    float2* rope = (float2*)(ws + WS_ROPE);
    for (size_t i = gt; i < (size_t)T * 32; i += NGT) {
        const int t = (int)(i >> 5), d = (int)(i & 31);
        const float inv = exp2f(-(float)d * (13.287712379549449f / 32.f));
        const float ang = (float)p.pos[t] * inv;
        const double rev = (double)ang * 0.15915494309189535;
        const float fr = (float)(rev - floor(rev));
        rope[i] = make_float2(__builtin_amdgcn_cosf(fr), __builtin_amdgcn_sinf(fr));
    }
}

namespace pg8 {
#define PG8_LAS __attribute__((address_space(3)))
constexpr int BM = 256, BK = 64, HALF = 128, HTB = HALF * BK * 2, STAGE_BYTES = 8 * HTB, NXCD = 8, WGM = 8;
__host__ __device__ __forceinline__ int lds_byte(int r, int c) { const int st = (r >> 4) * 2 + (c >> 5), rr = r & 15, cc = c & 31, ob = rr * 64 + cc * 2; return st * 1024 + (ob ^ (((ob >> 9) & 1) << 5)); }
__host__ __device__ __forceinline__ void stage_rc(int b, int& R, int& C) { const int st = b / 1024, sb = b % 1024, swz = sb ^ (((sb >> 9) & 1) << 5); R = (st >> 1) * 16 + swz / 64; C = (st & 1) * 32 + (swz % 64) / 2; }
__host__ __device__ __forceinline__ int perm32(int rho) { const int n = rho >> 4, i = rho & 15; return 8 * (i >> 2) + 4 * n + (i & 3); }

struct Unit { const char* a; const char* b; int nt, pm, pn, tag; };
DI void tile_of(int L, int nM, int nN, int& pm, int& pn) {
    const int nwg = nM * nN; int wgid = L; { const int q = nwg / NXCD, r = nwg % NXCD, xcd = wgid % NXCD, off = wgid / NXCD; wgid = (xcd < r ? xcd * (q + 1) : r * (q + 1) + (xcd - r) * q) + off; }
    const int nig = WGM * nN, gid = wgid / nig, fm = gid * WGM, gsz = (nM - fm) < WGM ? (nM - fm) : WGM;
    pm = fm + ((wgid % nig) % gsz); pn = (wgid % nig) / gsz;
}
template <class Epi, class Sched>
DI void gemm_phase(PG8_LAS unsigned char* lds, int lda, int ldb, const Sched& S, const Epi& E) {
    int tid = threadIdx.x; asm volatile("" : "+v"(tid));
    const int wid = __builtin_amdgcn_readfirstlane(tid >> 6), wr = wid >> 2, wc = wid & 3, lane = tid & 63, fr = lane & 15, fq = lane >> 4;
    unsigned voffA[2], voffB[2];
#pragma unroll
    for (int i = 0; i < 2; ++i) { int R, C; stage_rc(tid * 16 + i * 8192, R, C); const int Rb = (R & ~31) + perm32(R & 31);
        voffA[i] = (unsigned)(R * lda + C) * 2u; voffB[i] = (unsigned)(Rb * ldb + C) * 2u; }
    const size_t kstep = (size_t)(BK * 2);
    const size_t hstepA = (size_t)HALF * lda * 2, hstepB = (size_t)HALF * ldb * 2;
    const unsigned ldsw = (unsigned)wid * 1024u;
    const int aoff = lds_byte(wr * 64 + fr, fq * 8), boff = lds_byte(wc * 32 + fr, fq * 8);
#define PG8_SA(b, h) (((b) * 2 + (h)) * HTB)
#define PG8_SB(b, h) ((4 + (b) * 2 + (h)) * HTB)
#define PG8_STAGE(bufoff, gbase, voff) do { _Pragma("unroll") for (int _i = 0; _i < 2; ++_i) \
        __builtin_amdgcn_global_load_lds((const unsigned*)((const char*)(gbase) + (voff)[_i]), (PG8_LAS unsigned*)(lds + (bufoff) + ldsw + _i * 8192), 16, 0, 0); } while (0)
#define PG8_LDA(dst, b, h) do { _Pragma("unroll") for (int m = 0; m < 4; ++m) _Pragma("unroll") for (int k = 0; k < 2; ++k) dst[m][k] = *(const PG8_LAS bf16x8*)(lds + PG8_SA(b, h) + aoff + m * 2048 + k * 1024); } while (0)
#define PG8_LDB(dst, b, h) do { _Pragma("unroll") for (int n = 0; n < 2; ++n) _Pragma("unroll") for (int k = 0; k < 2; ++k) dst[n][k] = *(const PG8_LAS bf16x8*)(lds + PG8_SB(b, h) + boff + n * 2048 + k * 1024); } while (0)
#define PG8_MMA(ai, bj, At, Bt) do { __builtin_amdgcn_s_setprio(1); _Pragma("unroll") for (int m = 0; m < 4; ++m) _Pragma("unroll") for (int n = 0; n < 2; ++n) _Pragma("unroll") for (int k = 0; k < 2; ++k) \
        acc[ai][bj][m][n] = __builtin_amdgcn_mfma_f32_16x16x32_bf16(Bt[n][k], At[m][k], acc[ai][bj][m][n], 0, 0, 0); __builtin_amdgcn_s_setprio(0); } while (0)
#define PG8_WAIT_V(n) asm volatile("s_waitcnt vmcnt(" #n ")" ::: "memory")
#define PG8_WAIT_L(n) asm volatile("s_waitcnt lgkmcnt(" #n ")" ::: "memory")
#define PG8_BAR __builtin_amdgcn_s_barrier()
#define PG8_SCHED __builtin_amdgcn_sched_barrier(0)
    Unit cur, nxt; int ui = 0;
    if (!S.next(0, cur)) return;
    f32x4 acc[2][2][4][2];
#pragma unroll
    for (int a = 0; a < 2; ++a)
#pragma unroll
        for (int b = 0; b < 2; ++b)
#pragma unroll
            for (int m = 0; m < 4; ++m)
#pragma unroll
                for (int n = 0; n < 2; ++n) acc[a][b][m][n] = (f32x4){0.f, 0.f, 0.f, 0.f};
    bf16x8 At[4][2], B0[2][2], B1[2][2];
    const char* cA = cur.a; const char* cB = cur.b;
    PG8_STAGE(PG8_SB(0, 0), cB, voffB); PG8_STAGE(PG8_SB(0, 1), cB + hstepB, voffB); PG8_STAGE(PG8_SA(0, 0), cA, voffA); PG8_STAGE(PG8_SA(0, 1), cA + hstepA, voffA);
    if (wr == 1) PG8_BAR;
    PG8_WAIT_V(2); PG8_BAR;
    PG8_STAGE(PG8_SB(1, 0), cB + kstep, voffB); PG8_STAGE(PG8_SA(1, 0), cA + kstep, voffA); PG8_STAGE(PG8_SB(1, 1), cB + hstepB + kstep, voffB);
    PG8_WAIT_V(6); PG8_BAR;
    for (;;) {
        const bool has_next = S.next(ui + 1, nxt);
        const char* nA = has_next ? nxt.a : cA; const char* nB = has_next ? nxt.b : cB;
        const int nt = cur.nt;
        for (int t = 0; t < nt; t += 2) {
            const bool last = (t == nt - 2);
            const char* a1 = cA + (size_t)(t + 1) * kstep;
            const char* a2 = last ? nA : cA + (size_t)(t + 2) * kstep; const char* b2 = last ? nB : cB + (size_t)(t + 2) * kstep;
            const char* a3 = a2 + kstep; const char* b3 = b2 + kstep;
            PG8_LDB(B0, 0, 0); PG8_LDB(B1, 0, 1); PG8_SCHED; PG8_LDA(At, 0, 0); PG8_STAGE(PG8_SA(1, 1), a1 + hstepA, voffA);
            PG8_WAIT_V(8); PG8_WAIT_L(0); PG8_BAR; PG8_MMA(0, 0, At, B0); PG8_MMA(0, 1, At, B1); PG8_BAR; PG8_SCHED;
            PG8_LDA(At, 0, 1); PG8_STAGE(PG8_SB(0, 0), b2, voffB); PG8_STAGE(PG8_SB(0, 1), b2 + hstepB, voffB); PG8_STAGE(PG8_SA(0, 0), a2, voffA);
            PG8_WAIT_V(8); PG8_WAIT_L(0); PG8_BAR; PG8_MMA(1, 0, At, B0); PG8_MMA(1, 1, At, B1); PG8_BAR; PG8_SCHED;
            PG8_LDB(B0, 1, 0); PG8_LDB(B1, 1, 1); PG8_SCHED; PG8_LDA(At, 1, 0); PG8_STAGE(PG8_SA(0, 1), a2 + hstepA, voffA);
            PG8_WAIT_V(8); PG8_WAIT_L(0); PG8_BAR; PG8_MMA(0, 0, At, B0); PG8_MMA(0, 1, At, B1); PG8_BAR; PG8_SCHED;
            PG8_LDA(At, 1, 1); PG8_STAGE(PG8_SB(1, 0), b3, voffB); PG8_STAGE(PG8_SB(1, 1), b3 + hstepB, voffB); PG8_STAGE(PG8_SA(1, 0), a3, voffA);
            PG8_WAIT_V(8); PG8_WAIT_L(0); PG8_BAR; PG8_MMA(1, 0, At, B0); PG8_MMA(1, 1, At, B1); PG8_BAR; PG8_SCHED;
        }
        if (wr == 0) PG8_BAR;
        E(acc, cur, wr, wc, fr, fq);
        if (!has_next) break;
#pragma unroll
        for (int a = 0; a < 2; ++a)
#pragma unroll
            for (int b = 0; b < 2; ++b)
#pragma unroll
                for (int m = 0; m < 4; ++m)
#pragma unroll
                    for (int n = 0; n < 2; ++n) acc[a][b][m][n] = (f32x4){0.f, 0.f, 0.f, 0.f};
        cur = nxt; cA = nA; cB = nB; ++ui;
        if (wr == 1) PG8_BAR;
    }
    PG8_WAIT_V(0);
    PG8_BAR;
#undef PG8_SA
#undef PG8_SB
#undef PG8_STAGE
#undef PG8_LDA
#undef PG8_LDB
#undef PG8_MMA
#undef PG8_WAIT_V
#undef PG8_WAIT_L
#undef PG8_BAR
#undef PG8_SCHED
}
}
typedef f32x4 acc_t[2][2][4][2];

struct SchedPlain {
    const char* A; const char* Bt; int lda, ldb, nM, nN, nt, G, c;
    DI bool next(int i, pg8::Unit& u) const {
        const long L = (long)i * G + c; if (L >= (long)nM * nN) return false;
        pg8::tile_of((int)L, nM, nN, u.pm, u.pn); u.a = A + (size_t)u.pm * 256 * lda * 2; u.b = Bt + (size_t)u.pn * 256 * ldb * 2; u.nt = nt; u.tag = 0; return true;
    }
};
struct SchedZ {
    const char *xb, *win, *memb, *wmkv; int G, c;
    DI bool next(int i, pg8::Unit& u) const {
        const long L = (long)i * G + c; constexpr int NZ = 128 * 21;
        if (L < NZ) { pg8::tile_of((int)L, 128, 21, u.pm, u.pn); u.a = xb + (size_t)u.pm * 256 * 2048; u.b = win + (size_t)u.pn * 256 * 2048; u.nt = 16; u.tag = 0; return true; }
        const int j = (int)(L - NZ); if (j >= 32) return false;
        u.pm = j >> 2; u.pn = j & 3; u.a = memb + (size_t)u.pm * 256 * 2048; u.b = wmkv + (size_t)u.pn * 256 * 2048; u.nt = 16; u.tag = 1; return true;
    }
};
struct SchedGated {
    const char *ycat, *wbr; int G, c;
    DI bool next(int i, pg8::Unit& u) const {
        const int j = i / 3, b = i - 3 * j; const long L = (long)j * G + c; if (L >= 128 * 4) return false;
        pg8::tile_of((int)L, 128, 4, u.pm, u.pn);
        const int koff = (b == 0) ? 0 : (b == 1 ? 512 : 1536);
        u.a = ycat + ((size_t)u.pm * 256 * 2048 + koff) * 2; u.b = wbr + ((size_t)u.pn * 256 * 2048 + koff) * 2; u.nt = (b == 1) ? 16 : 8; u.tag = b; return true;
    }
};

DI u32x4 pack8(const f32x4& a, const f32x4& b) { u32x4 w; w.x = pk2(a[0], a[1]); w.y = pk2(a[2], a[3]); w.z = pk2(b[0], b[1]); w.w = pk2(b[2], b[3]); return w; }
struct EpiZ {
    const float* rstd1; const float* rstdm; const float2* rope; bf16_t *upool, *qr, *kr, *vv, *qm, *gates, *kvm;
    DI void operator()(const acc_t& acc, const pg8::Unit& u, int wr, int wc, int fr_, int fq_) const {
        int l_ = threadIdx.x; asm volatile("" : "+v"(l_)); const int fr = l_ & 15, fq = (l_ >> 4) & 3;
        const int row0 = u.pm * 256 + wr * 64 + fr;
        if (u.tag == 1) {
#pragma unroll
            for (int ai = 0; ai < 2; ++ai)
#pragma unroll
                for (int m = 0; m < 4; ++m) { const int row = row0 + ai * 128 + m * 16; const float rs = rstdm[row];
#pragma unroll
                    for (int bj = 0; bj < 2; ++bj) { const int c = u.pn * 256 + bj * 128 + wc * 32 + 8 * fq;
                        *(u32x4*)(kvm + (size_t)row * 1024 + c) = pack8(acc[ai][bj][m][0] * rs, acc[ai][bj][m][1] * rs); } }
            return;
        }
#pragma unroll
        for (int bj = 0; bj < 2; ++bj) {
            const int cb = u.pn * 256 + bj * 128;
            const int c = cb + wc * 32 + 8 * fq;
#pragma unroll
            for (int ai = 0; ai < 2; ++ai)
#pragma unroll
                for (int m = 0; m < 4; ++m) {
                    const int row = row0 + ai * 128 + m * 16; const float rs = rstd1[row];
                    const f32x4 v0 = acc[ai][bj][m][0] * rs, v1 = acc[ai][bj][m][1] * rs;
                    if (cb < 512) { *(u32x4*)(upool + (size_t)row * 512 + c) = pack8(v0, v1); }
                    else if (cb < 1664) {
                        const bool isq = cb < 1536; const int rel = isq ? c - 512 : c - 1536; const int hrel = rel & 63, d0 = hrel >> 1, hb = rel - hrel;
                        const f32x4 cs0 = *(const f32x4*)(rope + (size_t)row * 32 + d0), cs1 = *(const f32x4*)(rope + (size_t)row * 32 + d0 + 2);
                        const float sc = isq ? 0.125f : 1.f;
                        f32x4 o1, o2;
                        o1[0] = (v0[0] * cs0[0] - v1[0] * cs0[1]) * sc; o2[0] = (v1[0] * cs0[0] + v0[0] * cs0[1]) * sc;
                        o1[1] = (v0[1] * cs0[2] - v1[1] * cs0[3]) * sc; o2[1] = (v1[1] * cs0[2] + v0[1] * cs0[3]) * sc;
                        o1[2] = (v0[2] * cs1[0] - v1[2] * cs1[1]) * sc; o2[2] = (v1[2] * cs1[0] + v0[2] * cs1[1]) * sc;
                        o1[3] = (v0[3] * cs1[2] - v1[3] * cs1[3]) * sc; o2[3] = (v1[3] * cs1[2] + v0[3] * cs1[3]) * sc;
                        bf16_t* dst = isq ? qr + (size_t)row * 1024 + hb + d0 : kr + (size_t)row * 128 + hb + d0;
                        u32x2 w1, w2; w1.x = pk2(o1[0], o1[1]); w1.y = pk2(o1[2], o1[3]); w2.x = pk2(o2[0], o2[1]); w2.y = pk2(o2[2], o2[3]);
                        *(u32x2*)dst = w1; *(u32x2*)(dst + 32) = w2;
                    }
                    else if (cb < 1792) { *(u32x4*)(vv + (size_t)row * 128 + (c - 1664)) = pack8(v0, v1); }
                    else if (cb < 2304) { *(u32x4*)(qm + (size_t)row * 512 + (c - 1792)) = pack8(v0, v1); }
                    else { f32x4 s0, s1;
#pragma unroll
                        for (int e = 0; e < 4; ++e) { s0[e] = sigmoidf(v0[e]); s1[e] = sigmoidf(v1[e]); }
                        *(u32x4*)(gates + (size_t)row * 3072 + (c - 2304)) = pack8(s0, s1); }
                }
        }
    }
};
struct EpiGated {
    const bf16_t* gates; bf16_t* merged;
    DI void operator()(const acc_t& acc, const pg8::Unit& u, int wr, int wc, int fr_, int fq_) const {
        int l_ = threadIdx.x; asm volatile("" : "+v"(l_)); const int fr = l_ & 15, fq = (l_ >> 4) & 3;
        const int row0 = u.pm * 256 + wr * 64 + fr, b = u.tag;
#pragma unroll
        for (int ai = 0; ai < 2; ++ai)
#pragma unroll
            for (int m = 0; m < 4; ++m) { const int row = row0 + ai * 128 + m * 16;
#pragma unroll
                for (int bj = 0; bj < 2; ++bj) { const int c = u.pn * 256 + bj * 128 + wc * 32 + 8 * fq;
                    const u32x4 g = *(const u32x4*)(gates + (size_t)row * 3072 + b * 1024 + c);
                    bf16_t* mp = merged + (size_t)row * 1024 + c;
                    u32x4 old = (u32x4){0u, 0u, 0u, 0u}; if (b > 0) old = *(const u32x4*)mp;
                    const f32x4 a0 = acc[ai][bj][m][0], a1 = acc[ai][bj][m][1];
                    f32x4 r0, r1;
                    r0[0] = bflo(old.x) + bflo(g.x) * a0[0]; r0[1] = bfhi(old.x) + bfhi(g.x) * a0[1]; r0[2] = bflo(old.y) + bflo(g.y) * a0[2]; r0[3] = bfhi(old.y) + bfhi(g.y) * a0[3];
                    r1[0] = bflo(old.z) + bflo(g.z) * a1[0]; r1[1] = bfhi(old.z) + bfhi(g.z) * a1[1]; r1[2] = bflo(old.w) + bflo(g.w) * a1[2]; r1[3] = bfhi(old.w) + bfhi(g.w) * a1[3];
                    *(u32x4*)mp = pack8(r0, r1); } }
    }
};
struct EpiOut {
    const float* x; float* x1; bf16_t* x1b;
    DI void operator()(const acc_t& acc, const pg8::Unit& u, int wr, int wc, int fr_, int fq_) const {
        int l_ = threadIdx.x; asm volatile("" : "+v"(l_)); const int fr = l_ & 15, fq = (l_ >> 4) & 3;
        const int row0 = u.pm * 256 + wr * 64 + fr;
#pragma unroll
        for (int ai = 0; ai < 2; ++ai)
#pragma unroll
            for (int m = 0; m < 4; ++m) { const int row = row0 + ai * 128 + m * 16;
#pragma unroll
                for (int bj = 0; bj < 2; ++bj) { const size_t o = (size_t)row * D + u.pn * 256 + bj * 128 + wc * 32 + 8 * fq;
                    const f32x4 v0 = *(const f32x4*)(x + o) + acc[ai][bj][m][0], v1 = *(const f32x4*)(x + o + 4) + acc[ai][bj][m][1];
                    *(f32x4*)(x1 + o) = v0; *(f32x4*)(x1 + o + 4) = v1; *(u32x4*)(x1b + o) = pack8(v0, v1); } }
    }
};
struct EpiBf16 {
    bf16_t* O; int ldo;
    DI void operator()(const acc_t& acc, const pg8::Unit& u, int wr, int wc, int fr_, int fq_) const {
        int l_ = threadIdx.x; asm volatile("" : "+v"(l_)); const int fr = l_ & 15, fq = (l_ >> 4) & 3;
        const int row0 = u.pm * 256 + wr * 64 + fr;
#pragma unroll
        for (int ai = 0; ai < 2; ++ai)
#pragma unroll
            for (int m = 0; m < 4; ++m) { const int row = row0 + ai * 128 + m * 16;
#pragma unroll
                for (int bj = 0; bj < 2; ++bj) { const size_t o = (size_t)row * ldo + u.pn * 256 + bj * 128 + wc * 32 + 8 * fq;
                    *(u32x4*)(O + o) = pack8(acc[ai][bj][m][0], acc[ai][bj][m][1]); } }
    }
};

DI void pooled_phase(const bf16_t* upool, bf16_t* pooled) {
    const size_t gt = (size_t)blockIdx.x * NTHREADS + threadIdx.x, NGT = (size_t)gridDim.x * NTHREADS;
    for (size_t i = gt; i < (size_t)T * 512; i += NGT) {
        const int t = (int)(i >> 9), c = (int)(i & 511), g = c >> 7, w = 2 << g, s = t & (SEQ - 1);
        const int cnt = (s + 1 < w) ? s + 1 : w;
        float sum = 0.f;
        for (int j = 0; j < cnt; ++j) sum += bf2f(upool[(size_t)(t - j) * 512 + c]);
        const float u = bf2f(upool[i]);
        pooled[(size_t)t * 2048 + c] = (bf16_t)f2bf(sum / (float)cnt - u);
    }
}
typedef __bf16 bf16x2_t __attribute__((ext_vector_type(2)));
typedef float f32x2_t __attribute__((ext_vector_type(2)));
DI unsigned cvtpk(float lo, float hi) { f32x2_t v = {lo, hi}; bf16x2_t b = __builtin_convertvector(v, bf16x2_t); return __builtin_bit_cast(unsigned, b); }
DI int crow(int i, int h) { return (i & 3) + 8 * (i >> 2) + 4 * h; }
#define MFMA32(a, b, c) __builtin_amdgcn_mfma_f32_32x32x16_bf16((a), (b), (c), 0, 0, 0)
DI bf16x8 mk8(unsigned a, unsigned b, unsigned c, unsigned d) { u32x4 w = {a, b, c, d}; return __builtin_bit_cast(bf16x8, w); }

constexpr int SWA_KLD = 72, SWA_VLD = 260, SWA_VT_OFF = 256 * SWA_KLD * 2;
DI void swa_phase(const bf16_t* qr, const bf16_t* kr, const bf16_t* vv, const float* sinks, bf16_t* ycat, unsigned char* lds, int tid) {
    const int lane = tid & 63, w = tid >> 6, r = lane & 31, h = lane >> 5;
    bf16_t* Ks = (bf16_t*)lds; bf16_t* Vt = (bf16_t*)(lds + SWA_VT_OFF);
    for (int unit = blockIdx.x; unit < 512; unit += gridDim.x) {
        const int kvh = unit & 1, nb = (unit >> 1) & 31, b = unit >> 6;
        const int tq0 = b * SEQ + nb * 128, tk0 = tq0 - 128;
        __syncthreads();
#pragma unroll
        for (int i = 0; i < 4; ++i) {
            const int c = tid + 512 * i, kb = c >> 3, dc = (c & 7) * 8;
            u32x4 kv = {0u, 0u, 0u, 0u}, vx = {0u, 0u, 0u, 0u};
            if (nb > 0 || kb >= 128) { kv = *(const u32x4*)(kr + (size_t)(tk0 + kb) * 128 + kvh * 64 + dc); vx = *(const u32x4*)(vv + (size_t)(tk0 + kb) * 128 + kvh * 64 + dc); }
            *(u32x4*)(Ks + kb * SWA_KLD + dc) = kv;
            bf16_t* vp = Vt + dc * SWA_VLD + kb;
            vp[0 * SWA_VLD] = (bf16_t)(vx.x & 0xffffu); vp[1 * SWA_VLD] = (bf16_t)(vx.x >> 16); vp[2 * SWA_VLD] = (bf16_t)(vx.y & 0xffffu); vp[3 * SWA_VLD] = (bf16_t)(vx.y >> 16);
            vp[4 * SWA_VLD] = (bf16_t)(vx.z & 0xffffu); vp[5 * SWA_VLD] = (bf16_t)(vx.z >> 16); vp[6 * SWA_VLD] = (bf16_t)(vx.w & 0xffffu); vp[7 * SWA_VLD] = (bf16_t)(vx.w >> 16);
        }
        __syncthreads();
        const int hq = kvh * 8 + w; const float sink = sinks[hq];
        for (int qt = 0; qt < 4; ++qt) {
            const bf16_t* qp = qr + (size_t)(tq0 + 32 * qt + r) * 1024 + hq * 64 + 8 * h;
            bf16x8 qf[4];
#pragma unroll
            for (int s = 0; s < 4; ++s) qf[s] = *(const bf16x8*)(qp + 16 * s);
            f32x16 sa[5];
#pragma unroll
            for (int c = 0; c < 5; ++c) {
#pragma unroll
                for (int i = 0; i < 16; ++i) sa[c][i] = 0.f;
#pragma unroll
                for (int s = 0; s < 4; ++s) { const bf16x8 kf = *(const bf16x8*)(Ks + (32 * (qt + c) + r) * SWA_KLD + 16 * s + 8 * h); sa[c] = MFMA32(kf, qf[s], sa[c]); }
            }
            float mx = sink;
#pragma unroll
            for (int c = 0; c < 5; ++c)
#pragma unroll
                for (int i = 0; i < 16; ++i) {
                    const int kk = 32 * c + crow(i, h);
                    bool vis = (c == 0) ? (kk > r) : ((c == 4) ? (kk - 128 <= r) : true);
                    if (nb == 0) vis = vis && (32 * qt + kk >= 128);
                    const float s = vis ? sa[c][i] : -1e30f; sa[c][i] = s; mx = fmaxf(mx, s);
                }
            mx = fmaxf(mx, __shfl_xor(mx, 32));
            float l = 0.f;
#pragma unroll
            for (int c = 0; c < 5; ++c)
#pragma unroll
                for (int i = 0; i < 16; ++i) { const float pz = __expf(sa[c][i] - mx); sa[c][i] = pz; l += pz; }
            l += __shfl_xor(l, 32); l += __expf(sink - mx);
            const float inv = 1.f / l;
            f32x16 oa[2];
#pragma unroll
            for (int i = 0; i < 16; ++i) { oa[0][i] = 0.f; oa[1][i] = 0.f; }
#pragma unroll
            for (int c = 0; c < 5; ++c)
#pragma unroll
                for (int s2 = 0; s2 < 2; ++s2) {
                    const bf16x8 pf = mk8(cvtpk(sa[c][8 * s2 + 0], sa[c][8 * s2 + 1]), cvtpk(sa[c][8 * s2 + 2], sa[c][8 * s2 + 3]), cvtpk(sa[c][8 * s2 + 4], sa[c][8 * s2 + 5]), cvtpk(sa[c][8 * s2 + 6], sa[c][8 * s2 + 7]));
#pragma unroll
                    for (int dt = 0; dt < 2; ++dt) {
                        const bf16_t* va = Vt + (32 * dt + r) * SWA_VLD + 32 * (qt + c) + 16 * s2 + 4 * h;
                        const u32x2 lo = *(const u32x2*)va, hi = *(const u32x2*)(va + 8);
                        oa[dt] = MFMA32(mk8(lo.x, lo.y, hi.x, hi.y), pf, oa[dt]);
                    }
                }
            bf16_t* yp = ycat + (size_t)(tq0 + 32 * qt + r) * 2048 + 512 + hq * 64 + 4 * h;
#pragma unroll
            for (int dt = 0; dt < 2; ++dt)
#pragma unroll
                for (int g4 = 0; g4 < 4; ++g4) { u32x2 o; o.x = cvtpk(oa[dt][4 * g4] * inv, oa[dt][4 * g4 + 1] * inv); o.y = cvtpk(oa[dt][4 * g4 + 2] * inv, oa[dt][4 * g4 + 3] * inv);
                    *(u32x2*)(yp + 32 * dt + 8 * g4) = o; }
        }
    }
}

constexpr int MEM_KLD = 136, MEM_VLD = 260, MEM_VT_OFF = 256 * MEM_KLD * 2;
DI void mem_phase(const bf16_t* qm, const bf16_t* kvm, bf16_t* ycat, unsigned char* lds, int tid) {
    const int lane = tid & 63, w = tid >> 6, r = lane & 31, h = lane >> 5;
    bf16_t* Ks = (bf16_t*)lds; bf16_t* Vt = (bf16_t*)(lds + MEM_VT_OFF);
    for (int unit = blockIdx.x; unit < 256; unit += gridDim.x) {
        const int qc = unit & 7, hm = (unit >> 3) & 3, b = unit >> 5;
        __syncthreads();
#pragma unroll
        for (int i = 0; i < 8; ++i) {
            const int c = tid + 512 * i, m = c >> 4, dc = (c & 15) * 8;
            const bf16_t* src = kvm + (size_t)(b * MEML + m) * 1024 + hm * 128 + dc;
            const u32x4 kv = *(const u32x4*)src, vx = *(const u32x4*)(src + 512);
            *(u32x4*)(Ks + m * MEM_KLD + dc) = kv;
            bf16_t* vp = Vt + dc * MEM_VLD + m;
            vp[0 * MEM_VLD] = (bf16_t)(vx.x & 0xffffu); vp[1 * MEM_VLD] = (bf16_t)(vx.x >> 16); vp[2 * MEM_VLD] = (bf16_t)(vx.y & 0xffffu); vp[3 * MEM_VLD] = (bf16_t)(vx.y >> 16);
            vp[4 * MEM_VLD] = (bf16_t)(vx.z & 0xffffu); vp[5 * MEM_VLD] = (bf16_t)(vx.z >> 16); vp[6 * MEM_VLD] = (bf16_t)(vx.w & 0xffffu); vp[7 * MEM_VLD] = (bf16_t)(vx.w >> 16);
        }
        __syncthreads();
        for (int qi = 0; qi < 2; ++qi) {
            const int t0 = b * SEQ + qc * 512 + (w * 2 + qi) * 32;
            const bf16_t* qp = qm + (size_t)(t0 + r) * 512 + hm * 128 + 8 * h;
            bf16x8 qf[8];
#pragma unroll
            for (int s = 0; s < 8; ++s) qf[s] = *(const bf16x8*)(qp + 16 * s);
            float mx = -3e38f;
#pragma unroll 1
            for (int c = 0; c < 8; ++c) {
                f32x16 sc;
#pragma unroll
                for (int i = 0; i < 16; ++i) sc[i] = 0.f;
#pragma unroll
                for (int s = 0; s < 8; ++s) { const bf16x8 kf = *(const bf16x8*)(Ks + (32 * c + r) * MEM_KLD + 16 * s + 8 * h); sc = MFMA32(kf, qf[s], sc); }
#pragma unroll
                for (int i = 0; i < 16; ++i) mx = fmaxf(mx, sc[i]);
            }
            mx = fmaxf(mx, __shfl_xor(mx, 32));
            constexpr float SC = 0.08838834764831845f * 1.4426950408889634f;
            float l = 0.f;
            f32x16 oa[4];
#pragma unroll
            for (int dt = 0; dt < 4; ++dt)
#pragma unroll
                for (int i = 0; i < 16; ++i) oa[dt][i] = 0.f;
#pragma unroll 1
            for (int c = 0; c < 8; ++c) {
                f32x16 sc;
#pragma unroll
                for (int i = 0; i < 16; ++i) sc[i] = 0.f;
#pragma unroll
                for (int s = 0; s < 8; ++s) { const bf16x8 kf = *(const bf16x8*)(Ks + (32 * c + r) * MEM_KLD + 16 * s + 8 * h); sc = MFMA32(kf, qf[s], sc); }
#pragma unroll
                for (int i = 0; i < 16; ++i) { const float pz = exp2f((sc[i] - mx) * SC); sc[i] = pz; l += pz; }
#pragma unroll
                for (int s2 = 0; s2 < 2; ++s2) {
                    const bf16x8 pf = mk8(cvtpk(sc[8 * s2 + 0], sc[8 * s2 + 1]), cvtpk(sc[8 * s2 + 2], sc[8 * s2 + 3]), cvtpk(sc[8 * s2 + 4], sc[8 * s2 + 5]), cvtpk(sc[8 * s2 + 6], sc[8 * s2 + 7]));
#pragma unroll
                    for (int dt = 0; dt < 4; ++dt) {
                        const bf16_t* va = Vt + (32 * dt + r) * MEM_VLD + 32 * c + 16 * s2 + 4 * h;
                        const u32x2 lo = *(const u32x2*)va, hi = *(const u32x2*)(va + 8);
                        oa[dt] = MFMA32(mk8(lo.x, lo.y, hi.x, hi.y), pf, oa[dt]);
                    }
                }
            }
            l += __shfl_xor(l, 32);
            const float inv = 1.f / l;
            bf16_t* yp = ycat + (size_t)(t0 + r) * 2048 + 1536 + hm * 128 + 4 * h;
#pragma unroll
            for (int dt = 0; dt < 4; ++dt)
#pragma unroll
                for (int g4 = 0; g4 < 4; ++g4) { u32x2 o; o.x = cvtpk(oa[dt][4 * g4] * inv, oa[dt][4 * g4 + 1] * inv); o.y = cvtpk(oa[dt][4 * g4 + 2] * inv, oa[dt][4 * g4 + 3] * inv);
                    *(u32x2*)(yp + 32 * dt + 8 * g4) = o; }
        }
    }
}

DI unsigned umax_(unsigned a, unsigned b) { return a > b ? a : b; }
DI unsigned umin_(unsigned a, unsigned b) { return a < b ? a : b; }
DI void cexd(unsigned& a, unsigned& b) { const unsigned mx = umax_(a, b), mn = umin_(a, b); a = mx; b = mn; }
DI void sort16_desc(unsigned (&v)[16]) {
#pragma unroll
    for (int k = 2; k <= 16; k <<= 1)
#pragma unroll
        for (int j = k >> 1; j > 0; j >>= 1)
#pragma unroll
            for (int i = 0; i < 16; ++i) { const int l = i ^ j; if (l > i) { if ((i & k) == 0) cexd(v[i], v[l]); else cexd(v[l], v[i]); } }
}
DI void merge16_desc(unsigned (&a)[16], const unsigned (&b)[16]) {
#pragma unroll
    for (int i = 0; i < 16; ++i) a[i] = umax_(a[i], b[15 - i]);
#pragma unroll
    for (int j = 8; j > 0; j >>= 1)
#pragma unroll
        for (int i = 0; i < 16; ++i) { const int l = i ^ j; if (l > i) cexd(a[i], a[l]); }
}
DI unsigned mono(float f) { const unsigned u = __builtin_bit_cast(unsigned, f); return u ^ ((unsigned)((int)u >> 31) | 0x80000000u); }
DI float demono(unsigned m) { const unsigned t = (unsigned)((int)m >> 31); return __builtin_bit_cast(float, m ^ (~t | 0x80000000u)); }
constexpr int TK_KLD = 136, TK_SCR_OFF = 2 * 128 * TK_KLD * 2;
DI void topk_phase(const bf16_t* qp, const bf16_t* keysb, const float* rstd2, int* ids, float* gts, unsigned char* lds, int tid) {
    const int lane = tid & 63, w = tid >> 6, r = lane & 31, h2 = lane >> 5;
    bf16_t* Kl = (bf16_t*)lds;
    unsigned char* scr = lds + TK_SCR_OFF + w * 2048 + lane * 32;
    int staged = -1;
    for (int unit = blockIdx.x; unit < 1024; unit += gridDim.x) {
        const int hd = unit & 7, tile = unit >> 3;
        if (hd != staged) {
            __syncthreads();
#pragma unroll
            for (int i = 0; i < 8; ++i) { const int c = tid + 512 * i, row = c >> 4, dc = (c & 15) * 8;
                *(u32x4*)(Kl + row * TK_KLD + dc) = *(const u32x4*)(keysb + ((size_t)hd * 256 + row) * 128 + dc); }
            __syncthreads();
            staged = hd;
        }
        const int t0 = tile * 256 + w * 32;
        unsigned K0[16], K1[16];
#pragma unroll
        for (int p = 0; p < 2; ++p) {
            const bf16_t* qrow = qp + (size_t)(t0 + r) * 2048 + hd * 256 + p * 128 + 8 * h2;
            bf16x8 qf[8];
#pragma unroll
            for (int s = 0; s < 8; ++s) qf[s] = *(const bf16x8*)(qrow + 16 * s);
            unsigned blk[4][16];
#pragma unroll
            for (int c = 0; c < 4; ++c) {
                f32x16 sc;
#pragma unroll
                for (int i = 0; i < 16; ++i) sc[i] = 0.f;
#pragma unroll
                for (int s = 0; s < 8; ++s) { const bf16x8 kf = *(const bf16x8*)(Kl + (p * 128 + 32 * c + r) * TK_KLD + 16 * s + 8 * h2); sc = MFMA32(kf, qf[s], sc); }
#pragma unroll
                for (int i = 0; i < 16; ++i) blk[c][i] = (mono(sc[i]) & ~0x7Fu) | (unsigned)(32 * c + crow(i, h2));
                sort16_desc(blk[c]);
            }
            merge16_desc(blk[0], blk[1]); merge16_desc(blk[2], blk[3]); merge16_desc(blk[0], blk[2]);
            unsigned oth[16];
#pragma unroll
            for (int i = 0; i < 16; ++i) oth[i] = (unsigned)__shfl_xor((int)blk[0][i], 32);
            merge16_desc(blk[0], oth);
#pragma unroll
            for (int i = 0; i < 16; ++i) { if (p == 0) K0[i] = blk[0][i]; else K1[i] = blk[0][i]; }
        }
#pragma unroll
        for (int q = 0; q < 4; ++q) {
            ((unsigned*)scr)[q] = (K0[4 * q] & 0x7Fu) | ((K0[4 * q + 1] & 0x7Fu) << 8) | ((K0[4 * q + 2] & 0x7Fu) << 16) | ((K0[4 * q + 3] & 0x7Fu) << 24);
            ((unsigned*)scr)[4 + q] = (K1[4 * q] & 0x7Fu) | ((K1[4 * q + 1] & 0x7Fu) << 8) | ((K1[4 * q + 2] & 0x7Fu) << 16) | ((K1[4 * q + 3] & 0x7Fu) << 24);
        }
        float sx[16], sy[16];
#pragma unroll
        for (int i = 0; i < 16; ++i) { const float s0 = demono(K0[i] & ~0x7Fu), s1 = demono(K1[i] & ~0x7Fu); sx[i] = h2 ? s1 : s0; sy[i] = h2 ? s0 : s1; }
        unsigned ca[16], cb[16];
#pragma unroll
        for (int i = 0; i < 16; ++i) { ca[i] = 0u; cb[i] = 0u; }
#define CAND(n, a, b) do { const unsigned key_ = (mono(sx[a] + sy[b]) & ~0xFFu) | (h2 ? (unsigned)(((b) << 4) | (a)) : (unsigned)(((a) << 4) | (b))); if ((n) < 16) ca[(n) & 15] = key_; else cb[(n) & 15] = key_; } while (0)
            CAND(0, 0, 1);
            CAND(1, 0, 2);
            CAND(2, 0, 3);
            CAND(3, 0, 4);
            CAND(4, 0, 5);
            CAND(5, 0, 6);
            CAND(6, 0, 7);
            CAND(7, 0, 8);
            CAND(8, 0, 9);
            CAND(9, 0, 10);
            CAND(10, 0, 11);
            CAND(11, 0, 12);
            CAND(12, 0, 13);
            CAND(13, 0, 14);
            CAND(14, 0, 15);
            CAND(15, 1, 2);
            CAND(16, 1, 3);
            CAND(17, 1, 4);
            CAND(18, 1, 5);
            CAND(19, 1, 6);
            CAND(20, 1, 7);
            CAND(21, 2, 3);
            CAND(22, 2, 4);
#undef CAND
#pragma unroll
        for (int d = 0; d < 4; ++d) { const unsigned key_ = (mono(sx[d] + sy[d]) & ~0xFFu) | (unsigned)((d << 4) | d); cb[7 + d] = h2 ? 0u : key_; }
        sort16_desc(ca); sort16_desc(cb); merge16_desc(ca, cb);
        unsigned fin[16], cpart[16];
#pragma unroll
        for (int i = 0; i < 16; ++i) cpart[i] = (unsigned)__shfl_xor((int)ca[i], 32);
#pragma unroll
        for (int i = 0; i < 16; ++i) fin[i] = umax_(ca[i], cpart[15 - i]);
        const float rs = rstd2[t0 + r];
        float sv[16], mxv = -3e38f;
#pragma unroll
        for (int i = 0; i < 16; ++i) { sv[i] = demono(fin[i] & ~0xFFu) * rs; mxv = fmaxf(mxv, sv[i]); }
        float den = 0.f;
#pragma unroll
        for (int i = 0; i < 16; ++i) { sv[i] = __expf(sv[i] - mxv); den += sv[i]; }
        const float rden = 1.f / den;
        int oid[8]; float og[8];
#pragma unroll
        for (int j = 0; j < 8; ++j) {
            const unsigned wk = fin[j]; og[j] = sv[j] * rden;
            const unsigned a0 = (wk >> 4) & 15u, a1 = wk & 15u;
            oid[j] = (int)scr[a0] * 128 + (int)scr[16 + a1];
        }
        int* ip = ids + (size_t)(t0 + r) * 128 + hd * 16 + 8 * h2; float* gp = gts + (size_t)(t0 + r) * 128 + hd * 16 + 8 * h2;
        *(u32x4*)ip = (u32x4){(unsigned)oid[0], (unsigned)oid[1], (unsigned)oid[2], (unsigned)oid[3]}; *(u32x4*)(ip + 4) = (u32x4){(unsigned)oid[4], (unsigned)oid[5], (unsigned)oid[6], (unsigned)oid[7]};
        *(f32x4*)gp = (f32x4){og[0], og[1], og[2], og[3]}; *(f32x4*)(gp + 4) = (f32x4){og[4], og[5], og[6], og[7]};
    }
}

typedef _Float16 h2_t __attribute__((ext_vector_type(2)));
template <int CTRL> DI float dpp_f(float v) { return __builtin_bit_cast(float, __builtin_amdgcn_update_dpp(0, __builtin_bit_cast(int, v), CTRL, 0xf, 0xf, true)); }
DI float row16_sum(float v) {
    v += dpp_f<0xB1>(v); v += dpp_f<0x4E>(v); v += dpp_f<0x141>(v); v += dpp_f<0x140>(v); return v; }
DI h2_t as_h2(unsigned w) { return __builtin_bit_cast(h2_t, w); }
DI void gather_token(int t, const float* x1, const float* g2, const float* gf, const f16_t* u16, const f16_t* v16, const int* ids, const float* gts, float* out, int lane) {
    const int l16 = lane & 15, grp = lane >> 4;
    const float* xrow = x1 + (size_t)t * D;
    u32x4 hp[8];
    {
        f32x4 xa[8][2]; float ss = 0.f;
#pragma unroll
        for (int i = 0; i < 8; ++i) { const f32x4* px = (const f32x4*)(xrow + (i * 16 + l16) * 8); xa[i][0] = px[0]; xa[i][1] = px[1];
            ss += (xa[i][0].x * xa[i][0].x + xa[i][0].y * xa[i][0].y) + (xa[i][0].z * xa[i][0].z + xa[i][0].w * xa[i][0].w) + (xa[i][1].x * xa[i][1].x + xa[i][1].y * xa[i][1].y) + (xa[i][1].z * xa[i][1].z + xa[i][1].w * xa[i][1].w); }
        const float rs = 1.f / sqrtf(row16_sum(ss) * (1.f / D) + EPS);
#pragma unroll
        for (int i = 0; i < 8; ++i) { const f32x4* pg = (const f32x4*)(g2 + (i * 16 + l16) * 8); const f32x4 a = xa[i][0] * rs * pg[0], b = xa[i][1] * rs * pg[1];
            h2_t q0 = {(f16_t)a.x, (f16_t)a.y}, q1 = {(f16_t)a.z, (f16_t)a.w}, q2 = {(f16_t)b.x, (f16_t)b.y}, q3 = {(f16_t)b.z, (f16_t)b.w};
            hp[i].x = __builtin_bit_cast(unsigned, q0); hp[i].y = __builtin_bit_cast(unsigned, q1); hp[i].z = __builtin_bit_cast(unsigned, q2); hp[i].w = __builtin_bit_cast(unsigned, q3); }
    }
    float acc[8][8];
#pragma unroll
    for (int i = 0; i < 8; ++i)
#pragma unroll
        for (int j = 0; j < 8; ++j) acc[i][j] = 0.f;
    const int* idp = ids + (size_t)t * 128 + grp; const float* gtp = gts + (size_t)t * 128 + grp;
    int idn = idp[0];
    for (int r = 0; r < 32; ++r) {
        const int id = idn; const float gate = gtp[4 * r];
        if (r + 1 < 32) idn = idp[4 * (r + 1)];
        const u32x4* ur = (const u32x4*)(u16 + (size_t)id * D) + l16;
        const u32x4* vr = (const u32x4*)(v16 + (size_t)id * D) + l16;
        u32x4 uu[8], vv[8];
#pragma unroll
        for (int i = 0; i < 8; ++i) uu[i] = ur[i * 16];
#pragma unroll
        for (int i = 0; i < 8; ++i) vv[i] = vr[i * 16];
        float d0 = 0.f, d1 = 0.f;
#pragma unroll
        for (int i = 0; i < 8; ++i) {
            d0 = __builtin_amdgcn_fdot2(as_h2(hp[i].x), as_h2(uu[i].x), d0, false); d1 = __builtin_amdgcn_fdot2(as_h2(hp[i].y), as_h2(uu[i].y), d1, false);
            d0 = __builtin_amdgcn_fdot2(as_h2(hp[i].z), as_h2(uu[i].z), d0, false); d1 = __builtin_amdgcn_fdot2(as_h2(hp[i].w), as_h2(uu[i].w), d1, false);
        }
        const float d = row16_sum(d0 + d1);
        const float coef = gate * gelu_tanh(d);
#pragma unroll
        for (int i = 0; i < 8; ++i) {
            const h2_t a = as_h2(vv[i].x), b = as_h2(vv[i].y), c = as_h2(vv[i].z), e = as_h2(vv[i].w);
            acc[i][0] = __builtin_fmaf((float)a.x, coef, acc[i][0]); acc[i][1] = __builtin_fmaf((float)a.y, coef, acc[i][1]);
            acc[i][2] = __builtin_fmaf((float)b.x, coef, acc[i][2]); acc[i][3] = __builtin_fmaf((float)b.y, coef, acc[i][3]);
            acc[i][4] = __builtin_fmaf((float)c.x, coef, acc[i][4]); acc[i][5] = __builtin_fmaf((float)c.y, coef, acc[i][5]);
            acc[i][6] = __builtin_fmaf((float)e.x, coef, acc[i][6]); acc[i][7] = __builtin_fmaf((float)e.y, coef, acc[i][7]);
        }
    }
    float k4[4][8], k2[2][8];
    const bool hi2 = (grp & 2) != 0, hi1 = (grp & 1) != 0;
#pragma unroll
    for (int i = 0; i < 4; ++i)
#pragma unroll
        for (int j = 0; j < 8; ++j) { const float keep = hi2 ? acc[i + 4][j] : acc[i][j], send = hi2 ? acc[i][j] : acc[i + 4][j]; k4[i][j] = keep + __shfl_xor(send, 32); }
#pragma unroll
    for (int i = 0; i < 2; ++i)
#pragma unroll
        for (int j = 0; j < 8; ++j) { const float keep = hi1 ? k4[i + 2][j] : k4[i][j], send = hi1 ? k4[i][j] : k4[i + 2][j]; k2[i][j] = keep + __shfl_xor(send, 16); }
    float ss = 0.f;
#pragma unroll
    for (int i = 0; i < 2; ++i) { const f32x4* px = (const f32x4*)(xrow + ((2 * grp + i) * 16 + l16) * 8); const f32x4 a = px[0], b = px[1];
        k2[i][0] += a.x; k2[i][1] += a.y; k2[i][2] += a.z; k2[i][3] += a.w; k2[i][4] += b.x; k2[i][5] += b.y; k2[i][6] += b.z; k2[i][7] += b.w;
#pragma unroll
        for (int j = 0; j < 8; ++j) ss += k2[i][j] * k2[i][j]; }
    const float rf = 1.f / sqrtf(wave_sum(ss) * (1.f / D) + EPS);
#pragma unroll
    for (int i = 0; i < 2; ++i) { const int e0 = ((2 * grp + i) * 16 + l16) * 8; const f32x4* pg = (const f32x4*)(gf + e0); const f32x4 ga = pg[0], gb = pg[1];
        f32x4 o0 = {k2[i][0] * rf * ga.x, k2[i][1] * rf * ga.y, k2[i][2] * rf * ga.z, k2[i][3] * rf * ga.w}, o1 = {k2[i][4] * rf * gb.x, k2[i][5] * rf * gb.y, k2[i][6] * rf * gb.z, k2[i][7] * rf * gb.w};
        f32x4* po = (f32x4*)(out + (size_t)t * D + e0); po[0] = o0; po[1] = o1; }
}

constexpr int LDS_BYTES = 147456;
__global__ void __launch_bounds__(NTHREADS, 2) fwd_kernel(Params p) {
    extern __shared__ __attribute__((aligned(16))) unsigned char lds[];
    cg::grid_group grid = cg::this_grid();
    const int tid = threadIdx.x, lane = tid & 63, wave = tid >> 6;
    const int gw = blockIdx.x * NWAVES + wave, NGW = gridDim.x * NWAVES;
    const int G = gridDim.x, cu = blockIdx.x;
    unsigned char* ws = p.ws;
    PG8_LAS unsigned char* ldsl = (PG8_LAS unsigned char*)lds;
    bf16_t* ycat = (bf16_t*)p.out;

    phase0(p, (float*)lds, gw, NGW, wave, lane);
    grid.sync();
    {
        EpiZ E{(const float*)(ws + WS_RSTD1), (const float*)(ws + WS_RSTDM), (const float2*)(ws + WS_ROPE), (bf16_t*)(ws + WS_UPOOL), (bf16_t*)(ws + WS_QR), (bf16_t*)(ws + WS_KR), (bf16_t*)(ws + WS_VV), (bf16_t*)(ws + WS_QM), (bf16_t*)(ws + WS_GATES), (bf16_t*)(ws + WS_KVM)};
        SchedZ S{(const char*)(ws + WS_XB), (const char*)(ws + WS_WIN), (const char*)(ws + WS_MEMB), (const char*)(ws + WS_WMKV), G, cu};
        pg8::gemm_phase(ldsl, 1024, 1024, S, E);
    }
    grid.sync();
    pooled_phase((const bf16_t*)(ws + WS_UPOOL), ycat);
    swa_phase((const bf16_t*)(ws + WS_QR), (const bf16_t*)(ws + WS_KR), (const bf16_t*)(ws + WS_VV), p.sinks, ycat, lds, tid);
    mem_phase((const bf16_t*)(ws + WS_QM), (const bf16_t*)(ws + WS_KVM), ycat, lds, tid);
    grid.sync();
    {
        EpiGated E{(const bf16_t*)(ws + WS_GATES), (bf16_t*)(ws + WS_MERGED)};
        SchedGated S{(const char*)ycat, (const char*)(ws + WS_WBR), G, cu};
        pg8::gemm_phase(ldsl, 2048, 2048, S, E);
    }
    grid.sync();
    {
        EpiOut E{p.x, p.out, (bf16_t*)(ws + WS_X1B)};
        SchedPlain S{(const char*)(ws + WS_MERGED), (const char*)(ws + WS_WOUT), 1024, 1024, 128, 4, 16, G, cu};
        pg8::gemm_phase(ldsl, 1024, 1024, S, E);
    }
    grid.sync();
    {
        EpiBf16 E{(bf16_t*)(ws + WS_QP), 2048};
        SchedPlain S{(const char*)(ws + WS_X1B), (const char*)(ws + WS_WQ), 1024, 1024, 128, 8, 16, G, cu};
        pg8::gemm_phase(ldsl, 1024, 1024, S, E);
        float* rstd2 = (float*)(ws + WS_RSTD2);
        for (int m = gw; m < T; m += NGW) {
            const f32x4* xr = (const f32x4*)(p.out + (size_t)m * D) + lane; float s = 0.f;
#pragma unroll
            for (int j = 0; j < 4; ++j) { const f32x4 v = xr[64 * j]; s += (v.x * v.x + v.y * v.y) + (v.z * v.z + v.w * v.w); }
            s = wave_sum(s);
            if (lane == 0) rstd2[m] = 1.f / sqrtf(s * (1.f / D) + EPS);
        }
    }
    grid.sync();
    topk_phase((const bf16_t*)(ws + WS_QP), (const bf16_t*)(ws + WS_KEYS), (const float*)(ws + WS_RSTD2), (int*)(ws + WS_IDS), (float*)(ws + WS_GTS), lds, tid);
    grid.sync();
    for (int t = gw; t < T; t += NGW) gather_token(t, p.out, p.norm2_g, p.final_g, (const f16_t*)(ws + WS_U16), (const f16_t*)(ws + WS_V16), (const int*)(ws + WS_IDS), (const float*)(ws + WS_GTS), p.out, lane);
}

extern "C" void kernel_launch(void* const* d_in, const int* in_sizes, int n_in, void* d_out, int out_size, void* d_ws, size_t ws_size, hipStream_t stream) {
    static int grid_blocks = 0;
    if (grid_blocks == 0) {
        if (n_in != 20 || out_size != T * D || ws_size < WS_END) { fprintf(stderr, "kernel_launch: unexpected shapes: n_in %d out %d ws %zu\n", n_in, out_size, ws_size); grid_blocks = -1; return; }
        int dev = 0, cus = 0, per_cu = 0;
        (void)hipGetDevice(&dev);
        (void)hipDeviceGetAttribute(&cus, hipDeviceAttributeMultiprocessorCount, dev);
        if (hipFuncSetAttribute((const void*)fwd_kernel, hipFuncAttributeMaxDynamicSharedMemorySize, LDS_BYTES) != hipSuccess) { fprintf(stderr, "kernel_launch: hipFuncSetAttribute failed\n"); grid_blocks = -1; return; }
        (void)hipOccupancyMaxActiveBlocksPerMultiprocessor(&per_cu, (const void*)fwd_kernel, NTHREADS, LDS_BYTES);
        if (per_cu < 1) { fprintf(stderr, "kernel_launch: occupancy query says %d blocks per CU\n", per_cu); grid_blocks = -1; return; }
        grid_blocks = cus * per_cu;
        fprintf(stderr, "kernel_launch: cus %d per_cu %d grid %d ws %zu\n", cus, per_cu, grid_blocks, ws_size);
    }
    if (grid_blocks < 0) return;
    Params p{};
    p.x = (const float*)d_in[0]; p.mem = (const float*)d_in[1]; p.pos = (const int*)d_in[2]; p.norm1_g = (const float*)d_in[3]; p.mem_norm_g = (const float*)d_in[4];
    p.w_in = (const float*)d_in[5]; p.w_pool = (const float*)d_in[6]; p.pool_scale = (const float*)d_in[7]; p.sinks = (const float*)d_in[8]; p.w_mem_kv = (const float*)d_in[9];
    p.w_bpool = (const float*)d_in[10]; p.w_bswa = (const float*)d_in[11]; p.w_bmem = (const float*)d_in[12]; p.w_out = (const float*)d_in[13]; p.norm2_g = (const float*)d_in[14];
    p.w_q = (const float*)d_in[15]; p.sub_keys = (const float*)d_in[16]; p.peer_u = (const float*)d_in[17]; p.peer_v = (const float*)d_in[18]; p.final_g = (const float*)d_in[19];
    p.out = (float*)d_out; p.ws = (unsigned char*)d_ws;
    void* args[] = {&p};
    hipError_t e = hipLaunchCooperativeKernel((const void*)fwd_kernel, dim3(grid_blocks), dim3(NTHREADS), args, LDS_BYTES, stream);
    if (e != hipSuccess) fprintf(stderr, "cooperative launch failed: %s (grid %d)\n", hipGetErrorString(e), grid_blocks);
}
```

```cpp
#include <hip/hip_runtime.h>
#include <hip/hip_cooperative_groups.h>
#include <cstdio>
#include <cstdint>
namespace cg = cooperative_groups;

#define DI __device__ __forceinline__
typedef unsigned short bf16_t;
typedef _Float16 f16_t;
typedef short bf16x8 __attribute__((ext_vector_type(8)));
typedef float f32x4 __attribute__((ext_vector_type(4)));
typedef float f32x16 __attribute__((ext_vector_type(16)));
typedef unsigned u32x4 __attribute__((ext_vector_type(4)));
typedef unsigned u32x2 __attribute__((ext_vector_type(2)));
typedef _Float16 f16x4 __attribute__((ext_vector_type(4)));

constexpr int D = 1024, BATCH = 8, SEQ = 4096, T = BATCH * SEQ, MEML = 256, TMEM = BATCH * MEML;
constexpr int INW = 5376;
constexpr int NTHREADS = 512, NWAVES = 8;
constexpr int NEXP = 16384;
constexpr float EPS = 1e-6f;

constexpr size_t MiB = 1u << 20;
constexpr size_t WS_WIN = 1 * MiB;
constexpr size_t WS_WBR = 12 * MiB;
constexpr size_t WS_WOUT = 16 * MiB;
constexpr size_t WS_WQ = 18 * MiB;
constexpr size_t WS_KEYS = 22 * MiB;
constexpr size_t WS_WPOOL = 22 * MiB + 512 * 1024;
constexpr size_t WS_RSTD1 = 22 * MiB + 768 * 1024;
constexpr size_t WS_RSTD2 = 22 * MiB + 896 * 1024;
constexpr size_t WS_RSTDM = 23 * MiB;
constexpr size_t WS_WMKV = 24 * MiB;
constexpr size_t WS_MEMB = 26 * MiB;
constexpr size_t WS_KVM = 30 * MiB;
constexpr size_t WS_ROPE = 34 * MiB;
constexpr size_t WS_XB = 42 * MiB;
constexpr size_t WS_POOLED = 42 * MiB;
constexpr size_t WS_MERGED = 170 * MiB;
constexpr size_t WS_U16 = 106 * MiB;
constexpr size_t WS_V16 = 138 * MiB;
constexpr size_t WS_UPOOL = 170 * MiB;
constexpr size_t WS_QR = 202 * MiB;
constexpr size_t WS_KR = 266 * MiB;
constexpr size_t WS_VV = 274 * MiB;
constexpr size_t WS_QM = 282 * MiB;
constexpr size_t WS_GATES = 314 * MiB;
constexpr size_t WS_X1B = 234 * MiB;
constexpr size_t WS_QP = 314 * MiB;
constexpr size_t WS_IDS = 442 * MiB;
constexpr size_t WS_GTS = 458 * MiB;
constexpr size_t WS_END = 512 * MiB;

struct Params {
    const float* x; const float* mem; const int* pos; const float* norm1_g; const float* mem_norm_g; const float* w_in; const float* w_pool;
    const float* pool_scale; const float* sinks; const float* w_mem_kv; const float* w_bpool; const float* w_bswa; const float* w_bmem; const float* w_out;
    const float* norm2_g; const float* w_q; const float* sub_keys; const float* peer_u; const float* peer_v; const float* final_g;
    float* out; unsigned char* ws;
};

DI unsigned f2bf(float f) { unsigned u = __builtin_bit_cast(unsigned, f); return (u + 0x7fffu + ((u >> 16) & 1u)) >> 16; }
DI unsigned pk2(float lo, float hi) { return f2bf(lo) | (f2bf(hi) << 16); }
DI float bf2f(bf16_t b) { return __builtin_bit_cast(float, (unsigned)b << 16); }
DI float bflo(unsigned w) { return __builtin_bit_cast(float, w << 16); }
DI float bfhi(unsigned w) { return __builtin_bit_cast(float, w & 0xffff0000u); }
DI float wave_sum(float v) {
#pragma unroll
    for (int o = 1; o < 64; o <<= 1) v += __shfl_xor(v, o);
    return v;
}
DI float wave_max(float v) {
#pragma unroll
    for (int o = 1; o < 64; o <<= 1) v = fmaxf(v, __shfl_xor(v, o));
    return v;
}
DI float gelu_tanh(float x) {
    const float y = 0.7978845608028654f * (x + 0.044715f * x * x * x);
    const float e = __expf(2.f * y);
    const float th = 1.f - 2.f / (e + 1.f);
    return 0.5f * x * (1.f + th);
}
DI float sigmoidf(float x) { return 1.f / (1.f + __expf(-x)); }

DI int opaque_tid() { int t = threadIdx.x; asm volatile("" : "+v"(t)); return t; }
DI int zperm(int n) {
    if (n < 512 || n >= 1664) return n;
    const int d = (n - 512) & 63, hb = n - d; return hb + 8 * ((d & 31) >> 2) + (d & 3) + 4 * (d >> 5);
}
template <bool ZPERM>
DI void transpose_item(const float* W, int K, int N, bf16_t* WT, int ldt, int roff, int coff, const float* g, float* scr, int item, int lane) {
    const int nblk = N / 32, kb = item / nblk, nb = item % nblk, k0 = 64 * kb, n0 = 32 * nb;
#pragma unroll 8
    for (int i = 0; i < 32; ++i) { const int kk = 2 * i + (lane >> 5); float v = W[(size_t)(k0 + kk) * N + n0 + (lane & 31)]; if (g) v *= g[k0 + kk]; scr[kk * 33 + (lane & 31)] = v; }
    asm volatile("s_waitcnt lgkmcnt(0)" ::: "memory");
    const int c = lane & 7;
#pragma unroll
    for (int j = 0; j < 4; ++j) { const int n = (lane >> 3) + 8 * j; const float* s = scr + (8 * c) * 33 + n;
        u32x4 o; o.x = pk2(s[0 * 33], s[1 * 33]); o.y = pk2(s[2 * 33], s[3 * 33]); o.z = pk2(s[4 * 33], s[5 * 33]); o.w = pk2(s[6 * 33], s[7 * 33]);
        const int nd = ZPERM ? zperm(n0 + n) : n0 + n;
        *(u32x4*)(WT + (size_t)(roff + nd) * ldt + coff + k0 + 8 * c) = o; }
    asm volatile("s_waitcnt lgkmcnt(0)" ::: "memory");
}

DI void row_to_bf16_rstd(const float* xrow, bf16_t* orow, float* rstd_out, int lane) {
    const f32x4* xr = (const f32x4*)xrow + lane;
    f32x4 v[4]; float s = 0.f;
#pragma unroll
    for (int j = 0; j < 4; ++j) { v[j] = xr[64 * j]; s += (v[j].x * v[j].x + v[j].y * v[j].y) + (v[j].z * v[j].z + v[j].w * v[j].w); }
    s = wave_sum(s);
    if (lane == 0) *rstd_out = 1.f / sqrtf(s * (1.f / D) + EPS);
    u32x2* o8 = (u32x2*)orow + lane;
#pragma unroll
    for (int j = 0; j < 4; ++j) { u32x2 w; w.x = pk2(v[j].x, v[j].y); w.y = pk2(v[j].z, v[j].w); o8[64 * j] = w; }
}

DI void phase0(const Params& p, float* lds_f) {
    const int tid_ = opaque_tid(), lane = tid_ & 63, wave = tid_ >> 6, gw = blockIdx.x * NWAVES + wave, NGW = gridDim.x * NWAVES;
    unsigned char* ws = p.ws;
    float* scr = lds_f + wave * (64 * 33);
    bf16_t* WinT = (bf16_t*)(ws + WS_WIN); bf16_t* WbrT = (bf16_t*)(ws + WS_WBR); bf16_t* WoutT = (bf16_t*)(ws + WS_WOUT); bf16_t* WqT = (bf16_t*)(ws + WS_WQ);
    bf16_t* WmkvT = (bf16_t*)(ws + WS_WMKV);
    constexpr int I_IN = (D / 64) * (INW / 32), I_BS = (1024 / 64) * (D / 32), I_BM = (512 / 64) * (D / 32), I_OUT = (D / 64) * (D / 32), I_Q = (D / 64) * (2048 / 32), I_MKV = (D / 64) * (D / 32);
    constexpr int NITEMS = I_IN + I_BS + I_BM + I_OUT + I_Q + I_MKV;
    for (int it = gw; it < NITEMS; it += NGW) {
        int r = it;
        if (r < I_IN) { transpose_item<true>(p.w_in, D, INW, WinT, D, 0, 0, p.norm1_g, scr, r, lane); continue; } r -= I_IN;
        if (r < I_BS) { transpose_item<false>(p.w_bswa, 1024, D, WbrT, 2048, 0, 512, nullptr, scr, r, lane); continue; } r -= I_BS;
        if (r < I_BM) { transpose_item<false>(p.w_bmem, 512, D, WbrT, 2048, 0, 1536, nullptr, scr, r, lane); continue; } r -= I_BM;
        if (r < I_OUT) { transpose_item<false>(p.w_out, D, D, WoutT, D, 0, 0, nullptr, scr, r, lane); continue; } r -= I_OUT;
        if (r < I_Q) { transpose_item<false>(p.w_q, D, 2048, WqT, D, 0, 0, p.norm2_g, scr, r, lane); continue; } r -= I_Q;
        transpose_item<false>(p.w_mem_kv, D, D, WmkvT, D, 0, 0, p.mem_norm_g, scr, r, lane);
    }
    {
        const size_t gt0 = (size_t)gw * 64 + lane, NGT0 = (size_t)NGW * 64;
        for (size_t i = gt0; i < (size_t)512 * 1024; i += NGT0) {
            const int n = (int)(i & 1023), cp = (int)(i >> 10), g = cp >> 7;
            const float* wp = p.w_pool + (size_t)cp * 128; const float* sc = p.pool_scale + g * 128; const float* wb = p.w_bpool + (size_t)(g * 128) * 1024 + n;
            float a0 = 0.f, a1 = 0.f, a2 = 0.f, a3 = 0.f;
#pragma unroll 4
            for (int d = 0; d < 128; d += 4) {
                a0 += wp[d] * sc[d] * wb[(size_t)d * 1024]; a1 += wp[d + 1] * sc[d + 1] * wb[(size_t)(d + 1) * 1024];
                a2 += wp[d + 2] * sc[d + 2] * wb[(size_t)(d + 2) * 1024]; a3 += wp[d + 3] * sc[d + 3] * wb[(size_t)(d + 3) * 1024]; }
            const float a = (a0 + a1) + (a2 + a3);
            WbrT[(size_t)n * 2048 + cp] = (bf16_t)f2bf(a);
        }
    }
    bf16_t* xb = (bf16_t*)(ws + WS_XB); float* rstd1 = (float*)(ws + WS_RSTD1);
    for (int m = gw; m < T; m += NGW) row_to_bf16_rstd(p.x + (size_t)m * D, xb + (size_t)m * D, rstd1 + m, lane);
    bf16_t* memb = (bf16_t*)(ws + WS_MEMB); float* rstdm = (float*)(ws + WS_RSTDM);
    for (int m = gw; m < TMEM; m += NGW) row_to_bf16_rstd(p.mem + (size_t)m * D, memb + (size_t)m * D, rstdm + m, lane);
    const size_t gt = (size_t)gw * 64 + lane, NGT = (size_t)NGW * 64;
    bf16_t* keysb = (bf16_t*)(ws + WS_KEYS);
    for (size_t i = gt; i < (size_t)8 * 2 * 128 * 128 / 4; i += NGT) { const f32x4 v = ((const f32x4*)p.sub_keys)[i]; u32x2 w; w.x = pk2(v.x, v.y); w.y = pk2(v.z, v.w); ((u32x2*)keysb)[i] = w; }
    {
        u32x4* u8 = (u32x4*)(ws + WS_U16); u32x4* v8 = (u32x4*)(ws + WS_V16);
        for (size_t i = gt; i < (size_t)NEXP * D / 16; i += NGT) {
            const f32x4* pu = (const f32x4*)p.peer_u + 4 * i; const f32x4* pv = (const f32x4*)p.peer_v + 4 * i;
            u32x4 ou, ov;
#pragma unroll
            for (int j = 0; j < 4; ++j) { const f32x4 a = pu[j] * 32.f, b = pv[j] * 2.f;
                int wa = __builtin_amdgcn_cvt_pk_fp8_f32(a.x, a.y, 0, false); wa = __builtin_amdgcn_cvt_pk_fp8_f32(a.z, a.w, wa, true);
                int wb = __builtin_amdgcn_cvt_pk_fp8_f32(b.x, b.y, 0, false); wb = __builtin_amdgcn_cvt_pk_fp8_f32(b.z, b.w, wb, true);
                ou[j] = (unsigned)wa; ov[j] = (unsigned)wb; }
            u8[i] = ou; v8[i] = ov;
        }
    }
    for (size_t i = gt; i < (size_t)T; i += NGT) ((float*)(ws + WS_RSTD2))[i] = 0.f;
    float2* rope = (float2*)(ws + WS_ROPE);
    for (size_t i = gt; i < (size_t)T * 32; i += NGT) {
        const int t = (int)(i >> 5), d = (int)(i & 31);
        const float inv = exp2f(-(float)d * (13.287712379549449f / 32.f));
        const float ang = (float)p.pos[t] * inv;
        const double rev = (double)ang * 0.15915494309189535;
        const float fr = (float)(rev - floor(rev));
        rope[i] = make_float2(__builtin_amdgcn_cosf(fr), __builtin_amdgcn_sinf(fr));
    }
}

namespace pg8 {
#define PG8_LAS __attribute__((address_space(3)))
constexpr int BM = 256, BK = 64, HALF = 128, HTB = HALF * BK * 2, STAGE_BYTES = 8 * HTB, NXCD = 8, WGM = 8;
__host__ __device__ __forceinline__ int lds_byte(int r, int c) { const int st = (r >> 4) * 2 + (c >> 5), rr = r & 15, cc = c & 31, ob = rr * 64 + cc * 2; return st * 1024 + (ob ^ (((ob >> 9) & 1) << 5)); }
__host__ __device__ __forceinline__ void stage_rc(int b, int& R, int& C) { const int st = b / 1024, sb = b % 1024, swz = sb ^ (((sb >> 9) & 1) << 5); R = (st >> 1) * 16 + swz / 64; C = (st & 1) * 32 + (swz % 64) / 2; }
__host__ __device__ __forceinline__ int perm32(int rho) { const int n = rho >> 4, i = rho & 15; return 8 * (i >> 2) + 4 * n + (i & 3); }

struct Unit { const char* a; const char* b; int nt, pm, pn, tag; };
DI void tile_of(int L, int nM, int nN, int& pm, int& pn) {
    const int nwg = nM * nN; int wgid = L; { const int q = nwg / NXCD, r = nwg % NXCD, xcd = wgid % NXCD, off = wgid / NXCD; wgid = (xcd < r ? xcd * (q + 1) : r * (q + 1) + (xcd - r) * q) + off; }
    const int nig = WGM * nN, gid = wgid / nig, fm = gid * WGM, gsz = (nM - fm) < WGM ? (nM - fm) : WGM;
    pm = fm + ((wgid % nig) % gsz); pn = (wgid % nig) / gsz;
}
template <class Epi, class Sched>
DI void gemm_phase(PG8_LAS unsigned char* lds, int lda, int ldb, const Sched& S, const Epi& E) {
    int tid = threadIdx.x; asm volatile("" : "+v"(tid));
    const int wid = __builtin_amdgcn_readfirstlane(tid >> 6), wr = wid >> 2, wc = wid & 3, lane = tid & 63, fr = lane & 15, fq = lane >> 4;
    unsigned voffA[2], voffB[2];
#pragma unroll
    for (int i = 0; i < 2; ++i) { int R, C; stage_rc(tid * 16 + i * 8192, R, C); const int Rb = (R & ~31) + perm32(R & 31);
        voffA[i] = (unsigned)(R * lda + C) * 2u; voffB[i] = (unsigned)(Rb * ldb + C) * 2u; }
    const size_t kstep = (size_t)(BK * 2);
    const size_t hstepA = (size_t)HALF * lda * 2, hstepB = (size_t)HALF * ldb * 2;
    const unsigned ldsw = (unsigned)wid * 1024u;
    const int aoff = lds_byte(wr * 64 + fr, fq * 8), boff = lds_byte(wc * 32 + fr, fq * 8);
#define PG8_SA(b, h) (((b) * 2 + (h)) * HTB)
#define PG8_SB(b, h) ((4 + (b) * 2 + (h)) * HTB)
#define PG8_STAGE(bufoff, gbase, voff) do { _Pragma("unroll") for (int _i = 0; _i < 2; ++_i) \
        __builtin_amdgcn_global_load_lds((const unsigned*)((const char*)(gbase) + (voff)[_i]), (PG8_LAS unsigned*)(lds + (bufoff) + ldsw + _i * 8192), 16, 0, 0); } while (0)
#define PG8_LDA(dst, b, h) do { _Pragma("unroll") for (int m = 0; m < 4; ++m) _Pragma("unroll") for (int k = 0; k < 2; ++k) dst[m][k] = *(const PG8_LAS bf16x8*)(lds + PG8_SA(b, h) + aoff + m * 2048 + k * 1024); } while (0)
#define PG8_LDB(dst, b, h) do { _Pragma("unroll") for (int n = 0; n < 2; ++n) _Pragma("unroll") for (int k = 0; k < 2; ++k) dst[n][k] = *(const PG8_LAS bf16x8*)(lds + PG8_SB(b, h) + boff + n * 2048 + k * 1024); } while (0)
#define PG8_MMA(ai, bj, At, Bt) do { __builtin_amdgcn_s_setprio(1); _Pragma("unroll") for (int m = 0; m < 4; ++m) _Pragma("unroll") for (int n = 0; n < 2; ++n) _Pragma("unroll") for (int k = 0; k < 2; ++k) \
        acc[ai][bj][m][n] = __builtin_amdgcn_mfma_f32_16x16x32_bf16(Bt[n][k], At[m][k], acc[ai][bj][m][n], 0, 0, 0); __builtin_amdgcn_s_setprio(0); } while (0)
#define PG8_WAIT_V(n) asm volatile("s_waitcnt vmcnt(" #n ")" ::: "memory")
#define PG8_WAIT_L(n) asm volatile("s_waitcnt lgkmcnt(" #n ")" ::: "memory")
#define PG8_BAR __builtin_amdgcn_s_barrier()
#define PG8_SCHED __builtin_amdgcn_sched_barrier(0)
    Unit cur, nxt; int ui = 0;
    if (!S.next(0, cur)) return;
    f32x4 acc[2][2][4][2];
#pragma unroll
    for (int a = 0; a < 2; ++a)
#pragma unroll
        for (int b = 0; b < 2; ++b)
#pragma unroll
            for (int m = 0; m < 4; ++m)
#pragma unroll
                for (int n = 0; n < 2; ++n) acc[a][b][m][n] = (f32x4){0.f, 0.f, 0.f, 0.f};
    bf16x8 At[4][2], B0[2][2], B1[2][2];
    const char* cA = cur.a; const char* cB = cur.b;
    PG8_STAGE(PG8_SB(0, 0), cB, voffB); PG8_STAGE(PG8_SB(0, 1), cB + hstepB, voffB); PG8_STAGE(PG8_SA(0, 0), cA, voffA); PG8_STAGE(PG8_SA(0, 1), cA + hstepA, voffA);
    if (wr == 1) PG8_BAR;
    PG8_WAIT_V(2); PG8_BAR;
    PG8_STAGE(PG8_SB(1, 0), cB + kstep, voffB); PG8_STAGE(PG8_SA(1, 0), cA + kstep, voffA); PG8_STAGE(PG8_SB(1, 1), cB + hstepB + kstep, voffB);
    PG8_WAIT_V(6); PG8_BAR;
    for (;;) {
        const bool has_next = S.next(ui + 1, nxt);
        const char* nA = has_next ? nxt.a : cA; const char* nB = has_next ? nxt.b : cB;
        const int nt = cur.nt;
        for (int t = 0; t < nt; t += 2) {
            const bool last = (t == nt - 2);
            const char* a1 = cA + (size_t)(t + 1) * kstep;
            const char* a2 = last ? nA : cA + (size_t)(t + 2) * kstep; const char* b2 = last ? nB : cB + (size_t)(t + 2) * kstep;
            const char* a3 = a2 + kstep; const char* b3 = b2 + kstep;
            PG8_LDB(B0, 0, 0); PG8_LDB(B1, 0, 1); PG8_SCHED; PG8_LDA(At, 0, 0); PG8_STAGE(PG8_SA(1, 1), a1 + hstepA, voffA);
            PG8_WAIT_V(8); PG8_WAIT_L(0); PG8_BAR; PG8_MMA(0, 0, At, B0); PG8_MMA(0, 1, At, B1); PG8_BAR; PG8_SCHED;
            PG8_LDA(At, 0, 1); PG8_STAGE(PG8_SB(0, 0), b2, voffB); PG8_STAGE(PG8_SB(0, 1), b2 + hstepB, voffB); PG8_STAGE(PG8_SA(0, 0), a2, voffA);
            PG8_WAIT_V(8); PG8_WAIT_L(0); PG8_BAR; PG8_MMA(1, 0, At, B0); PG8_MMA(1, 1, At, B1); PG8_BAR; PG8_SCHED;
            PG8_LDB(B0, 1, 0); PG8_LDB(B1, 1, 1); PG8_SCHED; PG8_LDA(At, 1, 0); PG8_STAGE(PG8_SA(0, 1), a2 + hstepA, voffA);
            PG8_WAIT_V(8); PG8_WAIT_L(0); PG8_BAR; PG8_MMA(0, 0, At, B0); PG8_MMA(0, 1, At, B1); PG8_BAR; PG8_SCHED;
            PG8_LDA(At, 1, 1); PG8_STAGE(PG8_SB(1, 0), b3, voffB); PG8_STAGE(PG8_SB(1, 1), b3 + hstepB, voffB); PG8_STAGE(PG8_SA(1, 0), a3, voffA);
            PG8_WAIT_V(8); PG8_WAIT_L(0); PG8_BAR; PG8_MMA(1, 0, At, B0); PG8_MMA(1, 1, At, B1); PG8_BAR; PG8_SCHED;
        }
        if (wr == 0) PG8_BAR;
        E(acc, cur, wr, wc, fr, fq);
        if (!has_next) break;
#pragma unroll
        for (int a = 0; a < 2; ++a)
#pragma unroll
            for (int b = 0; b < 2; ++b)
#pragma unroll
                for (int m = 0; m < 4; ++m)
#pragma unroll
                    for (int n = 0; n < 2; ++n) acc[a][b][m][n] = (f32x4){0.f, 0.f, 0.f, 0.f};
        cur = nxt; cA = nA; cB = nB; ++ui;
        if (wr == 1) PG8_BAR;
    }
    PG8_WAIT_V(0);
    PG8_BAR;
#undef PG8_SA
#undef PG8_SB
#undef PG8_STAGE
#undef PG8_LDA
#undef PG8_LDB
#undef PG8_MMA
#undef PG8_WAIT_V
#undef PG8_WAIT_L
#undef PG8_BAR
#undef PG8_SCHED
}
}
typedef f32x4 acc_t[2][2][4][2];

struct SchedPlain {
    const char* A; const char* Bt; int lda, ldb, nM, nN, nt, G, c;
    DI bool next(int i, pg8::Unit& u) const {
        const long L = (long)i * G + c; if (L >= (long)nM * nN) return false;
        pg8::tile_of((int)L, nM, nN, u.pm, u.pn); u.a = A + (size_t)u.pm * 256 * lda * 2; u.b = Bt + (size_t)u.pn * 256 * ldb * 2; u.nt = nt; u.tag = 0; return true;
    }
};
struct SchedZ {
    const char *xb, *win, *memb, *wmkv; int G, c;
    DI bool next(int i, pg8::Unit& u) const {
        const long L = (long)i * G + c; constexpr int NZ = 128 * 21;
        if (L < NZ) { pg8::tile_of((int)L, 128, 21, u.pm, u.pn); u.a = xb + (size_t)u.pm * 256 * 2048; u.b = win + (size_t)u.pn * 256 * 2048; u.nt = 16; u.tag = 0; return true; }
        const int j = (int)(L - NZ); if (j >= 32) return false;
        u.pm = j >> 2; u.pn = j & 3; u.a = memb + (size_t)u.pm * 256 * 2048; u.b = wmkv + (size_t)u.pn * 256 * 2048; u.nt = 16; u.tag = 1; return true;
    }
};
struct SchedGated {
    const char *ycat, *wbr; int G, c;
    DI bool next(int i, pg8::Unit& u) const {
        const int j = i / 3, b = i - 3 * j; const long L = (long)j * G + c; if (L >= 128 * 4) return false;
        pg8::tile_of((int)L, 128, 4, u.pm, u.pn);
        const int koff = (b == 0) ? 0 : (b == 1 ? 512 : 1536);
        u.a = ycat + ((size_t)u.pm * 256 * 2048 + koff) * 2; u.b = wbr + ((size_t)u.pn * 256 * 2048 + koff) * 2; u.nt = (b == 1) ? 16 : 8; u.tag = b; return true;
    }
};

DI u32x4 pack8(const f32x4& a, const f32x4& b) { u32x4 w; w.x = pk2(a[0], a[1]); w.y = pk2(a[2], a[3]); w.z = pk2(b[0], b[1]); w.w = pk2(b[2], b[3]); return w; }
struct EpiZ {
    const float* rstd1; const float* rstdm; const float2* rope; bf16_t *upool, *qr, *kr, *vv, *qm, *gates, *kvm;
    DI void operator()(const acc_t& acc, const pg8::Unit& u, int wr, int wc, int fr_, int fq_) const {
        int l_ = threadIdx.x; asm volatile("" : "+v"(l_)); const int fr = l_ & 15, fq = (l_ >> 4) & 3;
        const int row0 = u.pm * 256 + wr * 64 + fr;
        if (u.tag == 1) {
#pragma unroll
            for (int ai = 0; ai < 2; ++ai)
#pragma unroll
                for (int m = 0; m < 4; ++m) { const int row = row0 + ai * 128 + m * 16; const float rs = rstdm[row];
#pragma unroll
                    for (int bj = 0; bj < 2; ++bj) { const int c = u.pn * 256 + bj * 128 + wc * 32 + 8 * fq;
                        *(u32x4*)(kvm + (size_t)row * 1024 + c) = pack8(acc[ai][bj][m][0] * rs, acc[ai][bj][m][1] * rs); } }
            return;
        }
#pragma unroll
        for (int bj = 0; bj < 2; ++bj) {
            const int cb = u.pn * 256 + bj * 128;
            const int c = cb + wc * 32 + 8 * fq;
#pragma unroll
            for (int ai = 0; ai < 2; ++ai)
#pragma unroll
                for (int m = 0; m < 4; ++m) {
                    const int row = row0 + ai * 128 + m * 16; const float rs = rstd1[row];
                    const f32x4 v0 = acc[ai][bj][m][0] * rs, v1 = acc[ai][bj][m][1] * rs;
                    if (cb < 512) { *(u32x4*)(upool + (size_t)row * 512 + c) = pack8(v0, v1); }
                    else if (cb < 1664) {
                        const bool isq = cb < 1536; const int rel = isq ? c - 512 : c - 1536; const int hrel = rel & 63, d0 = hrel >> 1, hb = rel - hrel;
                        const f32x4 cs0 = *(const f32x4*)(rope + (size_t)row * 32 + d0), cs1 = *(const f32x4*)(rope + (size_t)row * 32 + d0 + 2);
                        const float sc = isq ? 0.125f : 1.f;
                        f32x4 o1, o2;
                        o1[0] = (v0[0] * cs0[0] - v1[0] * cs0[1]) * sc; o2[0] = (v1[0] * cs0[0] + v0[0] * cs0[1]) * sc;
                        o1[1] = (v0[1] * cs0[2] - v1[1] * cs0[3]) * sc; o2[1] = (v1[1] * cs0[2] + v0[1] * cs0[3]) * sc;
                        o1[2] = (v0[2] * cs1[0] - v1[2] * cs1[1]) * sc; o2[2] = (v1[2] * cs1[0] + v0[2] * cs1[1]) * sc;
                        o1[3] = (v0[3] * cs1[2] - v1[3] * cs1[3]) * sc; o2[3] = (v1[3] * cs1[2] + v0[3] * cs1[3]) * sc;
                        bf16_t* dst = isq ? qr + (size_t)row * 1024 + hb + d0 : kr + (size_t)row * 128 + hb + d0;
                        u32x2 w1, w2; w1.x = pk2(o1[0], o1[1]); w1.y = pk2(o1[2], o1[3]); w2.x = pk2(o2[0], o2[1]); w2.y = pk2(o2[2], o2[3]);
                        *(u32x2*)dst = w1; *(u32x2*)(dst + 32) = w2;
                    }
                    else if (cb < 1792) { *(u32x4*)(vv + (size_t)row * 128 + (c - 1664)) = pack8(v0, v1); }
                    else if (cb < 2304) { *(u32x4*)(qm + (size_t)row * 512 + (c - 1792)) = pack8(v0, v1); }
                    else { f32x4 s0, s1;
#pragma unroll
                        for (int e = 0; e < 4; ++e) { s0[e] = sigmoidf(v0[e]); s1[e] = sigmoidf(v1[e]); }
                        *(u32x4*)(gates + (size_t)row * 3072 + (c - 2304)) = pack8(s0, s1); }
                }
        }
    }
};
struct EpiGated {
    const bf16_t* gates; bf16_t* merged;
    DI void operator()(const acc_t& acc, const pg8::Unit& u, int wr, int wc, int fr_, int fq_) const {
        int l_ = threadIdx.x; asm volatile("" : "+v"(l_)); const int fr = l_ & 15, fq = (l_ >> 4) & 3;
        const int row0 = u.pm * 256 + wr * 64 + fr, b = u.tag;
#pragma unroll
        for (int ai = 0; ai < 2; ++ai)
#pragma unroll
            for (int m = 0; m < 4; ++m) { const int row = row0 + ai * 128 + m * 16;
#pragma unroll
                for (int bj = 0; bj < 2; ++bj) { const int c = u.pn * 256 + bj * 128 + wc * 32 + 8 * fq;
                    const u32x4 g = *(const u32x4*)(gates + (size_t)row * 3072 + b * 1024 + c);
                    bf16_t* mp = merged + (size_t)row * 1024 + c;
                    u32x4 old = (u32x4){0u, 0u, 0u, 0u}; if (b > 0) old = *(const u32x4*)mp;
                    const f32x4 a0 = acc[ai][bj][m][0], a1 = acc[ai][bj][m][1];
                    f32x4 r0, r1;
                    r0[0] = bflo(old.x) + bflo(g.x) * a0[0]; r0[1] = bfhi(old.x) + bfhi(g.x) * a0[1]; r0[2] = bflo(old.y) + bflo(g.y) * a0[2]; r0[3] = bfhi(old.y) + bfhi(g.y) * a0[3];
                    r1[0] = bflo(old.z) + bflo(g.z) * a1[0]; r1[1] = bfhi(old.z) + bfhi(g.z) * a1[1]; r1[2] = bflo(old.w) + bflo(g.w) * a1[2]; r1[3] = bfhi(old.w) + bfhi(g.w) * a1[3];
                    *(u32x4*)mp = pack8(r0, r1); } }
    }
};
struct EpiOut {
    const bf16_t* xb; bf16_t* x1b; float* ssq;
    DI void operator()(const acc_t& acc, const pg8::Unit& u, int wr, int wc, int fr_, int fq_) const {
        int l_ = threadIdx.x; asm volatile("" : "+v"(l_)); const int fr = l_ & 15, fq = (l_ >> 4) & 3;
        const int row0 = u.pm * 256 + wr * 64 + fr;
#pragma unroll
        for (int ai = 0; ai < 2; ++ai)
#pragma unroll
            for (int m = 0; m < 4; ++m) { const int row = row0 + ai * 128 + m * 16; float sq = 0.f;
#pragma unroll
                for (int bj = 0; bj < 2; ++bj) { const size_t o = (size_t)row * D + u.pn * 256 + bj * 128 + wc * 32 + 8 * fq;
                    const u32x4 xw = *(const u32x4*)(xb + o);
                    f32x4 v0 = acc[ai][bj][m][0], v1 = acc[ai][bj][m][1];
                    v0[0] += bflo(xw.x); v0[1] += bfhi(xw.x); v0[2] += bflo(xw.y); v0[3] += bfhi(xw.y); v1[0] += bflo(xw.z); v1[1] += bfhi(xw.z); v1[2] += bflo(xw.w); v1[3] += bfhi(xw.w);
                    sq += (v0[0] * v0[0] + v0[1] * v0[1]) + (v0[2] * v0[2] + v0[3] * v0[3]) + (v1[0] * v1[0] + v1[1] * v1[1]) + (v1[2] * v1[2] + v1[3] * v1[3]);
                    *(u32x4*)(x1b + o) = pack8(v0, v1); }
                sq += __shfl_xor(sq, 16); sq += __shfl_xor(sq, 32);
                if (fq == 0) atomicAdd(ssq + row, sq); }
    }
};
struct EpiBf16 {
    bf16_t* O; int ldo;
    DI void operator()(const acc_t& acc, const pg8::Unit& u, int wr, int wc, int fr_, int fq_) const {
        int l_ = threadIdx.x; asm volatile("" : "+v"(l_)); const int fr = l_ & 15, fq = (l_ >> 4) & 3;
        const int row0 = u.pm * 256 + wr * 64 + fr;
#pragma unroll
        for (int ai = 0; ai < 2; ++ai)
#pragma unroll
            for (int m = 0; m < 4; ++m) { const int row = row0 + ai * 128 + m * 16;
#pragma unroll
                for (int bj = 0; bj < 2; ++bj) { const size_t o = (size_t)row * ldo + u.pn * 256 + bj * 128 + wc * 32 + 8 * fq;
                    *(u32x4*)(O + o) = pack8(acc[ai][bj][m][0], acc[ai][bj][m][1]); } }
    }
};

DI void pooled_phase(const bf16_t* upool, bf16_t* pooled) {
    const size_t gt = (size_t)blockIdx.x * NTHREADS + opaque_tid(), NGT = (size_t)gridDim.x * NTHREADS;
    for (size_t i = gt; i < (size_t)T * 64; i += NGT) {
        const int t = (int)(i >> 6), c = (int)(i & 63) * 8, g = c >> 7, w = 2 << g, s = t & (SEQ - 1);
        const int cnt = (s + 1 < w) ? s + 1 : w;
        const bf16_t* up = upool + (size_t)t * 512 + c;
        const u32x4 u0 = *(const u32x4*)up;
        float sum[8];
        sum[0] = bflo(u0.x); sum[1] = bfhi(u0.x); sum[2] = bflo(u0.y); sum[3] = bfhi(u0.y); sum[4] = bflo(u0.z); sum[5] = bfhi(u0.z); sum[6] = bflo(u0.w); sum[7] = bfhi(u0.w);
        float self[8];
#pragma unroll
        for (int e = 0; e < 8; ++e) self[e] = sum[e];
#pragma unroll 4
        for (int j = 1; j < cnt; ++j) { const u32x4 v = *(const u32x4*)(up - (size_t)j * 512);
            sum[0] += bflo(v.x); sum[1] += bfhi(v.x); sum[2] += bflo(v.y); sum[3] += bfhi(v.y); sum[4] += bflo(v.z); sum[5] += bfhi(v.z); sum[6] += bflo(v.w); sum[7] += bfhi(v.w); }
        const float ic = 1.f / (float)cnt;
        u32x4 o; o.x = pk2(sum[0] * ic - self[0], sum[1] * ic - self[1]); o.y = pk2(sum[2] * ic - self[2], sum[3] * ic - self[3]);
        o.z = pk2(sum[4] * ic - self[4], sum[5] * ic - self[5]); o.w = pk2(sum[6] * ic - self[6], sum[7] * ic - self[7]);
        *(u32x4*)(pooled + (size_t)t * 2048 + c) = o;
    }
}
typedef __bf16 bf16x2_t __attribute__((ext_vector_type(2)));
typedef float f32x2_t __attribute__((ext_vector_type(2)));
DI unsigned cvtpk(float lo, float hi) { f32x2_t v = {lo, hi}; bf16x2_t b = __builtin_convertvector(v, bf16x2_t); return __builtin_bit_cast(unsigned, b); }
DI int crow(int i, int h) { return (i & 3) + 8 * (i >> 2) + 4 * h; }
#define MFMA32(a, b, c) __builtin_amdgcn_mfma_f32_32x32x16_bf16((a), (b), (c), 0, 0, 0)
DI bf16x8 mk8(unsigned a, unsigned b, unsigned c, unsigned d) { u32x4 w = {a, b, c, d}; return __builtin_bit_cast(bf16x8, w); }

constexpr int SWA_KLD = 72, SWA_VLD = 260, SWA_VT_OFF = 256 * SWA_KLD * 2;
DI void swa_phase(const bf16_t* qr, const bf16_t* kr, const bf16_t* vv, const float* sinks, bf16_t* ycat, unsigned char* lds) {
    const int tid = opaque_tid();
    const int lane = tid & 63, w = tid >> 6, r = lane & 31, h = lane >> 5;
    bf16_t* Ks = (bf16_t*)lds; bf16_t* Vt = (bf16_t*)(lds + SWA_VT_OFF);
    for (int unit = blockIdx.x; unit < 512; unit += gridDim.x) {
        const int kvh = unit & 1, nb = (unit >> 1) & 31, b = unit >> 6;
        const int tq0 = b * SEQ + nb * 128, tk0 = tq0 - 128;
        __syncthreads();
#pragma unroll
        for (int i = 0; i < 4; ++i) {
            const int c = tid + 512 * i, kb = c >> 3, dc = (c & 7) * 8;
            u32x4 kv = {0u, 0u, 0u, 0u}, vx = {0u, 0u, 0u, 0u};
            if (nb > 0 || kb >= 128) { kv = *(const u32x4*)(kr + (size_t)(tk0 + kb) * 128 + kvh * 64 + dc); vx = *(const u32x4*)(vv + (size_t)(tk0 + kb) * 128 + kvh * 64 + dc); }
            *(u32x4*)(Ks + kb * SWA_KLD + dc) = kv;
            bf16_t* vp = Vt + dc * SWA_VLD + kb;
            vp[0 * SWA_VLD] = (bf16_t)(vx.x & 0xffffu); vp[1 * SWA_VLD] = (bf16_t)(vx.x >> 16); vp[2 * SWA_VLD] = (bf16_t)(vx.y & 0xffffu); vp[3 * SWA_VLD] = (bf16_t)(vx.y >> 16);
            vp[4 * SWA_VLD] = (bf16_t)(vx.z & 0xffffu); vp[5 * SWA_VLD] = (bf16_t)(vx.z >> 16); vp[6 * SWA_VLD] = (bf16_t)(vx.w & 0xffffu); vp[7 * SWA_VLD] = (bf16_t)(vx.w >> 16);
        }
        __syncthreads();
        const int hq = kvh * 8 + w; const float sink = sinks[hq];
        for (int qt = 0; qt < 4; ++qt) {
            const bf16_t* qp = qr + (size_t)(tq0 + 32 * qt + r) * 1024 + hq * 64 + 8 * h;
            bf16x8 qf[4];
#pragma unroll
            for (int s = 0; s < 4; ++s) qf[s] = *(const bf16x8*)(qp + 16 * s);
            f32x16 sa[5];
#pragma unroll
            for (int c = 0; c < 5; ++c) {
#pragma unroll
                for (int i = 0; i < 16; ++i) sa[c][i] = 0.f;
#pragma unroll
                for (int s = 0; s < 4; ++s) { const bf16x8 kf = *(const bf16x8*)(Ks + (32 * (qt + c) + r) * SWA_KLD + 16 * s + 8 * h); sa[c] = MFMA32(kf, qf[s], sa[c]); }
            }
            float mx = sink;
#pragma unroll
            for (int c = 0; c < 5; ++c)
#pragma unroll
                for (int i = 0; i < 16; ++i) {
                    const int kk = 32 * c + crow(i, h);
                    bool vis = (c == 0) ? (kk > r) : ((c == 4) ? (kk - 128 <= r) : true);
                    if (nb == 0) vis = vis && (32 * qt + kk >= 128);
                    const float s = vis ? sa[c][i] : -1e30f; sa[c][i] = s; mx = fmaxf(mx, s);
                }
            mx = fmaxf(mx, __shfl_xor(mx, 32));
            float l = 0.f;
#pragma unroll
            for (int c = 0; c < 5; ++c)
#pragma unroll
                for (int i = 0; i < 16; ++i) { const float pz = __expf(sa[c][i] - mx); sa[c][i] = pz; l += pz; }
            l += __shfl_xor(l, 32); l += __expf(sink - mx);
            const float inv = 1.f / l;
            f32x16 oa[2];
#pragma unroll
            for (int i = 0; i < 16; ++i) { oa[0][i] = 0.f; oa[1][i] = 0.f; }
#pragma unroll
            for (int c = 0; c < 5; ++c)
#pragma unroll
                for (int s2 = 0; s2 < 2; ++s2) {
                    const bf16x8 pf = mk8(cvtpk(sa[c][8 * s2 + 0], sa[c][8 * s2 + 1]), cvtpk(sa[c][8 * s2 + 2], sa[c][8 * s2 + 3]), cvtpk(sa[c][8 * s2 + 4], sa[c][8 * s2 + 5]), cvtpk(sa[c][8 * s2 + 6], sa[c][8 * s2 + 7]));
#pragma unroll
                    for (int dt = 0; dt < 2; ++dt) {
                        const bf16_t* va = Vt + (32 * dt + r) * SWA_VLD + 32 * (qt + c) + 16 * s2 + 4 * h;
                        const u32x2 lo = *(const u32x2*)va, hi = *(const u32x2*)(va + 8);
                        oa[dt] = MFMA32(mk8(lo.x, lo.y, hi.x, hi.y), pf, oa[dt]);
                    }
                }
            bf16_t* yp = ycat + (size_t)(tq0 + 32 * qt + r) * 2048 + 512 + hq * 64 + 4 * h;
#pragma unroll
            for (int dt = 0; dt < 2; ++dt)
#pragma unroll
                for (int g4 = 0; g4 < 4; ++g4) { u32x2 o; o.x = cvtpk(oa[dt][4 * g4] * inv, oa[dt][4 * g4 + 1] * inv); o.y = cvtpk(oa[dt][4 * g4 + 2] * inv, oa[dt][4 * g4 + 3] * inv);
                    *(u32x2*)(yp + 32 * dt + 8 * g4) = o; }
        }
    }
}

constexpr int MEM_KLD = 136, MEM_VLD = 260, MEM_VT_OFF = 256 * MEM_KLD * 2;
DI void mem_phase(const bf16_t* qm, const bf16_t* kvm, bf16_t* ycat, unsigned char* lds) {
    const int tid = opaque_tid();
    const int lane = tid & 63, w = tid >> 6, r = lane & 31, h = lane >> 5;
    bf16_t* Ks = (bf16_t*)lds; bf16_t* Vt = (bf16_t*)(lds + MEM_VT_OFF);
    for (int unit = blockIdx.x; unit < 256; unit += gridDim.x) {
        const int qc = unit & 7, hm = (unit >> 3) & 3, b = unit >> 5;
        __syncthreads();
#pragma unroll
        for (int i = 0; i < 8; ++i) {
            const int c = tid + 512 * i, m = c >> 4, dc = (c & 15) * 8;
            const bf16_t* src = kvm + (size_t)(b * MEML + m) * 1024 + hm * 128 + dc;
            const u32x4 kv = *(const u32x4*)src, vx = *(const u32x4*)(src + 512);
            *(u32x4*)(Ks + m * MEM_KLD + dc) = kv;
            bf16_t* vp = Vt + dc * MEM_VLD + m;
            vp[0 * MEM_VLD] = (bf16_t)(vx.x & 0xffffu); vp[1 * MEM_VLD] = (bf16_t)(vx.x >> 16); vp[2 * MEM_VLD] = (bf16_t)(vx.y & 0xffffu); vp[3 * MEM_VLD] = (bf16_t)(vx.y >> 16);
            vp[4 * MEM_VLD] = (bf16_t)(vx.z & 0xffffu); vp[5 * MEM_VLD] = (bf16_t)(vx.z >> 16); vp[6 * MEM_VLD] = (bf16_t)(vx.w & 0xffffu); vp[7 * MEM_VLD] = (bf16_t)(vx.w >> 16);
        }
        __syncthreads();
        for (int qi = 0; qi < 2; ++qi) {
            const int t0 = b * SEQ + qc * 512 + (w * 2 + qi) * 32;
            const bf16_t* qp = qm + (size_t)(t0 + r) * 512 + hm * 128 + 8 * h;
            bf16x8 qf[8];
#pragma unroll
            for (int s = 0; s < 8; ++s) qf[s] = *(const bf16x8*)(qp + 16 * s);
            float mx = -3e38f;
#pragma unroll 1
            for (int c = 0; c < 8; ++c) {
                f32x16 sc;
#pragma unroll
                for (int i = 0; i < 16; ++i) sc[i] = 0.f;
#pragma unroll
                for (int s = 0; s < 8; ++s) { const bf16x8 kf = *(const bf16x8*)(Ks + (32 * c + r) * MEM_KLD + 16 * s + 8 * h); sc = MFMA32(kf, qf[s], sc); }
#pragma unroll
                for (int i = 0; i < 16; ++i) mx = fmaxf(mx, sc[i]);
            }
            mx = fmaxf(mx, __shfl_xor(mx, 32));
            constexpr float SC = 0.08838834764831845f * 1.4426950408889634f;
            float l = 0.f;
            f32x16 oa[4];
#pragma unroll
            for (int dt = 0; dt < 4; ++dt)
#pragma unroll
                for (int i = 0; i < 16; ++i) oa[dt][i] = 0.f;
#pragma unroll 1
            for (int c = 0; c < 8; ++c) {
                f32x16 sc;
#pragma unroll
                for (int i = 0; i < 16; ++i) sc[i] = 0.f;
#pragma unroll
                for (int s = 0; s < 8; ++s) { const bf16x8 kf = *(const bf16x8*)(Ks + (32 * c + r) * MEM_KLD + 16 * s + 8 * h); sc = MFMA32(kf, qf[s], sc); }
#pragma unroll
                for (int i = 0; i < 16; ++i) { const float pz = exp2f((sc[i] - mx) * SC); sc[i] = pz; l += pz; }
#pragma unroll
                for (int s2 = 0; s2 < 2; ++s2) {
                    const bf16x8 pf = mk8(cvtpk(sc[8 * s2 + 0], sc[8 * s2 + 1]), cvtpk(sc[8 * s2 + 2], sc[8 * s2 + 3]), cvtpk(sc[8 * s2 + 4], sc[8 * s2 + 5]), cvtpk(sc[8 * s2 + 6], sc[8 * s2 + 7]));
#pragma unroll
                    for (int dt = 0; dt < 4; ++dt) {
                        const bf16_t* va = Vt + (32 * dt + r) * MEM_VLD + 32 * c + 16 * s2 + 4 * h;
                        const u32x2 lo = *(const u32x2*)va, hi = *(const u32x2*)(va + 8);
                        oa[dt] = MFMA32(mk8(lo.x, lo.y, hi.x, hi.y), pf, oa[dt]);
                    }
                }
            }
            l += __shfl_xor(l, 32);
            const float inv = 1.f / l;
            bf16_t* yp = ycat + (size_t)(t0 + r) * 2048 + 1536 + hm * 128 + 4 * h;
#pragma unroll
            for (int dt = 0; dt < 4; ++dt)
#pragma unroll
                for (int g4 = 0; g4 < 4; ++g4) { u32x2 o; o.x = cvtpk(oa[dt][4 * g4] * inv, oa[dt][4 * g4 + 1] * inv); o.y = cvtpk(oa[dt][4 * g4 + 2] * inv, oa[dt][4 * g4 + 3] * inv);
                    *(u32x2*)(yp + 32 * dt + 8 * g4) = o; }
        }
    }
}

DI unsigned umax_(unsigned a, unsigned b) { return a > b ? a : b; }
DI unsigned umin_(unsigned a, unsigned b) { return a < b ? a : b; }
DI void cexd(unsigned& a, unsigned& b) { const unsigned mx = umax_(a, b), mn = umin_(a, b); a = mx; b = mn; }
DI void sort16_desc(unsigned (&v)[16]) {
#pragma unroll
    for (int k = 2; k <= 16; k <<= 1)
#pragma unroll
        for (int j = k >> 1; j > 0; j >>= 1)
#pragma unroll
            for (int i = 0; i < 16; ++i) { const int l = i ^ j; if (l > i) { if ((i & k) == 0) cexd(v[i], v[l]); else cexd(v[l], v[i]); } }
}
DI void merge16_desc(unsigned (&a)[16], const unsigned (&b)[16]) {
#pragma unroll
    for (int i = 0; i < 16; ++i) a[i] = umax_(a[i], b[15 - i]);
#pragma unroll
    for (int j = 8; j > 0; j >>= 1)
#pragma unroll
        for (int i = 0; i < 16; ++i) { const int l = i ^ j; if (l > i) cexd(a[i], a[l]); }
}
DI unsigned mono(float f) { const unsigned u = __builtin_bit_cast(unsigned, f); return u ^ ((unsigned)((int)u >> 31) | 0x80000000u); }
DI float demono(unsigned m) { const unsigned t = (unsigned)((int)m >> 31); return __builtin_bit_cast(float, m ^ (~t | 0x80000000u)); }
constexpr int TK_KLD = 136, TK_SCR_OFF = 2 * 128 * TK_KLD * 2;
DI void topk_phase(const bf16_t* qp, const bf16_t* keysb, const float* rstd2, int* ids, float* gts, unsigned char* lds) {
    const int tid = opaque_tid();
    const int lane = tid & 63, w = tid >> 6, r = lane & 31, h2 = lane >> 5;
    bf16_t* Kl = (bf16_t*)lds;
    unsigned char* scr = lds + TK_SCR_OFF + w * 2048 + lane * 32;
    int staged = -1;
    for (int unit = blockIdx.x; unit < 1024; unit += gridDim.x) {
        const int hd = unit & 7, tile = unit >> 3;
        if (hd != staged) {
            __syncthreads();
#pragma unroll
            for (int i = 0; i < 8; ++i) { const int c = tid + 512 * i, row = c >> 4, dc = (c & 15) * 8;
                *(u32x4*)(Kl + row * TK_KLD + dc) = *(const u32x4*)(keysb + ((size_t)hd * 256 + row) * 128 + dc); }
            __syncthreads();
            staged = hd;
        }
        const int t0 = tile * 256 + w * 32;
        unsigned K0[16], K1[16];
#pragma unroll
        for (int p = 0; p < 2; ++p) {
            const bf16_t* qrow = qp + (size_t)(t0 + r) * 2048 + hd * 256 + p * 128 + 8 * h2;
            bf16x8 qf[8];
#pragma unroll
            for (int s = 0; s < 8; ++s) qf[s] = *(const bf16x8*)(qrow + 16 * s);
            unsigned blk[4][16];
#pragma unroll
            for (int c = 0; c < 4; ++c) {
                f32x16 sc;
#pragma unroll
                for (int i = 0; i < 16; ++i) sc[i] = 0.f;
#pragma unroll
                for (int s = 0; s < 8; ++s) { const bf16x8 kf = *(const bf16x8*)(Kl + (p * 128 + 32 * c + r) * TK_KLD + 16 * s + 8 * h2); sc = MFMA32(kf, qf[s], sc); }
#pragma unroll
                for (int i = 0; i < 16; ++i) blk[c][i] = (mono(sc[i]) & ~0x7Fu) | (unsigned)(32 * c + crow(i, h2));
                sort16_desc(blk[c]);
            }
            merge16_desc(blk[0], blk[1]); merge16_desc(blk[2], blk[3]); merge16_desc(blk[0], blk[2]);
            unsigned oth[16];
#pragma unroll
            for (int i = 0; i < 16; ++i) oth[i] = (unsigned)__shfl_xor((int)blk[0][i], 32);
            merge16_desc(blk[0], oth);
#pragma unroll
            for (int i = 0; i < 16; ++i) { if (p == 0) K0[i] = blk[0][i]; else K1[i] = blk[0][i]; }
        }
#pragma unroll
        for (int q = 0; q < 4; ++q) {
            ((unsigned*)scr)[q] = (K0[4 * q] & 0x7Fu) | ((K0[4 * q + 1] & 0x7Fu) << 8) | ((K0[4 * q + 2] & 0x7Fu) << 16) | ((K0[4 * q + 3] & 0x7Fu) << 24);
            ((unsigned*)scr)[4 + q] = (K1[4 * q] & 0x7Fu) | ((K1[4 * q + 1] & 0x7Fu) << 8) | ((K1[4 * q + 2] & 0x7Fu) << 16) | ((K1[4 * q + 3] & 0x7Fu) << 24);
        }
        float sx[16], sy[16];
#pragma unroll
        for (int i = 0; i < 16; ++i) { const float s0 = demono(K0[i] & ~0x7Fu), s1 = demono(K1[i] & ~0x7Fu); sx[i] = h2 ? s1 : s0; sy[i] = h2 ? s0 : s1; }
        unsigned ca[16], cb[16];
#pragma unroll
        for (int i = 0; i < 16; ++i) { ca[i] = 0u; cb[i] = 0u; }
#define CAND(n, a, b) do { const unsigned key_ = (mono(sx[a] + sy[b]) & ~0xFFu) | (h2 ? (unsigned)(((b) << 4) | (a)) : (unsigned)(((a) << 4) | (b))); if ((n) < 16) ca[(n) & 15] = key_; else cb[(n) & 15] = key_; } while (0)
            CAND(0, 0, 1);
            CAND(1, 0, 2);
            CAND(2, 0, 3);
            CAND(3, 0, 4);
            CAND(4, 0, 5);
            CAND(5, 0, 6);
            CAND(6, 0, 7);
            CAND(7, 0, 8);
            CAND(8, 0, 9);
            CAND(9, 0, 10);
            CAND(10, 0, 11);
            CAND(11, 0, 12);
            CAND(12, 0, 13);
            CAND(13, 0, 14);
            CAND(14, 0, 15);
            CAND(15, 1, 2);
            CAND(16, 1, 3);
            CAND(17, 1, 4);
            CAND(18, 1, 5);
            CAND(19, 1, 6);
            CAND(20, 1, 7);
            CAND(21, 2, 3);
            CAND(22, 2, 4);
#undef CAND
#pragma unroll
        for (int d = 0; d < 4; ++d) { const unsigned key_ = (mono(sx[d] + sy[d]) & ~0xFFu) | (unsigned)((d << 4) | d); cb[7 + d] = h2 ? 0u : key_; }
        sort16_desc(ca); sort16_desc(cb); merge16_desc(ca, cb);
        unsigned fin[16], cpart[16];
#pragma unroll
        for (int i = 0; i < 16; ++i) cpart[i] = (unsigned)__shfl_xor((int)ca[i], 32);
#pragma unroll
        for (int i = 0; i < 16; ++i) fin[i] = umax_(ca[i], cpart[15 - i]);
        const float rs = 1.f / sqrtf(rstd2[t0 + r] * (1.f / D) + EPS);
        float sv[16], mxv = -3e38f;
#pragma unroll
        for (int i = 0; i < 16; ++i) { sv[i] = demono(fin[i] & ~0xFFu) * rs; mxv = fmaxf(mxv, sv[i]); }
        float den = 0.f;
#pragma unroll
        for (int i = 0; i < 16; ++i) { sv[i] = __expf(sv[i] - mxv); den += sv[i]; }
        const float rden = 1.f / den;
        int oid[8]; float og[8];
#pragma unroll
        for (int j = 0; j < 8; ++j) {
            const unsigned wk = fin[j]; og[j] = sv[j] * rden;
            const unsigned a0 = (wk >> 4) & 15u, a1 = wk & 15u;
            oid[j] = (int)scr[a0] * 128 + (int)scr[16 + a1];
        }
        int* ip = ids + (size_t)(t0 + r) * 128 + hd * 16 + 8 * h2; float* gp = gts + (size_t)(t0 + r) * 128 + hd * 16 + 8 * h2;
        *(u32x4*)ip = (u32x4){(unsigned)oid[0], (unsigned)oid[1], (unsigned)oid[2], (unsigned)oid[3]}; *(u32x4*)(ip + 4) = (u32x4){(unsigned)oid[4], (unsigned)oid[5], (unsigned)oid[6], (unsigned)oid[7]};
        *(f32x4*)gp = (f32x4){og[0], og[1], og[2], og[3]}; *(f32x4*)(gp + 4) = (f32x4){og[4], og[5], og[6], og[7]};
    }
}

typedef _Float16 h2_t __attribute__((ext_vector_type(2)));
template <int CTRL> DI float dpp_f(float v) { return __builtin_bit_cast(float, __builtin_amdgcn_update_dpp(0, __builtin_bit_cast(int, v), CTRL, 0xf, 0xf, true)); }
DI float row16_sum(float v) {
    v += dpp_f<0xB1>(v); v += dpp_f<0x4E>(v); v += dpp_f<0x141>(v); v += dpp_f<0x140>(v); return v; }
DI void gather_token(int t, const bf16_t* x1, const float* g2, const float* gf, const unsigned char* u8, const unsigned char* v8, const int* ids, const float* gts, float* out, int lane) {
    const int l16 = lane & 15, grp = lane >> 4;
    const bf16_t* xrow = x1 + (size_t)t * D;
    h2_t hp[4][8];
    {
        f32x4 xa[4][4]; float ss = 0.f;
#pragma unroll
        for (int i = 0; i < 4; ++i)
#pragma unroll
            for (int hq = 0; hq < 2; ++hq) { const u32x4 w = *(const u32x4*)(xrow + (i * 16 + l16) * 16 + 8 * hq);
                xa[i][2 * hq] = (f32x4){bflo(w.x), bfhi(w.x), bflo(w.y), bfhi(w.y)}; xa[i][2 * hq + 1] = (f32x4){bflo(w.z), bfhi(w.z), bflo(w.w), bfhi(w.w)}; }
#pragma unroll
        for (int i = 0; i < 4; ++i)
#pragma unroll
            for (int q = 0; q < 4; ++q) ss += (xa[i][q].x * xa[i][q].x + xa[i][q].y * xa[i][q].y) + (xa[i][q].z * xa[i][q].z + xa[i][q].w * xa[i][q].w);
        const float rs = 1.f / sqrtf(row16_sum(ss) * (1.f / D) + EPS);
#pragma unroll
        for (int i = 0; i < 4; ++i)
#pragma unroll
            for (int q = 0; q < 4; ++q) { const f32x4 a = xa[i][q] * rs * *(const f32x4*)(g2 + (i * 16 + l16) * 16 + 4 * q);
                hp[i][2 * q] = (h2_t){(f16_t)a.x, (f16_t)a.y}; hp[i][2 * q + 1] = (h2_t){(f16_t)a.z, (f16_t)a.w}; }
    }
    f32x2_t acc[4][8];
#pragma unroll
    for (int i = 0; i < 4; ++i)
#pragma unroll
        for (int j = 0; j < 8; ++j) acc[i][j] = (f32x2_t){0.f, 0.f};
    const int* idp = ids + (size_t)t * 128 + grp; const float* gtp = gts + (size_t)t * 128 + grp;
    int idn = idp[0];
    for (int r = 0; r < 32; ++r) {
        const int id = idn; const float gate = gtp[4 * r];
        if (r + 1 < 32) idn = idp[4 * (r + 1)];
        const u32x4* ur = (const u32x4*)(u8 + (size_t)id * D) + l16;
        const u32x4* vr = (const u32x4*)(v8 + (size_t)id * D) + l16;
        u32x4 uu[4], vv[4];
#pragma unroll
        for (int i = 0; i < 4; ++i) uu[i] = ur[i * 16];
#pragma unroll
        for (int i = 0; i < 4; ++i) vv[i] = vr[i * 16];
        float d0 = 0.f, d1 = 0.f;
#pragma unroll
        for (int i = 0; i < 4; ++i)
#pragma unroll
            for (int q = 0; q < 4; ++q) {
                const h2_t z0 = __builtin_amdgcn_cvt_scalef32_pk_f16_fp8((int)uu[i][q], 1.0f, false), z1 = __builtin_amdgcn_cvt_scalef32_pk_f16_fp8((int)uu[i][q], 1.0f, true);
                d0 = __builtin_amdgcn_fdot2(hp[i][2 * q], z0, d0, false); d1 = __builtin_amdgcn_fdot2(hp[i][2 * q + 1], z1, d1, false);
            }
        const float d = row16_sum(d0 + d1) * (1.f / 32.f);
        const float coef = gate * gelu_tanh(d) * 0.5f;
        const f32x2_t cc = {coef, coef};
#pragma unroll
        for (int i = 0; i < 4; ++i)
#pragma unroll
            for (int q = 0; q < 4; ++q) {
                const f32x2_t a = __builtin_amdgcn_cvt_pk_f32_fp8((int)vv[i][q], false), b = __builtin_amdgcn_cvt_pk_f32_fp8((int)vv[i][q], true);
                acc[i][2 * q] = __builtin_elementwise_fma(a, cc, acc[i][2 * q]); acc[i][2 * q + 1] = __builtin_elementwise_fma(b, cc, acc[i][2 * q + 1]);
            }
    }
    f32x2_t k2[2][8], k1[8];
    const bool hi2 = (grp & 2) != 0, hi1 = (grp & 1) != 0;
#pragma unroll
    for (int i = 0; i < 2; ++i)
#pragma unroll
        for (int j = 0; j < 8; ++j) {
            const f32x2_t keep = hi2 ? acc[i + 2][j] : acc[i][j], send = hi2 ? acc[i][j] : acc[i + 2][j];
            k2[i][j] = (f32x2_t){keep.x + __shfl_xor(send.x, 32), keep.y + __shfl_xor(send.y, 32)}; }
#pragma unroll
    for (int j = 0; j < 8; ++j) {
        const f32x2_t keep = hi1 ? k2[1][j] : k2[0][j], send = hi1 ? k2[0][j] : k2[1][j];
        k1[j] = (f32x2_t){keep.x + __shfl_xor(send.x, 16), keep.y + __shfl_xor(send.y, 16)}; }
    const int e0 = (grp * 16 + l16) * 16;
    float ss = 0.f;
#pragma unroll
    for (int hq = 0; hq < 2; ++hq) { const u32x4 w = *(const u32x4*)(xrow + e0 + 8 * hq);
        k1[4 * hq].x += bflo(w.x); k1[4 * hq].y += bfhi(w.x); k1[4 * hq + 1].x += bflo(w.y); k1[4 * hq + 1].y += bfhi(w.y);
        k1[4 * hq + 2].x += bflo(w.z); k1[4 * hq + 2].y += bfhi(w.z); k1[4 * hq + 3].x += bflo(w.w); k1[4 * hq + 3].y += bfhi(w.w); }
#pragma unroll
    for (int j = 0; j < 8; ++j) ss += k1[j].x * k1[j].x + k1[j].y * k1[j].y;
    const float rf = 1.f / sqrtf(wave_sum(ss) * (1.f / D) + EPS);
#pragma unroll
    for (int q = 0; q < 4; ++q) { const f32x4 g = *(const f32x4*)(gf + e0 + 4 * q);
        *(f32x4*)(out + (size_t)t * D + e0 + 4 * q) = (f32x4){k1[2 * q].x * rf * g.x, k1[2 * q].y * rf * g.y, k1[2 * q + 1].x * rf * g.z, k1[2 * q + 1].y * rf * g.w}; }
}

#define LAS __attribute__((address_space(3)))
#define XB_TMO      128
#define XB_XCNT(j)  (256  + 64 * (j))
#define XB_XSUB(j)  (1280 + 64 * (j))
#define XB_XGEN(j)  (2304 + 64 * (j))
#define XB_TOP      3328
#define XB_TOPGEN   3392
#define XCD_BAR_WORDS 3456
#define XB_SPIN_CAP (1u << 18)
DI unsigned xb_ld(unsigned* p)              { return __hip_atomic_load(p, __ATOMIC_RELAXED, __HIP_MEMORY_SCOPE_AGENT); }
DI unsigned xb_add(unsigned* p, unsigned v) { return __hip_atomic_fetch_add(p, v, __ATOMIC_RELAXED, __HIP_MEMORY_SCOPE_AGENT); }
DI unsigned xb_xcc_id() { return (unsigned)__builtin_amdgcn_s_getreg((3 << 11) | 20) & 0xFu; }
#define XB_SPIN(cond, bar) do { unsigned _sp = 0; while (cond) { __builtin_amdgcn_s_sleep(1); \
    if ((++_sp & 255u) == 0u) { if (xb_ld(&(bar)[XB_TMO])) break; if (_sp > XB_SPIN_CAP) { atomicAdd(&(bar)[XB_TMO], 1u); break; } } } } while (0)
struct XcdBarrier { unsigned* bar; unsigned x; volatile LAS unsigned* st; };
DI XcdBarrier xcd_barrier_post(unsigned* bar, volatile LAS unsigned* st) {
    XcdBarrier b; b.bar = bar; b.x = xb_xcc_id(); b.st = st;
    if (threadIdx.x == 0) (void)xb_add(&bar[XB_XCNT(b.x)], 1u);
    return b;
}
DI void xcd_barrier_complete(unsigned* bar, unsigned x, unsigned& nloc, unsigned& nx) {
    const unsigned G = gridDim.x * gridDim.y * gridDim.z;
    unsigned sum, cnt, mine, sp = 0u;
    for (;;) {
        sum = 0u; cnt = 0u; mine = 0u;
#pragma unroll
        for (unsigned j = 0; j < 16; ++j) { const unsigned c = xb_ld(&bar[XB_XCNT(j)]); sum += c; cnt += (c > 0u) ? 1u : 0u; mine = (j == x) ? c : mine; }
        if (sum == G) break;
        __builtin_amdgcn_s_sleep(1);
        if ((++sp & 255u) == 0u) { if (xb_ld(&bar[XB_TMO])) break; if (sp > XB_SPIN_CAP) { atomicAdd(&bar[XB_TMO], 1u); break; } }
    }
    nloc = mine > 0u ? mine : 1u; nx = cnt > 0u ? cnt : 1u;
}
DI void xcd_barrier(const XcdBarrier& b) {
    asm volatile("s_waitcnt vmcnt(0)" ::: "memory");
    __syncthreads();
    if (threadIdx.x == 0) {
        unsigned* bar = b.bar;
        __builtin_amdgcn_s_waitcnt(0);
        unsigned nloc = b.st[0], nx = b.st[1];
        if (nloc == 0u) { xcd_barrier_complete(bar, b.x, nloc, nx); b.st[0] = nloc; b.st[1] = nx; }
        const unsigned old = xb_add(&bar[XB_XSUB(b.x)], 1u);
        const unsigned gen = old / nloc;
        if (old + 1u == (gen + 1u) * nloc) {
            __builtin_amdgcn_fence(__ATOMIC_RELEASE, "agent");
            asm volatile("s_waitcnt vmcnt(0)" ::: "memory");
            const unsigned og = xb_add(&bar[XB_TOP], 1u);
            const unsigned tg = og / nx;
            if (og + 1u == (tg + 1u) * nx) xb_add(&bar[XB_TOPGEN], 1u);
            else XB_SPIN(xb_ld(&bar[XB_TOPGEN]) == tg, bar);
            __builtin_amdgcn_fence(__ATOMIC_ACQUIRE, "agent");
            xb_add(&bar[XB_XGEN(b.x)], 1u);
            asm volatile("s_waitcnt vmcnt(0)" ::: "memory");
        } else {
            XB_SPIN(xb_ld(&bar[XB_XGEN(b.x)]) == gen, bar);
            __builtin_amdgcn_fence(__ATOMIC_ACQUIRE, "agent");
            asm volatile("s_waitcnt vmcnt(0)" ::: "memory");
        }
    }
    __syncthreads();
}

#ifndef DUP_PHASE
#define DUP_PHASE -1
#endif
constexpr int LDS_BYTES = 147456;
__global__ void __launch_bounds__(NTHREADS, 2) fwd_kernel(Params p) {
    extern __shared__ __attribute__((aligned(16))) unsigned char lds[];
    cg::grid_group grid = cg::this_grid();
    volatile LAS unsigned* bst = (volatile LAS unsigned*)((LAS unsigned char*)lds + (LDS_BYTES - 64));
    if (threadIdx.x < 2) bst[threadIdx.x] = 0u;
    __syncthreads();
    const XcdBarrier xbar = xcd_barrier_post((unsigned*)p.ws, bst);
    const int NGW = gridDim.x * NWAVES, G = gridDim.x, cu = blockIdx.x;
    unsigned char* ws = p.ws;
    PG8_LAS unsigned char* ldsl = (PG8_LAS unsigned char*)lds;
    bf16_t* ycat = (bf16_t*)p.out;

    for (int rep_ = 0; rep_ < (DUP_PHASE == 0 ? 2 : 1); ++rep_) { phase0(p, (float*)lds);
    grid.sync(); }
    for (int rep_ = 0; rep_ < (DUP_PHASE == 1 ? 2 : 1); ++rep_) {
        EpiZ E{(const float*)(ws + WS_RSTD1), (const float*)(ws + WS_RSTDM), (const float2*)(ws + WS_ROPE), (bf16_t*)(ws + WS_UPOOL), (bf16_t*)(ws + WS_QR), (bf16_t*)(ws + WS_KR), (bf16_t*)(ws + WS_VV), (bf16_t*)(ws + WS_QM), (bf16_t*)(ws + WS_GATES), (bf16_t*)(ws + WS_KVM)};
        SchedZ S{(const char*)(ws + WS_XB), (const char*)(ws + WS_WIN), (const char*)(ws + WS_MEMB), (const char*)(ws + WS_WMKV), G, cu};
        pg8::gemm_phase(ldsl, 1024, 1024, S, E);
    xcd_barrier(xbar); }
    for (int rep_ = 0; rep_ < (DUP_PHASE == 2 ? 2 : 1); ++rep_) {
    pooled_phase((const bf16_t*)(ws + WS_UPOOL), ycat);
    swa_phase((const bf16_t*)(ws + WS_QR), (const bf16_t*)(ws + WS_KR), (const bf16_t*)(ws + WS_VV), p.sinks, ycat, lds);
    mem_phase((const bf16_t*)(ws + WS_QM), (const bf16_t*)(ws + WS_KVM), ycat, lds);
    xcd_barrier(xbar); }
    for (int rep_ = 0; rep_ < (DUP_PHASE == 3 ? 2 : 1); ++rep_) {
        EpiGated E{(const bf16_t*)(ws + WS_GATES), (bf16_t*)(ws + WS_MERGED)};
        SchedGated S{(const char*)ycat, (const char*)(ws + WS_WBR), G, cu};
        pg8::gemm_phase(ldsl, 2048, 2048, S, E);
    xcd_barrier(xbar); }
    for (int rep_ = 0; rep_ < (DUP_PHASE == 4 ? 2 : 1); ++rep_) {
        EpiOut E{(const bf16_t*)(ws + WS_XB), (bf16_t*)(ws + WS_X1B), (float*)(ws + WS_RSTD2)};
        SchedPlain S{(const char*)(ws + WS_MERGED), (const char*)(ws + WS_WOUT), 1024, 1024, 128, 4, 16, G, cu};
        pg8::gemm_phase(ldsl, 1024, 1024, S, E);
    xcd_barrier(xbar); }
    for (int rep_ = 0; rep_ < (DUP_PHASE == 5 ? 2 : 1); ++rep_) {
        EpiBf16 E{(bf16_t*)(ws + WS_QP), 2048};
        SchedPlain S{(const char*)(ws + WS_X1B), (const char*)(ws + WS_WQ), 1024, 1024, 128, 8, 16, G, cu};
        pg8::gemm_phase(ldsl, 1024, 1024, S, E);
    xcd_barrier(xbar); }
    for (int rep_ = 0; rep_ < (DUP_PHASE == 6 ? 2 : 1); ++rep_) {
    topk_phase((const bf16_t*)(ws + WS_QP), (const bf16_t*)(ws + WS_KEYS), (const float*)(ws + WS_RSTD2), (int*)(ws + WS_IDS), (float*)(ws + WS_GTS), lds);
    xcd_barrier(xbar); }
    const int tid6_ = opaque_tid(), lane = tid6_ & 63, gw = blockIdx.x * NWAVES + (tid6_ >> 6);
    if (DUP_PHASE == 7) { for (int t = gw; t < T; t += NGW) gather_token(t, (const bf16_t*)(ws + WS_X1B), p.norm2_g, p.final_g, (const unsigned char*)(ws + WS_U16), (const unsigned char*)(ws + WS_V16), (const int*)(ws + WS_IDS), (const float*)(ws + WS_GTS), (float*)(ws + WS_QP), lane); }
    for (int t = gw; t < T; t += NGW) gather_token(t, (const bf16_t*)(ws + WS_X1B), p.norm2_g, p.final_g, (const unsigned char*)(ws + WS_U16), (const unsigned char*)(ws + WS_V16), (const int*)(ws + WS_IDS), (const float*)(ws + WS_GTS), p.out, lane);
}

extern "C" void kernel_launch(void* const* d_in, const int* in_sizes, int n_in, void* d_out, int out_size, void* d_ws, size_t ws_size, hipStream_t stream) {
    static int grid_blocks = 0;
    if (grid_blocks == 0) {
        if (n_in != 20 || out_size != T * D || ws_size < WS_END) { fprintf(stderr, "kernel_launch: unexpected shapes: n_in %d out %d ws %zu\n", n_in, out_size, ws_size); grid_blocks = -1; return; }
        int dev = 0, cus = 0, per_cu = 0;
        (void)hipGetDevice(&dev);
        (void)hipDeviceGetAttribute(&cus, hipDeviceAttributeMultiprocessorCount, dev);
        if (hipFuncSetAttribute((const void*)fwd_kernel, hipFuncAttributeMaxDynamicSharedMemorySize, LDS_BYTES) != hipSuccess) { fprintf(stderr, "kernel_launch: hipFuncSetAttribute failed\n"); grid_blocks = -1; return; }
        (void)hipOccupancyMaxActiveBlocksPerMultiprocessor(&per_cu, (const void*)fwd_kernel, NTHREADS, LDS_BYTES);
        if (per_cu < 1) { fprintf(stderr, "kernel_launch: occupancy query says %d blocks per CU\n", per_cu); grid_blocks = -1; return; }
        grid_blocks = cus * per_cu;
        fprintf(stderr, "kernel_launch: cus %d per_cu %d grid %d ws %zu\n", cus, per_cu, grid_blocks, ws_size);
    }
    if (grid_blocks < 0) return;
    Params p{};
    p.x = (const float*)d_in[0]; p.mem = (const float*)d_in[1]; p.pos = (const int*)d_in[2]; p.norm1_g = (const float*)d_in[3]; p.mem_norm_g = (const float*)d_in[4];
    p.w_in = (const float*)d_in[5]; p.w_pool = (const float*)d_in[6]; p.pool_scale = (const float*)d_in[7]; p.sinks = (const float*)d_in[8]; p.w_mem_kv = (const float*)d_in[9];
    p.w_bpool = (const float*)d_in[10]; p.w_bswa = (const float*)d_in[11]; p.w_bmem = (const float*)d_in[12]; p.w_out = (const float*)d_in[13]; p.norm2_g = (const float*)d_in[14];
    p.w_q = (const float*)d_in[15]; p.sub_keys = (const float*)d_in[16]; p.peer_u = (const float*)d_in[17]; p.peer_v = (const float*)d_in[18]; p.final_g = (const float*)d_in[19];
    p.out = (float*)d_out; p.ws = (unsigned char*)d_ws;
    (void)hipMemsetAsync(d_ws, 0, 16384, stream);
    void* args[] = {&p};
    hipError_t e = hipLaunchCooperativeKernel((const void*)fwd_kernel, dim3(grid_blocks), dim3(NTHREADS), args, LDS_BYTES, stream);
    if (e != hipSuccess) fprintf(stderr, "cooperative launch failed: %s (grid %d)\n", hipGetErrorString(e), grid_blocks);
}
```

```cpp
#include <hip/hip_runtime.h>
#include <hip/hip_cooperative_groups.h>
#include <cstdio>
#include <cstdint>
namespace cg = cooperative_groups;

#define DI __device__ __forceinline__
typedef unsigned short bf16_t;
typedef _Float16 f16_t;
typedef short bf16x8 __attribute__((ext_vector_type(8)));
typedef float f32x4 __attribute__((ext_vector_type(4)));
typedef float f32x16 __attribute__((ext_vector_type(16)));
typedef unsigned u32x4 __attribute__((ext_vector_type(4)));
typedef unsigned u32x2 __attribute__((ext_vector_type(2)));
typedef _Float16 f16x4 __attribute__((ext_vector_type(4)));

constexpr int D = 1024, BATCH = 8, SEQ = 4096, T = BATCH * SEQ, MEML = 256, TMEM = BATCH * MEML;
constexpr int INW = 5376;
constexpr int NTHREADS = 512, NWAVES = 8;
constexpr int NEXP = 16384;
constexpr float EPS = 1e-6f;

constexpr size_t MiB = 1u << 20;
constexpr size_t WS_WIN = 1 * MiB;
constexpr size_t WS_WBR = 12 * MiB;
constexpr size_t WS_WOUT = 16 * MiB;
constexpr size_t WS_WQ = 18 * MiB;
constexpr size_t WS_KEYS = 22 * MiB;
constexpr size_t WS_WPOOL = 22 * MiB + 512 * 1024;
constexpr size_t WS_RSTD1 = 22 * MiB + 768 * 1024;
constexpr size_t WS_RSTD2 = 22 * MiB + 896 * 1024;
constexpr size_t WS_RSTDM = 23 * MiB;
constexpr size_t WS_SSQO = 23 * MiB + 64 * 1024;
constexpr size_t WS_WMKV = 24 * MiB;
constexpr size_t WS_MEMB = 26 * MiB;
constexpr size_t WS_KVM = 30 * MiB;
constexpr size_t WS_ROPE = 34 * MiB;
constexpr size_t WS_XB = 42 * MiB;
constexpr size_t WS_POOLED = 42 * MiB;
constexpr size_t WS_MERGED = 170 * MiB;
constexpr size_t WS_U16 = 106 * MiB;
constexpr size_t WS_V16 = 138 * MiB;
constexpr size_t WS_UPOOL = 170 * MiB;
constexpr size_t WS_QR = 202 * MiB;
constexpr size_t WS_KR = 266 * MiB;
constexpr size_t WS_VV = 274 * MiB;
constexpr size_t WS_QM = 282 * MiB;
constexpr size_t WS_GATES = 314 * MiB;
constexpr size_t WS_X1B = 234 * MiB;
constexpr size_t WS_QP = 314 * MiB;
constexpr size_t WS_COEF = 314 * MiB;
constexpr size_t WS_IDS = 442 * MiB;
constexpr size_t WS_GTS = 458 * MiB;
constexpr size_t WS_END = 512 * MiB;

struct Params {
    const float* x; const float* mem; const int* pos; const float* norm1_g; const float* mem_norm_g; const float* w_in; const float* w_pool;
    const float* pool_scale; const float* sinks; const float* w_mem_kv; const float* w_bpool; const float* w_bswa; const float* w_bmem; const float* w_out;
    const float* norm2_g; const float* w_q; const float* sub_keys; const float* peer_u; const float* peer_v; const float* final_g;
    float* out; unsigned char* ws;
};

DI unsigned f2bf(float f) { unsigned u = __builtin_bit_cast(unsigned, f); return (u + 0x7fffu + ((u >> 16) & 1u)) >> 16; }
DI unsigned pk2(float lo, float hi) { return f2bf(lo) | (f2bf(hi) << 16); }
DI float bf2f(bf16_t b) { return __builtin_bit_cast(float, (unsigned)b << 16); }
DI float bflo(unsigned w) { return __builtin_bit_cast(float, w << 16); }
DI float bfhi(unsigned w) { return __builtin_bit_cast(float, w & 0xffff0000u); }
DI float wave_sum(float v) {
#pragma unroll
    for (int o = 1; o < 64; o <<= 1) v += __shfl_xor(v, o);
    return v;
}
DI float wave_max(float v) {
#pragma unroll
    for (int o = 1; o < 64; o <<= 1) v = fmaxf(v, __shfl_xor(v, o));
    return v;
}
DI float gelu_tanh(float x) {
    const float y = 0.7978845608028654f * (x + 0.044715f * x * x * x);
    const float e = __expf(2.f * y);
    const float th = 1.f - 2.f / (e + 1.f);
    return 0.5f * x * (1.f + th);
}
DI float sigmoidf(float x) { return 1.f / (1.f + __expf(-x)); }

DI int opaque_tid() { int t = threadIdx.x; asm volatile("" : "+v"(t)); return t; }
DI int zperm(int n) {
    if (n < 512 || n >= 1664) return n;
    const int d = (n - 512) & 63, hb = n - d; return hb + 8 * ((d & 31) >> 2) + (d & 3) + 4 * (d >> 5);
}
template <bool ZPERM>
DI void transpose_item(const float* W, int K, int N, bf16_t* WT, int ldt, int roff, int coff, const float* g, float* scr, int item, int lane) {
    const int nblk = N / 32, kb = item / nblk, nb = item % nblk, k0 = 64 * kb, n0 = 32 * nb;
#pragma unroll 8
    for (int i = 0; i < 32; ++i) { const int kk = 2 * i + (lane >> 5); float v = W[(size_t)(k0 + kk) * N + n0 + (lane & 31)]; if (g) v *= g[k0 + kk]; scr[kk * 33 + (lane & 31)] = v; }
    asm volatile("s_waitcnt lgkmcnt(0)" ::: "memory");
    const int c = lane & 7;
#pragma unroll
    for (int j = 0; j < 4; ++j) { const int n = (lane >> 3) + 8 * j; const float* s = scr + (8 * c) * 33 + n;
        u32x4 o; o.x = pk2(s[0 * 33], s[1 * 33]); o.y = pk2(s[2 * 33], s[3 * 33]); o.z = pk2(s[4 * 33], s[5 * 33]); o.w = pk2(s[6 * 33], s[7 * 33]);
        const int nd = ZPERM ? zperm(n0 + n) : n0 + n;
        *(u32x4*)(WT + (size_t)(roff + nd) * ldt + coff + k0 + 8 * c) = o; }
    asm volatile("s_waitcnt lgkmcnt(0)" ::: "memory");
}

DI void row_to_bf16_rstd(const float* xrow, bf16_t* orow, float* rstd_out, int lane) {
    const f32x4* xr = (const f32x4*)xrow + lane;
    f32x4 v[4]; float s = 0.f;
#pragma unroll
    for (int j = 0; j < 4; ++j) { v[j] = xr[64 * j]; s += (v[j].x * v[j].x + v[j].y * v[j].y) + (v[j].z * v[j].z + v[j].w * v[j].w); }
    s = wave_sum(s);
    if (lane == 0) *rstd_out = 1.f / sqrtf(s * (1.f / D) + EPS);
    u32x2* o8 = (u32x2*)orow + lane;
#pragma unroll
    for (int j = 0; j < 4; ++j) { u32x2 w; w.x = pk2(v[j].x, v[j].y); w.y = pk2(v[j].z, v[j].w); o8[64 * j] = w; }
}

DI void phase0(const Params& p, float* lds_f) {
    const int tid_ = opaque_tid(), lane = tid_ & 63, wave = tid_ >> 6, gw = blockIdx.x * NWAVES + wave, NGW = gridDim.x * NWAVES;
    unsigned char* ws = p.ws;
    float* scr = lds_f + wave * (64 * 33);
    bf16_t* WinT = (bf16_t*)(ws + WS_WIN); bf16_t* WbrT = (bf16_t*)(ws + WS_WBR); bf16_t* WoutT = (bf16_t*)(ws + WS_WOUT); bf16_t* WqT = (bf16_t*)(ws + WS_WQ);
    bf16_t* WmkvT = (bf16_t*)(ws + WS_WMKV);
    constexpr int I_IN = (D / 64) * (INW / 32), I_BS = (1024 / 64) * (D / 32), I_BM = (512 / 64) * (D / 32), I_OUT = (D / 64) * (D / 32), I_Q = (D / 64) * (2048 / 32), I_MKV = (D / 64) * (D / 32);
    constexpr int NITEMS = I_IN + I_BS + I_BM + I_OUT + I_Q + I_MKV;
    for (int it = gw; it < NITEMS; it += NGW) {
        int r = it;
        if (r < I_IN) { transpose_item<true>(p.w_in, D, INW, WinT, D, 0, 0, p.norm1_g, scr, r, lane); continue; } r -= I_IN;
        if (r < I_BS) { transpose_item<false>(p.w_bswa, 1024, D, WbrT, 2048, 0, 512, nullptr, scr, r, lane); continue; } r -= I_BS;
        if (r < I_BM) { transpose_item<false>(p.w_bmem, 512, D, WbrT, 2048, 0, 1536, nullptr, scr, r, lane); continue; } r -= I_BM;
        if (r < I_OUT) { transpose_item<false>(p.w_out, D, D, WoutT, D, 0, 0, nullptr, scr, r, lane); continue; } r -= I_OUT;
        if (r < I_Q) { transpose_item<false>(p.w_q, D, 2048, WqT, D, 0, 0, p.norm2_g, scr, r, lane); continue; } r -= I_Q;
        transpose_item<false>(p.w_mem_kv, D, D, WmkvT, D, 0, 0, p.mem_norm_g, scr, r, lane);
    }
    {
        const size_t gt0 = (size_t)gw * 64 + lane, NGT0 = (size_t)NGW * 64;
        for (size_t i = gt0; i < (size_t)512 * 1024; i += NGT0) {
            const int n = (int)(i & 1023), cp = (int)(i >> 10), g = cp >> 7;
            const float* wp = p.w_pool + (size_t)cp * 128; const float* sc = p.pool_scale + g * 128; const float* wb = p.w_bpool + (size_t)(g * 128) * 1024 + n;
            float a0 = 0.f, a1 = 0.f, a2 = 0.f, a3 = 0.f;
#pragma unroll 4
            for (int d = 0; d < 128; d += 4) {
                a0 += wp[d] * sc[d] * wb[(size_t)d * 1024]; a1 += wp[d + 1] * sc[d + 1] * wb[(size_t)(d + 1) * 1024];
                a2 += wp[d + 2] * sc[d + 2] * wb[(size_t)(d + 2) * 1024]; a3 += wp[d + 3] * sc[d + 3] * wb[(size_t)(d + 3) * 1024]; }
            const float a = (a0 + a1) + (a2 + a3);
            WbrT[(size_t)n * 2048 + cp] = (bf16_t)f2bf(a);
        }
    }
    bf16_t* xb = (bf16_t*)(ws + WS_XB); float* rstd1 = (float*)(ws + WS_RSTD1);
    for (int m = gw; m < T; m += 2 * NGW) {
        const int m2 = m + NGW;
        const f32x4* xr = (const f32x4*)(p.x + (size_t)m * D) + lane; const f32x4* xr2 = (const f32x4*)(p.x + (size_t)(m2 < T ? m2 : m) * D) + lane;
        f32x4 v[4], v2[4]; float s = 0.f, s2 = 0.f;
#pragma unroll
        for (int j = 0; j < 4; ++j) { v[j] = xr[64 * j]; v2[j] = xr2[64 * j]; }
#pragma unroll
        for (int j = 0; j < 4; ++j) { s += (v[j].x * v[j].x + v[j].y * v[j].y) + (v[j].z * v[j].z + v[j].w * v[j].w); s2 += (v2[j].x * v2[j].x + v2[j].y * v2[j].y) + (v2[j].z * v2[j].z + v2[j].w * v2[j].w); }
        s = wave_sum(s); s2 = wave_sum(s2);
        if (lane == 0) { rstd1[m] = 1.f / sqrtf(s * (1.f / D) + EPS); if (m2 < T) rstd1[m2] = 1.f / sqrtf(s2 * (1.f / D) + EPS); }
        u32x2* o8 = (u32x2*)(xb + (size_t)m * D) + lane; u32x2* o82 = (u32x2*)(xb + (size_t)m2 * D) + lane;
#pragma unroll
        for (int j = 0; j < 4; ++j) { u32x2 wv; wv.x = pk2(v[j].x, v[j].y); wv.y = pk2(v[j].z, v[j].w); o8[64 * j] = wv;
            if (m2 < T) { u32x2 w2; w2.x = pk2(v2[j].x, v2[j].y); w2.y = pk2(v2[j].z, v2[j].w); o82[64 * j] = w2; } }
    }
    bf16_t* memb = (bf16_t*)(ws + WS_MEMB); float* rstdm = (float*)(ws + WS_RSTDM);
    for (int m = gw; m < TMEM; m += NGW) row_to_bf16_rstd(p.mem + (size_t)m * D, memb + (size_t)m * D, rstdm + m, lane);
    const size_t gt = (size_t)gw * 64 + lane, NGT = (size_t)NGW * 64;
    bf16_t* keysb = (bf16_t*)(ws + WS_KEYS);
    for (size_t i = gt; i < (size_t)8 * 2 * 128 * 128 / 4; i += NGT) { const f32x4 v = ((const f32x4*)p.sub_keys)[i]; u32x2 w; w.x = pk2(v.x, v.y); w.y = pk2(v.z, v.w); ((u32x2*)keysb)[i] = w; }
    {
        u32x4* u8 = (u32x4*)(ws + WS_U16); u32x4* v8 = (u32x4*)(ws + WS_V16);
        for (size_t i = gt; i < (size_t)NEXP * D / 16; i += NGT) {
            const f32x4* pu = (const f32x4*)p.peer_u + 4 * i; const f32x4* pv = (const f32x4*)p.peer_v + 4 * i;
            u32x4 ou, ov;
            const f32x4* pg = (const f32x4*)p.norm2_g + ((4 * i) & 255);
#pragma unroll
            for (int j = 0; j < 4; ++j) { const f32x4 a = pu[j] * pg[j] * 32.f, b = pv[j] * 2.f;
                int wa = __builtin_amdgcn_cvt_pk_fp8_f32(a.x, a.y, 0, false); wa = __builtin_amdgcn_cvt_pk_fp8_f32(a.z, a.w, wa, true);
                int wb = __builtin_amdgcn_cvt_pk_fp8_f32(b.x, b.y, 0, false); wb = __builtin_amdgcn_cvt_pk_fp8_f32(b.z, b.w, wb, true);
                ou[j] = (unsigned)wa; ov[j] = (unsigned)wb; }
            u8[i] = ou; v8[i] = ov;
        }
    }
    for (size_t i = gt; i < (size_t)T; i += NGT) { ((float*)(ws + WS_RSTD2))[i] = 0.f; ((float*)(ws + WS_SSQO))[i] = 0.f; }
    float2* rope = (float2*)(ws + WS_ROPE);
    for (size_t i = gt; i < (size_t)T * 32; i += NGT) {
        const int t = (int)(i >> 5), d = (int)(i & 31);
        const float inv = exp2f(-(float)d * (13.287712379549449f / 32.f));
        const float ang = (float)p.pos[t] * inv;
        const double rev = (double)ang * 0.15915494309189535;
        const float fr = (float)(rev - floor(rev));
        rope[i] = make_float2(__builtin_amdgcn_cosf(fr), __builtin_amdgcn_sinf(fr));
    }
}

namespace pg8 {
#define PG8_LAS __attribute__((address_space(3)))
constexpr int BM = 256, BK = 64, HALF = 128, HTB = HALF * BK * 2, STAGE_BYTES = 8 * HTB, NXCD = 8, WGM = 8;
__host__ __device__ __forceinline__ int lds_byte(int r, int c) { const int st = (r >> 4) * 2 + (c >> 5), rr = r & 15, cc = c & 31, ob = rr * 64 + cc * 2; return st * 1024 + (ob ^ (((ob >> 9) & 1) << 5)); }
__host__ __device__ __forceinline__ void stage_rc(int b, int& R, int& C) { const int st = b / 1024, sb = b % 1024, swz = sb ^ (((sb >> 9) & 1) << 5); R = (st >> 1) * 16 + swz / 64; C = (st & 1) * 32 + (swz % 64) / 2; }
__host__ __device__ __forceinline__ int perm32(int rho) { const int n = rho >> 4, i = rho & 15; return 8 * (i >> 2) + 4 * n + (i & 3); }

struct Unit { const char* a; const char* b; int nt, pm, pn, tag; };
DI void tile_of(int L, int nM, int nN, int& pm, int& pn) {
    const int nwg = nM * nN; int wgid = L; { const int q = nwg / NXCD, r = nwg % NXCD, xcd = wgid % NXCD, off = wgid / NXCD; wgid = (xcd < r ? xcd * (q + 1) : r * (q + 1) + (xcd - r) * q) + off; }
    const int nig = WGM * nN, gid = wgid / nig, fm = gid * WGM, gsz = (nM - fm) < WGM ? (nM - fm) : WGM;
    pm = fm + ((wgid % nig) % gsz); pn = (wgid % nig) / gsz;
}
template <class Epi, class Sched>
DI void gemm_phase(PG8_LAS unsigned char* lds, int lda, int ldb, const Sched& S, const Epi& E) {
    int tid = threadIdx.x; asm volatile("" : "+v"(tid));
    const int wid = __builtin_amdgcn_readfirstlane(tid >> 6), wr = wid >> 2, wc = wid & 3, lane = tid & 63, fr = lane & 15, fq = lane >> 4;
    unsigned voffA[2], voffB[2];
#pragma unroll
    for (int i = 0; i < 2; ++i) { int R, C; stage_rc(tid * 16 + i * 8192, R, C); const int Rb = (R & ~31) + perm32(R & 31);
        voffA[i] = (unsigned)(R * lda + C) * 2u; voffB[i] = (unsigned)(Rb * ldb + C) * 2u; }
    const size_t kstep = (size_t)(BK * 2);
    const size_t hstepA = (size_t)HALF * lda * 2, hstepB = (size_t)HALF * ldb * 2;
    const unsigned ldsw = (unsigned)wid * 1024u;
    const int aoff = lds_byte(wr * 64 + fr, fq * 8), boff = lds_byte(wc * 32 + fr, fq * 8);
#define PG8_SA(b, h) (((b) * 2 + (h)) * HTB)
#define PG8_SB(b, h) ((4 + (b) * 2 + (h)) * HTB)
#define PG8_STAGE(bufoff, gbase, voff) do { _Pragma("unroll") for (int _i = 0; _i < 2; ++_i) \
        __builtin_amdgcn_global_load_lds((const unsigned*)((const char*)(gbase) + (voff)[_i]), (PG8_LAS unsigned*)(lds + (bufoff) + ldsw + _i * 8192), 16, 0, 0); } while (0)
#define PG8_LDA(dst, b, h) do { _Pragma("unroll") for (int m = 0; m < 4; ++m) _Pragma("unroll") for (int k = 0; k < 2; ++k) dst[m][k] = *(const PG8_LAS bf16x8*)(lds + PG8_SA(b, h) + aoff + m * 2048 + k * 1024); } while (0)
#define PG8_LDB(dst, b, h) do { _Pragma("unroll") for (int n = 0; n < 2; ++n) _Pragma("unroll") for (int k = 0; k < 2; ++k) dst[n][k] = *(const PG8_LAS bf16x8*)(lds + PG8_SB(b, h) + boff + n * 2048 + k * 1024); } while (0)
#define PG8_MMA(ai, bj, At, Bt) do { __builtin_amdgcn_s_setprio(1); _Pragma("unroll") for (int m = 0; m < 4; ++m) _Pragma("unroll") for (int n = 0; n < 2; ++n) _Pragma("unroll") for (int k = 0; k < 2; ++k) \
        acc[ai][bj][m][n] = __builtin_amdgcn_mfma_f32_16x16x32_bf16(Bt[n][k], At[m][k], acc[ai][bj][m][n], 0, 0, 0); __builtin_amdgcn_s_setprio(0); } while (0)
#define PG8_WAIT_V(n) asm volatile("s_waitcnt vmcnt(" #n ")" ::: "memory")
#define PG8_WAIT_L(n) asm volatile("s_waitcnt lgkmcnt(" #n ")" ::: "memory")
#define PG8_BAR __builtin_amdgcn_s_barrier()
#define PG8_SCHED __builtin_amdgcn_sched_barrier(0)
    Unit cur, nxt; int ui = 0;
    if (!S.next(0, cur)) return;
    f32x4 acc[2][2][4][2];
#pragma unroll
    for (int a = 0; a < 2; ++a)
#pragma unroll
        for (int b = 0; b < 2; ++b)
#pragma unroll
            for (int m = 0; m < 4; ++m)
#pragma unroll
                for (int n = 0; n < 2; ++n) acc[a][b][m][n] = (f32x4){0.f, 0.f, 0.f, 0.f};
    bf16x8 At[4][2], B0[2][2], B1[2][2];
    const char* cA = cur.a; const char* cB = cur.b;
    PG8_STAGE(PG8_SB(0, 0), cB, voffB); PG8_STAGE(PG8_SB(0, 1), cB + hstepB, voffB); PG8_STAGE(PG8_SA(0, 0), cA, voffA); PG8_STAGE(PG8_SA(0, 1), cA + hstepA, voffA);
    if (wr == 1) PG8_BAR;
    PG8_WAIT_V(2); PG8_BAR;
    PG8_STAGE(PG8_SB(1, 0), cB + kstep, voffB); PG8_STAGE(PG8_SA(1, 0), cA + kstep, voffA); PG8_STAGE(PG8_SB(1, 1), cB + hstepB + kstep, voffB);
    PG8_WAIT_V(6); PG8_BAR;
    for (;;) {
        const bool has_next = S.next(ui + 1, nxt);
        const char* nA = has_next ? nxt.a : cA; const char* nB = has_next ? nxt.b : cB;
        const int nt = cur.nt;
        for (int t = 0; t < nt; t += 2) {
            const bool last = (t == nt - 2);
            const char* a1 = cA + (size_t)(t + 1) * kstep;
            const char* a2 = last ? nA : cA + (size_t)(t + 2) * kstep; const char* b2 = last ? nB : cB + (size_t)(t + 2) * kstep;
            const char* a3 = a2 + kstep; const char* b3 = b2 + kstep;
            PG8_LDB(B0, 0, 0); PG8_LDB(B1, 0, 1); PG8_SCHED; PG8_LDA(At, 0, 0); PG8_STAGE(PG8_SA(1, 1), a1 + hstepA, voffA);
            PG8_WAIT_V(8); PG8_WAIT_L(0); PG8_BAR; PG8_MMA(0, 0, At, B0); PG8_MMA(0, 1, At, B1); PG8_BAR; PG8_SCHED;
            PG8_LDA(At, 0, 1); PG8_STAGE(PG8_SB(0, 0), b2, voffB); PG8_STAGE(PG8_SB(0, 1), b2 + hstepB, voffB); PG8_STAGE(PG8_SA(0, 0), a2, voffA);
            PG8_WAIT_V(8); PG8_WAIT_L(0); PG8_BAR; PG8_MMA(1, 0, At, B0); PG8_MMA(1, 1, At, B1); PG8_BAR; PG8_SCHED;
            PG8_LDB(B0, 1, 0); PG8_LDB(B1, 1, 1); PG8_SCHED; PG8_LDA(At, 1, 0); PG8_STAGE(PG8_SA(0, 1), a2 + hstepA, voffA);
            PG8_WAIT_V(8); PG8_WAIT_L(0); PG8_BAR; PG8_MMA(0, 0, At, B0); PG8_MMA(0, 1, At, B1); PG8_BAR; PG8_SCHED;
            PG8_LDA(At, 1, 1); PG8_STAGE(PG8_SB(1, 0), b3, voffB); PG8_STAGE(PG8_SB(1, 1), b3 + hstepB, voffB); PG8_STAGE(PG8_SA(1, 0), a3, voffA);
            PG8_WAIT_V(8); PG8_WAIT_L(0); PG8_BAR; PG8_MMA(1, 0, At, B0); PG8_MMA(1, 1, At, B1); PG8_BAR; PG8_SCHED;
        }
        if (wr == 0) PG8_BAR;
        E(acc, cur, wr, wc, fr, fq);
        if (!has_next) break;
#pragma unroll
        for (int a = 0; a < 2; ++a)
#pragma unroll
            for (int b = 0; b < 2; ++b)
#pragma unroll
                for (int m = 0; m < 4; ++m)
#pragma unroll
                    for (int n = 0; n < 2; ++n) acc[a][b][m][n] = (f32x4){0.f, 0.f, 0.f, 0.f};
        cur = nxt; cA = nA; cB = nB; ++ui;
        if (wr == 1) PG8_BAR;
    }
    PG8_WAIT_V(0);
    PG8_BAR;
#undef PG8_SA
#undef PG8_SB
#undef PG8_STAGE
#undef PG8_LDA
#undef PG8_LDB
#undef PG8_MMA
#undef PG8_WAIT_V
#undef PG8_WAIT_L
#undef PG8_BAR
#undef PG8_SCHED
}
}
typedef f32x4 acc_t[2][2][4][2];

struct SchedPlain {
    const char* A; const char* Bt; int lda, ldb, nM, nN, nt, G, c;
    DI bool next(int i, pg8::Unit& u) const {
        const long L = (long)i * G + c; if (L >= (long)nM * nN) return false;
        pg8::tile_of((int)L, nM, nN, u.pm, u.pn); u.a = A + (size_t)u.pm * 256 * lda * 2; u.b = Bt + (size_t)u.pn * 256 * ldb * 2; u.nt = nt; u.tag = 0; return true;
    }
};
struct SchedZ {
    const char *xb, *win, *memb, *wmkv; int G, c;
    DI bool next(int i, pg8::Unit& u) const {
        const long L = (long)i * G + c; constexpr int NZ = 128 * 21;
        if (L < NZ) { pg8::tile_of((int)L, 128, 21, u.pm, u.pn); u.a = xb + (size_t)u.pm * 256 * 2048; u.b = win + (size_t)u.pn * 256 * 2048; u.nt = 16; u.tag = 0; return true; }
        const int j = (int)(L - NZ); if (j >= 32) return false;
        u.pm = j >> 2; u.pn = j & 3; u.a = memb + (size_t)u.pm * 256 * 2048; u.b = wmkv + (size_t)u.pn * 256 * 2048; u.nt = 16; u.tag = 1; return true;
    }
};
struct SchedGated {
    const char *ycat, *wbr; int G, c;
    DI bool next(int i, pg8::Unit& u) const {
        const int j = i / 3, b = i - 3 * j; const long L = (long)j * G + c; if (L >= 128 * 4) return false;
        pg8::tile_of((int)L, 128, 4, u.pm, u.pn);
        const int koff = (b == 0) ? 0 : (b == 1 ? 512 : 1536);
        u.a = ycat + ((size_t)u.pm * 256 * 2048 + koff) * 2; u.b = wbr + ((size_t)u.pn * 256 * 2048 + koff) * 2; u.nt = (b == 1) ? 16 : 8; u.tag = b; return true;
    }
};

DI u32x4 pack8(const f32x4& a, const f32x4& b) { u32x4 w; w.x = pk2(a[0], a[1]); w.y = pk2(a[2], a[3]); w.z = pk2(b[0], b[1]); w.w = pk2(b[2], b[3]); return w; }
struct EpiZ {
    const float* rstd1; const float* rstdm; const float2* rope; bf16_t *upool, *qr, *kr, *vv, *qm, *gates, *kvm;
    DI void operator()(const acc_t& acc, const pg8::Unit& u, int wr, int wc, int fr_, int fq_) const {
        int l_ = threadIdx.x; asm volatile("" : "+v"(l_)); const int fr = l_ & 15, fq = (l_ >> 4) & 3;
        const int row0 = u.pm * 256 + wr * 64 + fr;
        if (u.tag == 1) {
#pragma unroll
            for (int ai = 0; ai < 2; ++ai)
#pragma unroll
                for (int m = 0; m < 4; ++m) { const int row = row0 + ai * 128 + m * 16; const float rs = rstdm[row];
#pragma unroll
                    for (int bj = 0; bj < 2; ++bj) { const int c = u.pn * 256 + bj * 128 + wc * 32 + 8 * fq;
                        *(u32x4*)(kvm + (size_t)row * 1024 + c) = pack8(acc[ai][bj][m][0] * rs, acc[ai][bj][m][1] * rs); } }
            return;
        }
#pragma unroll
        for (int bj = 0; bj < 2; ++bj) {
            const int cb = u.pn * 256 + bj * 128;
            const int c = cb + wc * 32 + 8 * fq;
#pragma unroll
            for (int ai = 0; ai < 2; ++ai)
#pragma unroll
                for (int m = 0; m < 4; ++m) {
                    const int row = row0 + ai * 128 + m * 16; const float rs = rstd1[row];
                    const f32x4 v0 = acc[ai][bj][m][0] * rs, v1 = acc[ai][bj][m][1] * rs;
                    if (cb < 512) { *(u32x4*)(upool + (size_t)row * 512 + c) = pack8(v0, v1); }
                    else if (cb < 1664) {
                        const bool isq = cb < 1536; const int rel = isq ? c - 512 : c - 1536; const int hrel = rel & 63, d0 = hrel >> 1, hb = rel - hrel;
                        const f32x4 cs0 = *(const f32x4*)(rope + (size_t)row * 32 + d0), cs1 = *(const f32x4*)(rope + (size_t)row * 32 + d0 + 2);
                        const float sc = isq ? 0.125f : 1.f;
                        f32x4 o1, o2;
                        o1[0] = (v0[0] * cs0[0] - v1[0] * cs0[1]) * sc; o2[0] = (v1[0] * cs0[0] + v0[0] * cs0[1]) * sc;
                        o1[1] = (v0[1] * cs0[2] - v1[1] * cs0[3]) * sc; o2[1] = (v1[1] * cs0[2] + v0[1] * cs0[3]) * sc;
                        o1[2] = (v0[2] * cs1[0] - v1[2] * cs1[1]) * sc; o2[2] = (v1[2] * cs1[0] + v0[2] * cs1[1]) * sc;
                        o1[3] = (v0[3] * cs1[2] - v1[3] * cs1[3]) * sc; o2[3] = (v1[3] * cs1[2] + v0[3] * cs1[3]) * sc;
                        bf16_t* dst = isq ? qr + (size_t)row * 1024 + hb + d0 : kr + (size_t)row * 128 + hb + d0;
                        u32x2 w1, w2; w1.x = pk2(o1[0], o1[1]); w1.y = pk2(o1[2], o1[3]); w2.x = pk2(o2[0], o2[1]); w2.y = pk2(o2[2], o2[3]);
                        *(u32x2*)dst = w1; *(u32x2*)(dst + 32) = w2;
                    }
                    else if (cb < 1792) { *(u32x4*)(vv + (size_t)row * 128 + (c - 1664)) = pack8(v0, v1); }
                    else if (cb < 2304) { *(u32x4*)(qm + (size_t)row * 512 + (c - 1792)) = pack8(v0, v1); }
                    else { f32x4 s0, s1;
#pragma unroll
                        for (int e = 0; e < 4; ++e) { s0[e] = sigmoidf(v0[e]); s1[e] = sigmoidf(v1[e]); }
                        *(u32x4*)(gates + (size_t)row * 3072 + (c - 2304)) = pack8(s0, s1); }
                }
        }
    }
};
struct EpiGated {
    const bf16_t* gates; bf16_t* merged;
    DI void operator()(const acc_t& acc, const pg8::Unit& u, int wr, int wc, int fr_, int fq_) const {
        int l_ = threadIdx.x; asm volatile("" : "+v"(l_)); const int fr = l_ & 15, fq = (l_ >> 4) & 3;
        const int row0 = u.pm * 256 + wr * 64 + fr, b = u.tag;
#pragma unroll
        for (int ai = 0; ai < 2; ++ai)
#pragma unroll
            for (int m = 0; m < 4; ++m) { const int row = row0 + ai * 128 + m * 16;
#pragma unroll
                for (int bj = 0; bj < 2; ++bj) { const int c = u.pn * 256 + bj * 128 + wc * 32 + 8 * fq;
                    const u32x4 g = *(const u32x4*)(gates + (size_t)row * 3072 + b * 1024 + c);
                    bf16_t* mp = merged + (size_t)row * 1024 + c;
                    u32x4 old = (u32x4){0u, 0u, 0u, 0u}; if (b > 0) old = *(const u32x4*)mp;
                    const f32x4 a0 = acc[ai][bj][m][0], a1 = acc[ai][bj][m][1];
                    f32x4 r0, r1;
                    r0[0] = bflo(old.x) + bflo(g.x) * a0[0]; r0[1] = bfhi(old.x) + bfhi(g.x) * a0[1]; r0[2] = bflo(old.y) + bflo(g.y) * a0[2]; r0[3] = bfhi(old.y) + bfhi(g.y) * a0[3];
                    r1[0] = bflo(old.z) + bflo(g.z) * a1[0]; r1[1] = bfhi(old.z) + bfhi(g.z) * a1[1]; r1[2] = bflo(old.w) + bflo(g.w) * a1[2]; r1[3] = bfhi(old.w) + bfhi(g.w) * a1[3];
                    *(u32x4*)mp = pack8(r0, r1); } }
    }
};
struct EpiOut {
    const bf16_t* xb; bf16_t* x1b; float* ssq;
    DI void operator()(const acc_t& acc, const pg8::Unit& u, int wr, int wc, int fr_, int fq_) const {
        int l_ = threadIdx.x; asm volatile("" : "+v"(l_)); const int fr = l_ & 15, fq = (l_ >> 4) & 3;
        const int row0 = u.pm * 256 + wr * 64 + fr;
#pragma unroll
        for (int ai = 0; ai < 2; ++ai)
#pragma unroll
            for (int m = 0; m < 4; ++m) { const int row = row0 + ai * 128 + m * 16; float sq = 0.f;
#pragma unroll
                for (int bj = 0; bj < 2; ++bj) { const size_t o = (size_t)row * D + u.pn * 256 + bj * 128 + wc * 32 + 8 * fq;
                    const u32x4 xw = *(const u32x4*)(xb + o);
                    f32x4 v0 = acc[ai][bj][m][0], v1 = acc[ai][bj][m][1];
                    v0[0] += bflo(xw.x); v0[1] += bfhi(xw.x); v0[2] += bflo(xw.y); v0[3] += bfhi(xw.y); v1[0] += bflo(xw.z); v1[1] += bfhi(xw.z); v1[2] += bflo(xw.w); v1[3] += bfhi(xw.w);
                    sq += (v0[0] * v0[0] + v0[1] * v0[1]) + (v0[2] * v0[2] + v0[3] * v0[3]) + (v1[0] * v1[0] + v1[1] * v1[1]) + (v1[2] * v1[2] + v1[3] * v1[3]);
                    *(u32x4*)(x1b + o) = pack8(v0, v1); }
                sq += __shfl_xor(sq, 16); sq += __shfl_xor(sq, 32);
                if (fq == 0) atomicAdd(ssq + row, sq); }
    }
};
struct EpiBf16 {
    bf16_t* O; int ldo;
    DI void operator()(const acc_t& acc, const pg8::Unit& u, int wr, int wc, int fr_, int fq_) const {
        int l_ = threadIdx.x; asm volatile("" : "+v"(l_)); const int fr = l_ & 15, fq = (l_ >> 4) & 3;
        const int row0 = u.pm * 256 + wr * 64 + fr;
#pragma unroll
        for (int ai = 0; ai < 2; ++ai)
#pragma unroll
            for (int m = 0; m < 4; ++m) { const int row = row0 + ai * 128 + m * 16;
#pragma unroll
                for (int bj = 0; bj < 2; ++bj) { const size_t o = (size_t)row * ldo + u.pn * 256 + bj * 128 + wc * 32 + 8 * fq;
                    *(u32x4*)(O + o) = pack8(acc[ai][bj][m][0], acc[ai][bj][m][1]); } }
    }
};

DI void unpack8(const u32x4& w, float (&f)[8]) { f[0] = bflo(w.x); f[1] = bfhi(w.x); f[2] = bflo(w.y); f[3] = bfhi(w.y); f[4] = bflo(w.z); f[5] = bfhi(w.z); f[6] = bflo(w.w); f[7] = bfhi(w.w); }
DI void pooled_phase(const bf16_t* upool, bf16_t* pooled) {
    const int tid = opaque_tid(), lane = tid & 63, gw = blockIdx.x * NWAVES + (tid >> 6), NGW = gridDim.x * NWAVES;
    const int c = lane * 8, w = 2 << (lane >> 4);
    for (int task = gw; task < T / 16; task += NGW) {
        const int t0 = task * 16, s0 = t0 & (SEQ - 1);
        const bf16_t* up = upool + (size_t)t0 * 512 + c;
        float win[8];
#pragma unroll
        for (int e = 0; e < 8; ++e) win[e] = 0.f;
#pragma unroll
        for (int j = 1; j < 16; ++j) {
            if (j < w && s0 - j >= 0) { float f[8]; unpack8(*(const u32x4*)(up - (size_t)j * 512), f);
#pragma unroll
                for (int e = 0; e < 8; ++e) win[e] += f[e]; }
        }
#pragma unroll
        for (int i = 0; i < 16; ++i) {
            const int s = s0 + i;
            float un[8], uo[8];
            unpack8(*(const u32x4*)(up + (size_t)i * 512), un);
            const bool has_old = (s - (w - 1)) >= 0;
            u32x4 ow = {0u, 0u, 0u, 0u}; if (has_old) ow = *(const u32x4*)(up + (ptrdiff_t)(i - (w - 1)) * 512);
            unpack8(ow, uo);
            const int cnt = (s + 1 < w) ? s + 1 : w; const float ic = 1.f / (float)cnt;
            float o[8];
#pragma unroll
            for (int e = 0; e < 8; ++e) { const float tot = win[e] + un[e]; o[e] = tot * ic - un[e]; win[e] = tot - uo[e]; }
            u32x4 ov; ov.x = pk2(o[0], o[1]); ov.y = pk2(o[2], o[3]); ov.z = pk2(o[4], o[5]); ov.w = pk2(o[6], o[7]);
            *(u32x4*)(pooled + (size_t)(t0 + i) * 2048 + c) = ov;
        }
    }
}
typedef __bf16 bf16x2_t __attribute__((ext_vector_type(2)));
typedef float f32x2_t __attribute__((ext_vector_type(2)));
DI unsigned cvtpk(float lo, float hi) { f32x2_t v = {lo, hi}; bf16x2_t b = __builtin_convertvector(v, bf16x2_t); return __builtin_bit_cast(unsigned, b); }
DI int crow(int i, int h) { return (i & 3) + 8 * (i >> 2) + 4 * h; }
#define MFMA32(a, b, c) __builtin_amdgcn_mfma_f32_32x32x16_bf16((a), (b), (c), 0, 0, 0)
DI bf16x8 mk8(unsigned a, unsigned b, unsigned c, unsigned d) { u32x4 w = {a, b, c, d}; return __builtin_bit_cast(bf16x8, w); }

constexpr int SWA_KLD = 72, SWA_VLD = 260, SWA_VT_OFF = 256 * SWA_KLD * 2;
DI void swa_phase(const bf16_t* qr, const bf16_t* kr, const bf16_t* vv, const float* sinks, bf16_t* ycat, unsigned char* lds) {
    const int tid = opaque_tid();
    const int lane = tid & 63, w = tid >> 6, r = lane & 31, h = lane >> 5;
    bf16_t* Ks = (bf16_t*)lds; bf16_t* Vt = (bf16_t*)(lds + SWA_VT_OFF);
    for (int unit = blockIdx.x; unit < 512; unit += gridDim.x) {
        const int kvh = unit & 1, nb = (unit >> 1) & 31, b = unit >> 6;
        const int tq0 = b * SEQ + nb * 128, tk0 = tq0 - 128;
        __syncthreads();
#pragma unroll
        for (int i = 0; i < 4; ++i) {
            const int c = tid + 512 * i, kb = c >> 3, dc = (c & 7) * 8;
            u32x4 kv = {0u, 0u, 0u, 0u}, vx = {0u, 0u, 0u, 0u};
            if (nb > 0 || kb >= 128) { kv = *(const u32x4*)(kr + (size_t)(tk0 + kb) * 128 + kvh * 64 + dc); vx = *(const u32x4*)(vv + (size_t)(tk0 + kb) * 128 + kvh * 64 + dc); }
            *(u32x4*)(Ks + kb * SWA_KLD + dc) = kv;
            bf16_t* vp = Vt + dc * SWA_VLD + kb;
            vp[0 * SWA_VLD] = (bf16_t)(vx.x & 0xffffu); vp[1 * SWA_VLD] = (bf16_t)(vx.x >> 16); vp[2 * SWA_VLD] = (bf16_t)(vx.y & 0xffffu); vp[3 * SWA_VLD] = (bf16_t)(vx.y >> 16);
            vp[4 * SWA_VLD] = (bf16_t)(vx.z & 0xffffu); vp[5 * SWA_VLD] = (bf16_t)(vx.z >> 16); vp[6 * SWA_VLD] = (bf16_t)(vx.w & 0xffffu); vp[7 * SWA_VLD] = (bf16_t)(vx.w >> 16);
        }
        __syncthreads();
        const int hq = kvh * 8 + w; const float sink = sinks[hq];
        for (int qt = 0; qt < 4; ++qt) {
            const bf16_t* qp = qr + (size_t)(tq0 + 32 * qt + r) * 1024 + hq * 64 + 8 * h;
            bf16x8 qf[4];
#pragma unroll
            for (int s = 0; s < 4; ++s) qf[s] = *(const bf16x8*)(qp + 16 * s);
            f32x16 sa[5];
#pragma unroll
            for (int c = 0; c < 5; ++c) {
#pragma unroll
                for (int i = 0; i < 16; ++i) sa[c][i] = 0.f;
#pragma unroll
                for (int s = 0; s < 4; ++s) { const bf16x8 kf = *(const bf16x8*)(Ks + (32 * (qt + c) + r) * SWA_KLD + 16 * s + 8 * h); sa[c] = MFMA32(kf, qf[s], sa[c]); }
            }
            float mx = sink;
#pragma unroll
            for (int c = 0; c < 5; ++c)
#pragma unroll
                for (int i = 0; i < 16; ++i) {
                    const int kk = 32 * c + crow(i, h);
                    bool vis = (c == 0) ? (kk > r) : ((c == 4) ? (kk - 128 <= r) : true);
                    if (nb == 0) vis = vis && (32 * qt + kk >= 128);
                    const float s = vis ? sa[c][i] : -1e30f; sa[c][i] = s; mx = fmaxf(mx, s);
                }
            mx = fmaxf(mx, __shfl_xor(mx, 32));
            float l = 0.f;
#pragma unroll
            for (int c = 0; c < 5; ++c)
#pragma unroll
                for (int i = 0; i < 16; ++i) { const float pz = __expf(sa[c][i] - mx); sa[c][i] = pz; l += pz; }
            l += __shfl_xor(l, 32); l += __expf(sink - mx);
            const float inv = 1.f / l;
            f32x16 oa[2];
#pragma unroll
            for (int i = 0; i < 16; ++i) { oa[0][i] = 0.f; oa[1][i] = 0.f; }
#pragma unroll
            for (int c = 0; c < 5; ++c)
#pragma unroll
                for (int s2 = 0; s2 < 2; ++s2) {
                    const bf16x8 pf = mk8(cvtpk(sa[c][8 * s2 + 0], sa[c][8 * s2 + 1]), cvtpk(sa[c][8 * s2 + 2], sa[c][8 * s2 + 3]), cvtpk(sa[c][8 * s2 + 4], sa[c][8 * s2 + 5]), cvtpk(sa[c][8 * s2 + 6], sa[c][8 * s2 + 7]));
#pragma unroll
                    for (int dt = 0; dt < 2; ++dt) {
                        const bf16_t* va = Vt + (32 * dt + r) * SWA_VLD + 32 * (qt + c) + 16 * s2 + 4 * h;
                        const u32x2 lo = *(const u32x2*)va, hi = *(const u32x2*)(va + 8);
                        oa[dt] = MFMA32(mk8(lo.x, lo.y, hi.x, hi.y), pf, oa[dt]);
                    }
                }
            bf16_t* yp = ycat + (size_t)(tq0 + 32 * qt + r) * 2048 + 512 + hq * 64 + 4 * h;
#pragma unroll
            for (int dt = 0; dt < 2; ++dt)
#pragma unroll
                for (int g4 = 0; g4 < 4; ++g4) { u32x2 o; o.x = cvtpk(oa[dt][4 * g4] * inv, oa[dt][4 * g4 + 1] * inv); o.y = cvtpk(oa[dt][4 * g4 + 2] * inv, oa[dt][4 * g4 + 3] * inv);
                    *(u32x2*)(yp + 32 * dt + 8 * g4) = o; }
        }
    }
}

constexpr int MEM_KLD = 136, MEM_VLD = 260, MEM_VT_OFF = 256 * MEM_KLD * 2;
DI void mem_phase(const bf16_t* qm, const bf16_t* kvm, bf16_t* ycat, unsigned char* lds) {
    const int tid = opaque_tid();
    const int lane = tid & 63, w = tid >> 6, r = lane & 31, h = lane >> 5;
    bf16_t* Ks = (bf16_t*)lds; bf16_t* Vt = (bf16_t*)(lds + MEM_VT_OFF);
    for (int unit = blockIdx.x; unit < 256; unit += gridDim.x) {
        const int qc = unit & 7, hm = (unit >> 3) & 3, b = unit >> 5;
        __syncthreads();
#pragma unroll
        for (int i = 0; i < 8; ++i) {
            const int c = tid + 512 * i, m = c >> 4, dc = (c & 15) * 8;
            const bf16_t* src = kvm + (size_t)(b * MEML + m) * 1024 + hm * 128 + dc;
            const u32x4 kv = *(const u32x4*)src, vx = *(const u32x4*)(src + 512);
            *(u32x4*)(Ks + m * MEM_KLD + dc) = kv;
            bf16_t* vp = Vt + dc * MEM_VLD + m;
            vp[0 * MEM_VLD] = (bf16_t)(vx.x & 0xffffu); vp[1 * MEM_VLD] = (bf16_t)(vx.x >> 16); vp[2 * MEM_VLD] = (bf16_t)(vx.y & 0xffffu); vp[3 * MEM_VLD] = (bf16_t)(vx.y >> 16);
            vp[4 * MEM_VLD] = (bf16_t)(vx.z & 0xffffu); vp[5 * MEM_VLD] = (bf16_t)(vx.z >> 16); vp[6 * MEM_VLD] = (bf16_t)(vx.w & 0xffffu); vp[7 * MEM_VLD] = (bf16_t)(vx.w >> 16);
        }
        __syncthreads();
        for (int qi = 0; qi < 2; ++qi) {
            const int t0 = b * SEQ + qc * 512 + (w * 2 + qi) * 32;
            const bf16_t* qp = qm + (size_t)(t0 + r) * 512 + hm * 128 + 8 * h;
            bf16x8 qf[8];
#pragma unroll
            for (int s = 0; s < 8; ++s) qf[s] = *(const bf16x8*)(qp + 16 * s);
            float mx = -3e38f;
#pragma unroll 1
            for (int c = 0; c < 8; ++c) {
                f32x16 sc;
#pragma unroll
                for (int i = 0; i < 16; ++i) sc[i] = 0.f;
#pragma unroll
                for (int s = 0; s < 8; ++s) { const bf16x8 kf = *(const bf16x8*)(Ks + (32 * c + r) * MEM_KLD + 16 * s + 8 * h); sc = MFMA32(kf, qf[s], sc); }
#pragma unroll
                for (int i = 0; i < 16; ++i) mx = fmaxf(mx, sc[i]);
            }
            mx = fmaxf(mx, __shfl_xor(mx, 32));
            constexpr float SC = 0.08838834764831845f * 1.4426950408889634f;
            float l = 0.f;
            f32x16 oa[4];
#pragma unroll
            for (int dt = 0; dt < 4; ++dt)
#pragma unroll
                for (int i = 0; i < 16; ++i) oa[dt][i] = 0.f;
#pragma unroll 1
            for (int c = 0; c < 8; ++c) {
                f32x16 sc;
#pragma unroll
                for (int i = 0; i < 16; ++i) sc[i] = 0.f;
#pragma unroll
                for (int s = 0; s < 8; ++s) { const bf16x8 kf = *(const bf16x8*)(Ks + (32 * c + r) * MEM_KLD + 16 * s + 8 * h); sc = MFMA32(kf, qf[s], sc); }
#pragma unroll
                for (int i = 0; i < 16; ++i) { const float pz = exp2f((sc[i] - mx) * SC); sc[i] = pz; l += pz; }
#pragma unroll
                for (int s2 = 0; s2 < 2; ++s2) {
                    const bf16x8 pf = mk8(cvtpk(sc[8 * s2 + 0], sc[8 * s2 + 1]), cvtpk(sc[8 * s2 + 2], sc[8 * s2 + 3]), cvtpk(sc[8 * s2 + 4], sc[8 * s2 + 5]), cvtpk(sc[8 * s2 + 6], sc[8 * s2 + 7]));
#pragma unroll
                    for (int dt = 0; dt < 4; ++dt) {
                        const bf16_t* va = Vt + (32 * dt + r) * MEM_VLD + 32 * c + 16 * s2 + 4 * h;
                        const u32x2 lo = *(const u32x2*)va, hi = *(const u32x2*)(va + 8);
                        oa[dt] = MFMA32(mk8(lo.x, lo.y, hi.x, hi.y), pf, oa[dt]);
                    }
                }
            }
            l += __shfl_xor(l, 32);
            const float inv = 1.f / l;
            bf16_t* yp = ycat + (size_t)(t0 + r) * 2048 + 1536 + hm * 128 + 4 * h;
#pragma unroll
            for (int dt = 0; dt < 4; ++dt)
#pragma unroll
                for (int g4 = 0; g4 < 4; ++g4) { u32x2 o; o.x = cvtpk(oa[dt][4 * g4] * inv, oa[dt][4 * g4 + 1] * inv); o.y = cvtpk(oa[dt][4 * g4 + 2] * inv, oa[dt][4 * g4 + 3] * inv);
                    *(u32x2*)(yp + 32 * dt + 8 * g4) = o; }
        }
    }
}

DI unsigned umax_(unsigned a, unsigned b) { return a > b ? a : b; }
DI unsigned umin_(unsigned a, unsigned b) { return a < b ? a : b; }
DI void cexd(unsigned& a, unsigned& b) { const unsigned mx = umax_(a, b), mn = umin_(a, b); a = mx; b = mn; }
DI void sort16_desc(unsigned (&v)[16]) {
#pragma unroll
    for (int k = 2; k <= 16; k <<= 1)
#pragma unroll
        for (int j = k >> 1; j > 0; j >>= 1)
#pragma unroll
            for (int i = 0; i < 16; ++i) { const int l = i ^ j; if (l > i) { if ((i & k) == 0) cexd(v[i], v[l]); else cexd(v[l], v[i]); } }
}
DI void merge16_desc(unsigned (&a)[16], const unsigned (&b)[16]) {
#pragma unroll
    for (int i = 0; i < 16; ++i) a[i] = umax_(a[i], b[15 - i]);
#pragma unroll
    for (int j = 8; j > 0; j >>= 1)
#pragma unroll
        for (int i = 0; i < 16; ++i) { const int l = i ^ j; if (l > i) cexd(a[i], a[l]); }
}
DI unsigned mono(float f) { const unsigned u = __builtin_bit_cast(unsigned, f); return u ^ ((unsigned)((int)u >> 31) | 0x80000000u); }
DI float demono(unsigned m) { const unsigned t = (unsigned)((int)m >> 31); return __builtin_bit_cast(float, m ^ (~t | 0x80000000u)); }
constexpr int TK_KLD = 136, TK_SCR_OFF = 2 * 128 * TK_KLD * 2;
DI void topk_phase(const bf16_t* qp, const bf16_t* keysb, const float* rstd2, int* ids, float* gts, unsigned char* lds) {
    const int tid = opaque_tid();
    const int lane = tid & 63, w = tid >> 6, r = lane & 31, h2 = lane >> 5;
    bf16_t* Kl = (bf16_t*)lds;
    unsigned char* scr = lds + TK_SCR_OFF + w * 2048 + lane * 32;
    int staged = -1;
    for (int unit = blockIdx.x; unit < 1024; unit += gridDim.x) {
        const int hd = unit & 7, tile = unit >> 3;
        if (hd != staged) {
            __syncthreads();
#pragma unroll
            for (int i = 0; i < 8; ++i) { const int c = tid + 512 * i, row = c >> 4, dc = (c & 15) * 8;
                *(u32x4*)(Kl + row * TK_KLD + dc) = *(const u32x4*)(keysb + ((size_t)hd * 256 + row) * 128 + dc); }
            __syncthreads();
            staged = hd;
        }
        const int t0 = tile * 256 + w * 32;
        unsigned K0[16], K1[16];
#pragma unroll
        for (int p = 0; p < 2; ++p) {
            const bf16_t* qrow = qp + (size_t)(t0 + r) * 2048 + hd * 256 + p * 128 + 8 * h2;
            bf16x8 qf[8];
#pragma unroll
            for (int s = 0; s < 8; ++s) qf[s] = *(const bf16x8*)(qrow + 16 * s);
            unsigned blk[4][16];
#pragma unroll
            for (int c = 0; c < 4; ++c) {
                f32x16 sc;
#pragma unroll
                for (int i = 0; i < 16; ++i) sc[i] = 0.f;
#pragma unroll
                for (int s = 0; s < 8; ++s) { const bf16x8 kf = *(const bf16x8*)(Kl + (p * 128 + 32 * c + r) * TK_KLD + 16 * s + 8 * h2); sc = MFMA32(kf, qf[s], sc); }
#pragma unroll
                for (int i = 0; i < 16; ++i) blk[c][i] = (mono(sc[i]) & ~0x7Fu) | (unsigned)(32 * c + crow(i, h2));
                sort16_desc(blk[c]);
            }
            merge16_desc(blk[0], blk[1]); merge16_desc(blk[2], blk[3]); merge16_desc(blk[0], blk[2]);
            unsigned oth[16];
#pragma unroll
            for (int i = 0; i < 16; ++i) oth[i] = (unsigned)__shfl_xor((int)blk[0][i], 32);
            merge16_desc(blk[0], oth);
#pragma unroll
            for (int i = 0; i < 16; ++i) { if (p == 0) K0[i] = blk[0][i]; else K1[i] = blk[0][i]; }
        }
#pragma unroll
        for (int q = 0; q < 4; ++q) {
            ((unsigned*)scr)[q] = (K0[4 * q] & 0x7Fu) | ((K0[4 * q + 1] & 0x7Fu) << 8) | ((K0[4 * q + 2] & 0x7Fu) << 16) | ((K0[4 * q + 3] & 0x7Fu) << 24);
            ((unsigned*)scr)[4 + q] = (K1[4 * q] & 0x7Fu) | ((K1[4 * q + 1] & 0x7Fu) << 8) | ((K1[4 * q + 2] & 0x7Fu) << 16) | ((K1[4 * q + 3] & 0x7Fu) << 24);
        }
        float sx[16], sy[16];
#pragma unroll
        for (int i = 0; i < 16; ++i) { const float s0 = demono(K0[i] & ~0x7Fu), s1 = demono(K1[i] & ~0x7Fu); sx[i] = h2 ? s1 : s0; sy[i] = h2 ? s0 : s1; }
        unsigned ca[16], cb[16];
#pragma unroll
        for (int i = 0; i < 16; ++i) { ca[i] = 0u; cb[i] = 0u; }
#define CAND(n, a, b) do { const unsigned key_ = (mono(sx[a] + sy[b]) & ~0xFFu) | (h2 ? (unsigned)(((b) << 4) | (a)) : (unsigned)(((a) << 4) | (b))); if ((n) < 16) ca[(n) & 15] = key_; else cb[(n) & 15] = key_; } while (0)
            CAND(0, 0, 1);
            CAND(1, 0, 2);
            CAND(2, 0, 3);
            CAND(3, 0, 4);
            CAND(4, 0, 5);
            CAND(5, 0, 6);
            CAND(6, 0, 7);
            CAND(7, 0, 8);
            CAND(8, 0, 9);
            CAND(9, 0, 10);
            CAND(10, 0, 11);
            CAND(11, 0, 12);
            CAND(12, 0, 13);
            CAND(13, 0, 14);
            CAND(14, 0, 15);
            CAND(15, 1, 2);
            CAND(16, 1, 3);
            CAND(17, 1, 4);
            CAND(18, 1, 5);
            CAND(19, 1, 6);
            CAND(20, 1, 7);
            CAND(21, 2, 3);
            CAND(22, 2, 4);
#undef CAND
#pragma unroll
        for (int d = 0; d < 4; ++d) { const unsigned key_ = (mono(sx[d] + sy[d]) & ~0xFFu) | (unsigned)((d << 4) | d); cb[7 + d] = h2 ? 0u : key_; }
        sort16_desc(ca); sort16_desc(cb); merge16_desc(ca, cb);
        unsigned fin[16], cpart[16];
#pragma unroll
        for (int i = 0; i < 16; ++i) cpart[i] = (unsigned)__shfl_xor((int)ca[i], 32);
#pragma unroll
        for (int i = 0; i < 16; ++i) fin[i] = umax_(ca[i], cpart[15 - i]);
        const float rs = 1.f / sqrtf(rstd2[t0 + r] * (1.f / D) + EPS);
        float sv[16], mxv = -3e38f;
#pragma unroll
        for (int i = 0; i < 16; ++i) { sv[i] = demono(fin[i] & ~0xFFu) * rs; mxv = fmaxf(mxv, sv[i]); }
        float den = 0.f;
#pragma unroll
        for (int i = 0; i < 16; ++i) { sv[i] = __expf(sv[i] - mxv); den += sv[i]; }
        const float rden = 1.f / den;
        int oid[8]; float og[8];
#pragma unroll
        for (int j = 0; j < 8; ++j) {
            const unsigned wk = fin[j]; og[j] = sv[j] * rden;
            const unsigned a0 = (wk >> 4) & 15u, a1 = wk & 15u;
            oid[j] = (int)scr[a0] * 128 + (int)scr[16 + a1];
        }
        int* ip = ids + (size_t)(t0 + r) * 128 + hd * 16 + 8 * h2; float* gp = gts + (size_t)(t0 + r) * 128 + hd * 16 + 8 * h2;
        *(u32x4*)ip = (u32x4){(unsigned)oid[0], (unsigned)oid[1], (unsigned)oid[2], (unsigned)oid[3]}; *(u32x4*)(ip + 4) = (u32x4){(unsigned)oid[4], (unsigned)oid[5], (unsigned)oid[6], (unsigned)oid[7]};
        *(f32x4*)gp = (f32x4){og[0], og[1], og[2], og[3]}; *(f32x4*)(gp + 4) = (f32x4){og[4], og[5], og[6], og[7]};
    }
}

typedef _Float16 h2_t __attribute__((ext_vector_type(2)));
template <int CTRL> DI float dpp_f(float v) { return __builtin_bit_cast(float, __builtin_amdgcn_update_dpp(0, __builtin_bit_cast(int, v), CTRL, 0xf, 0xf, true)); }
DI float row16_sum(float v) {
    v += dpp_f<0xB1>(v); v += dpp_f<0x4E>(v); v += dpp_f<0x141>(v); v += dpp_f<0x140>(v); return v; }
DI bf16x2_t as_b2(unsigned w) { return __builtin_bit_cast(bf16x2_t, w); }
DI float dot_row(const u32x4 (&xw)[4][2], const u32x4 (&ru)[4]) {
    float d0 = 0.f, d1 = 0.f;
#pragma unroll
    for (int i = 0; i < 4; ++i)
#pragma unroll
        for (int q = 0; q < 4; ++q) {
            const bf16x2_t z0 = __builtin_amdgcn_cvt_scalef32_pk_bf16_fp8((int)ru[i][q], 1.0f, false), z1 = __builtin_amdgcn_cvt_scalef32_pk_bf16_fp8((int)ru[i][q], 1.0f, true);
            d0 = __builtin_amdgcn_fdot2_f32_bf16(as_b2(xw[i][q >> 1][2 * (q & 1)]), z0, d0, false); d1 = __builtin_amdgcn_fdot2_f32_bf16(as_b2(xw[i][q >> 1][2 * (q & 1) + 1]), z1, d1, false);
        }
    return row16_sum(d0 + d1);
}
template <int VAR>
DI void peer_u_phase(const bf16_t* x1b, const float* ssq2, const unsigned char* u8, const int* ids, const float* gts, float* coef, unsigned char* lds, int lbl, int rnk, int cnt) {
    const int tid = opaque_tid(), lane = tid & 63, wave = tid >> 6, l16 = lane & 15, grp = lane >> 4;
    unsigned* lst = (unsigned*)(lds + wave * 4096 + grp * 1024);
    float* lsg = (float*)(lst + 128);
    const int stride = cnt * NWAVES * 4;
    for (int t0 = (rnk * NWAVES + wave) * 4; t0 < T; t0 += stride) {
        const int t = t0 + grp;
        u32x4 xw[4][2];
#pragma unroll
        for (int i = 0; i < 4; ++i) { xw[i][0] = *(const u32x4*)(x1b + (size_t)t * D + (i * 16 + l16) * 16); xw[i][1] = *(const u32x4*)(x1b + (size_t)t * D + (i * 16 + l16) * 16 + 8); }
        int idj[8]; float gtj[8];
#pragma unroll
        for (int j = 0; j < 8; ++j) { idj[j] = ids[(size_t)t * 128 + l16 + 16 * j]; gtj[j] = gts[(size_t)t * 128 + l16 + 16 * j]; }
        const float rs = (1.f / 32.f) / sqrtf(ssq2[t] * (1.f / D) + EPS);
        int n = 0;
#pragma unroll
        for (int j = 0; j < 8; ++j) {
            const bool f = (idj[j] >> 11) == lbl;
            const unsigned gm = (unsigned)(__ballot(f) >> (16 * grp)) & 0xffffu;
            if (f) { const int pos = n + __popc(gm & ((1u << l16) - 1u)); lst[pos] = (unsigned)(l16 + 16 * j) | ((unsigned)idj[j] << 8); lsg[pos] = gtj[j]; }
            n += __popc(gm);
        }
        const int nmax = max(max(__builtin_amdgcn_readlane(n, 0), __builtin_amdgcn_readlane(n, 16)), max(__builtin_amdgcn_readlane(n, 32), __builtin_amdgcn_readlane(n, 48)));
        float res0 = 0.f, res1 = 0.f; int kk0 = 0, kk1 = 0;
        float* co = coef + (size_t)t * 128;
        const int nlast = n > 0 ? n - 1 : 0;
#define U_FETCH(R, EX, GT, ROWS) do { const int e_ = (R) < n ? (R) : nlast; EX = lst[e_]; GT = lsg[e_]; \
            const u32x4* ur_ = (const u32x4*)(u8 + (size_t)((EX >> 8) & 16383u) * D) + l16; \
            _Pragma("unroll") for (int i = 0; i < 4; ++i) { if (VAR & 1) ROWS[i] = (u32x4){EX, EX * 3u, EX * 5u, EX * 7u + i}; else ROWS[i] = ur_[i * 16]; } } while (0)
#define U_REDUCE(R, EX, GT, ROWS) do { float d_; \
            if (VAR & 2) { unsigned za = 0u; _Pragma("unroll") for (int i = 0; i < 4; ++i) za ^= ROWS[i].x ^ ROWS[i].y ^ ROWS[i].z ^ ROWS[i].w ^ xw[i][0].x; d_ = row16_sum((float)(za & 0xffu)) * rs; } \
            else d_ = dot_row(xw, ROWS) * rs; \
            const float c_ = GT * gelu_tanh(d_) * 0.5f; const int k_ = (int)(EX & 127u); const bool valid_ = (R) < n;     \
            if (valid_ && l16 == ((R) & 15)) { if ((R) < 16) { res0 = c_; kk0 = k_; } else if ((R) < 32) { res1 = c_; kk1 = k_; } } \
            if ((R) >= 32 && valid_ && l16 == 0) co[k_] = c_;     } while (0)
        unsigned exA, exB; float gtA, gtB; u32x4 rowA[4], rowB[4];
        if (nmax > 0) U_FETCH(0, exA, gtA, rowA);
        for (int r = 0; r < nmax; r += 2) {
            U_FETCH(r + 1, exB, gtB, rowB);
            U_REDUCE(r, exA, gtA, rowA);
            U_FETCH(r + 2, exA, gtA, rowA);
            U_REDUCE(r + 1, exB, gtB, rowB);
        }
#undef U_FETCH
#undef U_REDUCE
        if (l16 < n) co[kk0] = res0;
        if (16 + l16 < n) co[kk1] = res1;
    }
}
DI float swz_xor4(float v) { return __builtin_bit_cast(float, __builtin_amdgcn_ds_swizzle(__builtin_bit_cast(int, v), 0x101F)); }
DI float* partial_base(unsigned char* ws, int x) { return (float*)(ws + (x < 4 ? 42 * MiB + (size_t)x * 16 * MiB : 170 * MiB + (size_t)(x - 4) * 16 * MiB)); }
template <int VAR>
DI void peer_u2_phase(const bf16_t* x1b, const unsigned char* u8, const int* ids, float* part, unsigned char* lds, int lbl, int rnk, int cnt) {
    const int tid = opaque_tid(), lane = tid & 63, wave = tid >> 6, g8 = lane >> 3, s8 = lane & 7;
    constexpr int LST = 132;
    int* lid = (int*)(lds + wave * (2 * 8 * LST * 4)); float* lpa = (float*)(lid + 8 * LST);
    const int stride = cnt * NWAVES * 8;
    const unsigned char* ubase = u8 + lbl * 128 + s8 * 16;
    const bool b4 = (s8 & 4) != 0, b2 = (s8 & 2) != 0, b1 = (s8 & 1) != 0;
    for (int t0 = (rnk * NWAVES + wave) * 8; t0 < T; t0 += stride) {
#pragma unroll
        for (int j = 0; j < 4; ++j) { const int f = lane * 4 + 256 * j, tk = f >> 7, k = f & 127; *(u32x4*)(lid + tk * LST + k) = *(const u32x4*)(ids + (size_t)t0 * 128 + f); }
        const size_t xo_ = (size_t)(t0 + g8) * D + lbl * 128 + 16 * s8;
        const u32x4 xa = *(const u32x4*)(x1b + xo_), xb2 = *(const u32x4*)(x1b + xo_ + 8);
        const int* myid = lid + g8 * LST; float* mypa = lpa + g8 * LST;
#pragma unroll 2
        for (int k8 = 0; k8 < 128; k8 += 8) {
            const u32x4 idq0 = *(const u32x4*)(myid + k8), idq1 = *(const u32x4*)(myid + k8 + 4);
            u32x4 rw[8];
#pragma unroll
            for (int i = 0; i < 8; ++i) { const unsigned id = i < 4 ? idq0[i & 3] : idq1[i & 3]; if (VAR & 1) rw[i] = (u32x4){id, id * 3u, id * 5u, id * 7u}; else rw[i] = *(const u32x4*)(ubase + (size_t)id * D); }
            float pp[8];
#pragma unroll
            for (int i = 0; i < 8; ++i) {
                if (VAR & 2) { pp[i] = (float)((rw[i].x ^ rw[i].y ^ rw[i].z ^ rw[i].w ^ xa.x) & 0xffu); continue; }
                float d0 = 0.f, d1 = 0.f;
#pragma unroll
                for (int q = 0; q < 4; ++q) {
                    const bf16x2_t z0 = __builtin_amdgcn_cvt_scalef32_pk_bf16_fp8((int)rw[i][q], 1.0f, false), z1 = __builtin_amdgcn_cvt_scalef32_pk_bf16_fp8((int)rw[i][q], 1.0f, true);
                    const unsigned x0 = q < 2 ? xa[2 * q] : xb2[2 * q - 4], x1 = q < 2 ? xa[2 * q + 1] : xb2[2 * q - 3];
                    d0 = __builtin_amdgcn_fdot2_f32_bf16(as_b2(x0), z0, d0, false); d1 = __builtin_amdgcn_fdot2_f32_bf16(as_b2(x1), z1, d1, false);
                }
                pp[i] = d0 + d1;
            }
            float q4[4], q2[2];
#pragma unroll
            for (int j = 0; j < 4; ++j) { const float keep = b4 ? pp[j + 4] : pp[j], send = b4 ? pp[j] : pp[j + 4]; q4[j] = keep + swz_xor4(send); }
#pragma unroll
            for (int j = 0; j < 2; ++j) { const float keep = b2 ? q4[j + 2] : q4[j], send = b2 ? q4[j] : q4[j + 2]; q2[j] = keep + dpp_f<0x4E>(send); }
            const float keep = b1 ? q2[1] : q2[0], send = b1 ? q2[0] : q2[1];
            mypa[k8 + s8] = keep + dpp_f<0xB1>(send);
        }
        float* pg = part + (size_t)t0 * 128;
#pragma unroll
        for (int j = 0; j < 4; ++j) { const int f = lane * 4 + 256 * j, tk = f >> 7, k = f & 127; *(f32x4*)(pg + f) = *(const f32x4*)(lpa + tk * LST + k); }
    }
}
DI void peer_combine_phase(unsigned char* ws, const float* ssq2, const float* gts, float* coef) {
    const size_t gt = (size_t)blockIdx.x * NTHREADS + opaque_tid(), NGT = (size_t)gridDim.x * NTHREADS;
    for (size_t i = gt; i < (size_t)T * 32; i += NGT) {
        const int t = (int)(i >> 5);
        f32x4 a = ((const f32x4*)partial_base(ws, 0))[i];
#pragma unroll
        for (int x = 1; x < 8; ++x) a += ((const f32x4*)partial_base(ws, x))[i];
        const float rs = (1.f / 32.f) / sqrtf(ssq2[t] * (1.f / D) + EPS);
        const f32x4 g = ((const f32x4*)gts)[i];
        ((f32x4*)coef)[i] = (f32x4){g.x * gelu_tanh(a.x * rs) * 0.5f, g.y * gelu_tanh(a.y * rs) * 0.5f, g.z * gelu_tanh(a.z * rs) * 0.5f, g.w * gelu_tanh(a.w * rs) * 0.5f};
    }
}
template <int VAR>
DI void peer_v_phase(const bf16_t* x1in, bf16_t* xout, const unsigned char* v8, const int* ids, const float* coef, float* ssqo, unsigned char* lds, int lbl, int rnk, int cnt) {
    const int tid = opaque_tid(), lane = tid & 63, wave = tid >> 6, g8 = lane >> 3, s8 = lane & 7;
    constexpr int LST = 132;
    int* lid = (int*)(lds + wave * (2 * 8 * LST * 4)); float* lco = (float*)(lid + 8 * LST);
    const int stride = cnt * NWAVES * 8;
    const unsigned char* vbase = v8 + lbl * 128 + s8 * 16;
    for (int t0 = (rnk * NWAVES + wave) * 8; t0 < T; t0 += stride) {
#pragma unroll
        for (int j = 0; j < 4; ++j) { const int f = lane * 4 + 256 * j, tk = f >> 7, k = f & 127;
            *(u32x4*)(lid + tk * LST + k) = *(const u32x4*)(ids + (size_t)t0 * 128 + f); *(f32x4*)(lco + tk * LST + k) = *(const f32x4*)(coef + (size_t)t0 * 128 + f); }
        f32x2_t acc[8];
#pragma unroll
        for (int j = 0; j < 8; ++j) acc[j] = (f32x2_t){0.f, 0.f};
        const int* myid = lid + g8 * LST; const float* myco = lco + g8 * LST;
#pragma unroll 2
        for (int k4 = 0; k4 < 128; k4 += 4) {
            const u32x4 idq = *(const u32x4*)(myid + k4); const f32x4 coq = *(const f32x4*)(myco + k4);
            u32x4 rw[4];
#pragma unroll
            for (int i = 0; i < 4; ++i) { if (VAR & 1) rw[i] = (u32x4){idq[i], idq[i] * 3u, idq[i] * 5u, idq[i] * 7u}; else rw[i] = *(const u32x4*)(vbase + (size_t)idq[i] * D); }
#pragma unroll
            for (int i = 0; i < 4; ++i) { const f32x2_t cc = {coq[i], coq[i]};
                if (VAR & 2) { acc[i].x += __builtin_bit_cast(float, (rw[i].x ^ rw[i].y ^ rw[i].z ^ rw[i].w) & 0x3fffffffu) * coq[i]; continue; }
#pragma unroll
                for (int q = 0; q < 4; ++q) { const f32x2_t a = __builtin_amdgcn_cvt_pk_f32_fp8((int)rw[i][q], false), b = __builtin_amdgcn_cvt_pk_f32_fp8((int)rw[i][q], true);
                    acc[2 * q] = __builtin_elementwise_fma(a, cc, acc[2 * q]); acc[2 * q + 1] = __builtin_elementwise_fma(b, cc, acc[2 * q + 1]); } }
        }
        const size_t xo_ = (size_t)(t0 + g8) * D + lbl * 128 + 16 * s8;
        const u32x4 xa = *(const u32x4*)(x1in + xo_), xb2 = *(const u32x4*)(x1in + xo_ + 8);
        float o[16];
        o[0] = bflo(xa.x) + acc[0].x; o[1] = bfhi(xa.x) + acc[0].y; o[2] = bflo(xa.y) + acc[1].x; o[3] = bfhi(xa.y) + acc[1].y; o[4] = bflo(xa.z) + acc[2].x; o[5] = bfhi(xa.z) + acc[2].y; o[6] = bflo(xa.w) + acc[3].x; o[7] = bfhi(xa.w) + acc[3].y;
        o[8] = bflo(xb2.x) + acc[4].x; o[9] = bfhi(xb2.x) + acc[4].y; o[10] = bflo(xb2.y) + acc[5].x; o[11] = bfhi(xb2.y) + acc[5].y; o[12] = bflo(xb2.z) + acc[6].x; o[13] = bfhi(xb2.z) + acc[6].y; o[14] = bflo(xb2.w) + acc[7].x; o[15] = bfhi(xb2.w) + acc[7].y;
        float ss = 0.f;
#pragma unroll
        for (int e = 0; e < 16; ++e) ss += o[e] * o[e];
        ss += dpp_f<0xB1>(ss); ss += dpp_f<0x4E>(ss); ss += dpp_f<0x141>(ss);
        if (s8 == 0) atomicAdd(ssqo + t0 + g8, ss);
        u32x4 w0, w1; w0.x = pk2(o[0], o[1]); w0.y = pk2(o[2], o[3]); w0.z = pk2(o[4], o[5]); w0.w = pk2(o[6], o[7]); w1.x = pk2(o[8], o[9]); w1.y = pk2(o[10], o[11]); w1.z = pk2(o[12], o[13]); w1.w = pk2(o[14], o[15]);
        *(u32x4*)(xout + xo_) = w0; *(u32x4*)(xout + xo_ + 8) = w1;
    }
}
DI void peer_final_phase(const bf16_t* xo, const float* ssqo, const float* gf, float* out) {
    const int tid = opaque_tid(), lane = tid & 63, gw = blockIdx.x * NWAVES + (tid >> 6), NGW = gridDim.x * NWAVES;
    f32x4 g[4];
#pragma unroll
    for (int q = 0; q < 4; ++q) g[q] = *(const f32x4*)(gf + lane * 16 + 4 * q);
    for (int t = gw; t < T; t += NGW) {
        const u32x4 w0 = *(const u32x4*)(xo + (size_t)t * D + lane * 16), w1 = *(const u32x4*)(xo + (size_t)t * D + lane * 16 + 8);
        const float rf = 1.f / sqrtf(ssqo[t] * (1.f / D) + EPS);
        f32x4* po = (f32x4*)(out + (size_t)t * D + lane * 16);
        po[0] = (f32x4){bflo(w0.x), bfhi(w0.x), bflo(w0.y), bfhi(w0.y)} * rf * g[0]; po[1] = (f32x4){bflo(w0.z), bfhi(w0.z), bflo(w0.w), bfhi(w0.w)} * rf * g[1];
        po[2] = (f32x4){bflo(w1.x), bfhi(w1.x), bflo(w1.y), bfhi(w1.y)} * rf * g[2]; po[3] = (f32x4){bflo(w1.z), bfhi(w1.z), bflo(w1.w), bfhi(w1.w)} * rf * g[3];
    }
}

#define LAS __attribute__((address_space(3)))
#define XB_TMO      128
#define XB_XCNT(j)  (256  + 64 * (j))
#define XB_XSUB(j)  (1280 + 64 * (j))
#define XB_XGEN(j)  (2304 + 64 * (j))
#define XB_TOP      3328
#define XB_TOPGEN   3392
#define XCD_BAR_WORDS 3456
#define XB_SPIN_CAP (1u << 18)
DI unsigned xb_ld(unsigned* p)              { return __hip_atomic_load(p, __ATOMIC_RELAXED, __HIP_MEMORY_SCOPE_AGENT); }
DI unsigned xb_add(unsigned* p, unsigned v) { return __hip_atomic_fetch_add(p, v, __ATOMIC_RELAXED, __HIP_MEMORY_SCOPE_AGENT); }
DI unsigned xb_xcc_id() { return (unsigned)__builtin_amdgcn_s_getreg((3 << 11) | 20) & 0xFu; }
#define XB_SPIN(cond, bar) do { unsigned _sp = 0; while (cond) { __builtin_amdgcn_s_sleep(1); \
    if ((++_sp & 255u) == 0u) { if (xb_ld(&(bar)[XB_TMO])) break; if (_sp > XB_SPIN_CAP) { atomicAdd(&(bar)[XB_TMO], 1u); break; } } } } while (0)
struct XcdBarrier { unsigned* bar; unsigned x; volatile LAS unsigned* st; };
DI XcdBarrier xcd_barrier_post(unsigned* bar, volatile LAS unsigned* st) {
    XcdBarrier b; b.bar = bar; b.x = xb_xcc_id(); b.st = st;
    if (threadIdx.x == 0) st[2] = xb_add(&bar[XB_XCNT(b.x)], 1u);
    return b;
}
DI void xcd_barrier_complete(unsigned* bar, unsigned x, unsigned& nloc, unsigned& nx) {
    const unsigned G = gridDim.x * gridDim.y * gridDim.z;
    unsigned sum, cnt, mine, sp = 0u;
    for (;;) {
        sum = 0u; cnt = 0u; mine = 0u;
#pragma unroll
        for (unsigned j = 0; j < 16; ++j) { const unsigned c = xb_ld(&bar[XB_XCNT(j)]); sum += c; cnt += (c > 0u) ? 1u : 0u; mine = (j == x) ? c : mine; }
        if (sum == G) break;
        __builtin_amdgcn_s_sleep(1);
        if ((++sp & 255u) == 0u) { if (xb_ld(&bar[XB_TMO])) break; if (sp > XB_SPIN_CAP) { atomicAdd(&bar[XB_TMO], 1u); break; } }
    }
    nloc = mine > 0u ? mine : 1u; nx = cnt > 0u ? cnt : 1u;
}
DI void xcd_barrier(const XcdBarrier& b) {
    asm volatile("s_waitcnt vmcnt(0)" ::: "memory");
    __syncthreads();
    if (threadIdx.x == 0) {
        unsigned* bar = b.bar;
        __builtin_amdgcn_s_waitcnt(0);
        unsigned nloc = b.st[0], nx = b.st[1];
        if (nloc == 0u) { xcd_barrier_complete(bar, b.x, nloc, nx); b.st[0] = nloc; b.st[1] = nx; }
        const unsigned old = xb_add(&bar[XB_XSUB(b.x)], 1u);
        const unsigned gen = old / nloc;
        if (old + 1u == (gen + 1u) * nloc) {
            __builtin_amdgcn_fence(__ATOMIC_RELEASE, "agent");
            asm volatile("s_waitcnt vmcnt(0)" ::: "memory");
            const unsigned og = xb_add(&bar[XB_TOP], 1u);
            const unsigned tg = og / nx;
            if (og + 1u == (tg + 1u) * nx) xb_add(&bar[XB_TOPGEN], 1u);
            else XB_SPIN(xb_ld(&bar[XB_TOPGEN]) == tg, bar);
            __builtin_amdgcn_fence(__ATOMIC_ACQUIRE, "agent");
            xb_add(&bar[XB_XGEN(b.x)], 1u);
            asm volatile("s_waitcnt vmcnt(0)" ::: "memory");
        } else {
            XB_SPIN(xb_ld(&bar[XB_XGEN(b.x)]) == gen, bar);
            __builtin_amdgcn_fence(__ATOMIC_ACQUIRE, "agent");
            asm volatile("s_waitcnt vmcnt(0)" ::: "memory");
        }
    }
    __syncthreads();
}

#ifndef DUP_PHASE
#define DUP_PHASE -1
#endif
#ifndef PROBE_VAR
#define PROBE_VAR 0
#endif
constexpr int LDS_BYTES = 147456;
__global__ void __launch_bounds__(NTHREADS, 2) fwd_kernel(Params p) {
    extern __shared__ __attribute__((aligned(16))) unsigned char lds[];
    cg::grid_group grid = cg::this_grid();
    volatile LAS unsigned* bst = (volatile LAS unsigned*)((LAS unsigned char*)lds + (LDS_BYTES - 64));
    if (threadIdx.x < 4) bst[threadIdx.x] = 0u;
    __syncthreads();
    const XcdBarrier xbar = xcd_barrier_post((unsigned*)p.ws, bst);
    const int NGW = gridDim.x * NWAVES, G = gridDim.x, cu = blockIdx.x;
    unsigned char* ws = p.ws;
    PG8_LAS unsigned char* ldsl = (PG8_LAS unsigned char*)lds;
    bf16_t* ycat = (bf16_t*)p.out;

    for (int rep_ = 0; rep_ < (DUP_PHASE == 0 ? 2 : 1); ++rep_) { phase0(p, (float*)lds);
    grid.sync(); }
    for (int rep_ = 0; rep_ < (DUP_PHASE == 1 ? 2 : 1); ++rep_) {
        EpiZ E{(const float*)(ws + WS_RSTD1), (const float*)(ws + WS_RSTDM), (const float2*)(ws + WS_ROPE), (bf16_t*)(ws + WS_UPOOL), (bf16_t*)(ws + WS_QR), (bf16_t*)(ws + WS_KR), (bf16_t*)(ws + WS_VV), (bf16_t*)(ws + WS_QM), (bf16_t*)(ws + WS_GATES), (bf16_t*)(ws + WS_KVM)};
        SchedZ S{(const char*)(ws + WS_XB), (const char*)(ws + WS_WIN), (const char*)(ws + WS_MEMB), (const char*)(ws + WS_WMKV), G, cu};
        pg8::gemm_phase(ldsl, 1024, 1024, S, E);
    xcd_barrier(xbar); }
    for (int rep_ = 0; rep_ < (DUP_PHASE == 2 ? 2 : 1); ++rep_) {
    pooled_phase((const bf16_t*)(ws + WS_UPOOL), ycat);
    swa_phase((const bf16_t*)(ws + WS_QR), (const bf16_t*)(ws + WS_KR), (const bf16_t*)(ws + WS_VV), p.sinks, ycat, lds);
    mem_phase((const bf16_t*)(ws + WS_QM), (const bf16_t*)(ws + WS_KVM), ycat, lds);
    xcd_barrier(xbar); }
    for (int rep_ = 0; rep_ < (DUP_PHASE == 3 ? 2 : 1); ++rep_) {
        EpiGated E{(const bf16_t*)(ws + WS_GATES), (bf16_t*)(ws + WS_MERGED)};
        SchedGated S{(const char*)ycat, (const char*)(ws + WS_WBR), G, cu};
        pg8::gemm_phase(ldsl, 2048, 2048, S, E);
    xcd_barrier(xbar); }
    for (int rep_ = 0; rep_ < (DUP_PHASE == 4 ? 2 : 1); ++rep_) {
        EpiOut E{(const bf16_t*)(ws + WS_XB), (bf16_t*)(ws + WS_X1B), (float*)(ws + WS_RSTD2)};
        SchedPlain S{(const char*)(ws + WS_MERGED), (const char*)(ws + WS_WOUT), 1024, 1024, 128, 4, 16, G, cu};
        pg8::gemm_phase(ldsl, 1024, 1024, S, E);
    xcd_barrier(xbar); }
    for (int rep_ = 0; rep_ < (DUP_PHASE == 5 ? 2 : 1); ++rep_) {
        EpiBf16 E{(bf16_t*)(ws + WS_QP), 2048};
        SchedPlain S{(const char*)(ws + WS_X1B), (const char*)(ws + WS_WQ), 1024, 1024, 128, 8, 16, G, cu};
        pg8::gemm_phase(ldsl, 1024, 1024, S, E);
    xcd_barrier(xbar); }
    for (int rep_ = 0; rep_ < (DUP_PHASE == 6 ? 2 : 1); ++rep_) {
    topk_phase((const bf16_t*)(ws + WS_QP), (const bf16_t*)(ws + WS_KEYS), (const float*)(ws + WS_RSTD2), (int*)(ws + WS_IDS), (float*)(ws + WS_GTS), lds);
    xcd_barrier(xbar); }
    int lbl, rnk, cnt;
    {
        unsigned* bar = (unsigned*)p.ws; unsigned sum = 0u, mine = 0u; bool ok = xbar.x < 8u;
#pragma unroll
        for (unsigned j = 0; j < 8; ++j) { const unsigned c = xb_ld(&bar[XB_XCNT(j)]); sum += c; ok = ok && (c > 0u); mine = (j == xbar.x) ? c : mine; }
        ok = ok && (sum == (unsigned)G);
        lbl = ok ? (int)xbar.x : (cu & 7); rnk = ok ? (int)bst[2] : (cu >> 3); cnt = ok ? (int)mine : ((G - (cu & 7) + 7) >> 3);
        lbl = __builtin_amdgcn_readfirstlane(lbl); rnk = __builtin_amdgcn_readfirstlane(rnk); cnt = __builtin_amdgcn_readfirstlane(cnt);
    }
    if (DUP_PHASE == 7) {
        peer_u2_phase<PROBE_VAR>((const bf16_t*)(ws + WS_X1B), (const unsigned char*)(ws + WS_U16), (const int*)(ws + WS_IDS), partial_base(ws, lbl), lds, lbl, rnk, cnt);
        xcd_barrier(xbar); }
    peer_u2_phase<0>((const bf16_t*)(ws + WS_X1B), (const unsigned char*)(ws + WS_U16), (const int*)(ws + WS_IDS), partial_base(ws, lbl), lds, lbl, rnk, cnt);
    xcd_barrier(xbar);
    peer_combine_phase(ws, (const float*)(ws + WS_RSTD2), (const float*)(ws + WS_GTS), (float*)(ws + WS_COEF));
    xcd_barrier(xbar);
    if (DUP_PHASE == 8) {
        peer_v_phase<PROBE_VAR>((const bf16_t*)(ws + WS_X1B), (bf16_t*)(ws + WS_MERGED), (const unsigned char*)(ws + WS_V16), (const int*)(ws + WS_IDS), (const float*)(ws + WS_COEF), (float*)(ws + WS_RSTD1), lds, lbl, rnk, cnt);
        xcd_barrier(xbar); }
    peer_v_phase<0>((const bf16_t*)(ws + WS_X1B), (bf16_t*)(ws + WS_X1B), (const unsigned char*)(ws + WS_V16), (const int*)(ws + WS_IDS), (const float*)(ws + WS_COEF), (float*)(ws + WS_SSQO), lds, lbl, rnk, cnt);
    xcd_barrier(xbar);
    for (int rep_ = 0; rep_ < (DUP_PHASE == 9 ? 2 : 1); ++rep_)
    peer_final_phase((const bf16_t*)(ws + WS_X1B), (const float*)(ws + WS_SSQO), p.final_g, p.out);
}

extern "C" void kernel_launch(void* const* d_in, const int* in_sizes, int n_in, void* d_out, int out_size, void* d_ws, size_t ws_size, hipStream_t stream) {
    static int grid_blocks = 0;
    if (grid_blocks == 0) {
        if (n_in != 20 || out_size != T * D || ws_size < WS_END) { fprintf(stderr, "kernel_launch: unexpected shapes: n_in %d out %d ws %zu\n", n_in, out_size, ws_size); grid_blocks = -1; return; }
        int dev = 0, cus = 0, per_cu = 0;
        (void)hipGetDevice(&dev);
        (void)hipDeviceGetAttribute(&cus, hipDeviceAttributeMultiprocessorCount, dev);
        if (hipFuncSetAttribute((const void*)fwd_kernel, hipFuncAttributeMaxDynamicSharedMemorySize, LDS_BYTES) != hipSuccess) { fprintf(stderr, "kernel_launch: hipFuncSetAttribute failed\n"); grid_blocks = -1; return; }
        (void)hipOccupancyMaxActiveBlocksPerMultiprocessor(&per_cu, (const void*)fwd_kernel, NTHREADS, LDS_BYTES);
        if (per_cu < 1) { fprintf(stderr, "kernel_launch: occupancy query says %d blocks per CU\n", per_cu); grid_blocks = -1; return; }
        grid_blocks = cus * per_cu;
        fprintf(stderr, "kernel_launch: cus %d per_cu %d grid %d ws %zu\n", cus, per_cu, grid_blocks, ws_size);
    }
    if (grid_blocks < 0) return;
    Params p{};
    p.x = (const float*)d_in[0]; p.mem = (const float*)d_in[1]; p.pos = (const int*)d_in[2]; p.norm1_g = (const float*)d_in[3]; p.mem_norm_g = (const float*)d_in[4];
    p.w_in = (const float*)d_in[5]; p.w_pool = (const float*)d_in[6]; p.pool_scale = (const float*)d_in[7]; p.sinks = (const float*)d_in[8]; p.w_mem_kv = (const float*)d_in[9];
    p.w_bpool = (const float*)d_in[10]; p.w_bswa = (const float*)d_in[11]; p.w_bmem = (const float*)d_in[12]; p.w_out = (const float*)d_in[13]; p.norm2_g = (const float*)d_in[14];
    p.w_q = (const float*)d_in[15]; p.sub_keys = (const float*)d_in[16]; p.peer_u = (const float*)d_in[17]; p.peer_v = (const float*)d_in[18]; p.final_g = (const float*)d_in[19];
    p.out = (float*)d_out; p.ws = (unsigned char*)d_ws;
    (void)hipMemsetAsync(d_ws, 0, 16384, stream);
    void* args[] = {&p};
    hipError_t e = hipLaunchCooperativeKernel((const void*)fwd_kernel, dim3(grid_blocks), dim3(NTHREADS), args, LDS_BYTES, stream);
    if (e != hipSuccess) fprintf(stderr, "cooperative launch failed: %s (grid %d)\n", hipGetErrorString(e), grid_blocks);
}
```

```cpp
#include <hip/hip_runtime.h>
#include <hip/hip_cooperative_groups.h>
#include <cstdio>
#include <cstdint>
namespace cg = cooperative_groups;

#define DI __device__ __forceinline__
typedef unsigned short bf16_t;
typedef _Float16 f16_t;
typedef short bf16x8 __attribute__((ext_vector_type(8)));
typedef float f32x4 __attribute__((ext_vector_type(4)));
typedef float f32x16 __attribute__((ext_vector_type(16)));
typedef unsigned u32x4 __attribute__((ext_vector_type(4)));
typedef unsigned u32x2 __attribute__((ext_vector_type(2)));
typedef _Float16 f16x4 __attribute__((ext_vector_type(4)));

constexpr int D = 1024, BATCH = 8, SEQ = 4096, T = BATCH * SEQ, MEML = 256, TMEM = BATCH * MEML;
constexpr int INW = 5376;
constexpr int NTHREADS = 512, NWAVES = 8;
constexpr int NEXP = 16384;
constexpr float EPS = 1e-6f;

constexpr size_t MiB = 1u << 20;
constexpr size_t WS_WIN = 1 * MiB;
constexpr size_t WS_WBR = 12 * MiB;
constexpr size_t WS_WOUT = 16 * MiB;
constexpr size_t WS_WQ = 18 * MiB;
constexpr size_t WS_KEYS = 22 * MiB;
constexpr size_t WS_WPOOL = 22 * MiB + 512 * 1024;
constexpr size_t WS_RSTD1 = 22 * MiB + 768 * 1024;
constexpr size_t WS_RSTD2 = 22 * MiB + 896 * 1024;
constexpr size_t WS_RSTDM = 23 * MiB;
constexpr size_t WS_SSQO = 23 * MiB + 64 * 1024;
constexpr size_t WS_SU = 23 * MiB + 256 * 1024;
constexpr size_t WS_WMKV = 24 * MiB;
constexpr size_t WS_MEMB = 26 * MiB;
constexpr size_t WS_KVM = 30 * MiB;
constexpr size_t WS_ROPE = 34 * MiB;
constexpr size_t WS_XB = 42 * MiB;
constexpr size_t WS_POOLED = 42 * MiB;
constexpr size_t WS_MERGED = 170 * MiB;
constexpr size_t WS_U16 = 106 * MiB;
constexpr size_t WS_V16 = 138 * MiB;
constexpr size_t WS_UPOOL = 170 * MiB;
constexpr size_t WS_QR = 202 * MiB;
constexpr size_t WS_KR = 266 * MiB;
constexpr size_t WS_VV = 274 * MiB;
constexpr size_t WS_QM = 282 * MiB;
constexpr size_t WS_GATES = 314 * MiB;
constexpr size_t WS_X1B = 234 * MiB;
constexpr size_t WS_QP = 314 * MiB;
constexpr size_t WS_COEF = 314 * MiB;
constexpr size_t WS_IDS = 442 * MiB;
constexpr size_t WS_GTS = 458 * MiB;
constexpr size_t WS_END = 512 * MiB;

struct Params {
    const float* x; const float* mem; const int* pos; const float* norm1_g; const float* mem_norm_g; const float* w_in; const float* w_pool;
    const float* pool_scale; const float* sinks; const float* w_mem_kv; const float* w_bpool; const float* w_bswa; const float* w_bmem; const float* w_out;
    const float* norm2_g; const float* w_q; const float* sub_keys; const float* peer_u; const float* peer_v; const float* final_g;
    float* out; unsigned char* ws;
    int use_cg_sync; int pad_;
};

DI unsigned f2bf(float f) { unsigned u = __builtin_bit_cast(unsigned, f); return (u + 0x7fffu + ((u >> 16) & 1u)) >> 16; }
DI unsigned pk2(float lo, float hi) { return f2bf(lo) | (f2bf(hi) << 16); }
DI float bf2f(bf16_t b) { return __builtin_bit_cast(float, (unsigned)b << 16); }
DI float bflo(unsigned w) { return __builtin_bit_cast(float, w << 16); }
DI float bfhi(unsigned w) { return __builtin_bit_cast(float, w & 0xffff0000u); }
DI float wave_sum(float v) {
#pragma unroll
    for (int o = 1; o < 64; o <<= 1) v += __shfl_xor(v, o);
    return v;
}
DI float wave_max(float v) {
#pragma unroll
    for (int o = 1; o < 64; o <<= 1) v = fmaxf(v, __shfl_xor(v, o));
    return v;
}
DI float gelu_tanh(float x) {
    const float y2 = 1.5957691216057308f * (x + 0.044715f * x * x * x);
    return x * __builtin_amdgcn_rcpf(1.f + __builtin_amdgcn_exp2f(-1.4426950408889634f * y2));
}
DI float sigmoidf(float x) { return __builtin_amdgcn_rcpf(1.f + __builtin_amdgcn_exp2f(-1.4426950408889634f * x)); }

DI int opaque_tid() { int t = threadIdx.x; asm volatile("" : "+v"(t)); return t; }
DI int zperm(int n) {
    if (n < 512 || n >= 1664) return n;
    const int d = (n - 512) & 63, hb = n - d; return hb + 8 * ((d & 31) >> 2) + (d & 3) + 4 * (d >> 5);
}
template <bool ZPERM>
DI void transpose_item(const float* W, int K, int N, bf16_t* WT, int ldt, int roff, int coff, const float* g, float* scr, int item, int lane) {
    const int nblk = N / 32, kb = item / nblk, nb = item % nblk, k0 = 64 * kb, n0 = 32 * nb;
#pragma unroll 8
    for (int i = 0; i < 32; ++i) { const int kk = 2 * i + (lane >> 5); float v = W[(size_t)(k0 + kk) * N + n0 + (lane & 31)]; if (g) v *= g[k0 + kk]; scr[kk * 33 + (lane & 31)] = v; }
    asm volatile("s_waitcnt lgkmcnt(0)" ::: "memory");
    const int c = lane & 7;
#pragma unroll
    for (int j = 0; j < 4; ++j) { const int n = (lane >> 3) + 8 * j; const float* s = scr + (8 * c) * 33 + n;
        u32x4 o; o.x = pk2(s[0 * 33], s[1 * 33]); o.y = pk2(s[2 * 33], s[3 * 33]); o.z = pk2(s[4 * 33], s[5 * 33]); o.w = pk2(s[6 * 33], s[7 * 33]);
        const int nd = ZPERM ? zperm(n0 + n) : n0 + n;
        *(u32x4*)(WT + (size_t)(roff + nd) * ldt + coff + k0 + 8 * c) = o; }
    asm volatile("s_waitcnt lgkmcnt(0)" ::: "memory");
}

DI void row_to_bf16_rstd(const float* xrow, bf16_t* orow, float* rstd_out, int lane) {
    const f32x4* xr = (const f32x4*)xrow + lane;
    f32x4 v[4]; float s = 0.f;
#pragma unroll
    for (int j = 0; j < 4; ++j) { v[j] = xr[64 * j]; s += (v[j].x * v[j].x + v[j].y * v[j].y) + (v[j].z * v[j].z + v[j].w * v[j].w); }
    s = wave_sum(s);
    if (lane == 0) *rstd_out = 1.f / sqrtf(s * (1.f / D) + EPS);
    u32x2* o8 = (u32x2*)orow + lane;
#pragma unroll
    for (int j = 0; j < 4; ++j) { u32x2 w; w.x = pk2(v[j].x, v[j].y); w.y = pk2(v[j].z, v[j].w); o8[64 * j] = w; }
}

DI void phase0(const Params& p, float* lds_f) {
    const int tid_ = opaque_tid(), lane = tid_ & 63, wave = tid_ >> 6, gw = blockIdx.x * NWAVES + wave, NGW = gridDim.x * NWAVES;
    unsigned char* ws = p.ws;
    float* scr = lds_f + wave * (64 * 33);
    bf16_t* WinT = (bf16_t*)(ws + WS_WIN); bf16_t* WbrT = (bf16_t*)(ws + WS_WBR); bf16_t* WoutT = (bf16_t*)(ws + WS_WOUT); bf16_t* WqT = (bf16_t*)(ws + WS_WQ);
    bf16_t* WmkvT = (bf16_t*)(ws + WS_WMKV);
    constexpr int I_IN = (D / 64) * (INW / 32), I_BS = (1024 / 64) * (D / 32), I_BM = (512 / 64) * (D / 32), I_OUT = (D / 64) * (D / 32), I_Q = (D / 64) * (2048 / 32), I_MKV = (D / 64) * (D / 32);
    constexpr int NITEMS = I_IN + I_BS + I_BM + I_OUT + I_Q + I_MKV;
    for (int it = gw; it < NITEMS; it += NGW) {
        int r = it;
        if (r < I_IN) { transpose_item<true>(p.w_in, D, INW, WinT, D, 0, 0, p.norm1_g, scr, r, lane); continue; } r -= I_IN;
        if (r < I_BS) { transpose_item<false>(p.w_bswa, 1024, D, WbrT, 2048, 0, 512, nullptr, scr, r, lane); continue; } r -= I_BS;
        if (r < I_BM) { transpose_item<false>(p.w_bmem, 512, D, WbrT, 2048, 0, 1536, nullptr, scr, r, lane); continue; } r -= I_BM;
        if (r < I_OUT) { transpose_item<false>(p.w_out, D, D, WoutT, D, 0, 0, nullptr, scr, r, lane); continue; } r -= I_OUT;
        if (r < I_Q) { transpose_item<false>(p.w_q, D, 2048, WqT, D, 0, 0, p.norm2_g, scr, r, lane); continue; } r -= I_Q;
        transpose_item<false>(p.w_mem_kv, D, D, WmkvT, D, 0, 0, p.mem_norm_g, scr, r, lane);
    }
    {
        const size_t gt0 = (size_t)gw * 64 + lane, NGT0 = (size_t)NGW * 64;
        for (size_t i = gt0; i < (size_t)512 * 1024; i += NGT0) {
            const int n = (int)(i & 1023), cp = (int)(i >> 10), g = cp >> 7;
            const float* wp = p.w_pool + (size_t)cp * 128; const float* sc = p.pool_scale + g * 128; const float* wb = p.w_bpool + (size_t)(g * 128) * 1024 + n;
            float a0 = 0.f, a1 = 0.f, a2 = 0.f, a3 = 0.f;
#pragma unroll 4
            for (int d = 0; d < 128; d += 4) {
                a0 += wp[d] * sc[d] * wb[(size_t)d * 1024]; a1 += wp[d + 1] * sc[d + 1] * wb[(size_t)(d + 1) * 1024];
                a2 += wp[d + 2] * sc[d + 2] * wb[(size_t)(d + 2) * 1024]; a3 += wp[d + 3] * sc[d + 3] * wb[(size_t)(d + 3) * 1024]; }
            const float a = (a0 + a1) + (a2 + a3);
            WbrT[(size_t)n * 2048 + cp] = (bf16_t)f2bf(a);
        }
    }
    bf16_t* xb = (bf16_t*)(ws + WS_XB); float* rstd1 = (float*)(ws + WS_RSTD1);
    for (int m = gw; m < T; m += 4 * NGW) {
        f32x4 v[4][4];
#pragma unroll
        for (int q = 0; q < 4; ++q) { const int mq = (m + q * NGW < T) ? m + q * NGW : m; const f32x4* xr = (const f32x4*)(p.x + (size_t)mq * D) + lane;
#pragma unroll
            for (int j = 0; j < 4; ++j) v[q][j] = xr[64 * j]; }
#pragma unroll
        for (int q = 0; q < 4; ++q) { const int mq = m + q * NGW; float s = 0.f;
#pragma unroll
            for (int j = 0; j < 4; ++j) s += (v[q][j].x * v[q][j].x + v[q][j].y * v[q][j].y) + (v[q][j].z * v[q][j].z + v[q][j].w * v[q][j].w);
            s = wave_sum(s);
            if (mq < T) { if (lane == 0) rstd1[mq] = __builtin_amdgcn_rsqf(s * (1.f / D) + EPS);
                u32x2* o8 = (u32x2*)(xb + (size_t)mq * D) + lane;
#pragma unroll
                for (int j = 0; j < 4; ++j) { u32x2 wv; wv.x = pk2(v[q][j].x, v[q][j].y); wv.y = pk2(v[q][j].z, v[q][j].w); o8[64 * j] = wv; } } }
    }
    bf16_t* memb = (bf16_t*)(ws + WS_MEMB); float* rstdm = (float*)(ws + WS_RSTDM);
    for (int m = gw; m < TMEM; m += NGW) row_to_bf16_rstd(p.mem + (size_t)m * D, memb + (size_t)m * D, rstdm + m, lane);
    const size_t gt = (size_t)gw * 64 + lane, NGT = (size_t)NGW * 64;
    bf16_t* keysb = (bf16_t*)(ws + WS_KEYS);
    for (size_t i = gt; i < (size_t)8 * 2 * 128 * 128 / 4; i += NGT) { const f32x4 v = ((const f32x4*)p.sub_keys)[i]; u32x2 w; w.x = pk2(v.x, v.y); w.y = pk2(v.z, v.w); ((u32x2*)keysb)[i] = w; }
    {
        unsigned* u8 = (unsigned*)(ws + WS_U16); unsigned* v8 = (unsigned*)(ws + WS_V16); float* su = (float*)(ws + WS_SU);
        f32x4 g2r[4];
#pragma unroll
        for (int j = 0; j < 4; ++j) g2r[j] = ((const f32x4*)p.norm2_g)[lane + 64 * j];
        for (int r0 = gw; r0 < NEXP; r0 += 2 * NGW) {
            f32x4 au[2][4], av[2][4];
#pragma unroll
            for (int h = 0; h < 2; ++h) { const int r = (r0 + h * NGW < NEXP) ? r0 + h * NGW : r0;
#pragma unroll
                for (int j = 0; j < 4; ++j) { au[h][j] = ((const f32x4*)p.peer_u)[(size_t)r * 256 + lane + 64 * j]; av[h][j] = ((const f32x4*)p.peer_v)[(size_t)r * 256 + lane + 64 * j]; } }
#pragma unroll
            for (int h = 0; h < 2; ++h) { const int r = r0 + h * NGW; if (r >= NEXP) continue;
                float mx = 0.f;
#pragma unroll
                for (int j = 0; j < 4; ++j) { au[h][j] = au[h][j] * g2r[j]; mx = fmaxf(fmaxf(mx, fmaxf(fabsf(au[h][j].x), fabsf(au[h][j].y))), fmaxf(fabsf(au[h][j].z), fabsf(au[h][j].w))); }
                mx = wave_max(mx);
                const float inv = mx > 0.f ? 127.f / mx : 0.f;
                if (lane == 0) su[r] = mx * (1.f / 127.f);
#pragma unroll
                for (int j = 0; j < 4; ++j) { const f32x4 b = av[h][j] * 2.f;
                    const int q0 = (int)__builtin_rintf(au[h][j].x * inv), q1 = (int)__builtin_rintf(au[h][j].y * inv), q2 = (int)__builtin_rintf(au[h][j].z * inv), q3 = (int)__builtin_rintf(au[h][j].w * inv);
                    const unsigned wa = (unsigned)(q0 & 255) | ((unsigned)(q1 & 255) << 8) | ((unsigned)(q2 & 255) << 16) | ((unsigned)q3 << 24);
                    int wb = __builtin_amdgcn_cvt_pk_fp8_f32(b.x, b.y, 0, false); wb = __builtin_amdgcn_cvt_pk_fp8_f32(b.z, b.w, wb, true);
                    u8[(size_t)r * 256 + lane + 64 * j] = wa; v8[(size_t)r * 256 + lane + 64 * j] = (unsigned)wb; } }
        }
    }
    for (size_t i = gt; i < (size_t)T; i += NGT) { ((float*)(ws + WS_RSTD2))[i] = 0.f; ((float*)(ws + WS_SSQO))[i] = 0.f; }
    float2* rope = (float2*)(ws + WS_ROPE);
    for (size_t i = gt; i < (size_t)T * 32; i += NGT) {
        const int t = (int)(i >> 5), d = (int)(i & 31);
        const float inv = exp2f(-(float)d * (13.287712379549449f / 32.f));
        const float ang = (float)p.pos[t] * inv;
        const double rev = (double)ang * 0.15915494309189535;
        const float fr = (float)(rev - floor(rev));
        rope[i] = make_float2(__builtin_amdgcn_cosf(fr), __builtin_amdgcn_sinf(fr));
    }
}

namespace pg8 {
#define PG8_LAS __attribute__((address_space(3)))
constexpr int BM = 256, BK = 64, HALF = 128, HTB = HALF * BK * 2, STAGE_BYTES = 8 * HTB, NXCD = 8, WGM = 8;
__host__ __device__ __forceinline__ int lds_byte(int r, int c) { const int st = (r >> 4) * 2 + (c >> 5), rr = r & 15, cc = c & 31, ob = rr * 64 + cc * 2; return st * 1024 + (ob ^ (((ob >> 9) & 1) << 5)); }
__host__ __device__ __forceinline__ void stage_rc(int b, int& R, int& C) { const int st = b / 1024, sb = b % 1024, swz = sb ^ (((sb >> 9) & 1) << 5); R = (st >> 1) * 16 + swz / 64; C = (st & 1) * 32 + (swz % 64) / 2; }
__host__ __device__ __forceinline__ int perm32(int rho) { const int n = rho >> 4, i = rho & 15; return 8 * (i >> 2) + 4 * n + (i & 3); }

struct Unit { const char* a; const char* b; int nt, pm, pn, tag; };
DI void tile_of(int L, int nM, int nN, int& pm, int& pn) {
    const int nwg = nM * nN; int wgid = L; { const int q = nwg / NXCD, r = nwg % NXCD, xcd = wgid % NXCD, off = wgid / NXCD; wgid = (xcd < r ? xcd * (q + 1) : r * (q + 1) + (xcd - r) * q) + off; }
    const int nig = WGM * nN, gid = wgid / nig, fm = gid * WGM, gsz = (nM - fm) < WGM ? (nM - fm) : WGM;
    pm = fm + ((wgid % nig) % gsz); pn = (wgid % nig) / gsz;
}
template <class Epi, class Sched>
DI void gemm_phase(PG8_LAS unsigned char* lds, int lda, int ldb, const Sched& S, const Epi& E) {
    int tid = threadIdx.x; asm volatile("" : "+v"(tid));
    const int wid = __builtin_amdgcn_readfirstlane(tid >> 6), wr = wid >> 2, wc = wid & 3, lane = tid & 63, fr = lane & 15, fq = lane >> 4;
    unsigned voffA[2], voffB[2];
#pragma unroll
    for (int i = 0; i < 2; ++i) { int R, C; stage_rc(tid * 16 + i * 8192, R, C); const int Rb = (R & ~31) + perm32(R & 31);
        voffA[i] = (unsigned)(R * lda + C) * 2u; voffB[i] = (unsigned)(Rb * ldb + C) * 2u; }
    const size_t kstep = (size_t)(BK * 2);
    const size_t hstepA = (size_t)HALF * lda * 2, hstepB = (size_t)HALF * ldb * 2;
    const unsigned ldsw = (unsigned)wid * 1024u;
    const int aoff = lds_byte(wr * 64 + fr, fq * 8), boff = lds_byte(wc * 32 + fr, fq * 8);
#define PG8_SA(b, h) (((b) * 2 + (h)) * HTB)
#define PG8_SB(b, h) ((4 + (b) * 2 + (h)) * HTB)
#define PG8_STAGE(bufoff, gbase, voff) do { _Pragma("unroll") for (int _i = 0; _i < 2; ++_i) \
        __builtin_amdgcn_global_load_lds((const unsigned*)((const char*)(gbase) + (voff)[_i]), (PG8_LAS unsigned*)(lds + (bufoff) + ldsw + _i * 8192), 16, 0, 0); } while (0)
#define PG8_LDA(dst, b, h) do { _Pragma("unroll") for (int m = 0; m < 4; ++m) _Pragma("unroll") for (int k = 0; k < 2; ++k) dst[m][k] = *(const PG8_LAS bf16x8*)(lds + PG8_SA(b, h) + aoff + m * 2048 + k * 1024); } while (0)
#define PG8_LDB(dst, b, h) do { _Pragma("unroll") for (int n = 0; n < 2; ++n) _Pragma("unroll") for (int k = 0; k < 2; ++k) dst[n][k] = *(const PG8_LAS bf16x8*)(lds + PG8_SB(b, h) + boff + n * 2048 + k * 1024); } while (0)
#define PG8_MMA(ai, bj, At, Bt) do { __builtin_amdgcn_s_setprio(1); _Pragma("unroll") for (int m = 0; m < 4; ++m) _Pragma("unroll") for (int n = 0; n < 2; ++n) _Pragma("unroll") for (int k = 0; k < 2; ++k) \
        acc[ai][bj][m][n] = __builtin_amdgcn_mfma_f32_16x16x32_bf16(Bt[n][k], At[m][k], acc[ai][bj][m][n], 0, 0, 0); __builtin_amdgcn_s_setprio(0); } while (0)
#define PG8_WAIT_V(n) asm volatile("s_waitcnt vmcnt(" #n ")" ::: "memory")
#define PG8_WAIT_L(n) asm volatile("s_waitcnt lgkmcnt(" #n ")" ::: "memory")
#define PG8_BAR __builtin_amdgcn_s_barrier()
#define PG8_SCHED __builtin_amdgcn_sched_barrier(0)
    Unit cur, nxt; int ui = 0;
    if (!S.next(0, cur)) return;
    f32x4 acc[2][2][4][2];
#pragma unroll
    for (int a = 0; a < 2; ++a)
#pragma unroll
        for (int b = 0; b < 2; ++b)
#pragma unroll
            for (int m = 0; m < 4; ++m)
#pragma unroll
                for (int n = 0; n < 2; ++n) acc[a][b][m][n] = (f32x4){0.f, 0.f, 0.f, 0.f};
    bf16x8 At[4][2], B0[2][2], B1[2][2];
    const char* cA = cur.a; const char* cB = cur.b;
    PG8_STAGE(PG8_SB(0, 0), cB, voffB); PG8_STAGE(PG8_SB(0, 1), cB + hstepB, voffB); PG8_STAGE(PG8_SA(0, 0), cA, voffA); PG8_STAGE(PG8_SA(0, 1), cA + hstepA, voffA);
    if (wr == 1) PG8_BAR;
    PG8_WAIT_V(2); PG8_BAR;
    PG8_STAGE(PG8_SB(1, 0), cB + kstep, voffB); PG8_STAGE(PG8_SA(1, 0), cA + kstep, voffA); PG8_STAGE(PG8_SB(1, 1), cB + hstepB + kstep, voffB);
    PG8_WAIT_V(6); PG8_BAR;
    for (;;) {
        const bool has_next = S.next(ui + 1, nxt);
        const char* nA = has_next ? nxt.a : cA; const char* nB = has_next ? nxt.b : cB;
        const int nt = cur.nt;
        for (int t = 0; t < nt; t += 2) {
            const bool last = (t == nt - 2);
            const char* a1 = cA + (size_t)(t + 1) * kstep;
            const char* a2 = last ? nA : cA + (size_t)(t + 2) * kstep; const char* b2 = last ? nB : cB + (size_t)(t + 2) * kstep;
            const char* a3 = a2 + kstep; const char* b3 = b2 + kstep;
            PG8_LDB(B0, 0, 0); PG8_LDB(B1, 0, 1); PG8_SCHED; PG8_LDA(At, 0, 0); PG8_STAGE(PG8_SA(1, 1), a1 + hstepA, voffA);
            PG8_WAIT_V(8); PG8_WAIT_L(0); PG8_BAR; PG8_MMA(0, 0, At, B0); PG8_MMA(0, 1, At, B1); PG8_BAR; PG8_SCHED;
            PG8_LDA(At, 0, 1); PG8_STAGE(PG8_SB(0, 0), b2, voffB); PG8_STAGE(PG8_SB(0, 1), b2 + hstepB, voffB); PG8_STAGE(PG8_SA(0, 0), a2, voffA);
            PG8_WAIT_V(8); PG8_WAIT_L(0); PG8_BAR; PG8_MMA(1, 0, At, B0); PG8_MMA(1, 1, At, B1); PG8_BAR; PG8_SCHED;
            PG8_LDB(B0, 1, 0); PG8_LDB(B1, 1, 1); PG8_SCHED; PG8_LDA(At, 1, 0); PG8_STAGE(PG8_SA(0, 1), a2 + hstepA, voffA);
            PG8_WAIT_V(8); PG8_WAIT_L(0); PG8_BAR; PG8_MMA(0, 0, At, B0); PG8_MMA(0, 1, At, B1); PG8_BAR; PG8_SCHED;
            PG8_LDA(At, 1, 1); PG8_STAGE(PG8_SB(1, 0), b3, voffB); PG8_STAGE(PG8_SB(1, 1), b3 + hstepB, voffB); PG8_STAGE(PG8_SA(1, 0), a3, voffA);
            PG8_WAIT_V(8); PG8_WAIT_L(0); PG8_BAR; PG8_MMA(1, 0, At, B0); PG8_MMA(1, 1, At, B1); PG8_BAR; PG8_SCHED;
        }
        if (wr == 0) PG8_BAR;
        const bool keep_ = E(acc, cur, wr, wc, fr, fq);
        if (!has_next) break;
        if (!keep_)
#pragma unroll
        for (int a = 0; a < 2; ++a)
#pragma unroll
            for (int b = 0; b < 2; ++b)
#pragma unroll
                for (int m = 0; m < 4; ++m)
#pragma unroll
                    for (int n = 0; n < 2; ++n) acc[a][b][m][n] = (f32x4){0.f, 0.f, 0.f, 0.f};
        cur = nxt; cA = nA; cB = nB; ++ui;
        if (wr == 1) PG8_BAR;
    }
    PG8_WAIT_V(0);
    PG8_BAR;
#undef PG8_SA
#undef PG8_SB
#undef PG8_STAGE
#undef PG8_LDA
#undef PG8_LDB
#undef PG8_MMA
#undef PG8_WAIT_V
#undef PG8_WAIT_L
#undef PG8_BAR
#undef PG8_SCHED
}
}
typedef f32x4 acc_t[2][2][4][2];

struct SchedPlain {
    const char* A; const char* Bt; int lda, ldb, nM, nN, nt, G, c;
    DI bool next(int i, pg8::Unit& u) const {
        const long L = (long)i * G + c; if (L >= (long)nM * nN) return false;
        pg8::tile_of((int)L, nM, nN, u.pm, u.pn); u.a = A + (size_t)u.pm * 256 * lda * 2; u.b = Bt + (size_t)u.pn * 256 * ldb * 2; u.nt = nt; u.tag = 0; return true;
    }
};
struct SchedZ {
    const char *xb, *win, *memb, *wmkv; int G, c;
    DI bool next(int i, pg8::Unit& u) const {
        const long L = (long)i * G + c; constexpr int NZ = 128 * 21;
        if (L < NZ) { pg8::tile_of((int)L, 128, 21, u.pm, u.pn); u.a = xb + (size_t)u.pm * 256 * 2048; u.b = win + (size_t)u.pn * 256 * 2048; u.nt = 16; u.tag = 0; return true; }
        const int j = (int)(L - NZ); if (j >= 32) return false;
        u.pm = j >> 2; u.pn = j & 3; u.a = memb + (size_t)u.pm * 256 * 2048; u.b = wmkv + (size_t)u.pn * 256 * 2048; u.nt = 16; u.tag = 1; return true;
    }
};
struct SchedGated {
    const char *ycat, *wbr; int G, c;
    DI bool next(int i, pg8::Unit& u) const {
        const int j = i / 3, b = i - 3 * j; const long L = (long)j * G + c; if (L >= 128 * 4) return false;
        pg8::tile_of((int)L, 128, 4, u.pm, u.pn);
        const int koff = (b == 0) ? 0 : (b == 1 ? 512 : 1536);
        u.a = ycat + ((size_t)u.pm * 256 * 2048 + koff) * 2; u.b = wbr + ((size_t)u.pn * 256 * 2048 + koff) * 2; u.nt = (b == 1) ? 16 : 8; u.tag = b; return true;
    }
};

DI u32x4 pack8(const f32x4& a, const f32x4& b) { u32x4 w; w.x = pk2(a[0], a[1]); w.y = pk2(a[2], a[3]); w.z = pk2(b[0], b[1]); w.w = pk2(b[2], b[3]); return w; }
struct EpiZ {
    const float* rstd1; const float* rstdm; const float2* rope; bf16_t *upool, *qr, *kr, *vv, *qm, *gates, *kvm;
    DI bool operator()(const acc_t& acc, const pg8::Unit& u, int wr, int wc, int fr_, int fq_) const {
        int l_ = threadIdx.x; asm volatile("" : "+v"(l_)); const int fr = l_ & 15, fq = (l_ >> 4) & 3;
        const int row0 = u.pm * 256 + wr * 64 + fr;
        const float* rsp = (u.tag == 1) ? rstdm : rstd1;
        float rs[2][4];
#pragma unroll
        for (int ai = 0; ai < 2; ++ai)
#pragma unroll
            for (int m = 0; m < 4; ++m) rs[ai][m] = rsp[row0 + ai * 128 + m * 16];
        if (u.tag == 1) {
#pragma unroll
            for (int ai = 0; ai < 2; ++ai)
#pragma unroll
                for (int m = 0; m < 4; ++m) { const int row = row0 + ai * 128 + m * 16;
#pragma unroll
                    for (int bj = 0; bj < 2; ++bj) { const int c = u.pn * 256 + bj * 128 + wc * 32 + 8 * fq;
                        *(u32x4*)(kvm + (size_t)row * 1024 + c) = pack8(acc[ai][bj][m][0] * rs[ai][m], acc[ai][bj][m][1] * rs[ai][m]); } }
            return false;
        }
#pragma unroll
        for (int bj = 0; bj < 2; ++bj) {
            const int cb = u.pn * 256 + bj * 128;
            const int c = cb + wc * 32 + 8 * fq;
            if (cb >= 512 && cb < 1664) {
                const bool isq = cb < 1536; const int rel = isq ? c - 512 : c - 1536; const int hrel = rel & 63, d0 = hrel >> 1, hb = rel - hrel;
                const float sc = isq ? 0.125f : 1.f;
#pragma unroll
                for (int ai = 0; ai < 2; ++ai) {
                    f32x4 cs0[4], cs1[4];
#pragma unroll
                    for (int m = 0; m < 4; ++m) { const int row = row0 + ai * 128 + m * 16;
                        cs0[m] = *(const f32x4*)(rope + (size_t)row * 32 + d0); cs1[m] = *(const f32x4*)(rope + (size_t)row * 32 + d0 + 2); }
#pragma unroll
                    for (int m = 0; m < 4; ++m) { const int row = row0 + ai * 128 + m * 16;
                        const f32x4 v0 = acc[ai][bj][m][0] * rs[ai][m], v1 = acc[ai][bj][m][1] * rs[ai][m], a0 = cs0[m], a1 = cs1[m];
                        f32x4 o1, o2;
                        o1[0] = (v0[0] * a0[0] - v1[0] * a0[1]) * sc; o2[0] = (v1[0] * a0[0] + v0[0] * a0[1]) * sc;
                        o1[1] = (v0[1] * a0[2] - v1[1] * a0[3]) * sc; o2[1] = (v1[1] * a0[2] + v0[1] * a0[3]) * sc;
                        o1[2] = (v0[2] * a1[0] - v1[2] * a1[1]) * sc; o2[2] = (v1[2] * a1[0] + v0[2] * a1[1]) * sc;
                        o1[3] = (v0[3] * a1[2] - v1[3] * a1[3]) * sc; o2[3] = (v1[3] * a1[2] + v0[3] * a1[3]) * sc;
                        bf16_t* dst = isq ? qr + (size_t)row * 1024 + hb + d0 : kr + (size_t)row * 128 + hb + d0;
                        u32x2 w1, w2; w1.x = pk2(o1[0], o1[1]); w1.y = pk2(o1[2], o1[3]); w2.x = pk2(o2[0], o2[1]); w2.y = pk2(o2[2], o2[3]);
                        *(u32x2*)dst = w1; *(u32x2*)(dst + 32) = w2; }
                }
                continue;
            }
#pragma unroll
            for (int ai = 0; ai < 2; ++ai)
#pragma unroll
                for (int m = 0; m < 4; ++m) {
                    const int row = row0 + ai * 128 + m * 16;
                    const f32x4 v0 = acc[ai][bj][m][0] * rs[ai][m], v1 = acc[ai][bj][m][1] * rs[ai][m];
                    if (cb < 512) { *(u32x4*)(upool + (size_t)row * 512 + c) = pack8(v0, v1); }
                    else if (cb < 1792) { *(u32x4*)(vv + (size_t)row * 128 + (c - 1664)) = pack8(v0, v1); }
                    else if (cb < 2304) { *(u32x4*)(qm + (size_t)row * 512 + (c - 1792)) = pack8(v0, v1); }
                    else { f32x4 s0, s1;
#pragma unroll
                        for (int e = 0; e < 4; ++e) { s0[e] = sigmoidf(v0[e]); s1[e] = sigmoidf(v1[e]); }
                        *(u32x4*)(gates + (size_t)row * 3072 + (c - 2304)) = pack8(s0, s1); }
                }
        }
        return false;
    }
};
struct EpiGated {
    const bf16_t* gates; bf16_t* merged;
    DI bool operator()(acc_t& acc, const pg8::Unit& u, int wr, int wc, int fr_, int fq_) const {
        int l_ = threadIdx.x; asm volatile("" : "+v"(l_)); const int fr = l_ & 15, fq = (l_ >> 4) & 3;
        const int row0 = u.pm * 256 + wr * 64 + fr, b = u.tag;
#pragma unroll
        for (int aim = 0; aim < 4; ++aim) { const int ai = aim >> 1, mh = (aim & 1) * 2;
            u32x4 gq[2][2], gnq[2][2];
#pragma unroll
            for (int m2 = 0; m2 < 2; ++m2)
#pragma unroll
                for (int bj = 0; bj < 2; ++bj) { const bf16_t* gp = gates + (size_t)(row0 + ai * 128 + (mh + m2) * 16) * 3072 + b * 1024 + u.pn * 256 + bj * 128 + wc * 32 + 8 * fq;
                    gq[m2][bj] = *(const u32x4*)gp; if (b < 2) gnq[m2][bj] = *(const u32x4*)(gp + 1024); else gnq[m2][bj] = gq[m2][bj]; }
#pragma unroll
            for (int m2 = 0; m2 < 2; ++m2) { const int m = mh + m2; const int row = row0 + ai * 128 + m * 16;
#pragma unroll
                for (int bj = 0; bj < 2; ++bj) { const int c = u.pn * 256 + bj * 128 + wc * 32 + 8 * fq;
                    const u32x4 g = gq[m2][bj], gn = gnq[m2][bj];
                    f32x4 s0 = {bflo(g.x), bfhi(g.x), bflo(g.y), bfhi(g.y)}, s1 = {bflo(g.z), bfhi(g.z), bflo(g.w), bfhi(g.w)};
#pragma unroll
                    for (int e = 0; e < 4; ++e) { s0[e] = fmaxf(s0[e], 1e-30f); s1[e] = fmaxf(s1[e], 1e-30f); }
                    if (b < 2) {
                        const float gn_[8] = {bflo(gn.x), bfhi(gn.x), bflo(gn.y), bfhi(gn.y), bflo(gn.z), bfhi(gn.z), bflo(gn.w), bfhi(gn.w)};
#pragma unroll
                        for (int e = 0; e < 4; ++e) { s0[e] *= __builtin_amdgcn_rcpf(fmaxf(gn_[e], 1e-30f)); s1[e] *= __builtin_amdgcn_rcpf(fmaxf(gn_[4 + e], 1e-30f)); }
                        acc[ai][bj][m][0] *= s0; acc[ai][bj][m][1] *= s1; }
                    else *(u32x4*)(merged + (size_t)row * 1024 + c) = pack8(acc[ai][bj][m][0] * s0, acc[ai][bj][m][1] * s1); } }
        }
        return b < 2;
    }
};
struct EpiOut {
    const bf16_t* xb; bf16_t* x1b; float* ssq;
    DI bool operator()(const acc_t& acc, const pg8::Unit& u, int wr, int wc, int fr_, int fq_) const {
        int l_ = threadIdx.x; asm volatile("" : "+v"(l_)); const int fr = l_ & 15, fq = (l_ >> 4) & 3;
        const int row0 = u.pm * 256 + wr * 64 + fr;
#pragma unroll
        for (int ai = 0; ai < 2; ++ai) {
            u32x4 xq[4][2];
#pragma unroll
            for (int m = 0; m < 4; ++m)
#pragma unroll
                for (int bj = 0; bj < 2; ++bj) xq[m][bj] = *(const u32x4*)(xb + (size_t)(row0 + ai * 128 + m * 16) * D + u.pn * 256 + bj * 128 + wc * 32 + 8 * fq);
#pragma unroll
            for (int m = 0; m < 4; ++m) { const int row = row0 + ai * 128 + m * 16; float sq = 0.f;
#pragma unroll
                for (int bj = 0; bj < 2; ++bj) { const size_t o = (size_t)row * D + u.pn * 256 + bj * 128 + wc * 32 + 8 * fq;
                    const u32x4 xw = xq[m][bj];
                    f32x4 v0 = acc[ai][bj][m][0], v1 = acc[ai][bj][m][1];
                    v0[0] += bflo(xw.x); v0[1] += bfhi(xw.x); v0[2] += bflo(xw.y); v0[3] += bfhi(xw.y); v1[0] += bflo(xw.z); v1[1] += bfhi(xw.z); v1[2] += bflo(xw.w); v1[3] += bfhi(xw.w);
                    sq += (v0[0] * v0[0] + v0[1] * v0[1]) + (v0[2] * v0[2] + v0[3] * v0[3]) + (v1[0] * v1[0] + v1[1] * v1[1]) + (v1[2] * v1[2] + v1[3] * v1[3]);
                    *(u32x4*)(x1b + o) = pack8(v0, v1); }
                sq += __shfl_xor(sq, 16); sq += __shfl_xor(sq, 32);
                if (fq == 0) atomicAdd(ssq + row, sq); }
        }
        return false;
    }
};
struct EpiBf16 {
    bf16_t* O; int ldo;
    DI bool operator()(const acc_t& acc, const pg8::Unit& u, int wr, int wc, int fr_, int fq_) const {
        int l_ = threadIdx.x; asm volatile("" : "+v"(l_)); const int fr = l_ & 15, fq = (l_ >> 4) & 3;
        const int row0 = u.pm * 256 + wr * 64 + fr;
#pragma unroll
        for (int ai = 0; ai < 2; ++ai)
#pragma unroll
            for (int m = 0; m < 4; ++m) { const int row = row0 + ai * 128 + m * 16;
#pragma unroll
                for (int bj = 0; bj < 2; ++bj) { const size_t o = (size_t)row * ldo + u.pn * 256 + bj * 128 + wc * 32 + 8 * fq;
                    *(u32x4*)(O + o) = pack8(acc[ai][bj][m][0], acc[ai][bj][m][1]); } }
        return false;
    }
};

DI void unpack8(const u32x4& w, float (&f)[8]) { f[0] = bflo(w.x); f[1] = bfhi(w.x); f[2] = bflo(w.y); f[3] = bfhi(w.y); f[4] = bflo(w.z); f[5] = bfhi(w.z); f[6] = bflo(w.w); f[7] = bfhi(w.w); }
DI void pooled_phase(const bf16_t* upool, bf16_t* pooled) {
    const int tid = opaque_tid(), lane = tid & 63, gw = blockIdx.x * NWAVES + (tid >> 6), NGW = gridDim.x * NWAVES;
    const int c = lane * 8, w = 2 << (lane >> 4);
    for (int task = gw; task < T / 16; task += NGW) {
        const int t0 = task * 16, s0 = t0 & (SEQ - 1);
        const bf16_t* up = upool + (size_t)t0 * 512 + c;
        float win[8];
#pragma unroll
        for (int e = 0; e < 8; ++e) win[e] = 0.f;
#pragma unroll
        for (int j = 1; j < 16; ++j) {
            if (j < w && s0 - j >= 0) { float f[8]; unpack8(*(const u32x4*)(up - (size_t)j * 512), f);
#pragma unroll
                for (int e = 0; e < 8; ++e) win[e] += f[e]; }
        }
#pragma unroll
        for (int i = 0; i < 16; ++i) {
            const int s = s0 + i;
            float un[8], uo[8];
            unpack8(*(const u32x4*)(up + (size_t)i * 512), un);
            const bool has_old = (s - (w - 1)) >= 0;
            u32x4 ow = {0u, 0u, 0u, 0u}; if (has_old) ow = *(const u32x4*)(up + (ptrdiff_t)(i - (w - 1)) * 512);
            unpack8(ow, uo);
            const int cnt = (s + 1 < w) ? s + 1 : w; const float ic = __builtin_amdgcn_rcpf((float)cnt);
            float o[8];
#pragma unroll
            for (int e = 0; e < 8; ++e) { const float tot = win[e] + un[e]; o[e] = tot * ic - un[e]; win[e] = tot - uo[e]; }
            u32x4 ov; ov.x = pk2(o[0], o[1]); ov.y = pk2(o[2], o[3]); ov.z = pk2(o[4], o[5]); ov.w = pk2(o[6], o[7]);
            *(u32x4*)(pooled + (size_t)(t0 + i) * 2048 + c) = ov;
        }
    }
}
typedef __bf16 bf16x2_t __attribute__((ext_vector_type(2)));
typedef float f32x2_t __attribute__((ext_vector_type(2)));
DI unsigned cvtpk(float lo, float hi) { f32x2_t v = {lo, hi}; bf16x2_t b = __builtin_convertvector(v, bf16x2_t); return __builtin_bit_cast(unsigned, b); }
DI int crow(int i, int h) { return (i & 3) + 8 * (i >> 2) + 4 * h; }
#define MFMA32(a, b, c) __builtin_amdgcn_mfma_f32_32x32x16_bf16((a), (b), (c), 0, 0, 0)
DI bf16x8 mk8(unsigned a, unsigned b, unsigned c, unsigned d) { u32x4 w = {a, b, c, d}; return __builtin_bit_cast(bf16x8, w); }

constexpr int SWA_KLD = 72, SWA_VLD = 260, SWA_VT_OFF = 256 * SWA_KLD * 2;
DI void swa_phase(const bf16_t* qr, const bf16_t* kr, const bf16_t* vv, const float* sinks, bf16_t* ycat, unsigned char* lds) {
    const int tid = opaque_tid();
    const int lane = tid & 63, w = tid >> 6, r = lane & 31, h = lane >> 5;
    bf16_t* Ks = (bf16_t*)lds; bf16_t* Vt = (bf16_t*)(lds + SWA_VT_OFF);
    for (int unit = blockIdx.x; unit < 512; unit += gridDim.x) {
        const int kvh = unit & 1, nb = (unit >> 1) & 31, b = unit >> 6;
        const int tq0 = b * SEQ + nb * 128, tk0 = tq0 - 128;
        __syncthreads();
#pragma unroll
        for (int i = 0; i < 4; ++i) {
            const int c = tid + 512 * i, kb = c >> 3, dc = (c & 7) * 8;
            u32x4 kv = {0u, 0u, 0u, 0u}, vx = {0u, 0u, 0u, 0u};
            if (nb > 0 || kb >= 128) { kv = *(const u32x4*)(kr + (size_t)(tk0 + kb) * 128 + kvh * 64 + dc); vx = *(const u32x4*)(vv + (size_t)(tk0 + kb) * 128 + kvh * 64 + dc); }
            *(u32x4*)(Ks + kb * SWA_KLD + dc) = kv;
            bf16_t* vp = Vt + dc * SWA_VLD + kb;
            vp[0 * SWA_VLD] = (bf16_t)(vx.x & 0xffffu); vp[1 * SWA_VLD] = (bf16_t)(vx.x >> 16); vp[2 * SWA_VLD] = (bf16_t)(vx.y & 0xffffu); vp[3 * SWA_VLD] = (bf16_t)(vx.y >> 16);
            vp[4 * SWA_VLD] = (bf16_t)(vx.z & 0xffffu); vp[5 * SWA_VLD] = (bf16_t)(vx.z >> 16); vp[6 * SWA_VLD] = (bf16_t)(vx.w & 0xffffu); vp[7 * SWA_VLD] = (bf16_t)(vx.w >> 16);
        }
        __syncthreads();
        const int hq = kvh * 8 + w; const float sink = sinks[hq];
        for (int qt = 0; qt < 4; ++qt) {
            const bf16_t* qp = qr + (size_t)(tq0 + 32 * qt + r) * 1024 + hq * 64 + 8 * h;
            bf16x8 qf[4];
#pragma unroll
            for (int s = 0; s < 4; ++s) qf[s] = *(const bf16x8*)(qp + 16 * s);
            f32x16 sa[5];
#pragma unroll
            for (int c = 0; c < 5; ++c) {
#pragma unroll
                for (int i = 0; i < 16; ++i) sa[c][i] = 0.f;
#pragma unroll
                for (int s = 0; s < 4; ++s) { const bf16x8 kf = *(const bf16x8*)(Ks + (32 * (qt + c) + r) * SWA_KLD + 16 * s + 8 * h); sa[c] = MFMA32(kf, qf[s], sa[c]); }
            }
            float mx = sink;
#pragma unroll
            for (int c = 0; c < 5; ++c)
#pragma unroll
                for (int i = 0; i < 16; ++i) {
                    const int kk = 32 * c + crow(i, h);
                    bool vis = (c == 0) ? (kk > r) : ((c == 4) ? (kk - 128 <= r) : true);
                    if (nb == 0) vis = vis && (32 * qt + kk >= 128);
                    const float s = vis ? sa[c][i] : -1e30f; sa[c][i] = s; mx = fmaxf(mx, s);
                }
            mx = fmaxf(mx, __shfl_xor(mx, 32));
            float l = 0.f;
#pragma unroll
            for (int c = 0; c < 5; ++c)
#pragma unroll
                for (int i = 0; i < 16; ++i) { const float pz = __expf(sa[c][i] - mx); sa[c][i] = pz; l += pz; }
            l += __shfl_xor(l, 32); l += __expf(sink - mx);
            const float inv = 1.f / l;
            f32x16 oa[2];
#pragma unroll
            for (int i = 0; i < 16; ++i) { oa[0][i] = 0.f; oa[1][i] = 0.f; }
#pragma unroll
            for (int c = 0; c < 5; ++c)
#pragma unroll
                for (int s2 = 0; s2 < 2; ++s2) {
                    const bf16x8 pf = mk8(cvtpk(sa[c][8 * s2 + 0], sa[c][8 * s2 + 1]), cvtpk(sa[c][8 * s2 + 2], sa[c][8 * s2 + 3]), cvtpk(sa[c][8 * s2 + 4], sa[c][8 * s2 + 5]), cvtpk(sa[c][8 * s2 + 6], sa[c][8 * s2 + 7]));
#pragma unroll
                    for (int dt = 0; dt < 2; ++dt) {
                        const bf16_t* va = Vt + (32 * dt + r) * SWA_VLD + 32 * (qt + c) + 16 * s2 + 4 * h;
                        const u32x2 lo = *(const u32x2*)va, hi = *(const u32x2*)(va + 8);
                        oa[dt] = MFMA32(mk8(lo.x, lo.y, hi.x, hi.y), pf, oa[dt]);
                    }
                }
            bf16_t* yp = ycat + (size_t)(tq0 + 32 * qt + r) * 2048 + 512 + hq * 64 + 4 * h;
#pragma unroll
            for (int dt = 0; dt < 2; ++dt)
#pragma unroll
                for (int g4 = 0; g4 < 4; ++g4) { u32x2 o; o.x = cvtpk(oa[dt][4 * g4] * inv, oa[dt][4 * g4 + 1] * inv); o.y = cvtpk(oa[dt][4 * g4 + 2] * inv, oa[dt][4 * g4 + 3] * inv);
                    *(u32x2*)(yp + 32 * dt + 8 * g4) = o; }
        }
    }
}

constexpr int MEM_KLD = 136, MEM_VLD = 260, MEM_VT_OFF = 256 * MEM_KLD * 2;
DI void mem_phase(const bf16_t* qm, const bf16_t* kvm, bf16_t* ycat, unsigned char* lds) {
    const int tid = opaque_tid();
    const int lane = tid & 63, w = tid >> 6, r = lane & 31, h = lane >> 5;
    bf16_t* Ks = (bf16_t*)lds; bf16_t* Vt = (bf16_t*)(lds + MEM_VT_OFF);
    for (int unit = blockIdx.x; unit < 256; unit += gridDim.x) {
        const int qc = unit & 7, hm = (unit >> 3) & 3, b = unit >> 5;
        __syncthreads();
#pragma unroll
        for (int i = 0; i < 8; ++i) {
            const int c = tid + 512 * i, m = c >> 4, dc = (c & 15) * 8;
            const bf16_t* src = kvm + (size_t)(b * MEML + m) * 1024 + hm * 128 + dc;
            const u32x4 kv = *(const u32x4*)src, vx = *(const u32x4*)(src + 512);
            *(u32x4*)(Ks + m * MEM_KLD + dc) = kv;
            bf16_t* vp = Vt + dc * MEM_VLD + m;
            vp[0 * MEM_VLD] = (bf16_t)(vx.x & 0xffffu); vp[1 * MEM_VLD] = (bf16_t)(vx.x >> 16); vp[2 * MEM_VLD] = (bf16_t)(vx.y & 0xffffu); vp[3 * MEM_VLD] = (bf16_t)(vx.y >> 16);
            vp[4 * MEM_VLD] = (bf16_t)(vx.z & 0xffffu); vp[5 * MEM_VLD] = (bf16_t)(vx.z >> 16); vp[6 * MEM_VLD] = (bf16_t)(vx.w & 0xffffu); vp[7 * MEM_VLD] = (bf16_t)(vx.w >> 16);
        }
        __syncthreads();
        for (int qi = 0; qi < 2; ++qi) {
            const int t0 = b * SEQ + qc * 512 + (w * 2 + qi) * 32;
            const bf16_t* qp = qm + (size_t)(t0 + r) * 512 + hm * 128 + 8 * h;
            bf16x8 qf[8];
#pragma unroll
            for (int s = 0; s < 8; ++s) qf[s] = *(const bf16x8*)(qp + 16 * s);
            float mx = -3e38f;
#pragma unroll 1
            for (int c = 0; c < 8; ++c) {
                f32x16 sc;
#pragma unroll
                for (int i = 0; i < 16; ++i) sc[i] = 0.f;
#pragma unroll
                for (int s = 0; s < 8; ++s) { const bf16x8 kf = *(const bf16x8*)(Ks + (32 * c + r) * MEM_KLD + 16 * s + 8 * h); sc = MFMA32(kf, qf[s], sc); }
#pragma unroll
                for (int i = 0; i < 16; ++i) mx = fmaxf(mx, sc[i]);
            }
            mx = fmaxf(mx, __shfl_xor(mx, 32));
            constexpr float SC = 0.08838834764831845f * 1.4426950408889634f;
            float l = 0.f;
            f32x16 oa[4];
#pragma unroll
            for (int dt = 0; dt < 4; ++dt)
#pragma unroll
                for (int i = 0; i < 16; ++i) oa[dt][i] = 0.f;
#pragma unroll 1
            for (int c = 0; c < 8; ++c) {
                f32x16 sc;
#pragma unroll
                for (int i = 0; i < 16; ++i) sc[i] = 0.f;
#pragma unroll
                for (int s = 0; s < 8; ++s) { const bf16x8 kf = *(const bf16x8*)(Ks + (32 * c + r) * MEM_KLD + 16 * s + 8 * h); sc = MFMA32(kf, qf[s], sc); }
#pragma unroll
                for (int i = 0; i < 16; ++i) { const float pz = exp2f((sc[i] - mx) * SC); sc[i] = pz; l += pz; }
#pragma unroll
                for (int s2 = 0; s2 < 2; ++s2) {
                    const bf16x8 pf = mk8(cvtpk(sc[8 * s2 + 0], sc[8 * s2 + 1]), cvtpk(sc[8 * s2 + 2], sc[8 * s2 + 3]), cvtpk(sc[8 * s2 + 4], sc[8 * s2 + 5]), cvtpk(sc[8 * s2 + 6], sc[8 * s2 + 7]));
#pragma unroll
                    for (int dt = 0; dt < 4; ++dt) {
                        const bf16_t* va = Vt + (32 * dt + r) * MEM_VLD + 32 * c + 16 * s2 + 4 * h;
                        const u32x2 lo = *(const u32x2*)va, hi = *(const u32x2*)(va + 8);
                        oa[dt] = MFMA32(mk8(lo.x, lo.y, hi.x, hi.y), pf, oa[dt]);
                    }
                }
            }
            l += __shfl_xor(l, 32);
            const float inv = 1.f / l;
            bf16_t* yp = ycat + (size_t)(t0 + r) * 2048 + 1536 + hm * 128 + 4 * h;
#pragma unroll
            for (int dt = 0; dt < 4; ++dt)
#pragma unroll
                for (int g4 = 0; g4 < 4; ++g4) { u32x2 o; o.x = cvtpk(oa[dt][4 * g4] * inv, oa[dt][4 * g4 + 1] * inv); o.y = cvtpk(oa[dt][4 * g4 + 2] * inv, oa[dt][4 * g4 + 3] * inv);
                    *(u32x2*)(yp + 32 * dt + 8 * g4) = o; }
        }
    }
}

DI unsigned umax_(unsigned a, unsigned b) { return a > b ? a : b; }
DI unsigned umin_(unsigned a, unsigned b) { return a < b ? a : b; }
DI void cexd(unsigned& a, unsigned& b) { const unsigned mx = umax_(a, b), mn = umin_(a, b); a = mx; b = mn; }
DI void sort16_desc(unsigned (&v)[16]) {
#pragma unroll
    for (int k = 2; k <= 16; k <<= 1)
#pragma unroll
        for (int j = k >> 1; j > 0; j >>= 1)
#pragma unroll
            for (int i = 0; i < 16; ++i) { const int l = i ^ j; if (l > i) { if ((i & k) == 0) cexd(v[i], v[l]); else cexd(v[l], v[i]); } }
}
DI void merge16_desc(unsigned (&a)[16], const unsigned (&b)[16]) {
#pragma unroll
    for (int i = 0; i < 16; ++i) a[i] = umax_(a[i], b[15 - i]);
#pragma unroll
    for (int j = 8; j > 0; j >>= 1)
#pragma unroll
        for (int i = 0; i < 16; ++i) { const int l = i ^ j; if (l > i) cexd(a[i], a[l]); }
}
DI unsigned mono(float f) { const unsigned u = __builtin_bit_cast(unsigned, f); return u ^ ((unsigned)((int)u >> 31) | 0x80000000u); }
DI float demono(unsigned m) { const unsigned t = (unsigned)((int)m >> 31); return __builtin_bit_cast(float, m ^ (~t | 0x80000000u)); }
constexpr int TK_KLD = 136, TK_SCR_OFF = 2 * 128 * TK_KLD * 2;
DI void topk_phase(const bf16_t* qp, const bf16_t* keysb, const float* rstd2, int* ids, float* gts, unsigned char* lds) {
    const int tid = opaque_tid();
    const int lane = tid & 63, w = tid >> 6, r = lane & 31, h2 = lane >> 5;
    bf16_t* Kl = (bf16_t*)lds;
    unsigned char* scr = lds + TK_SCR_OFF + w * 2048 + lane * 32;
    int staged = -1;
    for (int unit = blockIdx.x; unit < 1024; unit += gridDim.x) {
        const int hd = unit & 7, tile = unit >> 3;
        if (hd != staged) {
            __syncthreads();
#pragma unroll
            for (int i = 0; i < 8; ++i) { const int c = tid + 512 * i, row = c >> 4, dc = (c & 15) * 8;
                *(u32x4*)(Kl + row * TK_KLD + dc) = *(const u32x4*)(keysb + ((size_t)hd * 256 + row) * 128 + dc); }
            __syncthreads();
            staged = hd;
        }
        const int t0 = tile * 256 + w * 32;
        unsigned K0[16], K1[16];
#pragma unroll
        for (int p = 0; p < 2; ++p) {
            const bf16_t* qrow = qp + (size_t)(t0 + r) * 2048 + hd * 256 + p * 128 + 8 * h2;
            bf16x8 qf[8];
#pragma unroll
            for (int s = 0; s < 8; ++s) qf[s] = *(const bf16x8*)(qrow + 16 * s);
            unsigned blk[4][16];
#pragma unroll
            for (int c = 0; c < 4; ++c) {
                f32x16 sc;
#pragma unroll
                for (int i = 0; i < 16; ++i) sc[i] = 0.f;
#pragma unroll
                for (int s = 0; s < 8; ++s) { const bf16x8 kf = *(const bf16x8*)(Kl + (p * 128 + 32 * c + r) * TK_KLD + 16 * s + 8 * h2); sc = MFMA32(kf, qf[s], sc); }
#pragma unroll
                for (int i = 0; i < 16; ++i) blk[c][i] = (mono(sc[i]) & ~0x7Fu) | (unsigned)(32 * c + crow(i, h2));
                sort16_desc(blk[c]);
            }
            merge16_desc(blk[0], blk[1]); merge16_desc(blk[2], blk[3]); merge16_desc(blk[0], blk[2]);
            unsigned oth[16];
#pragma unroll
            for (int i = 0; i < 16; ++i) oth[i] = (unsigned)__shfl_xor((int)blk[0][i], 32);
            merge16_desc(blk[0], oth);
#pragma unroll
            for (int i = 0; i < 16; ++i) { if (p == 0) K0[i] = blk[0][i]; else K1[i] = blk[0][i]; }
        }
#pragma unroll
        for (int q = 0; q < 4; ++q) {
            ((unsigned*)scr)[q] = (K0[4 * q] & 0x7Fu) | ((K0[4 * q + 1] & 0x7Fu) << 8) | ((K0[4 * q + 2] & 0x7Fu) << 16) | ((K0[4 * q + 3] & 0x7Fu) << 24);
            ((unsigned*)scr)[4 + q] = (K1[4 * q] & 0x7Fu) | ((K1[4 * q + 1] & 0x7Fu) << 8) | ((K1[4 * q + 2] & 0x7Fu) << 16) | ((K1[4 * q + 3] & 0x7Fu) << 24);
        }
        float sx[16], sy[16];
#pragma unroll
        for (int i = 0; i < 16; ++i) { const float s0 = demono(K0[i] & ~0x7Fu), s1 = demono(K1[i] & ~0x7Fu); sx[i] = h2 ? s1 : s0; sy[i] = h2 ? s0 : s1; }
        unsigned ca[16], cb[16];
#pragma unroll
        for (int i = 0; i < 16; ++i) { ca[i] = 0u; cb[i] = 0u; }
#define CAND(n, a, b) do { const unsigned key_ = (mono(sx[a] + sy[b]) & ~0xFFu) | (h2 ? (unsigned)(((b) << 4) | (a)) : (unsigned)(((a) << 4) | (b))); if ((n) < 16) ca[(n) & 15] = key_; else cb[(n) & 15] = key_; } while (0)
            CAND(0, 0, 1);
            CAND(1, 0, 2);
            CAND(2, 0, 3);
            CAND(3, 0, 4);
            CAND(4, 0, 5);
            CAND(5, 0, 6);
            CAND(6, 0, 7);
            CAND(7, 0, 8);
            CAND(8, 0, 9);
            CAND(9, 0, 10);
            CAND(10, 0, 11);
            CAND(11, 0, 12);
            CAND(12, 0, 13);
            CAND(13, 0, 14);
            CAND(14, 0, 15);
            CAND(15, 1, 2);
            CAND(16, 1, 3);
            CAND(17, 1, 4);
            CAND(18, 1, 5);
            CAND(19, 1, 6);
            CAND(20, 1, 7);
            CAND(21, 2, 3);
            CAND(22, 2, 4);
#undef CAND
#pragma unroll
        for (int d = 0; d < 4; ++d) { const unsigned key_ = (mono(sx[d] + sy[d]) & ~0xFFu) | (unsigned)((d << 4) | d); cb[7 + d] = h2 ? 0u : key_; }
        sort16_desc(ca); sort16_desc(cb); merge16_desc(ca, cb);
        unsigned fin[16], cpart[16];
#pragma unroll
        for (int i = 0; i < 16; ++i) cpart[i] = (unsigned)__shfl_xor((int)ca[i], 32);
#pragma unroll
        for (int i = 0; i < 16; ++i) fin[i] = umax_(ca[i], cpart[15 - i]);
        const float rs = 1.f / sqrtf(rstd2[t0 + r] * (1.f / D) + EPS);
        float sv[16], mxv = -3e38f;
#pragma unroll
        for (int i = 0; i < 16; ++i) { sv[i] = demono(fin[i] & ~0xFFu) * rs; mxv = fmaxf(mxv, sv[i]); }
        float den = 0.f;
#pragma unroll
        for (int i = 0; i < 16; ++i) { sv[i] = __expf(sv[i] - mxv); den += sv[i]; }
        const float rden = 1.f / den;
        int oid[8]; float og[8];
#pragma unroll
        for (int j = 0; j < 8; ++j) {
            const unsigned wk = fin[j]; og[j] = sv[j] * rden;
            const unsigned a0 = (wk >> 4) & 15u, a1 = wk & 15u;
            oid[j] = (int)scr[a0] * 128 + (int)scr[16 + a1];
        }
        int* ip = ids + (size_t)(t0 + r) * 128 + hd * 16 + 8 * h2; float* gp = gts + (size_t)(t0 + r) * 128 + hd * 16 + 8 * h2;
        *(u32x4*)ip = (u32x4){(unsigned)oid[0], (unsigned)oid[1], (unsigned)oid[2], (unsigned)oid[3]}; *(u32x4*)(ip + 4) = (u32x4){(unsigned)oid[4], (unsigned)oid[5], (unsigned)oid[6], (unsigned)oid[7]};
        *(f32x4*)gp = (f32x4){og[0], og[1], og[2], og[3]}; *(f32x4*)(gp + 4) = (f32x4){og[4], og[5], og[6], og[7]};
    }
}

typedef _Float16 h2_t __attribute__((ext_vector_type(2)));
template <int CTRL> DI float dpp_f(float v) { return __builtin_bit_cast(float, __builtin_amdgcn_update_dpp(0, __builtin_bit_cast(int, v), CTRL, 0xf, 0xf, true)); }
DI float row16_sum(float v) {
    v += dpp_f<0xB1>(v); v += dpp_f<0x4E>(v); v += dpp_f<0x141>(v); v += dpp_f<0x140>(v); return v; }
DI bf16x2_t as_b2(unsigned w) { return __builtin_bit_cast(bf16x2_t, w); }
DI float dot_row(const u32x4 (&xw)[4][2], const u32x4 (&ru)[4]) {
    float d0 = 0.f, d1 = 0.f;
#pragma unroll
    for (int i = 0; i < 4; ++i)
#pragma unroll
        for (int q = 0; q < 4; ++q) {
            const bf16x2_t z0 = __builtin_amdgcn_cvt_scalef32_pk_bf16_fp8((int)ru[i][q], 1.0f, false), z1 = __builtin_amdgcn_cvt_scalef32_pk_bf16_fp8((int)ru[i][q], 1.0f, true);
            d0 = __builtin_amdgcn_fdot2_f32_bf16(as_b2(xw[i][q >> 1][2 * (q & 1)]), z0, d0, false); d1 = __builtin_amdgcn_fdot2_f32_bf16(as_b2(xw[i][q >> 1][2 * (q & 1) + 1]), z1, d1, false);
        }
    return row16_sum(d0 + d1);
}
DI float swz_xor4(float v) { return __builtin_bit_cast(float, __builtin_amdgcn_ds_swizzle(__builtin_bit_cast(int, v), 0x101F)); }
DI float* partial_base(unsigned char* ws, int x) { return (float*)(ws + (x < 4 ? 42 * MiB + (size_t)x * 16 * MiB : 170 * MiB + (size_t)(x - 4) * 16 * MiB)); }
template <int VAR>
DI void peer_u2_phase(const bf16_t* x1b, const unsigned char* u8, const int* ids, float* part, unsigned char* lds, int lbl, int rnk, int cnt) {
    const int tid = opaque_tid(), lane = tid & 63, wave = tid >> 6, g8 = lane >> 3, s8 = lane & 7;
    constexpr int LST = 132;
    int* lid = (int*)(lds + wave * (2 * 8 * LST * 4)); float* lpa = (float*)(lid + 8 * LST);
    const int stride = cnt * NWAVES * 8;
    const unsigned char* ubase = u8 + lbl * 128;
    const bool b4 = (s8 & 4) != 0, b2 = (s8 & 2) != 0, b1 = (s8 & 1) != 0;
    for (int t0 = (rnk * NWAVES + wave) * 8; t0 < T; t0 += stride) {
#pragma unroll
        for (int j = 0; j < 4; ++j) { const int f = lane * 4 + 256 * j, tk = f >> 7, k = f & 127; *(u32x4*)(lid + tk * LST + k) = *(const u32x4*)(ids + (size_t)t0 * 128 + f); }
        const size_t xo_ = (size_t)(t0 + g8) * D + lbl * 128 + 16 * s8;
        const u32x4 xa = *(const u32x4*)(x1b + xo_), xb2 = *(const u32x4*)(x1b + xo_ + 8);
        float xf[16];
        xf[0] = bflo(xa.x); xf[1] = bfhi(xa.x); xf[2] = bflo(xa.y); xf[3] = bfhi(xa.y); xf[4] = bflo(xa.z); xf[5] = bfhi(xa.z); xf[6] = bflo(xa.w); xf[7] = bfhi(xa.w);
        xf[8] = bflo(xb2.x); xf[9] = bfhi(xb2.x); xf[10] = bflo(xb2.y); xf[11] = bfhi(xb2.y); xf[12] = bflo(xb2.z); xf[13] = bfhi(xb2.z); xf[14] = bflo(xb2.w); xf[15] = bfhi(xb2.w);
        float xm = 0.f;
#pragma unroll
        for (int e = 0; e < 16; ++e) xm = fmaxf(xm, fabsf(xf[e]));
        xm = fmaxf(xm, dpp_f<0xB1>(xm)); xm = fmaxf(xm, dpp_f<0x4E>(xm)); xm = fmaxf(xm, dpp_f<0x141>(xm));
        const float xinv = xm > 0.f ? 127.f / xm : 0.f, sx = xm * (1.f / 127.f);
        int xq[4];
#pragma unroll
        for (int q = 0; q < 4; ++q) { const int q0 = (int)__builtin_rintf(xf[4 * q] * xinv), q1 = (int)__builtin_rintf(xf[4 * q + 1] * xinv), q2 = (int)__builtin_rintf(xf[4 * q + 2] * xinv), q3 = (int)__builtin_rintf(xf[4 * q + 3] * xinv);
            xq[q] = (int)((unsigned)(q0 & 255) | ((unsigned)(q1 & 255) << 8) | ((unsigned)(q2 & 255) << 16) | ((unsigned)q3 << 24)); }
        const int* myid = lid + g8 * LST; float* mypa = lpa + g8 * LST;
        const unsigned loff = (unsigned)(s8 * 16);
#define U2_FETCH(K8, RW) do { const int kc_ = (K8) < 128 ? (K8) : 120; const u32x4 i0_ = *(const u32x4*)(myid + kc_), i1_ = *(const u32x4*)(myid + kc_ + 4); \
            _Pragma("unroll") for (int i = 0; i < 8; ++i) { const unsigned id_ = i < 4 ? i0_[i & 3] : i1_[i & 3]; \
                if (VAR & 1) RW[i] = (u32x4){id_, id_ * 3u, id_ * 5u, id_ * 7u}; else RW[i] = *(const u32x4*)(ubase + (id_ * (unsigned)D + loff)); } } while (0)
#define U2_REDUCE(K8, RW) do { int pp[8]; \
            _Pragma("unroll") for (int i = 0; i < 8; ++i) { \
                if (VAR & 2) { pp[i] = (int)((RW[i].x ^ RW[i].y ^ RW[i].z ^ RW[i].w ^ xa.x) & 0xffu); continue; } \
                int d_ = 0; \
                _Pragma("unroll") for (int q = 0; q < 4; ++q) d_ = __builtin_amdgcn_sdot4((int)RW[i][q], xq[q], d_, false); \
                pp[i] = d_; } \
            int q4[4], q2[2]; \
            _Pragma("unroll") for (int j = 0; j < 4; ++j) { const int keep = b4 ? pp[j + 4] : pp[j], send = b4 ? pp[j] : pp[j + 4]; q4[j] = keep + __builtin_amdgcn_ds_swizzle(send, 0x101F); } \
            _Pragma("unroll") for (int j = 0; j < 2; ++j) { const int keep = b2 ? q4[j + 2] : q4[j], send = b2 ? q4[j] : q4[j + 2]; q2[j] = keep + __builtin_amdgcn_update_dpp(0, send, 0x4E, 0xf, 0xf, true); } \
            const int keep1 = b1 ? q2[1] : q2[0], send1 = b1 ? q2[0] : q2[1]; \
            mypa[(K8) + s8] = (float)(keep1 + __builtin_amdgcn_update_dpp(0, send1, 0xB1, 0xf, 0xf, true)) * sx;     } while (0)
        u32x4 rwA[8], rwB[8];
        U2_FETCH(0, rwA);
        for (int k8 = 0; k8 < 128; k8 += 16) {
            U2_FETCH(k8 + 8, rwB);
            U2_REDUCE(k8, rwA);
            U2_FETCH(k8 + 16, rwA);
            U2_REDUCE(k8 + 8, rwB);
        }
#undef U2_FETCH
#undef U2_REDUCE
        float* pg = part + (size_t)t0 * 128;
#pragma unroll
        for (int j = 0; j < 4; ++j) { const int f = lane * 4 + 256 * j, tk = f >> 7, k = f & 127; *(f32x4*)(pg + f) = *(const f32x4*)(lpa + tk * LST + k); }
    }
}
DI void peer_combine_phase(unsigned char* ws, const float* ssq2, const float* gts, const int* ids, const float* su, float* coef) {
    const size_t gt = (size_t)blockIdx.x * NTHREADS + opaque_tid(), NGT = (size_t)gridDim.x * NTHREADS;
    for (size_t i = gt; i < (size_t)T * 32; i += NGT) {
        const int t = (int)(i >> 5);
        f32x4 a = ((const f32x4*)partial_base(ws, 0))[i];
#pragma unroll
        for (int x = 1; x < 8; ++x) a += ((const f32x4*)partial_base(ws, x))[i];
        const float rs = __builtin_amdgcn_rsqf(ssq2[t] * (1.f / D) + EPS);
        const f32x4 g = ((const f32x4*)gts)[i]; const u32x4 id = ((const u32x4*)ids)[i];
        ((f32x4*)coef)[i] = (f32x4){g.x * gelu_tanh(a.x * rs * su[id.x]) * 0.5f, g.y * gelu_tanh(a.y * rs * su[id.y]) * 0.5f, g.z * gelu_tanh(a.z * rs * su[id.z]) * 0.5f, g.w * gelu_tanh(a.w * rs * su[id.w]) * 0.5f};
    }
}
template <int VAR>
DI void peer_v_phase(const bf16_t* x1in, bf16_t* xout, const unsigned char* v8, const int* ids, const float* coef, float* ssqo, unsigned char* lds, int lbl, int rnk, int cnt) {
    const int tid = opaque_tid(), lane = tid & 63, wave = tid >> 6, g8 = lane >> 3, s8 = lane & 7;
    constexpr int LST = 132;
    int* lid = (int*)(lds + wave * (2 * 8 * LST * 4)); float* lco = (float*)(lid + 8 * LST);
    const int stride = cnt * NWAVES * 8;
    const unsigned char* vbase = v8 + lbl * 128;
    for (int t0 = (rnk * NWAVES + wave) * 8; t0 < T; t0 += stride) {
#pragma unroll
        for (int j = 0; j < 4; ++j) { const int f = lane * 4 + 256 * j, tk = f >> 7, k = f & 127;
            *(u32x4*)(lid + tk * LST + k) = *(const u32x4*)(ids + (size_t)t0 * 128 + f); *(f32x4*)(lco + tk * LST + k) = *(const f32x4*)(coef + (size_t)t0 * 128 + f); }
        f32x2_t acc[8];
#pragma unroll
        for (int j = 0; j < 8; ++j) acc[j] = (f32x2_t){0.f, 0.f};
        const int* myid = lid + g8 * LST; const float* myco = lco + g8 * LST;
        const unsigned loff = (unsigned)(s8 * 16);
#define V_FETCH(K8, RW, CO) do { const int kc_ = (K8) < 128 ? (K8) : 120; const u32x4 i0_ = *(const u32x4*)(myid + kc_), i1_ = *(const u32x4*)(myid + kc_ + 4); \
            const f32x4 c0_ = *(const f32x4*)(myco + kc_), c1_ = *(const f32x4*)(myco + kc_ + 4); \
            _Pragma("unroll") for (int i = 0; i < 8; ++i) { const unsigned id_ = i < 4 ? i0_[i & 3] : i1_[i & 3]; CO[i] = i < 4 ? c0_[i & 3] : c1_[i & 3]; \
                if (VAR & 1) RW[i] = (u32x4){id_, id_ * 3u, id_ * 5u, id_ * 7u}; else RW[i] = *(const u32x4*)(vbase + (id_ * (unsigned)D + loff)); } } while (0)
#define V_ACCUM(RW, CO) do { _Pragma("unroll") for (int i = 0; i < 8; ++i) { const f32x2_t cc = {CO[i], CO[i]}; \
                if (VAR & 2) { acc[i].x += __builtin_bit_cast(float, (RW[i].x ^ RW[i].y ^ RW[i].z ^ RW[i].w) & 0x3fffffffu) * CO[i]; continue; } \
                _Pragma("unroll") for (int q = 0; q < 4; ++q) { const f32x2_t a = __builtin_amdgcn_cvt_pk_f32_fp8((int)RW[i][q], false), b = __builtin_amdgcn_cvt_pk_f32_fp8((int)RW[i][q], true); \
                    acc[2 * q] = __builtin_elementwise_fma(a, cc, acc[2 * q]); acc[2 * q + 1] = __builtin_elementwise_fma(b, cc, acc[2 * q + 1]); } } } while (0)
        u32x4 rwA[8], rwB[8]; float coA[8], coB[8];
        V_FETCH(0, rwA, coA);
        for (int k8 = 0; k8 < 128; k8 += 16) {
            V_FETCH(k8 + 8, rwB, coB);
            V_ACCUM(rwA, coA);
            V_FETCH(k8 + 16, rwA, coA);
            V_ACCUM(rwB, coB);
        }
#undef V_FETCH
#undef V_ACCUM
        const size_t xo_ = (size_t)(t0 + g8) * D + lbl * 128 + 16 * s8;
        const u32x4 xa = *(const u32x4*)(x1in + xo_), xb2 = *(const u32x4*)(x1in + xo_ + 8);
        float o[16];
        o[0] = bflo(xa.x) + acc[0].x; o[1] = bfhi(xa.x) + acc[0].y; o[2] = bflo(xa.y) + acc[1].x; o[3] = bfhi(xa.y) + acc[1].y; o[4] = bflo(xa.z) + acc[2].x; o[5] = bfhi(xa.z) + acc[2].y; o[6] = bflo(xa.w) + acc[3].x; o[7] = bfhi(xa.w) + acc[3].y;
        o[8] = bflo(xb2.x) + acc[4].x; o[9] = bfhi(xb2.x) + acc[4].y; o[10] = bflo(xb2.y) + acc[5].x; o[11] = bfhi(xb2.y) + acc[5].y; o[12] = bflo(xb2.z) + acc[6].x; o[13] = bfhi(xb2.z) + acc[6].y; o[14] = bflo(xb2.w) + acc[7].x; o[15] = bfhi(xb2.w) + acc[7].y;
        float ss = 0.f;
#pragma unroll
        for (int e = 0; e < 16; ++e) ss += o[e] * o[e];
        ss += dpp_f<0xB1>(ss); ss += dpp_f<0x4E>(ss); ss += dpp_f<0x141>(ss);
        if (s8 == 0) atomicAdd(ssqo + t0 + g8, ss);
        u32x4 w0, w1; w0.x = pk2(o[0], o[1]); w0.y = pk2(o[2], o[3]); w0.z = pk2(o[4], o[5]); w0.w = pk2(o[6], o[7]); w1.x = pk2(o[8], o[9]); w1.y = pk2(o[10], o[11]); w1.z = pk2(o[12], o[13]); w1.w = pk2(o[14], o[15]);
        *(u32x4*)(xout + xo_) = w0; *(u32x4*)(xout + xo_ + 8) = w1;
    }
}
DI void peer_final_phase(const bf16_t* xo, const float* ssqo, const float* gf, float* out) {
    const int tid = opaque_tid(), lane = tid & 63, gw = blockIdx.x * NWAVES + (tid >> 6), NGW = gridDim.x * NWAVES;
    f32x4 g[4];
#pragma unroll
    for (int q = 0; q < 4; ++q) g[q] = *(const f32x4*)(gf + lane * 16 + 4 * q);
    for (int t = gw; t < T; t += NGW) {
        const u32x4 w0 = *(const u32x4*)(xo + (size_t)t * D + lane * 16), w1 = *(const u32x4*)(xo + (size_t)t * D + lane * 16 + 8);
        const float rf = 1.f / sqrtf(ssqo[t] * (1.f / D) + EPS);
        f32x4* po = (f32x4*)(out + (size_t)t * D + lane * 16);
        po[0] = (f32x4){bflo(w0.x), bfhi(w0.x), bflo(w0.y), bfhi(w0.y)} * rf * g[0]; po[1] = (f32x4){bflo(w0.z), bfhi(w0.z), bflo(w0.w), bfhi(w0.w)} * rf * g[1];
        po[2] = (f32x4){bflo(w1.x), bfhi(w1.x), bflo(w1.y), bfhi(w1.y)} * rf * g[2]; po[3] = (f32x4){bflo(w1.z), bfhi(w1.z), bflo(w1.w), bfhi(w1.w)} * rf * g[3];
    }
}

#define LAS __attribute__((address_space(3)))
#define XB_TMO      128
#define XB_XCNT(j)  (256  + 64 * (j))
#define XB_XSUB(j)  (1280 + 64 * (j))
#define XB_XGEN(j)  (2304 + 64 * (j))
#define XB_TOP      3328
#define XB_TOPGEN   3392
#define XCD_BAR_WORDS 3456
#define XB_SPIN_CAP (1u << 18)
DI unsigned xb_ld(unsigned* p)              { return __hip_atomic_load(p, __ATOMIC_RELAXED, __HIP_MEMORY_SCOPE_AGENT); }
DI unsigned xb_add(unsigned* p, unsigned v) { return __hip_atomic_fetch_add(p, v, __ATOMIC_RELAXED, __HIP_MEMORY_SCOPE_AGENT); }
DI unsigned xb_xcc_id() { return (unsigned)__builtin_amdgcn_s_getreg((3 << 11) | 20) & 0xFu; }
#define XB_SPIN(cond, bar) do { unsigned _sp = 0; while (cond) { __builtin_amdgcn_s_sleep(1); \
    if ((++_sp & 255u) == 0u) { if (xb_ld(&(bar)[XB_TMO])) break; if (_sp > XB_SPIN_CAP) { atomicAdd(&(bar)[XB_TMO], 1u); break; } } } } while (0)
struct XcdBarrier { unsigned* bar; unsigned x; volatile LAS unsigned* st; };
DI XcdBarrier xcd_barrier_post(unsigned* bar, volatile LAS unsigned* st) {
    XcdBarrier b; b.bar = bar; b.x = xb_xcc_id(); b.st = st;
    if (threadIdx.x == 0) st[2] = xb_add(&bar[XB_XCNT(b.x)], 1u);
    return b;
}
DI void xcd_barrier_complete(unsigned* bar, unsigned x, unsigned& nloc, unsigned& nx) {
    const unsigned G = gridDim.x * gridDim.y * gridDim.z;
    unsigned sum, cnt, mine, sp = 0u;
    for (;;) {
        sum = 0u; cnt = 0u; mine = 0u;
#pragma unroll
        for (unsigned j = 0; j < 16; ++j) { const unsigned c = xb_ld(&bar[XB_XCNT(j)]); sum += c; cnt += (c > 0u) ? 1u : 0u; mine = (j == x) ? c : mine; }
        if (sum == G) break;
        __builtin_amdgcn_s_sleep(1);
        if ((++sp & 255u) == 0u) { if (xb_ld(&bar[XB_TMO])) break; if (sp > XB_SPIN_CAP) { atomicAdd(&bar[XB_TMO], 1u); break; } }
    }
    nloc = mine > 0u ? mine : 1u; nx = cnt > 0u ? cnt : 1u;
}
DI void xcd_barrier(const XcdBarrier& b) {
    asm volatile("s_waitcnt vmcnt(0)" ::: "memory");
    __syncthreads();
    if (threadIdx.x == 0) {
        unsigned* bar = b.bar;
        __builtin_amdgcn_s_waitcnt(0);
        unsigned nloc = b.st[0], nx = b.st[1];
        if (nloc == 0u) { xcd_barrier_complete(bar, b.x, nloc, nx); b.st[0] = nloc; b.st[1] = nx; }
        const unsigned old = xb_add(&bar[XB_XSUB(b.x)], 1u);
        const unsigned gen = old / nloc;
        if (old + 1u == (gen + 1u) * nloc) {
            __builtin_amdgcn_fence(__ATOMIC_RELEASE, "agent");
            asm volatile("s_waitcnt vmcnt(0)" ::: "memory");
            const unsigned og = xb_add(&bar[XB_TOP], 1u);
            const unsigned tg = og / nx;
            if (og + 1u == (tg + 1u) * nx) xb_add(&bar[XB_TOPGEN], 1u);
            else XB_SPIN(xb_ld(&bar[XB_TOPGEN]) == tg, bar);
            __builtin_amdgcn_fence(__ATOMIC_ACQUIRE, "agent");
            xb_add(&bar[XB_XGEN(b.x)], 1u);
            asm volatile("s_waitcnt vmcnt(0)" ::: "memory");
        } else {
            XB_SPIN(xb_ld(&bar[XB_XGEN(b.x)]) == gen, bar);
            __builtin_amdgcn_fence(__ATOMIC_ACQUIRE, "agent");
            asm volatile("s_waitcnt vmcnt(0)" ::: "memory");
        }
    }
    __syncthreads();
}

#ifndef DUP_PHASE
#define DUP_PHASE -1
#endif
#ifndef PROBE_VAR
#define PROBE_VAR 0
#endif
constexpr int LDS_BYTES = 147456;
__global__ void __launch_bounds__(NTHREADS, 2) fwd_kernel(Params p) {
    extern __shared__ __attribute__((aligned(16))) unsigned char lds[];
    cg::grid_group grid = cg::this_grid();
    volatile LAS unsigned* bst = (volatile LAS unsigned*)((LAS unsigned char*)lds + (LDS_BYTES - 64));
    if (threadIdx.x < 4) bst[threadIdx.x] = 0u;
    __syncthreads();
    const XcdBarrier xbar = xcd_barrier_post((unsigned*)p.ws, bst);
    const int NGW = gridDim.x * NWAVES, G = gridDim.x, cu = blockIdx.x;
    unsigned char* ws = p.ws;
    PG8_LAS unsigned char* ldsl = (PG8_LAS unsigned char*)lds;
    bf16_t* ycat = (bf16_t*)p.out;

    for (int rep_ = 0; rep_ < (DUP_PHASE == 0 ? 2 : 1); ++rep_) { phase0(p, (float*)lds);
    if (p.use_cg_sync) grid.sync(); else xcd_barrier(xbar); }
    for (int rep_ = 0; rep_ < (DUP_PHASE == 1 ? 2 : 1); ++rep_) {
        EpiZ E{(const float*)(ws + WS_RSTD1), (const float*)(ws + WS_RSTDM), (const float2*)(ws + WS_ROPE), (bf16_t*)(ws + WS_UPOOL), (bf16_t*)(ws + WS_QR), (bf16_t*)(ws + WS_KR), (bf16_t*)(ws + WS_VV), (bf16_t*)(ws + WS_QM), (bf16_t*)(ws + WS_GATES), (bf16_t*)(ws + WS_KVM)};
        SchedZ S{(const char*)(ws + WS_XB), (const char*)(ws + WS_WIN), (const char*)(ws + WS_MEMB), (const char*)(ws + WS_WMKV), G, cu};
        pg8::gemm_phase(ldsl, 1024, 1024, S, E);
    xcd_barrier(xbar); }
    for (int rep_ = 0; rep_ < (DUP_PHASE == 2 ? 2 : 1); ++rep_) {
    pooled_phase((const bf16_t*)(ws + WS_UPOOL), ycat);
    swa_phase((const bf16_t*)(ws + WS_QR), (const bf16_t*)(ws + WS_KR), (const bf16_t*)(ws + WS_VV), p.sinks, ycat, lds);
    mem_phase((const bf16_t*)(ws + WS_QM), (const bf16_t*)(ws + WS_KVM), ycat, lds);
    xcd_barrier(xbar); }
    for (int rep_ = 0; rep_ < (DUP_PHASE == 3 ? 2 : 1); ++rep_) {
        EpiGated E{(const bf16_t*)(ws + WS_GATES), (bf16_t*)(ws + WS_MERGED)};
        SchedGated S{(const char*)ycat, (const char*)(ws + WS_WBR), G, cu};
        pg8::gemm_phase(ldsl, 2048, 2048, S, E);
    xcd_barrier(xbar); }
    for (int rep_ = 0; rep_ < (DUP_PHASE == 4 ? 2 : 1); ++rep_) {
        EpiOut E{(const bf16_t*)(ws + WS_XB), (bf16_t*)(ws + WS_X1B), (float*)(ws + WS_RSTD2)};
        SchedPlain S{(const char*)(ws + WS_MERGED), (const char*)(ws + WS_WOUT), 1024, 1024, 128, 4, 16, G, cu};
        pg8::gemm_phase(ldsl, 1024, 1024, S, E);
    xcd_barrier(xbar); }
    for (int rep_ = 0; rep_ < (DUP_PHASE == 5 ? 2 : 1); ++rep_) {
        EpiBf16 E{(bf16_t*)(ws + WS_QP), 2048};
        SchedPlain S{(const char*)(ws + WS_X1B), (const char*)(ws + WS_WQ), 1024, 1024, 128, 8, 16, G, cu};
        pg8::gemm_phase(ldsl, 1024, 1024, S, E);
    xcd_barrier(xbar); }
    for (int rep_ = 0; rep_ < (DUP_PHASE == 6 ? 2 : 1); ++rep_) {
    topk_phase((const bf16_t*)(ws + WS_QP), (const bf16_t*)(ws + WS_KEYS), (const float*)(ws + WS_RSTD2), (int*)(ws + WS_IDS), (float*)(ws + WS_GTS), lds);
    xcd_barrier(xbar); }
    int lbl, rnk, cnt;
    {
        unsigned* bar = (unsigned*)p.ws; unsigned sum = 0u, mine = 0u; bool ok = xbar.x < 8u;
#pragma unroll
        for (unsigned j = 0; j < 8; ++j) { const unsigned c = xb_ld(&bar[XB_XCNT(j)]); sum += c; ok = ok && (c > 0u); mine = (j == xbar.x) ? c : mine; }
        ok = ok && (sum == (unsigned)G);
        lbl = ok ? (int)xbar.x : (cu & 7); rnk = ok ? (int)bst[2] : (cu >> 3); cnt = ok ? (int)mine : ((G - (cu & 7) + 7) >> 3);
        lbl = __builtin_amdgcn_readfirstlane(lbl); rnk = __builtin_amdgcn_readfirstlane(rnk); cnt = __builtin_amdgcn_readfirstlane(cnt);
    }
    if (DUP_PHASE == 7) {
        peer_u2_phase<PROBE_VAR>((const bf16_t*)(ws + WS_X1B), (const unsigned char*)(ws + WS_U16), (const int*)(ws + WS_IDS), partial_base(ws, lbl), lds, lbl, rnk, cnt);
        xcd_barrier(xbar); }
    peer_u2_phase<0>((const bf16_t*)(ws + WS_X1B), (const unsigned char*)(ws + WS_U16), (const int*)(ws + WS_IDS), partial_base(ws, lbl), lds, lbl, rnk, cnt);
    xcd_barrier(xbar);
    peer_combine_phase(ws, (const float*)(ws + WS_RSTD2), (const float*)(ws + WS_GTS), (const int*)(ws + WS_IDS), (const float*)(ws + WS_SU), (float*)(ws + WS_COEF));
    xcd_barrier(xbar);
    if (DUP_PHASE == 8) {
        peer_v_phase<PROBE_VAR>((const bf16_t*)(ws + WS_X1B), (bf16_t*)(ws + WS_MERGED), (const unsigned char*)(ws + WS_V16), (const int*)(ws + WS_IDS), (const float*)(ws + WS_COEF), (float*)(ws + WS_RSTD1), lds, lbl, rnk, cnt);
        xcd_barrier(xbar); }
    peer_v_phase<0>((const bf16_t*)(ws + WS_X1B), (bf16_t*)(ws + WS_X1B), (const unsigned char*)(ws + WS_V16), (const int*)(ws + WS_IDS), (const float*)(ws + WS_COEF), (float*)(ws + WS_SSQO), lds, lbl, rnk, cnt);
    xcd_barrier(xbar);
    for (int rep_ = 0; rep_ < (DUP_PHASE == 9 ? 2 : 1); ++rep_)
    peer_final_phase((const bf16_t*)(ws + WS_X1B), (const float*)(ws + WS_SSQO), p.final_g, p.out);
}

extern "C" void kernel_launch(void* const* d_in, const int* in_sizes, int n_in, void* d_out, int out_size, void* d_ws, size_t ws_size, hipStream_t stream) {
    static int grid_blocks = 0;
    if (grid_blocks == 0) {
        if (n_in != 20 || out_size != T * D || ws_size < WS_END) { fprintf(stderr, "kernel_launch: unexpected shapes: n_in %d out %d ws %zu\n", n_in, out_size, ws_size); grid_blocks = -1; return; }
        int dev = 0, cus = 0, per_cu = 0;
        (void)hipGetDevice(&dev);
        (void)hipDeviceGetAttribute(&cus, hipDeviceAttributeMultiprocessorCount, dev);
        if (hipFuncSetAttribute((const void*)fwd_kernel, hipFuncAttributeMaxDynamicSharedMemorySize, LDS_BYTES) != hipSuccess) { fprintf(stderr, "kernel_launch: hipFuncSetAttribute failed\n"); grid_blocks = -1; return; }
        (void)hipOccupancyMaxActiveBlocksPerMultiprocessor(&per_cu, (const void*)fwd_kernel, NTHREADS, LDS_BYTES);
        if (per_cu < 1) { fprintf(stderr, "kernel_launch: occupancy query says %d blocks per CU\n", per_cu); grid_blocks = -1; return; }
        grid_blocks = cus * per_cu;
        fprintf(stderr, "kernel_launch: cus %d per_cu %d grid %d ws %zu\n", cus, per_cu, grid_blocks, ws_size);
    }
    if (grid_blocks < 0) return;
    Params p{};
    p.x = (const float*)d_in[0]; p.mem = (const float*)d_in[1]; p.pos = (const int*)d_in[2]; p.norm1_g = (const float*)d_in[3]; p.mem_norm_g = (const float*)d_in[4];
    p.w_in = (const float*)d_in[5]; p.w_pool = (const float*)d_in[6]; p.pool_scale = (const float*)d_in[7]; p.sinks = (const float*)d_in[8]; p.w_mem_kv = (const float*)d_in[9];
    p.w_bpool = (const float*)d_in[10]; p.w_bswa = (const float*)d_in[11]; p.w_bmem = (const float*)d_in[12]; p.w_out = (const float*)d_in[13]; p.norm2_g = (const float*)d_in[14];
    p.w_q = (const float*)d_in[15]; p.sub_keys = (const float*)d_in[16]; p.peer_u = (const float*)d_in[17]; p.peer_v = (const float*)d_in[18]; p.final_g = (const float*)d_in[19];
    p.out = (float*)d_out; p.ws = (unsigned char*)d_ws;
    (void)hipMemsetAsync(d_ws, 0, 16384, stream);
    void* args[] = {&p};
    hipError_t e = hipLaunchCooperativeKernel((const void*)fwd_kernel, dim3(grid_blocks), dim3(NTHREADS), args, LDS_BYTES, stream);
    if (e != hipSuccess) fprintf(stderr, "cooperative launch failed: %s (grid %d)\n", hipGetErrorString(e), grid_blocks);
}
```

```cpp
#include <hip/hip_runtime.h>
#include <hip/hip_cooperative_groups.h>
#include <cstdio>
#include <cstdint>
namespace cg = cooperative_groups;

#define DI __device__ __forceinline__
typedef unsigned short bf16_t;
typedef _Float16 f16_t;
typedef short bf16x8 __attribute__((ext_vector_type(8)));
typedef float f32x4 __attribute__((ext_vector_type(4)));
typedef float f32x16 __attribute__((ext_vector_type(16)));
typedef unsigned u32x4 __attribute__((ext_vector_type(4)));
typedef unsigned u32x2 __attribute__((ext_vector_type(2)));
typedef _Float16 f16x4 __attribute__((ext_vector_type(4)));

#ifndef DUP_PHASE
#define DUP_PHASE -1
#endif
#ifndef PROBE_VAR
#define PROBE_VAR 0
#endif
constexpr int D = 1024, BATCH = 8, SEQ = 4096, T = BATCH * SEQ, MEML = 256, TMEM = BATCH * MEML;
constexpr int INW = 5376;
constexpr int NTHREADS = 512, NWAVES = 8;
constexpr int NEXP = 16384;
constexpr float EPS = 1e-6f;

constexpr size_t MiB = 1u << 20;
constexpr size_t WS_WIN = 1 * MiB;
constexpr size_t WS_WBR = 12 * MiB;
constexpr size_t WS_WOUT = 16 * MiB;
constexpr size_t WS_WQ = 18 * MiB;
constexpr size_t WS_KEYS = 22 * MiB;
constexpr size_t WS_WPOOL = 22 * MiB + 512 * 1024;
constexpr size_t WS_RSTD1 = 22 * MiB + 768 * 1024;
constexpr size_t WS_RSTD2 = 22 * MiB + 896 * 1024;
constexpr size_t WS_RSTDM = 23 * MiB;
constexpr size_t WS_SSQO = 23 * MiB + 64 * 1024;
constexpr size_t WS_SU = 23 * MiB + 256 * 1024;
constexpr size_t WS_WMKV = 24 * MiB;
constexpr size_t WS_MEMB = 26 * MiB;
constexpr size_t WS_KVM = 30 * MiB;
constexpr size_t WS_ROPE = 34 * MiB;
constexpr size_t WS_XB = 42 * MiB;
constexpr size_t WS_POOLED = 42 * MiB;
constexpr size_t WS_MERGED = 170 * MiB;
constexpr size_t WS_U16 = 106 * MiB;
constexpr size_t WS_V16 = 138 * MiB;
constexpr size_t WS_UPOOL = 170 * MiB;
constexpr size_t WS_QR = 202 * MiB;
constexpr size_t WS_KR = 266 * MiB;
constexpr size_t WS_VV = 274 * MiB;
constexpr size_t WS_QM = 282 * MiB;
constexpr size_t WS_GATES = 314 * MiB;
constexpr size_t WS_X1B = 234 * MiB;
constexpr size_t WS_QP = 314 * MiB;
constexpr size_t WS_COEF = 314 * MiB;
constexpr size_t WS_IDS = 442 * MiB;
constexpr size_t WS_GTS = 458 * MiB;
constexpr size_t WS_END = 512 * MiB;

struct Params {
    const float* x; const float* mem; const int* pos; const float* norm1_g; const float* mem_norm_g; const float* w_in; const float* w_pool;
    const float* pool_scale; const float* sinks; const float* w_mem_kv; const float* w_bpool; const float* w_bswa; const float* w_bmem; const float* w_out;
    const float* norm2_g; const float* w_q; const float* sub_keys; const float* peer_u; const float* peer_v; const float* final_g;
    float* out; unsigned char* ws;
    int use_cg_sync; int pad_;
};

DI unsigned f2bf(float f) { unsigned u = __builtin_bit_cast(unsigned, f); return (u + 0x7fffu + ((u >> 16) & 1u)) >> 16; }
DI unsigned pk2(float lo, float hi) { return f2bf(lo) | (f2bf(hi) << 16); }
DI float bf2f(bf16_t b) { return __builtin_bit_cast(float, (unsigned)b << 16); }
DI float bflo(unsigned w) { return __builtin_bit_cast(float, w << 16); }
DI float bfhi(unsigned w) { return __builtin_bit_cast(float, w & 0xffff0000u); }
DI float wave_sum(float v) {
#pragma unroll
    for (int o = 1; o < 64; o <<= 1) v += __shfl_xor(v, o);
    return v;
}
DI float wave_max(float v) {
#pragma unroll
    for (int o = 1; o < 64; o <<= 1) v = fmaxf(v, __shfl_xor(v, o));
    return v;
}
DI float gelu_tanh(float x) {
    const float y2 = 1.5957691216057308f * (x + 0.044715f * x * x * x);
    return x * __builtin_amdgcn_rcpf(1.f + __builtin_amdgcn_exp2f(-1.4426950408889634f * y2));
}
DI float sigmoidf(float x) { return __builtin_amdgcn_rcpf(1.f + __builtin_amdgcn_exp2f(-1.4426950408889634f * x)); }

DI int opaque_tid() { int t = threadIdx.x; asm volatile("" : "+v"(t)); return t; }
DI int zperm(int n) {
    if (n < 512 || n >= 1664) return n;
    const int d = (n - 512) & 63, hb = n - d; return hb + 8 * ((d & 31) >> 2) + (d & 3) + 4 * (d >> 5);
}
template <bool ZPERM>
DI void transpose_item(const float* W, int K, int N, bf16_t* WT, int ldt, int roff, int coff, const float* g, float* scr, int item, int lane) {
    const int nblk = N / 32, kb = item / nblk, nb = item % nblk, k0 = 64 * kb, n0 = 32 * nb;
    float tv[32];
#pragma unroll
    for (int i = 0; i < 32; ++i) tv[i] = W[(size_t)(k0 + 2 * i + (lane >> 5)) * N + n0 + (lane & 31)];
#pragma unroll
    for (int i = 0; i < 32; ++i) { const int kk = 2 * i + (lane >> 5); float v = tv[i]; if (g) v *= g[k0 + kk]; scr[kk * 33 + (lane & 31)] = v; }
    asm volatile("s_waitcnt lgkmcnt(0)" ::: "memory");
    const int c = lane & 7;
#pragma unroll
    for (int j = 0; j < 4; ++j) { const int n = (lane >> 3) + 8 * j; const float* s = scr + (8 * c) * 33 + n;
        u32x4 o; o.x = pk2(s[0 * 33], s[1 * 33]); o.y = pk2(s[2 * 33], s[3 * 33]); o.z = pk2(s[4 * 33], s[5 * 33]); o.w = pk2(s[6 * 33], s[7 * 33]);
        const int nd = ZPERM ? zperm(n0 + n) : n0 + n;
        *(u32x4*)(WT + (size_t)(roff + nd) * ldt + coff + k0 + 8 * c) = o; }
    asm volatile("s_waitcnt lgkmcnt(0)" ::: "memory");
}

DI void row_to_bf16_rstd(const float* xrow, bf16_t* orow, float* rstd_out, int lane) {
    const f32x4* xr = (const f32x4*)xrow + lane;
    f32x4 v[4]; float s = 0.f;
#pragma unroll
    for (int j = 0; j < 4; ++j) { v[j] = xr[64 * j]; s += (v[j].x * v[j].x + v[j].y * v[j].y) + (v[j].z * v[j].z + v[j].w * v[j].w); }
    s = wave_sum(s);
    if (lane == 0) *rstd_out = 1.f / sqrtf(s * (1.f / D) + EPS);
    u32x2* o8 = (u32x2*)orow + lane;
#pragma unroll
    for (int j = 0; j < 4; ++j) { u32x2 w; w.x = pk2(v[j].x, v[j].y); w.y = pk2(v[j].z, v[j].w); o8[64 * j] = w; }
}

DI void phase0(const Params& p, float* lds_f) {
    const int tid_ = opaque_tid(), lane = tid_ & 63, wave = tid_ >> 6, gw = blockIdx.x * NWAVES + wave, NGW = gridDim.x * NWAVES;
    unsigned char* ws = p.ws;
    float* scr = lds_f + wave * (64 * 33);
    bf16_t* WinT = (bf16_t*)(ws + WS_WIN); bf16_t* WbrT = (bf16_t*)(ws + WS_WBR); bf16_t* WoutT = (bf16_t*)(ws + WS_WOUT); bf16_t* WqT = (bf16_t*)(ws + WS_WQ);
    bf16_t* WmkvT = (bf16_t*)(ws + WS_WMKV);
    constexpr int I_IN = (D / 64) * (INW / 32), I_BS = (1024 / 64) * (D / 32), I_BM = (512 / 64) * (D / 32), I_OUT = (D / 64) * (D / 32), I_Q = (D / 64) * (2048 / 32), I_MKV = (D / 64) * (D / 32);
    constexpr int NITEMS = I_IN + I_BS + I_BM + I_OUT + I_Q + I_MKV;
    for (int rp_ = 0; rp_ < (DUP_PHASE == 10 ? 2 : 1); ++rp_) {
    for (int it = gw; it < NITEMS; it += NGW) {
        int r = it;
        if (r < I_IN) { transpose_item<true>(p.w_in, D, INW, WinT, D, 0, 0, p.norm1_g, scr, r, lane); continue; } r -= I_IN;
        if (r < I_BS) { transpose_item<false>(p.w_bswa, 1024, D, WbrT, 2048, 0, 512, nullptr, scr, r, lane); continue; } r -= I_BS;
        if (r < I_BM) { transpose_item<false>(p.w_bmem, 512, D, WbrT, 2048, 0, 1536, nullptr, scr, r, lane); continue; } r -= I_BM;
        if (r < I_OUT) { transpose_item<false>(p.w_out, D, D, WoutT, D, 0, 0, nullptr, scr, r, lane); continue; } r -= I_OUT;
        if (r < I_Q) { transpose_item<false>(p.w_q, D, 2048, WqT, D, 0, 0, p.norm2_g, scr, r, lane); continue; } r -= I_Q;
        transpose_item<false>(p.w_mem_kv, D, D, WmkvT, D, 0, 0, p.mem_norm_g, scr, r, lane);
    }
    }
    for (int rp_ = 0; rp_ < (DUP_PHASE == 11 ? 2 : 1); ++rp_) {
    {
        const size_t gt0 = (size_t)gw * 64 + lane, NGT0 = (size_t)NGW * 64;
        for (size_t i = gt0; i < (size_t)512 * 256; i += NGT0) {
            const int n4 = (int)(i & 255), cp = (int)(i >> 8), g = cp >> 7;
            const float* wp = p.w_pool + (size_t)cp * 128; const float* sc = p.pool_scale + g * 128; const f32x4* wb = (const f32x4*)(p.w_bpool + (size_t)(g * 128) * 1024) + n4;
            f32x4 a = {0.f, 0.f, 0.f, 0.f};
#pragma unroll 16
            for (int d = 0; d < 128; ++d) a += wb[(size_t)d * 256] * (wp[d] * sc[d]);
            bf16_t* o = WbrT + (size_t)(4 * n4) * 2048 + cp;
            o[0] = (bf16_t)f2bf(a.x); o[2048] = (bf16_t)f2bf(a.y); o[4096] = (bf16_t)f2bf(a.z); o[6144] = (bf16_t)f2bf(a.w);
        }
    }
    }
    bf16_t* xb = (bf16_t*)(ws + WS_XB); float* rstd1 = (float*)(ws + WS_RSTD1);
    for (int rp_ = 0; rp_ < (DUP_PHASE == 12 ? 2 : 1); ++rp_) {
    for (int m = gw; m < T; m += 4 * NGW) {
        f32x4 v[4][4];
#pragma unroll
        for (int q = 0; q < 4; ++q) { const int mq = (m + q * NGW < T) ? m + q * NGW : m; const f32x4* xr = (const f32x4*)(p.x + (size_t)mq * D) + lane;
#pragma unroll
            for (int j = 0; j < 4; ++j) v[q][j] = xr[64 * j]; }
#pragma unroll
        for (int q = 0; q < 4; ++q) { const int mq = m + q * NGW; float s = 0.f;
#pragma unroll
            for (int j = 0; j < 4; ++j) s += (v[q][j].x * v[q][j].x + v[q][j].y * v[q][j].y) + (v[q][j].z * v[q][j].z + v[q][j].w * v[q][j].w);
            s = wave_sum(s);
            if (mq < T) { if (lane == 0) rstd1[mq] = __builtin_amdgcn_rsqf(s * (1.f / D) + EPS);
                u32x2* o8 = (u32x2*)(xb + (size_t)mq * D) + lane;
#pragma unroll
                for (int j = 0; j < 4; ++j) { u32x2 wv; wv.x = pk2(v[q][j].x, v[q][j].y); wv.y = pk2(v[q][j].z, v[q][j].w); o8[64 * j] = wv; } } }
    }
    }
    bf16_t* memb = (bf16_t*)(ws + WS_MEMB); float* rstdm = (float*)(ws + WS_RSTDM);
    for (int m = gw; m < TMEM; m += NGW) row_to_bf16_rstd(p.mem + (size_t)m * D, memb + (size_t)m * D, rstdm + m, lane);
    const size_t gt = (size_t)gw * 64 + lane, NGT = (size_t)NGW * 64;
    bf16_t* keysb = (bf16_t*)(ws + WS_KEYS);
    for (size_t i = gt; i < (size_t)8 * 2 * 128 * 128 / 4; i += NGT) { const f32x4 v = ((const f32x4*)p.sub_keys)[i]; u32x2 w; w.x = pk2(v.x, v.y); w.y = pk2(v.z, v.w); ((u32x2*)keysb)[i] = w; }
    for (int rp_ = 0; rp_ < (DUP_PHASE == 14 ? 2 : 1); ++rp_) {
    {
        unsigned* u8 = (unsigned*)(ws + WS_U16); unsigned* v8 = (unsigned*)(ws + WS_V16); float* su = (float*)(ws + WS_SU);
        f32x4 g2r[4];
#pragma unroll
        for (int j = 0; j < 4; ++j) g2r[j] = ((const f32x4*)p.norm2_g)[lane + 64 * j];
        for (int r0 = gw; r0 < NEXP; r0 += 2 * NGW) {
            f32x4 au[2][4], av[2][4];
#pragma unroll
            for (int h = 0; h < 2; ++h) { const int r = (r0 + h * NGW < NEXP) ? r0 + h * NGW : r0;
#pragma unroll
                for (int j = 0; j < 4; ++j) { au[h][j] = ((const f32x4*)p.peer_u)[(size_t)r * 256 + lane + 64 * j]; av[h][j] = ((const f32x4*)p.peer_v)[(size_t)r * 256 + lane + 64 * j]; } }
#pragma unroll
            for (int h = 0; h < 2; ++h) { const int r = r0 + h * NGW; if (r >= NEXP) continue;
                float mx = 0.f;
#pragma unroll
                for (int j = 0; j < 4; ++j) { au[h][j] = au[h][j] * g2r[j]; mx = fmaxf(fmaxf(mx, fmaxf(fabsf(au[h][j].x), fabsf(au[h][j].y))), fmaxf(fabsf(au[h][j].z), fabsf(au[h][j].w))); }
                mx = wave_max(mx);
                const float inv = mx > 0.f ? 127.f / mx : 0.f;
                if (lane == 0) su[r] = mx * (1.f / 127.f);
#pragma unroll
                for (int j = 0; j < 4; ++j) { const f32x4 b = av[h][j] * 2.f;
                    const int q0 = (int)__builtin_rintf(au[h][j].x * inv), q1 = (int)__builtin_rintf(au[h][j].y * inv), q2 = (int)__builtin_rintf(au[h][j].z * inv), q3 = (int)__builtin_rintf(au[h][j].w * inv);
                    const unsigned wa = (unsigned)(q0 & 255) | ((unsigned)(q1 & 255) << 8) | ((unsigned)(q2 & 255) << 16) | ((unsigned)q3 << 24);
                    int wb = __builtin_amdgcn_cvt_pk_fp8_f32(b.x, b.y, 0, false); wb = __builtin_amdgcn_cvt_pk_fp8_f32(b.z, b.w, wb, true);
                    u8[(size_t)r * 256 + lane + 64 * j] = wa; v8[(size_t)r * 256 + lane + 64 * j] = (unsigned)wb; } }
        }
    }
    }
    for (size_t i = gt; i < (size_t)T; i += NGT) { ((float*)(ws + WS_RSTD2))[i] = 0.f; ((float*)(ws + WS_SSQO))[i] = 0.f; }
    for (int rp_ = 0; rp_ < (DUP_PHASE == 15 ? 2 : 1); ++rp_) {
    float2* rope = (float2*)(ws + WS_ROPE);
    for (size_t i = gt; i < (size_t)T * 32; i += NGT) {
        const int t = (int)(i >> 5), d = (int)(i & 31);
        const float inv = exp2f(-(float)d * (13.287712379549449f / 32.f));
        const float ang = (float)p.pos[t] * inv;
        const double rev = (double)ang * 0.15915494309189535;
        const float fr = (float)(rev - floor(rev));
        rope[i] = make_float2(__builtin_amdgcn_cosf(fr), __builtin_amdgcn_sinf(fr));
    }
    }
}

namespace pg8 {
#define PG8_LAS __attribute__((address_space(3)))
constexpr int BM = 256, BK = 64, HALF = 128, HTB = HALF * BK * 2, STAGE_BYTES = 8 * HTB, NXCD = 8, WGM = 8;
__host__ __device__ __forceinline__ int lds_byte(int r, int c) { const int st = (r >> 4) * 2 + (c >> 5), rr = r & 15, cc = c & 31, ob = rr * 64 + cc * 2; return st * 1024 + (ob ^ (((ob >> 9) & 1) << 5)); }
__host__ __device__ __forceinline__ void stage_rc(int b, int& R, int& C) { const int st = b / 1024, sb = b % 1024, swz = sb ^ (((sb >> 9) & 1) << 5); R = (st >> 1) * 16 + swz / 64; C = (st & 1) * 32 + (swz % 64) / 2; }
__host__ __device__ __forceinline__ int perm32(int rho) { const int n = rho >> 4, i = rho & 15; return 8 * (i >> 2) + 4 * n + (i & 3); }

struct Unit { const char* a; const char* b; int nt, pm, pn, tag; };
DI void tile_of(int L, int nM, int nN, int& pm, int& pn) {
    const int nwg = nM * nN; int wgid = L; { const int q = nwg / NXCD, r = nwg % NXCD, xcd = wgid % NXCD, off = wgid / NXCD; wgid = (xcd < r ? xcd * (q + 1) : r * (q + 1) + (xcd - r) * q) + off; }
    const int nig = WGM * nN, gid = wgid / nig, fm = gid * WGM, gsz = (nM - fm) < WGM ? (nM - fm) : WGM;
    pm = fm + ((wgid % nig) % gsz); pn = (wgid % nig) / gsz;
}
template <class Epi, class Sched>
DI void gemm_phase(PG8_LAS unsigned char* lds, int lda, int ldb, const Sched& S, const Epi& E) {
    int tid = threadIdx.x; asm volatile("" : "+v"(tid));
    const int wid = __builtin_amdgcn_readfirstlane(tid >> 6), wr = wid >> 2, wc = wid & 3, lane = tid & 63, fr = lane & 15, fq = lane >> 4;
    unsigned voffA[2], voffB[2];
#pragma unroll
    for (int i = 0; i < 2; ++i) { int R, C; stage_rc(tid * 16 + i * 8192, R, C); const int Rb = (R & ~31) + perm32(R & 31);
        voffA[i] = (unsigned)(R * lda + C) * 2u; voffB[i] = (unsigned)(Rb * ldb + C) * 2u; }
    const size_t kstep = (size_t)(BK * 2);
    const size_t hstepA = (size_t)HALF * lda * 2, hstepB = (size_t)HALF * ldb * 2;
    const unsigned ldsw = (unsigned)wid * 1024u;
    const int aoff = lds_byte(wr * 64 + fr, fq * 8), boff = lds_byte(wc * 32 + fr, fq * 8);
#define PG8_SA(b, h) (((b) * 2 + (h)) * HTB)
#define PG8_SB(b, h) ((4 + (b) * 2 + (h)) * HTB)
#define PG8_STAGE(bufoff, gbase, voff) do { _Pragma("unroll") for (int _i = 0; _i < 2; ++_i) \
        __builtin_amdgcn_global_load_lds((const unsigned*)((const char*)(gbase) + (voff)[_i]), (PG8_LAS unsigned*)(lds + (bufoff) + ldsw + _i * 8192), 16, 0, 0); } while (0)
#define PG8_LDA(dst, b, h) do { _Pragma("unroll") for (int m = 0; m < 4; ++m) _Pragma("unroll") for (int k = 0; k < 2; ++k) dst[m][k] = *(const PG8_LAS bf16x8*)(lds + PG8_SA(b, h) + aoff + m * 2048 + k * 1024); } while (0)
#define PG8_LDB(dst, b, h) do { _Pragma("unroll") for (int n = 0; n < 2; ++n) _Pragma("unroll") for (int k = 0; k < 2; ++k) dst[n][k] = *(const PG8_LAS bf16x8*)(lds + PG8_SB(b, h) + boff + n * 2048 + k * 1024); } while (0)
#define PG8_MMA(ai, bj, At, Bt) do { __builtin_amdgcn_s_setprio(1); _Pragma("unroll") for (int m = 0; m < 4; ++m) _Pragma("unroll") for (int n = 0; n < 2; ++n) _Pragma("unroll") for (int k = 0; k < 2; ++k) \
        acc[ai][bj][m][n] = __builtin_amdgcn_mfma_f32_16x16x32_bf16(Bt[n][k], At[m][k], acc[ai][bj][m][n], 0, 0, 0); __builtin_amdgcn_s_setprio(0); } while (0)
#define PG8_WAIT_V(n) asm volatile("s_waitcnt vmcnt(" #n ")" ::: "memory")
#define PG8_WAIT_L(n) asm volatile("s_waitcnt lgkmcnt(" #n ")" ::: "memory")
#define PG8_BAR __builtin_amdgcn_s_barrier()
#define PG8_SCHED __builtin_amdgcn_sched_barrier(0)
    Unit cur, nxt; int ui = 0;
    if (!S.next(0, cur)) return;
    f32x4 acc[2][2][4][2];
#pragma unroll
    for (int a = 0; a < 2; ++a)
#pragma unroll
        for (int b = 0; b < 2; ++b)
#pragma unroll
            for (int m = 0; m < 4; ++m)
#pragma unroll
                for (int n = 0; n < 2; ++n) acc[a][b][m][n] = (f32x4){0.f, 0.f, 0.f, 0.f};
    bf16x8 At[4][2], B0[2][2], B1[2][2];
    const char* cA = cur.a; const char* cB = cur.b;
    PG8_STAGE(PG8_SB(0, 0), cB, voffB); PG8_STAGE(PG8_SB(0, 1), cB + hstepB, voffB); PG8_STAGE(PG8_SA(0, 0), cA, voffA); PG8_STAGE(PG8_SA(0, 1), cA + hstepA, voffA);
    if (wr == 1) PG8_BAR;
    PG8_WAIT_V(2); PG8_BAR;
    PG8_STAGE(PG8_SB(1, 0), cB + kstep, voffB); PG8_STAGE(PG8_SA(1, 0), cA + kstep, voffA); PG8_STAGE(PG8_SB(1, 1), cB + hstepB + kstep, voffB);
    PG8_WAIT_V(6); PG8_BAR;
    for (;;) {
        const bool has_next = S.next(ui + 1, nxt);
        const char* nA = has_next ? nxt.a : cA; const char* nB = has_next ? nxt.b : cB;
        const int nt = cur.nt;
        for (int t = 0; t < nt; t += 2) {
            const bool last = (t == nt - 2);
            const char* a1 = cA + (size_t)(t + 1) * kstep;
            const char* a2 = last ? nA : cA + (size_t)(t + 2) * kstep; const char* b2 = last ? nB : cB + (size_t)(t + 2) * kstep;
            const char* a3 = a2 + kstep; const char* b3 = b2 + kstep;
            PG8_LDB(B0, 0, 0); PG8_LDB(B1, 0, 1); PG8_SCHED; PG8_LDA(At, 0, 0); PG8_STAGE(PG8_SA(1, 1), a1 + hstepA, voffA);
            PG8_WAIT_V(8); PG8_WAIT_L(0); PG8_BAR; PG8_MMA(0, 0, At, B0); PG8_MMA(0, 1, At, B1); PG8_BAR; PG8_SCHED;
            PG8_LDA(At, 0, 1); PG8_STAGE(PG8_SB(0, 0), b2, voffB); PG8_STAGE(PG8_SB(0, 1), b2 + hstepB, voffB); PG8_STAGE(PG8_SA(0, 0), a2, voffA);
            PG8_WAIT_V(8); PG8_WAIT_L(0); PG8_BAR; PG8_MMA(1, 0, At, B0); PG8_MMA(1, 1, At, B1); PG8_BAR; PG8_SCHED;
            PG8_LDB(B0, 1, 0); PG8_LDB(B1, 1, 1); PG8_SCHED; PG8_LDA(At, 1, 0); PG8_STAGE(PG8_SA(0, 1), a2 + hstepA, voffA);
            PG8_WAIT_V(8); PG8_WAIT_L(0); PG8_BAR; PG8_MMA(0, 0, At, B0); PG8_MMA(0, 1, At, B1); PG8_BAR; PG8_SCHED;
            PG8_LDA(At, 1, 1); PG8_STAGE(PG8_SB(1, 0), b3, voffB); PG8_STAGE(PG8_SB(1, 1), b3 + hstepB, voffB); PG8_STAGE(PG8_SA(1, 0), a3, voffA);
            PG8_WAIT_V(8); PG8_WAIT_L(0); PG8_BAR; PG8_MMA(1, 0, At, B0); PG8_MMA(1, 1, At, B1); PG8_BAR; PG8_SCHED;
        }
        if (wr == 0) PG8_BAR;
        const bool keep_ = E(acc, cur, wr, wc, fr, fq);
        if (!has_next) break;
        if (!keep_)
#pragma unroll
        for (int a = 0; a < 2; ++a)
#pragma unroll
            for (int b = 0; b < 2; ++b)
#pragma unroll
                for (int m = 0; m < 4; ++m)
#pragma unroll
                    for (int n = 0; n < 2; ++n) acc[a][b][m][n] = (f32x4){0.f, 0.f, 0.f, 0.f};
        cur = nxt; cA = nA; cB = nB; ++ui;
        if (wr == 1) PG8_BAR;
    }
    PG8_WAIT_V(0);
    PG8_BAR;
#undef PG8_SA
#undef PG8_SB
#undef PG8_STAGE
#undef PG8_LDA
#undef PG8_LDB
#undef PG8_MMA
#undef PG8_WAIT_V
#undef PG8_WAIT_L
#undef PG8_BAR
#undef PG8_SCHED
}
}
typedef f32x4 acc_t[2][2][4][2];

struct SchedPlain {
    const char* A; const char* Bt; int lda, ldb, nM, nN, nt, G, c;
    DI bool next(int i, pg8::Unit& u) const {
        const long L = (long)i * G + c; if (L >= (long)nM * nN) return false;
        pg8::tile_of((int)L, nM, nN, u.pm, u.pn); u.a = A + (size_t)u.pm * 256 * lda * 2; u.b = Bt + (size_t)u.pn * 256 * ldb * 2; u.nt = nt; u.tag = 0; return true;
    }
};
struct SchedZ {
    const char *xb, *win, *memb, *wmkv; int G, c;
    DI bool next(int i, pg8::Unit& u) const {
        const long L = (long)i * G + c; constexpr int NZ = 128 * 21;
        if (L < NZ) { pg8::tile_of((int)L, 128, 21, u.pm, u.pn); u.a = xb + (size_t)u.pm * 256 * 2048; u.b = win + (size_t)u.pn * 256 * 2048; u.nt = 16; u.tag = 0; return true; }
        const int j = (int)(L - NZ); if (j >= 32) return false;
        u.pm = j >> 2; u.pn = j & 3; u.a = memb + (size_t)u.pm * 256 * 2048; u.b = wmkv + (size_t)u.pn * 256 * 2048; u.nt = 16; u.tag = 1; return true;
    }
};
struct SchedGated {
    const char *ycat, *wbr; int G, c;
    DI bool next(int i, pg8::Unit& u) const {
        const int j = i / 3, b = i - 3 * j; const long L = (long)j * G + c; if (L >= 128 * 4) return false;
        pg8::tile_of((int)L, 128, 4, u.pm, u.pn);
        const int koff = (b == 0) ? 0 : (b == 1 ? 512 : 1536);
        u.a = ycat + ((size_t)u.pm * 256 * 2048 + koff) * 2; u.b = wbr + ((size_t)u.pn * 256 * 2048 + koff) * 2; u.nt = (b == 1) ? 16 : 8; u.tag = b; return true;
    }
};

DI u32x4 pack8(const f32x4& a, const f32x4& b) { u32x4 w; w.x = pk2(a[0], a[1]); w.y = pk2(a[2], a[3]); w.z = pk2(b[0], b[1]); w.w = pk2(b[2], b[3]); return w; }
struct EpiZ {
    const float* rstd1; const float* rstdm; const float2* rope; bf16_t *upool, *qr, *kr, *vv, *qm, *gates, *kvm;
    DI bool operator()(const acc_t& acc, const pg8::Unit& u, int wr, int wc, int fr_, int fq_) const {
        int l_ = threadIdx.x; asm volatile("" : "+v"(l_)); const int fr = l_ & 15, fq = (l_ >> 4) & 3;
        const int row0 = u.pm * 256 + wr * 64 + fr;
        const float* rsp = (u.tag == 1) ? rstdm : rstd1;
        float rs[2][4];
#pragma unroll
        for (int ai = 0; ai < 2; ++ai)
#pragma unroll
            for (int m = 0; m < 4; ++m) rs[ai][m] = rsp[row0 + ai * 128 + m * 16];
        if (u.tag == 1) {
#pragma unroll
            for (int ai = 0; ai < 2; ++ai)
#pragma unroll
                for (int m = 0; m < 4; ++m) { const int row = row0 + ai * 128 + m * 16;
#pragma unroll
                    for (int bj = 0; bj < 2; ++bj) { const int c = u.pn * 256 + bj * 128 + wc * 32 + 8 * fq;
                        *(u32x4*)(kvm + (size_t)row * 1024 + c) = pack8(acc[ai][bj][m][0] * rs[ai][m], acc[ai][bj][m][1] * rs[ai][m]); } }
            return false;
        }
#pragma unroll
        for (int bj = 0; bj < 2; ++bj) {
            const int cb = u.pn * 256 + bj * 128;
            const int c = cb + wc * 32 + 8 * fq;
            if (cb >= 512 && cb < 1664) {
                const bool isq = cb < 1536; const int rel = isq ? c - 512 : c - 1536; const int hrel = rel & 63, d0 = hrel >> 1, hb = rel - hrel;
                const float sc = isq ? 0.125f : 1.f;
#pragma unroll
                for (int ai = 0; ai < 2; ++ai) {
                    f32x4 cs0[4], cs1[4];
#pragma unroll
                    for (int m = 0; m < 4; ++m) { const int row = row0 + ai * 128 + m * 16;
                        cs0[m] = *(const f32x4*)(rope + (size_t)row * 32 + d0); cs1[m] = *(const f32x4*)(rope + (size_t)row * 32 + d0 + 2); }
#pragma unroll
                    for (int m = 0; m < 4; ++m) { const int row = row0 + ai * 128 + m * 16;
                        const f32x4 v0 = acc[ai][bj][m][0] * rs[ai][m], v1 = acc[ai][bj][m][1] * rs[ai][m], a0 = cs0[m], a1 = cs1[m];
                        f32x4 o1, o2;
                        o1[0] = (v0[0] * a0[0] - v1[0] * a0[1]) * sc; o2[0] = (v1[0] * a0[0] + v0[0] * a0[1]) * sc;
                        o1[1] = (v0[1] * a0[2] - v1[1] * a0[3]) * sc; o2[1] = (v1[1] * a0[2] + v0[1] * a0[3]) * sc;
                        o1[2] = (v0[2] * a1[0] - v1[2] * a1[1]) * sc; o2[2] = (v1[2] * a1[0] + v0[2] * a1[1]) * sc;
                        o1[3] = (v0[3] * a1[2] - v1[3] * a1[3]) * sc; o2[3] = (v1[3] * a1[2] + v0[3] * a1[3]) * sc;
                        bf16_t* dst = isq ? qr + (size_t)row * 1024 + hb + d0 : kr + (size_t)row * 128 + hb + d0;
                        u32x2 w1, w2; w1.x = pk2(o1[0], o1[1]); w1.y = pk2(o1[2], o1[3]); w2.x = pk2(o2[0], o2[1]); w2.y = pk2(o2[2], o2[3]);
                        *(u32x2*)dst = w1; *(u32x2*)(dst + 32) = w2; }
                }
                continue;
            }
#pragma unroll
            for (int ai = 0; ai < 2; ++ai)
#pragma unroll
                for (int m = 0; m < 4; ++m) {
                    const int row = row0 + ai * 128 + m * 16;
                    const f32x4 v0 = acc[ai][bj][m][0] * rs[ai][m], v1 = acc[ai][bj][m][1] * rs[ai][m];
                    if (cb < 512) { *(u32x4*)(upool + (size_t)row * 512 + c) = pack8(v0, v1); }
                    else if (cb < 1792) { *(u32x4*)(vv + (size_t)row * 128 + (c - 1664)) = pack8(v0, v1); }
                    else if (cb < 2304) { *(u32x4*)(qm + (size_t)row * 512 + (c - 1792)) = pack8(v0, v1); }
                    else { f32x4 s0, s1;
#pragma unroll
                        for (int e = 0; e < 4; ++e) { s0[e] = sigmoidf(v0[e]); s1[e] = sigmoidf(v1[e]); }
                        *(u32x4*)(gates + (size_t)row * 3072 + (c - 2304)) = pack8(s0, s1); }
                }
        }
        return false;
    }
};
struct EpiGated {
    const bf16_t* gates; bf16_t* merged;
    DI bool operator()(acc_t& acc, const pg8::Unit& u, int wr, int wc, int fr_, int fq_) const {
        int l_ = threadIdx.x; asm volatile("" : "+v"(l_)); const int fr = l_ & 15, fq = (l_ >> 4) & 3;
        const int row0 = u.pm * 256 + wr * 64 + fr, b = u.tag;
#pragma unroll
        for (int aim = 0; aim < 4; ++aim) { const int ai = aim >> 1, mh = (aim & 1) * 2;
            u32x4 gq[2][2], gnq[2][2];
#pragma unroll
            for (int m2 = 0; m2 < 2; ++m2)
#pragma unroll
                for (int bj = 0; bj < 2; ++bj) { const bf16_t* gp = gates + (size_t)(row0 + ai * 128 + (mh + m2) * 16) * 3072 + b * 1024 + u.pn * 256 + bj * 128 + wc * 32 + 8 * fq;
                    gq[m2][bj] = *(const u32x4*)gp; if (b < 2) gnq[m2][bj] = *(const u32x4*)(gp + 1024); else gnq[m2][bj] = gq[m2][bj]; }
#pragma unroll
            for (int m2 = 0; m2 < 2; ++m2) { const int m = mh + m2; const int row = row0 + ai * 128 + m * 16;
#pragma unroll
                for (int bj = 0; bj < 2; ++bj) { const int c = u.pn * 256 + bj * 128 + wc * 32 + 8 * fq;
                    const u32x4 g = gq[m2][bj], gn = gnq[m2][bj];
                    f32x4 s0 = {bflo(g.x), bfhi(g.x), bflo(g.y), bfhi(g.y)}, s1 = {bflo(g.z), bfhi(g.z), bflo(g.w), bfhi(g.w)};
#pragma unroll
                    for (int e = 0; e < 4; ++e) { s0[e] = fmaxf(s0[e], 1e-30f); s1[e] = fmaxf(s1[e], 1e-30f); }
                    if (b < 2) {
                        const float gn_[8] = {bflo(gn.x), bfhi(gn.x), bflo(gn.y), bfhi(gn.y), bflo(gn.z), bfhi(gn.z), bflo(gn.w), bfhi(gn.w)};
#pragma unroll
                        for (int e = 0; e < 4; ++e) { s0[e] *= __builtin_amdgcn_rcpf(fmaxf(gn_[e], 1e-30f)); s1[e] *= __builtin_amdgcn_rcpf(fmaxf(gn_[4 + e], 1e-30f)); }
                        acc[ai][bj][m][0] *= s0; acc[ai][bj][m][1] *= s1; }
                    else *(u32x4*)(merged + (size_t)row * 1024 + c) = pack8(acc[ai][bj][m][0] * s0, acc[ai][bj][m][1] * s1); } }
        }
        return b < 2;
    }
};
struct EpiOut {
    const bf16_t* xb; bf16_t* x1b; float* ssq;
    DI bool operator()(const acc_t& acc, const pg8::Unit& u, int wr, int wc, int fr_, int fq_) const {
        int l_ = threadIdx.x; asm volatile("" : "+v"(l_)); const int fr = l_ & 15, fq = (l_ >> 4) & 3;
        const int row0 = u.pm * 256 + wr * 64 + fr;
#pragma unroll
        for (int ai = 0; ai < 2; ++ai) {
            u32x4 xq[4][2];
#pragma unroll
            for (int m = 0; m < 4; ++m)
#pragma unroll
                for (int bj = 0; bj < 2; ++bj) xq[m][bj] = *(const u32x4*)(xb + (size_t)(row0 + ai * 128 + m * 16) * D + u.pn * 256 + bj * 128 + wc * 32 + 8 * fq);
#pragma unroll
            for (int m = 0; m < 4; ++m) { const int row = row0 + ai * 128 + m * 16; float sq = 0.f;
#pragma unroll
                for (int bj = 0; bj < 2; ++bj) { const size_t o = (size_t)row * D + u.pn * 256 + bj * 128 + wc * 32 + 8 * fq;
                    const u32x4 xw = xq[m][bj];
                    f32x4 v0 = acc[ai][bj][m][0], v1 = acc[ai][bj][m][1];
                    v0[0] += bflo(xw.x); v0[1] += bfhi(xw.x); v0[2] += bflo(xw.y); v0[3] += bfhi(xw.y); v1[0] += bflo(xw.z); v1[1] += bfhi(xw.z); v1[2] += bflo(xw.w); v1[3] += bfhi(xw.w);
                    sq += (v0[0] * v0[0] + v0[1] * v0[1]) + (v0[2] * v0[2] + v0[3] * v0[3]) + (v1[0] * v1[0] + v1[1] * v1[1]) + (v1[2] * v1[2] + v1[3] * v1[3]);
                    *(u32x4*)(x1b + o) = pack8(v0, v1); }
                sq += __shfl_xor(sq, 16); sq += __shfl_xor(sq, 32);
                if (fq == 0) atomicAdd(ssq + row, sq); }
        }
        return false;
    }
};
struct EpiBf16 {
    bf16_t* O; int ldo;
    DI bool operator()(const acc_t& acc, const pg8::Unit& u, int wr, int wc, int fr_, int fq_) const {
        int l_ = threadIdx.x; asm volatile("" : "+v"(l_)); const int fr = l_ & 15, fq = (l_ >> 4) & 3;
        const int row0 = u.pm * 256 + wr * 64 + fr;
#pragma unroll
        for (int ai = 0; ai < 2; ++ai)
#pragma unroll
            for (int m = 0; m < 4; ++m) { const int row = row0 + ai * 128 + m * 16;
#pragma unroll
                for (int bj = 0; bj < 2; ++bj) { const size_t o = (size_t)row * ldo + u.pn * 256 + bj * 128 + wc * 32 + 8 * fq;
                    *(u32x4*)(O + o) = pack8(acc[ai][bj][m][0], acc[ai][bj][m][1]); } }
        return false;
    }
};

DI void unpack8(const u32x4& w, float (&f)[8]) { f[0] = bflo(w.x); f[1] = bfhi(w.x); f[2] = bflo(w.y); f[3] = bfhi(w.y); f[4] = bflo(w.z); f[5] = bfhi(w.z); f[6] = bflo(w.w); f[7] = bfhi(w.w); }
DI void pooled_phase(const bf16_t* upool, bf16_t* pooled) {
    const int tid = opaque_tid(), lane = tid & 63, gw = blockIdx.x * NWAVES + (tid >> 6), NGW = gridDim.x * NWAVES;
    const int c = lane * 8, w = 2 << (lane >> 4);
    for (int task = gw; task < T / 16; task += NGW) {
        const int t0 = task * 16, s0 = t0 & (SEQ - 1);
        const bf16_t* up = upool + (size_t)t0 * 512 + c;
        u32x4 hw[15], nw[16], ow[16];
#pragma unroll
        for (int j = 1; j < 16; ++j) { const int jj = (s0 - j >= 0) ? j : 0; hw[j - 1] = *(const u32x4*)(up - (ptrdiff_t)jj * 512); }
#pragma unroll
        for (int i = 0; i < 16; ++i) { nw[i] = *(const u32x4*)(up + (size_t)i * 512); const int back = (s0 + i - (w - 1) >= 0) ? (w - 1) : 0; ow[i] = *(const u32x4*)(up + (ptrdiff_t)(i - back) * 512); }
        float win[8];
#pragma unroll
        for (int e = 0; e < 8; ++e) win[e] = 0.f;
#pragma unroll
        for (int j = 1; j < 16; ++j) { float f[8]; unpack8(hw[j - 1], f); const float mk = (j < w && s0 - j >= 0) ? 1.f : 0.f;
#pragma unroll
            for (int e = 0; e < 8; ++e) win[e] += mk * f[e]; }
#pragma unroll
        for (int i = 0; i < 16; ++i) {
            const int s = s0 + i;
            float un[8], uo[8];
            unpack8(nw[i], un); unpack8(ow[i], uo);
            const float mo = (s - (w - 1) >= 0) ? 1.f : 0.f;
            const int cnt = (s + 1 < w) ? s + 1 : w; const float ic = __builtin_amdgcn_rcpf((float)cnt);
            float o[8];
#pragma unroll
            for (int e = 0; e < 8; ++e) { const float tot = win[e] + un[e]; o[e] = tot * ic - un[e]; win[e] = tot - mo * uo[e]; }
            u32x4 ov; ov.x = pk2(o[0], o[1]); ov.y = pk2(o[2], o[3]); ov.z = pk2(o[4], o[5]); ov.w = pk2(o[6], o[7]);
            *(u32x4*)(pooled + (size_t)(t0 + i) * 2048 + c) = ov;
        }
    }
}
typedef __bf16 bf16x2_t __attribute__((ext_vector_type(2)));
typedef float f32x2_t __attribute__((ext_vector_type(2)));
DI unsigned cvtpk(float lo, float hi) { f32x2_t v = {lo, hi}; bf16x2_t b = __builtin_convertvector(v, bf16x2_t); return __builtin_bit_cast(unsigned, b); }
DI int crow(int i, int h) { return (i & 3) + 8 * (i >> 2) + 4 * h; }
#define MFMA32(a, b, c) __builtin_amdgcn_mfma_f32_32x32x16_bf16((a), (b), (c), 0, 0, 0)
DI bf16x8 mk8(unsigned a, unsigned b, unsigned c, unsigned d) { u32x4 w = {a, b, c, d}; return __builtin_bit_cast(bf16x8, w); }

constexpr int SWA_KLD = 72, SWA_VLD = 260, SWA_VT_OFF = 256 * SWA_KLD * 2;
DI void swa_phase(const bf16_t* qr, const bf16_t* kr, const bf16_t* vv, const float* sinks, bf16_t* ycat, unsigned char* lds) {
    const int tid = opaque_tid();
    const int lane = tid & 63, w = tid >> 6, r = lane & 31, h = lane >> 5;
    bf16_t* Ks = (bf16_t*)lds; bf16_t* Vt = (bf16_t*)(lds + SWA_VT_OFF);
    for (int unit = blockIdx.x; unit < 512; unit += gridDim.x) {
        const int kvh = unit & 1, nb = (unit >> 1) & 31, b = unit >> 6;
        const int tq0 = b * SEQ + nb * 128, tk0 = tq0 - 128;
        const int hq = kvh * 8 + w; const float sink = sinks[hq];
        bf16x8 qn[4];
        { const bf16_t* qp = qr + (size_t)(tq0 + r) * 1024 + hq * 64 + 8 * h;
#pragma unroll
          for (int s = 0; s < 4; ++s) qn[s] = *(const bf16x8*)(qp + 16 * s); }
        __syncthreads();
#pragma unroll
        for (int i = 0; i < 4; ++i) {
            const int c = tid + 512 * i, kb = c >> 3, dc = (c & 7) * 8;
            u32x4 kv = {0u, 0u, 0u, 0u}, vx = {0u, 0u, 0u, 0u};
            if (nb > 0 || kb >= 128) { kv = *(const u32x4*)(kr + (size_t)(tk0 + kb) * 128 + kvh * 64 + dc); vx = *(const u32x4*)(vv + (size_t)(tk0 + kb) * 128 + kvh * 64 + dc); }
            *(u32x4*)(Ks + kb * SWA_KLD + dc) = kv;
            bf16_t* vp = Vt + dc * SWA_VLD + kb;
            vp[0 * SWA_VLD] = (bf16_t)(vx.x & 0xffffu); vp[1 * SWA_VLD] = (bf16_t)(vx.x >> 16); vp[2 * SWA_VLD] = (bf16_t)(vx.y & 0xffffu); vp[3 * SWA_VLD] = (bf16_t)(vx.y >> 16);
            vp[4 * SWA_VLD] = (bf16_t)(vx.z & 0xffffu); vp[5 * SWA_VLD] = (bf16_t)(vx.z >> 16); vp[6 * SWA_VLD] = (bf16_t)(vx.w & 0xffffu); vp[7 * SWA_VLD] = (bf16_t)(vx.w >> 16);
        }
        __syncthreads();
        for (int qt = 0; qt < 4; ++qt) {
            bf16x8 qf[4];
#pragma unroll
            for (int s = 0; s < 4; ++s) qf[s] = qn[s];
            if (qt < 3) { const bf16_t* qp = qr + (size_t)(tq0 + 32 * (qt + 1) + r) * 1024 + hq * 64 + 8 * h;
#pragma unroll
                for (int s = 0; s < 4; ++s) qn[s] = *(const bf16x8*)(qp + 16 * s); }
            f32x16 sa[5];
#pragma unroll
            for (int c = 0; c < 5; ++c) {
#pragma unroll
                for (int i = 0; i < 16; ++i) sa[c][i] = 0.f;
#pragma unroll
                for (int s = 0; s < 4; ++s) { const bf16x8 kf = *(const bf16x8*)(Ks + (32 * (qt + c) + r) * SWA_KLD + 16 * s + 8 * h); sa[c] = MFMA32(kf, qf[s], sa[c]); }
            }
            float mx = sink;
#pragma unroll
            for (int c = 0; c < 5; ++c)
#pragma unroll
                for (int i = 0; i < 16; ++i) {
                    const int kk = 32 * c + crow(i, h);
                    bool vis = (c == 0) ? (kk > r) : ((c == 4) ? (kk - 128 <= r) : true);
                    if (nb == 0) vis = vis && (32 * qt + kk >= 128);
                    const float s = vis ? sa[c][i] : -1e30f; sa[c][i] = s; mx = fmaxf(mx, s);
                }
            mx = fmaxf(mx, __shfl_xor(mx, 32));
            float l = 0.f;
#pragma unroll
            for (int c = 0; c < 5; ++c)
#pragma unroll
                for (int i = 0; i < 16; ++i) { const float pz = __expf(sa[c][i] - mx); sa[c][i] = pz; l += pz; }
            l += __shfl_xor(l, 32); l += __expf(sink - mx);
            const float inv = 1.f / l;
            f32x16 oa[2];
#pragma unroll
            for (int i = 0; i < 16; ++i) { oa[0][i] = 0.f; oa[1][i] = 0.f; }
#pragma unroll
            for (int c = 0; c < 5; ++c)
#pragma unroll
                for (int s2 = 0; s2 < 2; ++s2) {
                    const bf16x8 pf = mk8(cvtpk(sa[c][8 * s2 + 0], sa[c][8 * s2 + 1]), cvtpk(sa[c][8 * s2 + 2], sa[c][8 * s2 + 3]), cvtpk(sa[c][8 * s2 + 4], sa[c][8 * s2 + 5]), cvtpk(sa[c][8 * s2 + 6], sa[c][8 * s2 + 7]));
#pragma unroll
                    for (int dt = 0; dt < 2; ++dt) {
                        const bf16_t* va = Vt + (32 * dt + r) * SWA_VLD + 32 * (qt + c) + 16 * s2 + 4 * h;
                        const u32x2 lo = *(const u32x2*)va, hi = *(const u32x2*)(va + 8);
                        oa[dt] = MFMA32(mk8(lo.x, lo.y, hi.x, hi.y), pf, oa[dt]);
                    }
                }
            bf16_t* yp = ycat + (size_t)(tq0 + 32 * qt + r) * 2048 + 512 + hq * 64 + 4 * h;
#pragma unroll
            for (int dt = 0; dt < 2; ++dt)
#pragma unroll
                for (int g4 = 0; g4 < 4; ++g4) { u32x2 o; o.x = cvtpk(oa[dt][4 * g4] * inv, oa[dt][4 * g4 + 1] * inv); o.y = cvtpk(oa[dt][4 * g4 + 2] * inv, oa[dt][4 * g4 + 3] * inv);
                    *(u32x2*)(yp + 32 * dt + 8 * g4) = o; }
        }
    }
}

constexpr int MEM_KLD = 136, MEM_VLD = 260, MEM_VT_OFF = 256 * MEM_KLD * 2;
DI void mem_phase(const bf16_t* qm, const bf16_t* kvm, bf16_t* ycat, unsigned char* lds) {
    const int tid = opaque_tid();
    const int lane = tid & 63, w = tid >> 6, r = lane & 31, h = lane >> 5;
    bf16_t* Ks = (bf16_t*)lds; bf16_t* Vt = (bf16_t*)(lds + MEM_VT_OFF);
    for (int unit = blockIdx.x; unit < 256; unit += gridDim.x) {
        const int qc = unit & 7, hm = (unit >> 3) & 3, b = unit >> 5;
        bf16x8 qn[8];
        { const bf16_t* qp = qm + (size_t)(b * SEQ + qc * 512 + (w * 2) * 32 + r) * 512 + hm * 128 + 8 * h;
#pragma unroll
          for (int s = 0; s < 8; ++s) qn[s] = *(const bf16x8*)(qp + 16 * s); }
        __syncthreads();
#pragma unroll
        for (int i = 0; i < 8; ++i) {
            const int c = tid + 512 * i, m = c >> 4, dc = (c & 15) * 8;
            const bf16_t* src = kvm + (size_t)(b * MEML + m) * 1024 + hm * 128 + dc;
            const u32x4 kv = *(const u32x4*)src, vx = *(const u32x4*)(src + 512);
            *(u32x4*)(Ks + m * MEM_KLD + dc) = kv;
            bf16_t* vp = Vt + dc * MEM_VLD + m;
            vp[0 * MEM_VLD] = (bf16_t)(vx.x & 0xffffu); vp[1 * MEM_VLD] = (bf16_t)(vx.x >> 16); vp[2 * MEM_VLD] = (bf16_t)(vx.y & 0xffffu); vp[3 * MEM_VLD] = (bf16_t)(vx.y >> 16);
            vp[4 * MEM_VLD] = (bf16_t)(vx.z & 0xffffu); vp[5 * MEM_VLD] = (bf16_t)(vx.z >> 16); vp[6 * MEM_VLD] = (bf16_t)(vx.w & 0xffffu); vp[7 * MEM_VLD] = (bf16_t)(vx.w >> 16);
        }
        __syncthreads();
        for (int qi = 0; qi < 2; ++qi) {
            const int t0 = b * SEQ + qc * 512 + (w * 2 + qi) * 32;
            bf16x8 qf[8];
#pragma unroll
            for (int s = 0; s < 8; ++s) qf[s] = qn[s];
            if (qi == 0) { const bf16_t* qp = qm + (size_t)(t0 + 32 + r) * 512 + hm * 128 + 8 * h;
#pragma unroll
                for (int s = 0; s < 8; ++s) qn[s] = *(const bf16x8*)(qp + 16 * s); }
            float mx = -3e38f;
#pragma unroll 1
            for (int c = 0; c < 8; ++c) {
                f32x16 sc;
#pragma unroll
                for (int i = 0; i < 16; ++i) sc[i] = 0.f;
#pragma unroll
                for (int s = 0; s < 8; ++s) { const bf16x8 kf = *(const bf16x8*)(Ks + (32 * c + r) * MEM_KLD + 16 * s + 8 * h); sc = MFMA32(kf, qf[s], sc); }
#pragma unroll
                for (int i = 0; i < 16; ++i) mx = fmaxf(mx, sc[i]);
            }
            mx = fmaxf(mx, __shfl_xor(mx, 32));
            constexpr float SC = 0.08838834764831845f * 1.4426950408889634f;
            float l = 0.f;
            f32x16 oa[4];
#pragma unroll
            for (int dt = 0; dt < 4; ++dt)
#pragma unroll
                for (int i = 0; i < 16; ++i) oa[dt][i] = 0.f;
#pragma unroll 1
            for (int c = 0; c < 8; ++c) {
                f32x16 sc;
#pragma unroll
                for (int i = 0; i < 16; ++i) sc[i] = 0.f;
#pragma unroll
                for (int s = 0; s < 8; ++s) { const bf16x8 kf = *(const bf16x8*)(Ks + (32 * c + r) * MEM_KLD + 16 * s + 8 * h); sc = MFMA32(kf, qf[s], sc); }
#pragma unroll
                for (int i = 0; i < 16; ++i) { const float pz = exp2f((sc[i] - mx) * SC); sc[i] = pz; l += pz; }
#pragma unroll
                for (int s2 = 0; s2 < 2; ++s2) {
                    const bf16x8 pf = mk8(cvtpk(sc[8 * s2 + 0], sc[8 * s2 + 1]), cvtpk(sc[8 * s2 + 2], sc[8 * s2 + 3]), cvtpk(sc[8 * s2 + 4], sc[8 * s2 + 5]), cvtpk(sc[8 * s2 + 6], sc[8 * s2 + 7]));
#pragma unroll
                    for (int dt = 0; dt < 4; ++dt) {
                        const bf16_t* va = Vt + (32 * dt + r) * MEM_VLD + 32 * c + 16 * s2 + 4 * h;
                        const u32x2 lo = *(const u32x2*)va, hi = *(const u32x2*)(va + 8);
                        oa[dt] = MFMA32(mk8(lo.x, lo.y, hi.x, hi.y), pf, oa[dt]);
                    }
                }
            }
            l += __shfl_xor(l, 32);
            const float inv = 1.f / l;
            bf16_t* yp = ycat + (size_t)(t0 + r) * 2048 + 1536 + hm * 128 + 4 * h;
#pragma unroll
            for (int dt = 0; dt < 4; ++dt)
#pragma unroll
                for (int g4 = 0; g4 < 4; ++g4) { u32x2 o; o.x = cvtpk(oa[dt][4 * g4] * inv, oa[dt][4 * g4 + 1] * inv); o.y = cvtpk(oa[dt][4 * g4 + 2] * inv, oa[dt][4 * g4 + 3] * inv);
                    *(u32x2*)(yp + 32 * dt + 8 * g4) = o; }
        }
    }
}

DI unsigned umax_(unsigned a, unsigned b) { return a > b ? a : b; }
DI unsigned umin_(unsigned a, unsigned b) { return a < b ? a : b; }
DI void cexd(unsigned& a, unsigned& b) { const unsigned mx = umax_(a, b), mn = umin_(a, b); a = mx; b = mn; }
DI void sort16_desc(unsigned (&v)[16]) {
#pragma unroll
    for (int k = 2; k <= 16; k <<= 1)
#pragma unroll
        for (int j = k >> 1; j > 0; j >>= 1)
#pragma unroll
            for (int i = 0; i < 16; ++i) { const int l = i ^ j; if (l > i) { if ((i & k) == 0) cexd(v[i], v[l]); else cexd(v[l], v[i]); } }
}
DI void merge16_desc(unsigned (&a)[16], const unsigned (&b)[16]) {
#pragma unroll
    for (int i = 0; i < 16; ++i) a[i] = umax_(a[i], b[15 - i]);
#pragma unroll
    for (int j = 8; j > 0; j >>= 1)
#pragma unroll
        for (int i = 0; i < 16; ++i) { const int l = i ^ j; if (l > i) cexd(a[i], a[l]); }
}
DI unsigned mono(float f) { const unsigned u = __builtin_bit_cast(unsigned, f); return u ^ ((unsigned)((int)u >> 31) | 0x80000000u); }
DI float demono(unsigned m) { const unsigned t = (unsigned)((int)m >> 31); return __builtin_bit_cast(float, m ^ (~t | 0x80000000u)); }
constexpr int TK_KLD = 136, TK_SCR_OFF = 2 * 128 * TK_KLD * 2;
DI void topk_phase(const bf16_t* qp, const bf16_t* keysb, const float* rstd2, int* ids, float* gts, unsigned char* lds) {
    const int tid = opaque_tid();
    const int lane = tid & 63, w = tid >> 6, r = lane & 31, h2 = lane >> 5;
    bf16_t* Kl = (bf16_t*)lds;
    unsigned char* scr = lds + TK_SCR_OFF + w * 2048 + lane * 32;
    int staged = -1;
    for (int unit = blockIdx.x; unit < 1024; unit += gridDim.x) {
        const int hd = unit & 7, tile = unit >> 3;
        if (hd != staged) {
            __syncthreads();
#pragma unroll
            for (int i = 0; i < 8; ++i) { const int c = tid + 512 * i, row = c >> 4, dc = (c & 15) * 8;
                *(u32x4*)(Kl + row * TK_KLD + dc) = *(const u32x4*)(keysb + ((size_t)hd * 256 + row) * 128 + dc); }
            __syncthreads();
            staged = hd;
        }
        const int t0 = tile * 256 + w * 32;
        unsigned K0[16], K1[16];
#pragma unroll
        for (int p = 0; p < 2; ++p) {
            const bf16_t* qrow = qp + (size_t)(t0 + r) * 2048 + hd * 256 + p * 128 + 8 * h2;
            bf16x8 qf[8];
#pragma unroll
            for (int s = 0; s < 8; ++s) qf[s] = *(const bf16x8*)(qrow + 16 * s);
            unsigned blk[4][16];
#pragma unroll
            for (int c = 0; c < 4; ++c) {
                f32x16 sc;
#pragma unroll
                for (int i = 0; i < 16; ++i) sc[i] = 0.f;
#pragma unroll
                for (int s = 0; s < 8; ++s) { const bf16x8 kf = *(const bf16x8*)(Kl + (p * 128 + 32 * c + r) * TK_KLD + 16 * s + 8 * h2); sc = MFMA32(kf, qf[s], sc); }
#pragma unroll
                for (int i = 0; i < 16; ++i) blk[c][i] = (mono(sc[i]) & ~0x7Fu) | (unsigned)(32 * c + crow(i, h2));
                sort16_desc(blk[c]);
            }
            merge16_desc(blk[0], blk[1]); merge16_desc(blk[2], blk[3]); merge16_desc(blk[0], blk[2]);
            unsigned oth[16];
#pragma unroll
            for (int i = 0; i < 16; ++i) oth[i] = (unsigned)__shfl_xor((int)blk[0][i], 32);
            merge16_desc(blk[0], oth);
#pragma unroll
            for (int i = 0; i < 16; ++i) { if (p == 0) K0[i] = blk[0][i]; else K1[i] = blk[0][i]; }
        }
#pragma unroll
        for (int q = 0; q < 4; ++q) {
            ((unsigned*)scr)[q] = (K0[4 * q] & 0x7Fu) | ((K0[4 * q + 1] & 0x7Fu) << 8) | ((K0[4 * q + 2] & 0x7Fu) << 16) | ((K0[4 * q + 3] & 0x7Fu) << 24);
            ((unsigned*)scr)[4 + q] = (K1[4 * q] & 0x7Fu) | ((K1[4 * q + 1] & 0x7Fu) << 8) | ((K1[4 * q + 2] & 0x7Fu) << 16) | ((K1[4 * q + 3] & 0x7Fu) << 24);
        }
        float sx[16], sy[16];
#pragma unroll
        for (int i = 0; i < 16; ++i) { const float s0 = demono(K0[i] & ~0x7Fu), s1 = demono(K1[i] & ~0x7Fu); sx[i] = h2 ? s1 : s0; sy[i] = h2 ? s0 : s1; }
        unsigned ca[16], cb[16];
#pragma unroll
        for (int i = 0; i < 16; ++i) { ca[i] = 0u; cb[i] = 0u; }
#define CAND(n, a, b) do { const unsigned key_ = (mono(sx[a] + sy[b]) & ~0xFFu) | (h2 ? (unsigned)(((b) << 4) | (a)) : (unsigned)(((a) << 4) | (b))); if ((n) < 16) ca[(n) & 15] = key_; else cb[(n) & 15] = key_; } while (0)
            CAND(0, 0, 1);
            CAND(1, 0, 2);
            CAND(2, 0, 3);
            CAND(3, 0, 4);
            CAND(4, 0, 5);
            CAND(5, 0, 6);
            CAND(6, 0, 7);
            CAND(7, 0, 8);
            CAND(8, 0, 9);
            CAND(9, 0, 10);
            CAND(10, 0, 11);
            CAND(11, 0, 12);
            CAND(12, 0, 13);
            CAND(13, 0, 14);
            CAND(14, 0, 15);
            CAND(15, 1, 2);
            CAND(16, 1, 3);
            CAND(17, 1, 4);
            CAND(18, 1, 5);
            CAND(19, 1, 6);
            CAND(20, 1, 7);
            CAND(21, 2, 3);
            CAND(22, 2, 4);
#undef CAND
#pragma unroll
        for (int d = 0; d < 4; ++d) { const unsigned key_ = (mono(sx[d] + sy[d]) & ~0xFFu) | (unsigned)((d << 4) | d); cb[7 + d] = h2 ? 0u : key_; }
        sort16_desc(ca); sort16_desc(cb); merge16_desc(ca, cb);
        unsigned fin[16], cpart[16];
#pragma unroll
        for (int i = 0; i < 16; ++i) cpart[i] = (unsigned)__shfl_xor((int)ca[i], 32);
#pragma unroll
        for (int i = 0; i < 16; ++i) fin[i] = umax_(ca[i], cpart[15 - i]);
        const float rs = 1.f / sqrtf(rstd2[t0 + r] * (1.f / D) + EPS);
        float sv[16], mxv = -3e38f;
#pragma unroll
        for (int i = 0; i < 16; ++i) { sv[i] = demono(fin[i] & ~0xFFu) * rs; mxv = fmaxf(mxv, sv[i]); }
        float den = 0.f;
#pragma unroll
        for (int i = 0; i < 16; ++i) { sv[i] = __expf(sv[i] - mxv); den += sv[i]; }
        const float rden = 1.f / den;
        int oid[8]; float og[8];
#pragma unroll
        for (int j = 0; j < 8; ++j) {
            const unsigned wk = fin[j]; og[j] = sv[j] * rden;
            const unsigned a0 = (wk >> 4) & 15u, a1 = wk & 15u;
            oid[j] = (int)scr[a0] * 128 + (int)scr[16 + a1];
        }
        int* ip = ids + (size_t)(t0 + r) * 128 + hd * 16 + 8 * h2; float* gp = gts + (size_t)(t0 + r) * 128 + hd * 16 + 8 * h2;
        *(u32x4*)ip = (u32x4){(unsigned)oid[0], (unsigned)oid[1], (unsigned)oid[2], (unsigned)oid[3]}; *(u32x4*)(ip + 4) = (u32x4){(unsigned)oid[4], (unsigned)oid[5], (unsigned)oid[6], (unsigned)oid[7]};
        *(f32x4*)gp = (f32x4){og[0], og[1], og[2], og[3]}; *(f32x4*)(gp + 4) = (f32x4){og[4], og[5], og[6], og[7]};
    }
}

typedef _Float16 h2_t __attribute__((ext_vector_type(2)));
template <int CTRL> DI float dpp_f(float v) { return __builtin_bit_cast(float, __builtin_amdgcn_update_dpp(0, __builtin_bit_cast(int, v), CTRL, 0xf, 0xf, true)); }
DI float row16_sum(float v) {
    v += dpp_f<0xB1>(v); v += dpp_f<0x4E>(v); v += dpp_f<0x141>(v); v += dpp_f<0x140>(v); return v; }
DI bf16x2_t as_b2(unsigned w) { return __builtin_bit_cast(bf16x2_t, w); }
DI float dot_row(const u32x4 (&xw)[4][2], const u32x4 (&ru)[4]) {
    float d0 = 0.f, d1 = 0.f;
#pragma unroll
    for (int i = 0; i < 4; ++i)
#pragma unroll
        for (int q = 0; q < 4; ++q) {
            const bf16x2_t z0 = __builtin_amdgcn_cvt_scalef32_pk_bf16_fp8((int)ru[i][q], 1.0f, false), z1 = __builtin_amdgcn_cvt_scalef32_pk_bf16_fp8((int)ru[i][q], 1.0f, true);
            d0 = __builtin_amdgcn_fdot2_f32_bf16(as_b2(xw[i][q >> 1][2 * (q & 1)]), z0, d0, false); d1 = __builtin_amdgcn_fdot2_f32_bf16(as_b2(xw[i][q >> 1][2 * (q & 1) + 1]), z1, d1, false);
        }
    return row16_sum(d0 + d1);
}
DI float swz_xor4(float v) { return __builtin_bit_cast(float, __builtin_amdgcn_ds_swizzle(__builtin_bit_cast(int, v), 0x101F)); }
DI float* partial_base(unsigned char* ws, int x) { return (float*)(ws + (x < 4 ? 42 * MiB + (size_t)x * 16 * MiB : 170 * MiB + (size_t)(x - 4) * 16 * MiB)); }
template <int VAR>
DI void peer_u2_phase(const bf16_t* x1b, const unsigned char* u8, const int* ids, float* part, unsigned char* lds, int lbl, int rnk, int cnt) {
    const int tid = opaque_tid(), lane = tid & 63, wave = tid >> 6, g8 = lane >> 3, s8 = lane & 7;
    constexpr int LST = 132;
    int* lid = (int*)(lds + wave * (2 * 8 * LST * 4)); float* lpa = (float*)(lid + 8 * LST);
    const int stride = cnt * NWAVES * 8;
    const unsigned char* ubase = u8 + lbl * 128;
    const bool b4 = (s8 & 4) != 0, b2 = (s8 & 2) != 0, b1 = (s8 & 1) != 0;
    for (int t0 = (rnk * NWAVES + wave) * 8; t0 < T; t0 += stride) {
#pragma unroll
        for (int j = 0; j < 4; ++j) { const int f = lane * 4 + 256 * j, tk = f >> 7, k = f & 127; *(u32x4*)(lid + tk * LST + k) = *(const u32x4*)(ids + (size_t)t0 * 128 + f); }
        const size_t xo_ = (size_t)(t0 + g8) * D + lbl * 128 + 16 * s8;
        const u32x4 xa = *(const u32x4*)(x1b + xo_), xb2 = *(const u32x4*)(x1b + xo_ + 8);
        float xf[16];
        xf[0] = bflo(xa.x); xf[1] = bfhi(xa.x); xf[2] = bflo(xa.y); xf[3] = bfhi(xa.y); xf[4] = bflo(xa.z); xf[5] = bfhi(xa.z); xf[6] = bflo(xa.w); xf[7] = bfhi(xa.w);
        xf[8] = bflo(xb2.x); xf[9] = bfhi(xb2.x); xf[10] = bflo(xb2.y); xf[11] = bfhi(xb2.y); xf[12] = bflo(xb2.z); xf[13] = bfhi(xb2.z); xf[14] = bflo(xb2.w); xf[15] = bfhi(xb2.w);
        float xm = 0.f;
#pragma unroll
        for (int e = 0; e < 16; ++e) xm = fmaxf(xm, fabsf(xf[e]));
        xm = fmaxf(xm, dpp_f<0xB1>(xm)); xm = fmaxf(xm, dpp_f<0x4E>(xm)); xm = fmaxf(xm, dpp_f<0x141>(xm));
        const float xinv = xm > 0.f ? 127.f / xm : 0.f, sx = xm * (1.f / 127.f);
        int xq[4];
#pragma unroll
        for (int q = 0; q < 4; ++q) { const int q0 = (int)__builtin_rintf(xf[4 * q] * xinv), q1 = (int)__builtin_rintf(xf[4 * q + 1] * xinv), q2 = (int)__builtin_rintf(xf[4 * q + 2] * xinv), q3 = (int)__builtin_rintf(xf[4 * q + 3] * xinv);
            xq[q] = (int)((unsigned)(q0 & 255) | ((unsigned)(q1 & 255) << 8) | ((unsigned)(q2 & 255) << 16) | ((unsigned)q3 << 24)); }
        const int* myid = lid + g8 * LST; float* mypa = lpa + g8 * LST;
        const unsigned loff = (unsigned)(s8 * 16);
#define U2_FETCH(K8, RW) do { const int kc_ = (K8) < 128 ? (K8) : 120; const u32x4 i0_ = *(const u32x4*)(myid + kc_), i1_ = *(const u32x4*)(myid + kc_ + 4); \
            _Pragma("unroll") for (int i = 0; i < 8; ++i) { const unsigned id_ = i < 4 ? i0_[i & 3] : i1_[i & 3]; \
                if (VAR & 1) RW[i] = (u32x4){id_, id_ * 3u, id_ * 5u, id_ * 7u}; else RW[i] = *(const u32x4*)(ubase + (id_ * (unsigned)D + loff)); } } while (0)
#define U2_REDUCE(K8, RW) do { int pp[8]; \
            _Pragma("unroll") for (int i = 0; i < 8; ++i) { \
                if (VAR & 2) { pp[i] = (int)((RW[i].x ^ RW[i].y ^ RW[i].z ^ RW[i].w ^ xa.x) & 0xffu); continue; } \
                int d_ = 0; \
                _Pragma("unroll") for (int q = 0; q < 4; ++q) d_ = __builtin_amdgcn_sdot4((int)RW[i][q], xq[q], d_, false); \
                pp[i] = d_; } \
            int q4[4], q2[2]; \
            _Pragma("unroll") for (int j = 0; j < 4; ++j) { const int keep = b4 ? pp[j + 4] : pp[j], send = b4 ? pp[j] : pp[j + 4]; q4[j] = keep + __builtin_amdgcn_ds_swizzle(send, 0x101F); } \
            _Pragma("unroll") for (int j = 0; j < 2; ++j) { const int keep = b2 ? q4[j + 2] : q4[j], send = b2 ? q4[j] : q4[j + 2]; q2[j] = keep + __builtin_amdgcn_update_dpp(0, send, 0x4E, 0xf, 0xf, true); } \
            const int keep1 = b1 ? q2[1] : q2[0], send1 = b1 ? q2[0] : q2[1]; \
            mypa[(K8) + s8] = (float)(keep1 + __builtin_amdgcn_update_dpp(0, send1, 0xB1, 0xf, 0xf, true)) * sx;     } while (0)
        u32x4 rwA[8], rwB[8];
        U2_FETCH(0, rwA);
        for (int k8 = 0; k8 < 128; k8 += 16) {
            U2_FETCH(k8 + 8, rwB);
            U2_REDUCE(k8, rwA);
            U2_FETCH(k8 + 16, rwA);
            U2_REDUCE(k8 + 8, rwB);
        }
#undef U2_FETCH
#undef U2_REDUCE
        float* pg = part + (size_t)t0 * 128;
#pragma unroll
        for (int j = 0; j < 4; ++j) { const int f = lane * 4 + 256 * j, tk = f >> 7, k = f & 127; *(f32x4*)(pg + f) = *(const f32x4*)(lpa + tk * LST + k); }
    }
}
DI void peer_combine_phase(unsigned char* ws, const float* ssq2, const float* gts, const int* ids, const float* su, float* coef) {
    const size_t gt = (size_t)blockIdx.x * NTHREADS + opaque_tid(), NGT = (size_t)gridDim.x * NTHREADS;
    for (size_t i = gt; i < (size_t)T * 32; i += NGT) {
        const int t = (int)(i >> 5);
        f32x4 a = ((const f32x4*)partial_base(ws, 0))[i];
#pragma unroll
        for (int x = 1; x < 8; ++x) a += ((const f32x4*)partial_base(ws, x))[i];
        const float rs = __builtin_amdgcn_rsqf(ssq2[t] * (1.f / D) + EPS);
        const f32x4 g = ((const f32x4*)gts)[i]; const u32x4 id = ((const u32x4*)ids)[i];
        ((f32x4*)coef)[i] = (f32x4){g.x * gelu_tanh(a.x * rs * su[id.x]) * 0.5f, g.y * gelu_tanh(a.y * rs * su[id.y]) * 0.5f, g.z * gelu_tanh(a.z * rs * su[id.z]) * 0.5f, g.w * gelu_tanh(a.w * rs * su[id.w]) * 0.5f};
    }
}
template <int VAR>
DI void peer_v_phase(const bf16_t* x1in, bf16_t* xout, const unsigned char* v8, const int* ids, const float* coef, float* ssqo, unsigned char* lds, int lbl, int rnk, int cnt) {
    const int tid = opaque_tid(), lane = tid & 63, wave = tid >> 6, g8 = lane >> 3, s8 = lane & 7;
    constexpr int LST = 132;
    int* lid = (int*)(lds + wave * (2 * 8 * LST * 4)); float* lco = (float*)(lid + 8 * LST);
    const int stride = cnt * NWAVES * 8;
    const unsigned char* vbase = v8 + lbl * 128;
    for (int t0 = (rnk * NWAVES + wave) * 8; t0 < T; t0 += stride) {
#pragma unroll
        for (int j = 0; j < 4; ++j) { const int f = lane * 4 + 256 * j, tk = f >> 7, k = f & 127;
            *(u32x4*)(lid + tk * LST + k) = *(const u32x4*)(ids + (size_t)t0 * 128 + f); *(f32x4*)(lco + tk * LST + k) = *(const f32x4*)(coef + (size_t)t0 * 128 + f); }
        f32x2_t acc[8];
#pragma unroll
        for (int j = 0; j < 8; ++j) acc[j] = (f32x2_t){0.f, 0.f};
        const int* myid = lid + g8 * LST; const float* myco = lco + g8 * LST;
        const unsigned loff = (unsigned)(s8 * 16);
#define V_FETCH(K8, RW, CO) do { const int kc_ = (K8) < 128 ? (K8) : 120; const u32x4 i0_ = *(const u32x4*)(myid + kc_), i1_ = *(const u32x4*)(myid + kc_ + 4); \
            const f32x4 c0_ = *(const f32x4*)(myco + kc_), c1_ = *(const f32x4*)(myco + kc_ + 4); \
            _Pragma("unroll") for (int i = 0; i < 8; ++i) { const unsigned id_ = i < 4 ? i0_[i & 3] : i1_[i & 3]; CO[i] = i < 4 ? c0_[i & 3] : c1_[i & 3]; \
                if (VAR & 1) RW[i] = (u32x4){id_, id_ * 3u, id_ * 5u, id_ * 7u}; else RW[i] = *(const u32x4*)(vbase + (id_ * (unsigned)D + loff)); } } while (0)
#define V_ACCUM(RW, CO) do { _Pragma("unroll") for (int i = 0; i < 8; ++i) { const f32x2_t cc = {CO[i], CO[i]}; \
                if (VAR & 2) { acc[i].x += __builtin_bit_cast(float, (RW[i].x ^ RW[i].y ^ RW[i].z ^ RW[i].w) & 0x3fffffffu) * CO[i]; continue; } \
                _Pragma("unroll") for (int q = 0; q < 4; ++q) { const f32x2_t a = __builtin_amdgcn_cvt_pk_f32_fp8((int)RW[i][q], false), b = __builtin_amdgcn_cvt_pk_f32_fp8((int)RW[i][q], true); \
                    acc[2 * q] = __builtin_elementwise_fma(a, cc, acc[2 * q]); acc[2 * q + 1] = __builtin_elementwise_fma(b, cc, acc[2 * q + 1]); } } } while (0)
        u32x4 rwA[8], rwB[8]; float coA[8], coB[8];
        V_FETCH(0, rwA, coA);
        for (int k8 = 0; k8 < 128; k8 += 16) {
            V_FETCH(k8 + 8, rwB, coB);
            V_ACCUM(rwA, coA);
            V_FETCH(k8 + 16, rwA, coA);
            V_ACCUM(rwB, coB);
        }
#undef V_FETCH
#undef V_ACCUM
        const size_t xo_ = (size_t)(t0 + g8) * D + lbl * 128 + 16 * s8;
        const u32x4 xa = *(const u32x4*)(x1in + xo_), xb2 = *(const u32x4*)(x1in + xo_ + 8);
        float o[16];
        o[0] = bflo(xa.x) + acc[0].x; o[1] = bfhi(xa.x) + acc[0].y; o[2] = bflo(xa.y) + acc[1].x; o[3] = bfhi(xa.y) + acc[1].y; o[4] = bflo(xa.z) + acc[2].x; o[5] = bfhi(xa.z) + acc[2].y; o[6] = bflo(xa.w) + acc[3].x; o[7] = bfhi(xa.w) + acc[3].y;
        o[8] = bflo(xb2.x) + acc[4].x; o[9] = bfhi(xb2.x) + acc[4].y; o[10] = bflo(xb2.y) + acc[5].x; o[11] = bfhi(xb2.y) + acc[5].y; o[12] = bflo(xb2.z) + acc[6].x; o[13] = bfhi(xb2.z) + acc[6].y; o[14] = bflo(xb2.w) + acc[7].x; o[15] = bfhi(xb2.w) + acc[7].y;
        float ss = 0.f;
#pragma unroll
        for (int e = 0; e < 16; ++e) ss += o[e] * o[e];
        ss += dpp_f<0xB1>(ss); ss += dpp_f<0x4E>(ss); ss += dpp_f<0x141>(ss);
        if (s8 == 0) atomicAdd(ssqo + t0 + g8, ss);
        u32x4 w0, w1; w0.x = pk2(o[0], o[1]); w0.y = pk2(o[2], o[3]); w0.z = pk2(o[4], o[5]); w0.w = pk2(o[6], o[7]); w1.x = pk2(o[8], o[9]); w1.y = pk2(o[10], o[11]); w1.z = pk2(o[12], o[13]); w1.w = pk2(o[14], o[15]);
        *(u32x4*)(xout + xo_) = w0; *(u32x4*)(xout + xo_ + 8) = w1;
    }
}
DI void peer_final_phase(const bf16_t* xo, const float* ssqo, const float* gf, float* out) {
    const int tid = opaque_tid(), lane = tid & 63, gw = blockIdx.x * NWAVES + (tid >> 6), NGW = gridDim.x * NWAVES;
    f32x4 g[4];
#pragma unroll
    for (int q = 0; q < 4; ++q) g[q] = *(const f32x4*)(gf + lane * 16 + 4 * q);
    for (int t = gw; t < T; t += NGW) {
        const u32x4 w0 = *(const u32x4*)(xo + (size_t)t * D + lane * 16), w1 = *(const u32x4*)(xo + (size_t)t * D + lane * 16 + 8);
        const float rf = 1.f / sqrtf(ssqo[t] * (1.f / D) + EPS);
        f32x4* po = (f32x4*)(out + (size_t)t * D + lane * 16);
        po[0] = (f32x4){bflo(w0.x), bfhi(w0.x), bflo(w0.y), bfhi(w0.y)} * rf * g[0]; po[1] = (f32x4){bflo(w0.z), bfhi(w0.z), bflo(w0.w), bfhi(w0.w)} * rf * g[1];
        po[2] = (f32x4){bflo(w1.x), bfhi(w1.x), bflo(w1.y), bfhi(w1.y)} * rf * g[2]; po[3] = (f32x4){bflo(w1.z), bfhi(w1.z), bflo(w1.w), bfhi(w1.w)} * rf * g[3];
    }
}

#define LAS __attribute__((address_space(3)))
#define XB_TMO      128
#define XB_XCNT(j)  (256  + 64 * (j))
#define XB_XSUB(j)  (1280 + 64 * (j))
#define XB_XGEN(j)  (2304 + 64 * (j))
#define XB_TOP      3328
#define XB_TOPGEN   3392
#define XCD_BAR_WORDS 3456
#define XB_SPIN_CAP (1u << 18)
DI unsigned xb_ld(unsigned* p)              { return __hip_atomic_load(p, __ATOMIC_RELAXED, __HIP_MEMORY_SCOPE_AGENT); }
DI unsigned xb_add(unsigned* p, unsigned v) { return __hip_atomic_fetch_add(p, v, __ATOMIC_RELAXED, __HIP_MEMORY_SCOPE_AGENT); }
DI unsigned xb_xcc_id() { return (unsigned)__builtin_amdgcn_s_getreg((3 << 11) | 20) & 0xFu; }
#define XB_SPIN(cond, bar) do { unsigned _sp = 0; while (cond) { __builtin_amdgcn_s_sleep(1); \
    if ((++_sp & 255u) == 0u) { if (xb_ld(&(bar)[XB_TMO])) break; if (_sp > XB_SPIN_CAP) { atomicAdd(&(bar)[XB_TMO], 1u); break; } } } } while (0)
struct XcdBarrier { unsigned* bar; unsigned x; volatile LAS unsigned* st; };
DI XcdBarrier xcd_barrier_post(unsigned* bar, volatile LAS unsigned* st) {
    XcdBarrier b; b.bar = bar; b.x = xb_xcc_id(); b.st = st;
    if (threadIdx.x == 0) st[2] = xb_add(&bar[XB_XCNT(b.x)], 1u);
    return b;
}
DI void xcd_barrier_complete(unsigned* bar, unsigned x, unsigned& nloc, unsigned& nx) {
    const unsigned G = gridDim.x * gridDim.y * gridDim.z;
    unsigned sum, cnt, mine, sp = 0u;
    for (;;) {
        sum = 0u; cnt = 0u; mine = 0u;
#pragma unroll
        for (unsigned j = 0; j < 16; ++j) { const unsigned c = xb_ld(&bar[XB_XCNT(j)]); sum += c; cnt += (c > 0u) ? 1u : 0u; mine = (j == x) ? c : mine; }
        if (sum == G) break;
        __builtin_amdgcn_s_sleep(1);
        if ((++sp & 255u) == 0u) { if (xb_ld(&bar[XB_TMO])) break; if (sp > XB_SPIN_CAP) { atomicAdd(&bar[XB_TMO], 1u); break; } }
    }
    nloc = mine > 0u ? mine : 1u; nx = cnt > 0u ? cnt : 1u;
}
DI void xcd_barrier(const XcdBarrier& b) {
    asm volatile("s_waitcnt vmcnt(0)" ::: "memory");
    __syncthreads();
    if (threadIdx.x == 0) {
        unsigned* bar = b.bar;
        __builtin_amdgcn_s_waitcnt(0);
        unsigned nloc = b.st[0], nx = b.st[1];
        if (nloc == 0u) { xcd_barrier_complete(bar, b.x, nloc, nx); b.st[0] = nloc; b.st[1] = nx; }
        const unsigned old = xb_add(&bar[XB_XSUB(b.x)], 1u);
        const unsigned gen = old / nloc;
        if (old + 1u == (gen + 1u) * nloc) {
            __builtin_amdgcn_fence(__ATOMIC_RELEASE, "agent");
            asm volatile("s_waitcnt vmcnt(0)" ::: "memory");
            const unsigned og = xb_add(&bar[XB_TOP], 1u);
            const unsigned tg = og / nx;
            if (og + 1u == (tg + 1u) * nx) xb_add(&bar[XB_TOPGEN], 1u);
            else XB_SPIN(xb_ld(&bar[XB_TOPGEN]) == tg, bar);
            __builtin_amdgcn_fence(__ATOMIC_ACQUIRE, "agent");
            xb_add(&bar[XB_XGEN(b.x)], 1u);
            asm volatile("s_waitcnt vmcnt(0)" ::: "memory");
        } else {
            XB_SPIN(xb_ld(&bar[XB_XGEN(b.x)]) == gen, bar);
            __builtin_amdgcn_fence(__ATOMIC_ACQUIRE, "agent");
            asm volatile("s_waitcnt vmcnt(0)" ::: "memory");
        }
    }
    __syncthreads();
}


constexpr int LDS_BYTES = 147456;
__global__ void __launch_bounds__(NTHREADS, 2) fwd_kernel(Params p) {
    extern __shared__ __attribute__((aligned(16))) unsigned char lds[];
    cg::grid_group grid = cg::this_grid();
    volatile LAS unsigned* bst = (volatile LAS unsigned*)((LAS unsigned char*)lds + (LDS_BYTES - 64));
    if (threadIdx.x < 4) bst[threadIdx.x] = 0u;
    __syncthreads();
    const XcdBarrier xbar = xcd_barrier_post((unsigned*)p.ws, bst);
    const int NGW = gridDim.x * NWAVES, G = gridDim.x, cu = blockIdx.x;
    unsigned char* ws = p.ws;
    PG8_LAS unsigned char* ldsl = (PG8_LAS unsigned char*)lds;
    bf16_t* ycat = (bf16_t*)p.out;

    for (int rep_ = 0; rep_ < (DUP_PHASE == 0 ? 2 : 1); ++rep_) { phase0(p, (float*)lds);
    if (p.use_cg_sync) grid.sync(); else xcd_barrier(xbar); }
    for (int rep_ = 0; rep_ < (DUP_PHASE == 1 ? 2 : 1); ++rep_) {
        EpiZ E{(const float*)(ws + WS_RSTD1), (const float*)(ws + WS_RSTDM), (const float2*)(ws + WS_ROPE), (bf16_t*)(ws + WS_UPOOL), (bf16_t*)(ws + WS_QR), (bf16_t*)(ws + WS_KR), (bf16_t*)(ws + WS_VV), (bf16_t*)(ws + WS_QM), (bf16_t*)(ws + WS_GATES), (bf16_t*)(ws + WS_KVM)};
        SchedZ S{(const char*)(ws + WS_XB), (const char*)(ws + WS_WIN), (const char*)(ws + WS_MEMB), (const char*)(ws + WS_WMKV), G, cu};
        pg8::gemm_phase(ldsl, 1024, 1024, S, E);
    xcd_barrier(xbar); }
    for (int rep_ = 0; rep_ < (DUP_PHASE == 2 ? 2 : 1); ++rep_) {
    pooled_phase((const bf16_t*)(ws + WS_UPOOL), ycat);
    swa_phase((const bf16_t*)(ws + WS_QR), (const bf16_t*)(ws + WS_KR), (const bf16_t*)(ws + WS_VV), p.sinks, ycat, lds);
    mem_phase((const bf16_t*)(ws + WS_QM), (const bf16_t*)(ws + WS_KVM), ycat, lds);
    xcd_barrier(xbar); }
    for (int rep_ = 0; rep_ < (DUP_PHASE == 3 ? 2 : 1); ++rep_) {
        EpiGated E{(const bf16_t*)(ws + WS_GATES), (bf16_t*)(ws + WS_MERGED)};
        SchedGated S{(const char*)ycat, (const char*)(ws + WS_WBR), G, cu};
        pg8::gemm_phase(ldsl, 2048, 2048, S, E);
    xcd_barrier(xbar); }
    for (int rep_ = 0; rep_ < (DUP_PHASE == 4 ? 2 : 1); ++rep_) {
        EpiOut E{(const bf16_t*)(ws + WS_XB), (bf16_t*)(ws + WS_X1B), (float*)(ws + WS_RSTD2)};
        SchedPlain S{(const char*)(ws + WS_MERGED), (const char*)(ws + WS_WOUT), 1024, 1024, 128, 4, 16, G, cu};
        pg8::gemm_phase(ldsl, 1024, 1024, S, E);
    xcd_barrier(xbar); }
    for (int rep_ = 0; rep_ < (DUP_PHASE == 5 ? 2 : 1); ++rep_) {
        EpiBf16 E{(bf16_t*)(ws + WS_QP), 2048};
        SchedPlain S{(const char*)(ws + WS_X1B), (const char*)(ws + WS_WQ), 1024, 1024, 128, 8, 16, G, cu};
        pg8::gemm_phase(ldsl, 1024, 1024, S, E);
    xcd_barrier(xbar); }
    for (int rep_ = 0; rep_ < (DUP_PHASE == 6 ? 2 : 1); ++rep_) {
    topk_phase((const bf16_t*)(ws + WS_QP), (const bf16_t*)(ws + WS_KEYS), (const float*)(ws + WS_RSTD2), (int*)(ws + WS_IDS), (float*)(ws + WS_GTS), lds);
    xcd_barrier(xbar); }
    int lbl, rnk, cnt;
    {
        unsigned* bar = (unsigned*)p.ws; unsigned sum = 0u, mine = 0u; bool ok = xbar.x < 8u;
#pragma unroll
        for (unsigned j = 0; j < 8; ++j) { const unsigned c = xb_ld(&bar[XB_XCNT(j)]); sum += c; ok = ok && (c > 0u); mine = (j == xbar.x) ? c : mine; }
        ok = ok && (sum == (unsigned)G);
        lbl = ok ? (int)xbar.x : (cu & 7); rnk = ok ? (int)bst[2] : (cu >> 3); cnt = ok ? (int)mine : ((G - (cu & 7) + 7) >> 3);
        lbl = __builtin_amdgcn_readfirstlane(lbl); rnk = __builtin_amdgcn_readfirstlane(rnk); cnt = __builtin_amdgcn_readfirstlane(cnt);
    }
    if (DUP_PHASE == 7) {
        peer_u2_phase<PROBE_VAR>((const bf16_t*)(ws + WS_X1B), (const unsigned char*)(ws + WS_U16), (const int*)(ws + WS_IDS), partial_base(ws, lbl), lds, lbl, rnk, cnt);
        xcd_barrier(xbar); }
    peer_u2_phase<0>((const bf16_t*)(ws + WS_X1B), (const unsigned char*)(ws + WS_U16), (const int*)(ws + WS_IDS), partial_base(ws, lbl), lds, lbl, rnk, cnt);
    xcd_barrier(xbar);
    peer_combine_phase(ws, (const float*)(ws + WS_RSTD2), (const float*)(ws + WS_GTS), (const int*)(ws + WS_IDS), (const float*)(ws + WS_SU), (float*)(ws + WS_COEF));
    xcd_barrier(xbar);
    if (DUP_PHASE == 8) {
        peer_v_phase<PROBE_VAR>((const bf16_t*)(ws + WS_X1B), (bf16_t*)(ws + WS_MERGED), (const unsigned char*)(ws + WS_V16), (const int*)(ws + WS_IDS), (const float*)(ws + WS_COEF), (float*)(ws + WS_RSTD1), lds, lbl, rnk, cnt);
        xcd_barrier(xbar); }
    peer_v_phase<0>((const bf16_t*)(ws + WS_X1B), (bf16_t*)(ws + WS_X1B), (const unsigned char*)(ws + WS_V16), (const int*)(ws + WS_IDS), (const float*)(ws + WS_COEF), (float*)(ws + WS_SSQO), lds, lbl, rnk, cnt);
    xcd_barrier(xbar);
    for (int rep_ = 0; rep_ < (DUP_PHASE == 9 ? 2 : 1); ++rep_)
    peer_final_phase((const bf16_t*)(ws + WS_X1B), (const float*)(ws + WS_SSQO), p.final_g, p.out);
}

extern "C" void kernel_launch(void* const* d_in, const int* in_sizes, int n_in, void* d_out, int out_size, void* d_ws, size_t ws_size, hipStream_t stream) {
    static int grid_blocks = 0;
    if (grid_blocks == 0) {
        if (n_in != 20 || out_size != T * D || ws_size < WS_END) { fprintf(stderr, "kernel_launch: unexpected shapes: n_in %d out %d ws %zu\n", n_in, out_size, ws_size); grid_blocks = -1; return; }
        int dev = 0, cus = 0, per_cu = 0;
        (void)hipGetDevice(&dev);
        (void)hipDeviceGetAttribute(&cus, hipDeviceAttributeMultiprocessorCount, dev);
        if (hipFuncSetAttribute((const void*)fwd_kernel, hipFuncAttributeMaxDynamicSharedMemorySize, LDS_BYTES) != hipSuccess) { fprintf(stderr, "kernel_launch: hipFuncSetAttribute failed\n"); grid_blocks = -1; return; }
        (void)hipOccupancyMaxActiveBlocksPerMultiprocessor(&per_cu, (const void*)fwd_kernel, NTHREADS, LDS_BYTES);
        if (per_cu < 1) { fprintf(stderr, "kernel_launch: occupancy query says %d blocks per CU\n", per_cu); grid_blocks = -1; return; }
        grid_blocks = cus * per_cu;
        fprintf(stderr, "kernel_launch: cus %d per_cu %d grid %d ws %zu\n", cus, per_cu, grid_blocks, ws_size);
    }
    if (grid_blocks < 0) return;
    Params p{};
    p.x = (const float*)d_in[0]; p.mem = (const float*)d_in[1]; p.pos = (const int*)d_in[2]; p.norm1_g = (const float*)d_in[3]; p.mem_norm_g = (const float*)d_in[4];
    p.w_in = (const float*)d_in[5]; p.w_pool = (const float*)d_in[6]; p.pool_scale = (const float*)d_in[7]; p.sinks = (const float*)d_in[8]; p.w_mem_kv = (const float*)d_in[9];
    p.w_bpool = (const float*)d_in[10]; p.w_bswa = (const float*)d_in[11]; p.w_bmem = (const float*)d_in[12]; p.w_out = (const float*)d_in[13]; p.norm2_g = (const float*)d_in[14];
    p.w_q = (const float*)d_in[15]; p.sub_keys = (const float*)d_in[16]; p.peer_u = (const float*)d_in[17]; p.peer_v = (const float*)d_in[18]; p.final_g = (const float*)d_in[19];
    p.out = (float*)d_out; p.ws = (unsigned char*)d_ws;
    (void)hipMemsetAsync(d_ws, 0, 16384, stream);
    void* args[] = {&p};
    hipError_t e = hipLaunchCooperativeKernel((const void*)fwd_kernel, dim3(grid_blocks), dim3(NTHREADS), args, LDS_BYTES, stream);
    if (e != hipSuccess) fprintf(stderr, "cooperative launch failed: %s (grid %d)\n", hipGetErrorString(e), grid_blocks);
}
```

```cpp
#include <hip/hip_runtime.h>
#include <hip/hip_cooperative_groups.h>
#include <cstdio>
#include <cstdint>
namespace cg = cooperative_groups;

#define DI __device__ __forceinline__
typedef unsigned short bf16_t;
typedef _Float16 f16_t;
typedef short bf16x8 __attribute__((ext_vector_type(8)));
typedef float f32x4 __attribute__((ext_vector_type(4)));
typedef float f32x16 __attribute__((ext_vector_type(16)));
typedef unsigned u32x4 __attribute__((ext_vector_type(4)));
typedef unsigned u32x2 __attribute__((ext_vector_type(2)));
typedef _Float16 f16x4 __attribute__((ext_vector_type(4)));

#ifndef DUP_PHASE
#define DUP_PHASE -1
#endif
#ifndef PROBE_VAR
#define PROBE_VAR 0
#endif
constexpr int D = 1024, BATCH = 8, SEQ = 4096, T = BATCH * SEQ, MEML = 256, TMEM = BATCH * MEML;
constexpr int INW = 5376;
constexpr int NTHREADS = 512, NWAVES = 8;
constexpr int NEXP = 16384;
constexpr float EPS = 1e-6f;

constexpr size_t MiB = 1u << 20;
constexpr size_t WS_WIN = 1 * MiB;
constexpr size_t WS_WBR = 12 * MiB;
constexpr size_t WS_WOUT = 16 * MiB;
constexpr size_t WS_WQ = 18 * MiB;
constexpr size_t WS_KEYS = 22 * MiB;
constexpr size_t WS_WPOOL = 22 * MiB + 512 * 1024;
constexpr size_t WS_RSTD1 = 22 * MiB + 768 * 1024;
constexpr size_t WS_RSTD2 = 22 * MiB + 896 * 1024;
constexpr size_t WS_RSTDM = 23 * MiB;
constexpr size_t WS_SSQO = 23 * MiB + 64 * 1024;
constexpr size_t WS_SU = 23 * MiB + 256 * 1024;
constexpr size_t WS_WMKV = 24 * MiB;
constexpr size_t WS_MEMB = 26 * MiB;
constexpr size_t WS_KVM = 30 * MiB;
constexpr size_t WS_ROPE = 34 * MiB;
constexpr size_t WS_XB = 42 * MiB;
constexpr size_t WS_POOLED = 42 * MiB;
constexpr size_t WS_MERGED = 170 * MiB;
constexpr size_t WS_U16 = 106 * MiB;
constexpr size_t WS_V16 = 138 * MiB;
constexpr size_t WS_UPOOL = 170 * MiB;
constexpr size_t WS_QR = 202 * MiB;
constexpr size_t WS_KR = 266 * MiB;
constexpr size_t WS_VV = 274 * MiB;
constexpr size_t WS_QM = 282 * MiB;
constexpr size_t WS_GATES = 314 * MiB;
constexpr size_t WS_X1B = 234 * MiB;
constexpr size_t WS_QP = 314 * MiB;
constexpr size_t WS_COEF = 314 * MiB;
constexpr size_t WS_IDS = 442 * MiB;
constexpr size_t WS_GTS = 458 * MiB;
constexpr size_t WS_END = 512 * MiB;

struct Params {
    const float* x; const float* mem; const int* pos; const float* norm1_g; const float* mem_norm_g; const float* w_in; const float* w_pool;
    const float* pool_scale; const float* sinks; const float* w_mem_kv; const float* w_bpool; const float* w_bswa; const float* w_bmem; const float* w_out;
    const float* norm2_g; const float* w_q; const float* sub_keys; const float* peer_u; const float* peer_v; const float* final_g;
    float* out; unsigned char* ws;
    int use_cg_sync; int pad_;
};

DI unsigned f2bf(float f) { unsigned u = __builtin_bit_cast(unsigned, f); return (u + 0x7fffu + ((u >> 16) & 1u)) >> 16; }
DI unsigned pk2(float lo, float hi) { return f2bf(lo) | (f2bf(hi) << 16); }
DI float bf2f(bf16_t b) { return __builtin_bit_cast(float, (unsigned)b << 16); }
DI float bflo(unsigned w) { return __builtin_bit_cast(float, w << 16); }
DI float bfhi(unsigned w) { return __builtin_bit_cast(float, w & 0xffff0000u); }
DI float wave_sum(float v) {
#pragma unroll
    for (int o = 1; o < 64; o <<= 1) v += __shfl_xor(v, o);
    return v;
}
DI float wave_max(float v) {
#pragma unroll
    for (int o = 1; o < 64; o <<= 1) v = fmaxf(v, __shfl_xor(v, o));
    return v;
}
DI float gelu_tanh(float x) {
    const float y2 = 1.5957691216057308f * (x + 0.044715f * x * x * x);
    return x * __builtin_amdgcn_rcpf(1.f + __builtin_amdgcn_exp2f(-1.4426950408889634f * y2));
}
DI float sigmoidf(float x) { return __builtin_amdgcn_rcpf(1.f + __builtin_amdgcn_exp2f(-1.4426950408889634f * x)); }

DI int opaque_tid() { int t = threadIdx.x; asm volatile("" : "+v"(t)); return t; }
DI int zperm(int n) {
    if (n < 512 || n >= 1664) return n;
    const int d = (n - 512) & 63, hb = n - d; return hb + 8 * ((d & 31) >> 2) + (d & 3) + 4 * (d >> 5);
}
template <bool ZPERM>
DI void transpose_item(const float* W, int K, int N, bf16_t* WT, int ldt, int roff, int coff, const float* g, float* scr, int item, int lane) {
    const int nblk = N / 32, kb = item / nblk, nb = item % nblk, k0 = 64 * kb, n0 = 32 * nb;
    float tv[32];
#pragma unroll
    for (int i = 0; i < 32; ++i) tv[i] = W[(size_t)(k0 + 2 * i + (lane >> 5)) * N + n0 + (lane & 31)];
#pragma unroll
    for (int i = 0; i < 32; ++i) { const int kk = 2 * i + (lane >> 5); float v = tv[i]; if (g) v *= g[k0 + kk]; scr[kk * 33 + (lane & 31)] = v; }
    asm volatile("s_waitcnt lgkmcnt(0)" ::: "memory");
    const int c = lane & 7;
#pragma unroll
    for (int j = 0; j < 4; ++j) { const int n = (lane >> 3) + 8 * j; const float* s = scr + (8 * c) * 33 + n;
        u32x4 o; o.x = pk2(s[0 * 33], s[1 * 33]); o.y = pk2(s[2 * 33], s[3 * 33]); o.z = pk2(s[4 * 33], s[5 * 33]); o.w = pk2(s[6 * 33], s[7 * 33]);
        const int nd = ZPERM ? zperm(n0 + n) : n0 + n;
        *(u32x4*)(WT + (size_t)(roff + nd) * ldt + coff + k0 + 8 * c) = o; }
    asm volatile("s_waitcnt lgkmcnt(0)" ::: "memory");
}

DI void row_to_bf16_rstd(const float* xrow, bf16_t* orow, float* rstd_out, int lane) {
    const f32x4* xr = (const f32x4*)xrow + lane;
    f32x4 v[4]; float s = 0.f;
#pragma unroll
    for (int j = 0; j < 4; ++j) { v[j] = xr[64 * j]; s += (v[j].x * v[j].x + v[j].y * v[j].y) + (v[j].z * v[j].z + v[j].w * v[j].w); }
    s = wave_sum(s);
    if (lane == 0) *rstd_out = 1.f / sqrtf(s * (1.f / D) + EPS);
    u32x2* o8 = (u32x2*)orow + lane;
#pragma unroll
    for (int j = 0; j < 4; ++j) { u32x2 w; w.x = pk2(v[j].x, v[j].y); w.y = pk2(v[j].z, v[j].w); o8[64 * j] = w; }
}

DI void phase0(const Params& p, float* lds_f) {
    const int tid_ = opaque_tid(), lane = tid_ & 63, wave = tid_ >> 6, gw = blockIdx.x * NWAVES + wave, NGW = gridDim.x * NWAVES;
    unsigned char* ws = p.ws;
    float* scr = lds_f + wave * (64 * 33);
    bf16_t* WinT = (bf16_t*)(ws + WS_WIN); bf16_t* WbrT = (bf16_t*)(ws + WS_WBR); bf16_t* WoutT = (bf16_t*)(ws + WS_WOUT); bf16_t* WqT = (bf16_t*)(ws + WS_WQ);
    bf16_t* WmkvT = (bf16_t*)(ws + WS_WMKV);
    constexpr int I_IN = (D / 64) * (INW / 32), I_BS = (1024 / 64) * (D / 32), I_BM = (512 / 64) * (D / 32), I_OUT = (D / 64) * (D / 32), I_Q = (D / 64) * (2048 / 32), I_MKV = (D / 64) * (D / 32);
    constexpr int NITEMS = I_IN + I_BS + I_BM + I_OUT + I_Q + I_MKV;
    for (int rp_ = 0; rp_ < (DUP_PHASE == 10 ? 2 : 1); ++rp_) {
    for (int it = gw; it < NITEMS; it += NGW) {
        int r = it;
        if (r < I_IN) { transpose_item<true>(p.w_in, D, INW, WinT, D, 0, 0, p.norm1_g, scr, r, lane); continue; } r -= I_IN;
        if (r < I_BS) { transpose_item<false>(p.w_bswa, 1024, D, WbrT, 2048, 0, 512, nullptr, scr, r, lane); continue; } r -= I_BS;
        if (r < I_BM) { transpose_item<false>(p.w_bmem, 512, D, WbrT, 2048, 0, 1536, nullptr, scr, r, lane); continue; } r -= I_BM;
        if (r < I_OUT) { transpose_item<false>(p.w_out, D, D, WoutT, D, 0, 0, nullptr, scr, r, lane); continue; } r -= I_OUT;
        if (r < I_Q) { transpose_item<false>(p.w_q, D, 2048, WqT, D, 0, 0, p.norm2_g, scr, r, lane); continue; } r -= I_Q;
        transpose_item<false>(p.w_mem_kv, D, D, WmkvT, D, 0, 0, p.mem_norm_g, scr, r, lane);
    }
    }
    for (int rp_ = 0; rp_ < (DUP_PHASE == 11 ? 2 : 1); ++rp_) {
    {
        const size_t gt0 = (size_t)gw * 64 + lane, NGT0 = (size_t)NGW * 64;
        for (size_t i = gt0; i < (size_t)512 * 256; i += NGT0) {
            const int n4 = (int)(i & 255), cp = (int)(i >> 8), g = cp >> 7;
            const float* wp = p.w_pool + (size_t)cp * 128; const float* sc = p.pool_scale + g * 128; const f32x4* wb = (const f32x4*)(p.w_bpool + (size_t)(g * 128) * 1024) + n4;
            f32x4 a = {0.f, 0.f, 0.f, 0.f};
#pragma unroll 16
            for (int d = 0; d < 128; ++d) a += wb[(size_t)d * 256] * (wp[d] * sc[d]);
            bf16_t* o = WbrT + (size_t)(4 * n4) * 2048 + cp;
            o[0] = (bf16_t)f2bf(a.x); o[2048] = (bf16_t)f2bf(a.y); o[4096] = (bf16_t)f2bf(a.z); o[6144] = (bf16_t)f2bf(a.w);
        }
    }
    }
    bf16_t* xb = (bf16_t*)(ws + WS_XB); float* rstd1 = (float*)(ws + WS_RSTD1);
    for (int rp_ = 0; rp_ < (DUP_PHASE == 12 ? 2 : 1); ++rp_) {
    for (int m = gw; m < T; m += 4 * NGW) {
        f32x4 v[4][4];
#pragma unroll
        for (int q = 0; q < 4; ++q) { const int mq = (m + q * NGW < T) ? m + q * NGW : m; const f32x4* xr = (const f32x4*)(p.x + (size_t)mq * D) + lane;
#pragma unroll
            for (int j = 0; j < 4; ++j) v[q][j] = xr[64 * j]; }
#pragma unroll
        for (int q = 0; q < 4; ++q) { const int mq = m + q * NGW; float s = 0.f;
#pragma unroll
            for (int j = 0; j < 4; ++j) s += (v[q][j].x * v[q][j].x + v[q][j].y * v[q][j].y) + (v[q][j].z * v[q][j].z + v[q][j].w * v[q][j].w);
            s = wave_sum(s);
            if (mq < T) { if (lane == 0) rstd1[mq] = __builtin_amdgcn_rsqf(s * (1.f / D) + EPS);
                u32x2* o8 = (u32x2*)(xb + (size_t)mq * D) + lane;
#pragma unroll
                for (int j = 0; j < 4; ++j) { u32x2 wv; wv.x = pk2(v[q][j].x, v[q][j].y); wv.y = pk2(v[q][j].z, v[q][j].w); o8[64 * j] = wv; } } }
    }
    }
    bf16_t* memb = (bf16_t*)(ws + WS_MEMB); float* rstdm = (float*)(ws + WS_RSTDM);
    for (int m = gw; m < TMEM; m += NGW) row_to_bf16_rstd(p.mem + (size_t)m * D, memb + (size_t)m * D, rstdm + m, lane);
    const size_t gt = (size_t)gw * 64 + lane, NGT = (size_t)NGW * 64;
    bf16_t* keysb = (bf16_t*)(ws + WS_KEYS);
    for (size_t i = gt; i < (size_t)8 * 2 * 128 * 128 / 4; i += NGT) { const f32x4 v = ((const f32x4*)p.sub_keys)[i]; u32x2 w; w.x = pk2(v.x, v.y); w.y = pk2(v.z, v.w); ((u32x2*)keysb)[i] = w; }
    for (int rp_ = 0; rp_ < (DUP_PHASE == 14 ? 2 : 1); ++rp_) {
    {
        unsigned* u8 = (unsigned*)(ws + WS_U16); unsigned* v8 = (unsigned*)(ws + WS_V16); float* su = (float*)(ws + WS_SU);
        f32x4 g2r[4];
#pragma unroll
        for (int j = 0; j < 4; ++j) g2r[j] = ((const f32x4*)p.norm2_g)[lane + 64 * j];
        for (int r0 = gw; r0 < NEXP; r0 += 2 * NGW) {
            f32x4 au[2][4], av[2][4];
#pragma unroll
            for (int h = 0; h < 2; ++h) { const int r = (r0 + h * NGW < NEXP) ? r0 + h * NGW : r0;
#pragma unroll
                for (int j = 0; j < 4; ++j) { au[h][j] = ((const f32x4*)p.peer_u)[(size_t)r * 256 + lane + 64 * j]; av[h][j] = ((const f32x4*)p.peer_v)[(size_t)r * 256 + lane + 64 * j]; } }
#pragma unroll
            for (int h = 0; h < 2; ++h) { const int r = r0 + h * NGW; if (r >= NEXP) continue;
                float mx = 0.f;
#pragma unroll
                for (int j = 0; j < 4; ++j) { au[h][j] = au[h][j] * g2r[j]; mx = fmaxf(fmaxf(mx, fmaxf(fabsf(au[h][j].x), fabsf(au[h][j].y))), fmaxf(fabsf(au[h][j].z), fabsf(au[h][j].w))); }
                mx = wave_max(mx);
                const float inv = mx > 0.f ? 127.f / mx : 0.f;
                if (lane == 0) su[r] = mx * (1.f / 127.f);
#pragma unroll
                for (int j = 0; j < 4; ++j) { const f32x4 b = av[h][j] * 2.f;
                    const int q0 = (int)__builtin_rintf(au[h][j].x * inv), q1 = (int)__builtin_rintf(au[h][j].y * inv), q2 = (int)__builtin_rintf(au[h][j].z * inv), q3 = (int)__builtin_rintf(au[h][j].w * inv);
                    const unsigned wa = (unsigned)(q0 & 255) | ((unsigned)(q1 & 255) << 8) | ((unsigned)(q2 & 255) << 16) | ((unsigned)q3 << 24);
                    int wb = __builtin_amdgcn_cvt_pk_fp8_f32(b.x, b.y, 0, false); wb = __builtin_amdgcn_cvt_pk_fp8_f32(b.z, b.w, wb, true);
                    u8[(size_t)r * 256 + lane + 64 * j] = wa; v8[(size_t)r * 256 + lane + 64 * j] = (unsigned)wb; } }
        }
    }
    }
    for (size_t i = gt; i < (size_t)T; i += NGT) { ((float*)(ws + WS_RSTD2))[i] = 0.f; ((float*)(ws + WS_SSQO))[i] = 0.f; }
    for (int rp_ = 0; rp_ < (DUP_PHASE == 15 ? 2 : 1); ++rp_) {
    float2* rope = (float2*)(ws + WS_ROPE);
    for (size_t i = gt; i < (size_t)T * 32; i += NGT) {
        const int t = (int)(i >> 5), d = (int)(i & 31);
        const float inv = exp2f(-(float)d * (13.287712379549449f / 32.f));
        const float ang = (float)p.pos[t] * inv;
        const double rev = (double)ang * 0.15915494309189535;
        const float fr = (float)(rev - floor(rev));
        rope[i] = make_float2(__builtin_amdgcn_cosf(fr), __builtin_amdgcn_sinf(fr));
    }
    }
}

namespace pg8 {
#define PG8_LAS __attribute__((address_space(3)))
constexpr int BM = 256, BK = 64, HALF = 128, HTB = HALF * BK * 2, STAGE_BYTES = 8 * HTB, NXCD = 8, WGM = 8;
__host__ __device__ __forceinline__ int lds_byte(int r, int c) { const int st = (r >> 4) * 2 + (c >> 5), rr = r & 15, cc = c & 31, ob = rr * 64 + cc * 2; return st * 1024 + (ob ^ (((ob >> 9) & 1) << 5)); }
__host__ __device__ __forceinline__ void stage_rc(int b, int& R, int& C) { const int st = b / 1024, sb = b % 1024, swz = sb ^ (((sb >> 9) & 1) << 5); R = (st >> 1) * 16 + swz / 64; C = (st & 1) * 32 + (swz % 64) / 2; }
__host__ __device__ __forceinline__ int perm32(int rho) { const int n = rho >> 4, i = rho & 15; return 8 * (i >> 2) + 4 * n + (i & 3); }

struct Unit { const char* a; const char* b; int nt, pm, pn, tag; };
DI void tile_of(int L, int nM, int nN, int& pm, int& pn) {
    const int nwg = nM * nN; int wgid = L; { const int q = nwg / NXCD, r = nwg % NXCD, xcd = wgid % NXCD, off = wgid / NXCD; wgid = (xcd < r ? xcd * (q + 1) : r * (q + 1) + (xcd - r) * q) + off; }
    const int nig = WGM * nN, gid = wgid / nig, fm = gid * WGM, gsz = (nM - fm) < WGM ? (nM - fm) : WGM;
    pm = fm + ((wgid % nig) % gsz); pn = (wgid % nig) / gsz;
}
template <class Epi, class Sched>
DI void gemm_phase(PG8_LAS unsigned char* lds, int lda, int ldb, const Sched& S, const Epi& E) {
    int tid = threadIdx.x; asm volatile("" : "+v"(tid));
    const int wid = __builtin_amdgcn_readfirstlane(tid >> 6), wr = wid >> 2, wc = wid & 3, lane = tid & 63, fr = lane & 15, fq = lane >> 4;
    unsigned voffA[2], voffB[2];
#pragma unroll
    for (int i = 0; i < 2; ++i) { int R, C; stage_rc(tid * 16 + i * 8192, R, C); const int Rb = (R & ~31) + perm32(R & 31);
        voffA[i] = (unsigned)(R * lda + C) * 2u; voffB[i] = (unsigned)(Rb * ldb + C) * 2u; }
    const size_t kstep = (size_t)(BK * 2);
    const size_t hstepA = (size_t)HALF * lda * 2, hstepB = (size_t)HALF * ldb * 2;
    const unsigned ldsw = (unsigned)wid * 1024u;
    const int aoff = lds_byte(wr * 64 + fr, fq * 8), boff = lds_byte(wc * 32 + fr, fq * 8);
#define PG8_SA(b, h) (((b) * 2 + (h)) * HTB)
#define PG8_SB(b, h) ((4 + (b) * 2 + (h)) * HTB)
#define PG8_STAGE(bufoff, gbase, voff) do { _Pragma("unroll") for (int _i = 0; _i < 2; ++_i) \
        __builtin_amdgcn_global_load_lds((const unsigned*)((const char*)(gbase) + (voff)[_i]), (PG8_LAS unsigned*)(lds + (bufoff) + ldsw + _i * 8192), 16, 0, 0); } while (0)
#define PG8_LDA(dst, b, h) do { _Pragma("unroll") for (int m = 0; m < 4; ++m) _Pragma("unroll") for (int k = 0; k < 2; ++k) dst[m][k] = *(const PG8_LAS bf16x8*)(lds + PG8_SA(b, h) + aoff + m * 2048 + k * 1024); } while (0)
#define PG8_LDB(dst, b, h) do { _Pragma("unroll") for (int n = 0; n < 2; ++n) _Pragma("unroll") for (int k = 0; k < 2; ++k) dst[n][k] = *(const PG8_LAS bf16x8*)(lds + PG8_SB(b, h) + boff + n * 2048 + k * 1024); } while (0)
#define PG8_MMA(ai, bj, At, Bt) do { __builtin_amdgcn_s_setprio(1); _Pragma("unroll") for (int m = 0; m < 4; ++m) _Pragma("unroll") for (int n = 0; n < 2; ++n) _Pragma("unroll") for (int k = 0; k < 2; ++k) \
        acc[ai][bj][m][n] = __builtin_amdgcn_mfma_f32_16x16x32_bf16(Bt[n][k], At[m][k], acc[ai][bj][m][n], 0, 0, 0); __builtin_amdgcn_s_setprio(0); } while (0)
#define PG8_WAIT_V(n) asm volatile("s_waitcnt vmcnt(" #n ")" ::: "memory")
#define PG8_WAIT_L(n) asm volatile("s_waitcnt lgkmcnt(" #n ")" ::: "memory")
#define PG8_BAR __builtin_amdgcn_s_barrier()
#define PG8_SCHED __builtin_amdgcn_sched_barrier(0)
    Unit cur, nxt; int ui = 0;
    if (!S.next(0, cur)) return;
    f32x4 acc[2][2][4][2];
#pragma unroll
    for (int a = 0; a < 2; ++a)
#pragma unroll
        for (int b = 0; b < 2; ++b)
#pragma unroll
            for (int m = 0; m < 4; ++m)
#pragma unroll
                for (int n = 0; n < 2; ++n) acc[a][b][m][n] = (f32x4){0.f, 0.f, 0.f, 0.f};
    bf16x8 At[4][2], B0[2][2], B1[2][2];
    const char* cA = cur.a; const char* cB = cur.b;
    PG8_STAGE(PG8_SB(0, 0), cB, voffB); PG8_STAGE(PG8_SB(0, 1), cB + hstepB, voffB); PG8_STAGE(PG8_SA(0, 0), cA, voffA); PG8_STAGE(PG8_SA(0, 1), cA + hstepA, voffA);
    if (wr == 1) PG8_BAR;
    PG8_WAIT_V(2); PG8_BAR;
    PG8_STAGE(PG8_SB(1, 0), cB + kstep, voffB); PG8_STAGE(PG8_SA(1, 0), cA + kstep, voffA); PG8_STAGE(PG8_SB(1, 1), cB + hstepB + kstep, voffB);
    PG8_WAIT_V(6); PG8_BAR;
    for (;;) {
        const bool has_next = S.next(ui + 1, nxt);
        const char* nA = has_next ? nxt.a : cA; const char* nB = has_next ? nxt.b : cB;
        const int nt = cur.nt;
        for (int t = 0; t < nt; t += 2) {
            const bool last = (t == nt - 2);
            const char* a1 = cA + (size_t)(t + 1) * kstep;
            const char* a2 = last ? nA : cA + (size_t)(t + 2) * kstep; const char* b2 = last ? nB : cB + (size_t)(t + 2) * kstep;
            const char* a3 = a2 + kstep; const char* b3 = b2 + kstep;
            PG8_LDB(B0, 0, 0); PG8_LDB(B1, 0, 1); PG8_SCHED; PG8_LDA(At, 0, 0); PG8_STAGE(PG8_SA(1, 1), a1 + hstepA, voffA);
            PG8_WAIT_V(8); PG8_WAIT_L(0); PG8_BAR; PG8_MMA(0, 0, At, B0); PG8_MMA(0, 1, At, B1); PG8_BAR; PG8_SCHED;
            PG8_LDA(At, 0, 1); PG8_STAGE(PG8_SB(0, 0), b2, voffB); PG8_STAGE(PG8_SB(0, 1), b2 + hstepB, voffB); PG8_STAGE(PG8_SA(0, 0), a2, voffA);
            PG8_WAIT_V(8); PG8_WAIT_L(0); PG8_BAR; PG8_MMA(1, 0, At, B0); PG8_MMA(1, 1, At, B1); PG8_BAR; PG8_SCHED;
            PG8_LDB(B0, 1, 0); PG8_LDB(B1, 1, 1); PG8_SCHED; PG8_LDA(At, 1, 0); PG8_STAGE(PG8_SA(0, 1), a2 + hstepA, voffA);
            PG8_WAIT_V(8); PG8_WAIT_L(0); PG8_BAR; PG8_MMA(0, 0, At, B0); PG8_MMA(0, 1, At, B1); PG8_BAR; PG8_SCHED;
            PG8_LDA(At, 1, 1); PG8_STAGE(PG8_SB(1, 0), b3, voffB); PG8_STAGE(PG8_SB(1, 1), b3 + hstepB, voffB); PG8_STAGE(PG8_SA(1, 0), a3, voffA);
            PG8_WAIT_V(8); PG8_WAIT_L(0); PG8_BAR; PG8_MMA(1, 0, At, B0); PG8_MMA(1, 1, At, B1); PG8_BAR; PG8_SCHED;
        }
        if (wr == 0) PG8_BAR;
        const bool keep_ = E(acc, cur, wr, wc, fr, fq);
        if (!has_next) break;
        if (!keep_)
#pragma unroll
        for (int a = 0; a < 2; ++a)
#pragma unroll
            for (int b = 0; b < 2; ++b)
#pragma unroll
                for (int m = 0; m < 4; ++m)
#pragma unroll
                    for (int n = 0; n < 2; ++n) acc[a][b][m][n] = (f32x4){0.f, 0.f, 0.f, 0.f};
        cur = nxt; cA = nA; cB = nB; ++ui;
        if (wr == 1) PG8_BAR;
    }
    PG8_WAIT_V(0);
    PG8_BAR;
#undef PG8_SA
#undef PG8_SB
#undef PG8_STAGE
#undef PG8_LDA
#undef PG8_LDB
#undef PG8_MMA
#undef PG8_WAIT_V
#undef PG8_WAIT_L
#undef PG8_BAR
#undef PG8_SCHED
}
}
typedef f32x4 acc_t[2][2][4][2];

struct SchedPlain {
    const char* A; const char* Bt; int lda, ldb, nM, nN, nt, G, c;
    DI bool next(int i, pg8::Unit& u) const {
        const long L = (long)i * G + c; if (L >= (long)nM * nN) return false;
        pg8::tile_of((int)L, nM, nN, u.pm, u.pn); u.a = A + (size_t)u.pm * 256 * lda * 2; u.b = Bt + (size_t)u.pn * 256 * ldb * 2; u.nt = nt; u.tag = 0; return true;
    }
};
struct SchedZ {
    const char *xb, *win, *memb, *wmkv; int G, c;
    DI bool next(int i, pg8::Unit& u) const {
        const long L = (long)i * G + c; constexpr int NZ = 128 * 21;
        if (L < NZ) { pg8::tile_of((int)L, 128, 21, u.pm, u.pn); u.a = xb + (size_t)u.pm * 256 * 2048; u.b = win + (size_t)u.pn * 256 * 2048; u.nt = 16; u.tag = 0; return true; }
        const int j = (int)(L - NZ); if (j >= 32) return false;
        u.pm = j >> 2; u.pn = j & 3; u.a = memb + (size_t)u.pm * 256 * 2048; u.b = wmkv + (size_t)u.pn * 256 * 2048; u.nt = 16; u.tag = 1; return true;
    }
};
struct SchedGated {
    const char *ycat, *wbr; int G, c;
    DI bool next(int i, pg8::Unit& u) const {
        const int j = i / 3, b = i - 3 * j; const long L = (long)j * G + c; if (L >= 128 * 4) return false;
        pg8::tile_of((int)L, 128, 4, u.pm, u.pn);
        const int koff = (b == 0) ? 0 : (b == 1 ? 512 : 1536);
        u.a = ycat + ((size_t)u.pm * 256 * 2048 + koff) * 2; u.b = wbr + ((size_t)u.pn * 256 * 2048 + koff) * 2; u.nt = (b == 1) ? 16 : 8; u.tag = b; return true;
    }
};

DI u32x4 pack8(const f32x4& a, const f32x4& b) { u32x4 w; w.x = pk2(a[0], a[1]); w.y = pk2(a[2], a[3]); w.z = pk2(b[0], b[1]); w.w = pk2(b[2], b[3]); return w; }
struct EpiZ {
    const float* rstd1; const float* rstdm; const float2* rope; bf16_t *upool, *qr, *kr, *vv, *qm; unsigned char* gates; bf16_t* kvm;
    DI bool operator()(const acc_t& acc, const pg8::Unit& u, int wr, int wc, int fr_, int fq_) const {
        int l_ = threadIdx.x; asm volatile("" : "+v"(l_)); const int fr = l_ & 15, fq = (l_ >> 4) & 3;
        const int row0 = u.pm * 256 + wr * 64 + fr;
        const float* rsp = (u.tag == 1) ? rstdm : rstd1;
        float rs[2][4];
#pragma unroll
        for (int ai = 0; ai < 2; ++ai)
#pragma unroll
            for (int m = 0; m < 4; ++m) rs[ai][m] = rsp[row0 + ai * 128 + m * 16];
        if (u.tag == 1) {
#pragma unroll
            for (int ai = 0; ai < 2; ++ai)
#pragma unroll
                for (int m = 0; m < 4; ++m) { const int row = row0 + ai * 128 + m * 16;
#pragma unroll
                    for (int bj = 0; bj < 2; ++bj) { const int c = u.pn * 256 + bj * 128 + wc * 32 + 8 * fq;
                        *(u32x4*)(kvm + (size_t)row * 1024 + c) = pack8(acc[ai][bj][m][0] * rs[ai][m], acc[ai][bj][m][1] * rs[ai][m]); } }
            return false;
        }
#pragma unroll
        for (int bj = 0; bj < 2; ++bj) {
            const int cb = u.pn * 256 + bj * 128;
            const int c = cb + wc * 32 + 8 * fq;
            if (cb >= 512 && cb < 1664) {
                const bool isq = cb < 1536; const int rel = isq ? c - 512 : c - 1536; const int hrel = rel & 63, d0 = hrel >> 1, hb = rel - hrel;
                const float sc = isq ? 0.125f : 1.f;
#pragma unroll
                for (int ai = 0; ai < 2; ++ai) {
                    f32x4 cs0[4], cs1[4];
#pragma unroll
                    for (int m = 0; m < 4; ++m) { const int row = row0 + ai * 128 + m * 16;
                        cs0[m] = *(const f32x4*)(rope + (size_t)row * 32 + d0); cs1[m] = *(const f32x4*)(rope + (size_t)row * 32 + d0 + 2); }
#pragma unroll
                    for (int m = 0; m < 4; ++m) { const int row = row0 + ai * 128 + m * 16;
                        const f32x4 v0 = acc[ai][bj][m][0] * rs[ai][m], v1 = acc[ai][bj][m][1] * rs[ai][m], a0 = cs0[m], a1 = cs1[m];
                        f32x4 o1, o2;
                        o1[0] = (v0[0] * a0[0] - v1[0] * a0[1]) * sc; o2[0] = (v1[0] * a0[0] + v0[0] * a0[1]) * sc;
                        o1[1] = (v0[1] * a0[2] - v1[1] * a0[3]) * sc; o2[1] = (v1[1] * a0[2] + v0[1] * a0[3]) * sc;
                        o1[2] = (v0[2] * a1[0] - v1[2] * a1[1]) * sc; o2[2] = (v1[2] * a1[0] + v0[2] * a1[1]) * sc;
                        o1[3] = (v0[3] * a1[2] - v1[3] * a1[3]) * sc; o2[3] = (v1[3] * a1[2] + v0[3] * a1[3]) * sc;
                        bf16_t* dst = isq ? qr + (size_t)row * 1024 + hb + d0 : kr + (size_t)row * 128 + hb + d0;
                        u32x2 w1, w2; w1.x = pk2(o1[0], o1[1]); w1.y = pk2(o1[2], o1[3]); w2.x = pk2(o2[0], o2[1]); w2.y = pk2(o2[2], o2[3]);
                        *(u32x2*)dst = w1; *(u32x2*)(dst + 32) = w2; }
                }
                continue;
            }
#pragma unroll
            for (int ai = 0; ai < 2; ++ai)
#pragma unroll
                for (int m = 0; m < 4; ++m) {
                    const int row = row0 + ai * 128 + m * 16;
                    const f32x4 v0 = acc[ai][bj][m][0] * rs[ai][m], v1 = acc[ai][bj][m][1] * rs[ai][m];
                    if (cb < 512) { *(u32x4*)(upool + (size_t)row * 512 + c) = pack8(v0, v1); }
                    else if (cb < 1792) { *(u32x4*)(vv + (size_t)row * 128 + (c - 1664)) = pack8(v0, v1); }
                    else if (cb < 2304) { *(u32x4*)(qm + (size_t)row * 512 + (c - 1792)) = pack8(v0, v1); }
                    else { unsigned q[8];
#pragma unroll
                        for (int e = 0; e < 4; ++e) { q[e] = (unsigned)fminf(sigmoidf(v0[e]) * 256.f, 255.f); q[4 + e] = (unsigned)fminf(sigmoidf(v1[e]) * 256.f, 255.f); }
                        u32x2 w; w.x = q[0] | (q[1] << 8) | (q[2] << 16) | (q[3] << 24); w.y = q[4] | (q[5] << 8) | (q[6] << 16) | (q[7] << 24);
                        *(u32x2*)(gates + (size_t)row * 3072 + (c - 2304)) = w; }
                }
        }
        return false;
    }
};
struct EpiGated {
    const unsigned char* gates; bf16_t* merged;
    static DI float gv(unsigned w, int e) { return ((float)((w >> (8 * e)) & 255u) + 0.5f) * (1.f / 256.f); }
    DI bool operator()(acc_t& acc, const pg8::Unit& u, int wr, int wc, int fr_, int fq_) const {
        int l_ = threadIdx.x; asm volatile("" : "+v"(l_)); const int fr = l_ & 15, fq = (l_ >> 4) & 3;
        const int row0 = u.pm * 256 + wr * 64 + fr, b = u.tag;
#pragma unroll
        for (int ai = 0; ai < 2; ++ai) {
            u32x2 gq[4][2], gnq[4][2];
#pragma unroll
            for (int m = 0; m < 4; ++m)
#pragma unroll
                for (int bj = 0; bj < 2; ++bj) { const unsigned char* gp = gates + (size_t)(row0 + ai * 128 + m * 16) * 3072 + b * 1024 + u.pn * 256 + bj * 128 + wc * 32 + 8 * fq;
                    gq[m][bj] = *(const u32x2*)gp; if (b < 2) gnq[m][bj] = *(const u32x2*)(gp + 1024); else gnq[m][bj] = gq[m][bj]; }
#pragma unroll
            for (int m = 0; m < 4; ++m) { const int row = row0 + ai * 128 + m * 16;
#pragma unroll
                for (int bj = 0; bj < 2; ++bj) { const int c = u.pn * 256 + bj * 128 + wc * 32 + 8 * fq;
                    const u32x2 g = gq[m][bj], gn = gnq[m][bj];
                    f32x4 s0, s1;
#pragma unroll
                    for (int e = 0; e < 4; ++e) { s0[e] = gv(g.x, e); s1[e] = gv(g.y, e); }
                    if (b < 2) {
#pragma unroll
                        for (int e = 0; e < 4; ++e) { s0[e] *= __builtin_amdgcn_rcpf(gv(gn.x, e)); s1[e] *= __builtin_amdgcn_rcpf(gv(gn.y, e)); }
                        acc[ai][bj][m][0] *= s0; acc[ai][bj][m][1] *= s1; }
                    else *(u32x4*)(merged + (size_t)row * 1024 + c) = pack8(acc[ai][bj][m][0] * s0, acc[ai][bj][m][1] * s1); } }
        }
        return b < 2;
    }
};
struct EpiOut {
    const bf16_t* xb; bf16_t* x1b; float* ssq;
    DI bool operator()(const acc_t& acc, const pg8::Unit& u, int wr, int wc, int fr_, int fq_) const {
        int l_ = threadIdx.x; asm volatile("" : "+v"(l_)); const int fr = l_ & 15, fq = (l_ >> 4) & 3;
        const int row0 = u.pm * 256 + wr * 64 + fr;
#pragma unroll
        for (int ai = 0; ai < 2; ++ai) {
            u32x4 xq[4][2];
#pragma unroll
            for (int m = 0; m < 4; ++m)
#pragma unroll
                for (int bj = 0; bj < 2; ++bj) xq[m][bj] = *(const u32x4*)(xb + (size_t)(row0 + ai * 128 + m * 16) * D + u.pn * 256 + bj * 128 + wc * 32 + 8 * fq);
#pragma unroll
            for (int m = 0; m < 4; ++m) { const int row = row0 + ai * 128 + m * 16; float sq = 0.f;
#pragma unroll
                for (int bj = 0; bj < 2; ++bj) { const size_t o = (size_t)row * D + u.pn * 256 + bj * 128 + wc * 32 + 8 * fq;
                    const u32x4 xw = xq[m][bj];
                    f32x4 v0 = acc[ai][bj][m][0], v1 = acc[ai][bj][m][1];
                    v0[0] += bflo(xw.x); v0[1] += bfhi(xw.x); v0[2] += bflo(xw.y); v0[3] += bfhi(xw.y); v1[0] += bflo(xw.z); v1[1] += bfhi(xw.z); v1[2] += bflo(xw.w); v1[3] += bfhi(xw.w);
                    sq += (v0[0] * v0[0] + v0[1] * v0[1]) + (v0[2] * v0[2] + v0[3] * v0[3]) + (v1[0] * v1[0] + v1[1] * v1[1]) + (v1[2] * v1[2] + v1[3] * v1[3]);
                    *(u32x4*)(x1b + o) = pack8(v0, v1); }
                sq += __shfl_xor(sq, 16); sq += __shfl_xor(sq, 32);
                if (fq == 0) atomicAdd(ssq + row, sq); }
        }
        return false;
    }
};
struct EpiBf16 {
    bf16_t* O; int ldo;
    DI bool operator()(const acc_t& acc, const pg8::Unit& u, int wr, int wc, int fr_, int fq_) const {
        int l_ = threadIdx.x; asm volatile("" : "+v"(l_)); const int fr = l_ & 15, fq = (l_ >> 4) & 3;
        const int row0 = u.pm * 256 + wr * 64 + fr;
#pragma unroll
        for (int ai = 0; ai < 2; ++ai)
#pragma unroll
            for (int m = 0; m < 4; ++m) { const int row = row0 + ai * 128 + m * 16;
#pragma unroll
                for (int bj = 0; bj < 2; ++bj) { const size_t o = (size_t)row * ldo + u.pn * 256 + bj * 128 + wc * 32 + 8 * fq;
                    *(u32x4*)(O + o) = pack8(acc[ai][bj][m][0], acc[ai][bj][m][1]); } }
        return false;
    }
};

DI void unpack8(const u32x4& w, float (&f)[8]) { f[0] = bflo(w.x); f[1] = bfhi(w.x); f[2] = bflo(w.y); f[3] = bfhi(w.y); f[4] = bflo(w.z); f[5] = bfhi(w.z); f[6] = bflo(w.w); f[7] = bfhi(w.w); }
DI void pooled_phase(const bf16_t* upool, bf16_t* pooled) {
    const int tid = opaque_tid(), lane = tid & 63, gw = blockIdx.x * NWAVES + (tid >> 6), NGW = gridDim.x * NWAVES;
    const int c = lane * 8, w = 2 << (lane >> 4);
    for (int task = gw; task < T / 16; task += NGW) {
        const int t0 = task * 16, s0 = t0 & (SEQ - 1);
        const bf16_t* up = upool + (size_t)t0 * 512 + c;
        u32x4 hw[15], nw[16], ow[16];
#pragma unroll
        for (int j = 1; j < 16; ++j) { const int jj = (s0 - j >= 0) ? j : 0; hw[j - 1] = *(const u32x4*)(up - (ptrdiff_t)jj * 512); }
#pragma unroll
        for (int i = 0; i < 16; ++i) { nw[i] = *(const u32x4*)(up + (size_t)i * 512); const int back = (s0 + i - (w - 1) >= 0) ? (w - 1) : 0; ow[i] = *(const u32x4*)(up + (ptrdiff_t)(i - back) * 512); }
        float win[8];
#pragma unroll
        for (int e = 0; e < 8; ++e) win[e] = 0.f;
#pragma unroll
        for (int j = 1; j < 16; ++j) { float f[8]; unpack8(hw[j - 1], f); const float mk = (j < w && s0 - j >= 0) ? 1.f : 0.f;
#pragma unroll
            for (int e = 0; e < 8; ++e) win[e] += mk * f[e]; }
#pragma unroll
        for (int i = 0; i < 16; ++i) {
            const int s = s0 + i;
            float un[8], uo[8];
            unpack8(nw[i], un); unpack8(ow[i], uo);
            const float mo = (s - (w - 1) >= 0) ? 1.f : 0.f;
            const int cnt = (s + 1 < w) ? s + 1 : w; const float ic = __builtin_amdgcn_rcpf((float)cnt);
            float o[8];
#pragma unroll
            for (int e = 0; e < 8; ++e) { const float tot = win[e] + un[e]; o[e] = tot * ic - un[e]; win[e] = tot - mo * uo[e]; }
            u32x4 ov; ov.x = pk2(o[0], o[1]); ov.y = pk2(o[2], o[3]); ov.z = pk2(o[4], o[5]); ov.w = pk2(o[6], o[7]);
            *(u32x4*)(pooled + (size_t)(t0 + i) * 2048 + c) = ov;
        }
    }
}
typedef __bf16 bf16x2_t __attribute__((ext_vector_type(2)));
typedef float f32x2_t __attribute__((ext_vector_type(2)));
DI unsigned cvtpk(float lo, float hi) { f32x2_t v = {lo, hi}; bf16x2_t b = __builtin_convertvector(v, bf16x2_t); return __builtin_bit_cast(unsigned, b); }
DI int crow(int i, int h) { return (i & 3) + 8 * (i >> 2) + 4 * h; }
#define MFMA32(a, b, c) __builtin_amdgcn_mfma_f32_32x32x16_bf16((a), (b), (c), 0, 0, 0)
DI bf16x8 mk8(unsigned a, unsigned b, unsigned c, unsigned d) { u32x4 w = {a, b, c, d}; return __builtin_bit_cast(bf16x8, w); }

constexpr int SWA_KLD = 72, SWA_VLD = 260, SWA_VT_OFF = 256 * SWA_KLD * 2;
DI void swa_phase(const bf16_t* qr, const bf16_t* kr, const bf16_t* vv, const float* sinks, bf16_t* ycat, unsigned char* lds) {
    const int tid = opaque_tid();
    const int lane = tid & 63, w = tid >> 6, r = lane & 31, h = lane >> 5;
    bf16_t* Ks = (bf16_t*)lds; bf16_t* Vt = (bf16_t*)(lds + SWA_VT_OFF);
    for (int unit = blockIdx.x; unit < 512; unit += gridDim.x) {
        const int kvh = unit & 1, nb = (unit >> 1) & 31, b = unit >> 6;
        const int tq0 = b * SEQ + nb * 128, tk0 = tq0 - 128;
        const int hq = kvh * 8 + w; const float sink = sinks[hq];
        bf16x8 qn[4];
        { const bf16_t* qp = qr + (size_t)(tq0 + r) * 1024 + hq * 64 + 8 * h;
#pragma unroll
          for (int s = 0; s < 4; ++s) qn[s] = *(const bf16x8*)(qp + 16 * s); }
        __syncthreads();
#pragma unroll
        for (int i = 0; i < 4; ++i) {
            const int c = tid + 512 * i, kb = c >> 3, dc = (c & 7) * 8;
            u32x4 kv = {0u, 0u, 0u, 0u}, vx = {0u, 0u, 0u, 0u};
            if (nb > 0 || kb >= 128) { kv = *(const u32x4*)(kr + (size_t)(tk0 + kb) * 128 + kvh * 64 + dc); vx = *(const u32x4*)(vv + (size_t)(tk0 + kb) * 128 + kvh * 64 + dc); }
            *(u32x4*)(Ks + kb * SWA_KLD + dc) = kv;
            bf16_t* vp = Vt + dc * SWA_VLD + kb;
            vp[0 * SWA_VLD] = (bf16_t)(vx.x & 0xffffu); vp[1 * SWA_VLD] = (bf16_t)(vx.x >> 16); vp[2 * SWA_VLD] = (bf16_t)(vx.y & 0xffffu); vp[3 * SWA_VLD] = (bf16_t)(vx.y >> 16);
            vp[4 * SWA_VLD] = (bf16_t)(vx.z & 0xffffu); vp[5 * SWA_VLD] = (bf16_t)(vx.z >> 16); vp[6 * SWA_VLD] = (bf16_t)(vx.w & 0xffffu); vp[7 * SWA_VLD] = (bf16_t)(vx.w >> 16);
        }
        __syncthreads();
        for (int qt = 0; qt < 4; ++qt) {
            bf16x8 qf[4];
#pragma unroll
            for (int s = 0; s < 4; ++s) qf[s] = qn[s];
            if (qt < 3) { const bf16_t* qp = qr + (size_t)(tq0 + 32 * (qt + 1) + r) * 1024 + hq * 64 + 8 * h;
#pragma unroll
                for (int s = 0; s < 4; ++s) qn[s] = *(const bf16x8*)(qp + 16 * s); }
            f32x16 sa[5];
#pragma unroll
            for (int c = 0; c < 5; ++c) {
#pragma unroll
                for (int i = 0; i < 16; ++i) sa[c][i] = 0.f;
#pragma unroll
                for (int s = 0; s < 4; ++s) { const bf16x8 kf = *(const bf16x8*)(Ks + (32 * (qt + c) + r) * SWA_KLD + 16 * s + 8 * h); sa[c] = MFMA32(kf, qf[s], sa[c]); }
            }
            float mx = sink;
#pragma unroll
            for (int c = 0; c < 5; ++c)
#pragma unroll
                for (int i = 0; i < 16; ++i) {
                    const int kk = 32 * c + crow(i, h);
                    bool vis = (c == 0) ? (kk > r) : ((c == 4) ? (kk - 128 <= r) : true);
                    if (nb == 0) vis = vis && (32 * qt + kk >= 128);
                    const float s = vis ? sa[c][i] : -1e30f; sa[c][i] = s; mx = fmaxf(mx, s);
                }
            mx = fmaxf(mx, __shfl_xor(mx, 32));
            float l = 0.f;
#pragma unroll
            for (int c = 0; c < 5; ++c)
#pragma unroll
                for (int i = 0; i < 16; ++i) { const float pz = __expf(sa[c][i] - mx); sa[c][i] = pz; l += pz; }
            l += __shfl_xor(l, 32); l += __expf(sink - mx);
            const float inv = 1.f / l;
            f32x16 oa[2];
#pragma unroll
            for (int i = 0; i < 16; ++i) { oa[0][i] = 0.f; oa[1][i] = 0.f; }
#pragma unroll
            for (int c = 0; c < 5; ++c)
#pragma unroll
                for (int s2 = 0; s2 < 2; ++s2) {
                    const bf16x8 pf = mk8(cvtpk(sa[c][8 * s2 + 0], sa[c][8 * s2 + 1]), cvtpk(sa[c][8 * s2 + 2], sa[c][8 * s2 + 3]), cvtpk(sa[c][8 * s2 + 4], sa[c][8 * s2 + 5]), cvtpk(sa[c][8 * s2 + 6], sa[c][8 * s2 + 7]));
#pragma unroll
                    for (int dt = 0; dt < 2; ++dt) {
                        const bf16_t* va = Vt + (32 * dt + r) * SWA_VLD + 32 * (qt + c) + 16 * s2 + 4 * h;
                        const u32x2 lo = *(const u32x2*)va, hi = *(const u32x2*)(va + 8);
                        oa[dt] = MFMA32(mk8(lo.x, lo.y, hi.x, hi.y), pf, oa[dt]);
                    }
                }
            bf16_t* yp = ycat + (size_t)(tq0 + 32 * qt + r) * 2048 + 512 + hq * 64 + 4 * h;
#pragma unroll
            for (int dt = 0; dt < 2; ++dt)
#pragma unroll
                for (int g4 = 0; g4 < 4; ++g4) { u32x2 o; o.x = cvtpk(oa[dt][4 * g4] * inv, oa[dt][4 * g4 + 1] * inv); o.y = cvtpk(oa[dt][4 * g4 + 2] * inv, oa[dt][4 * g4 + 3] * inv);
                    *(u32x2*)(yp + 32 * dt + 8 * g4) = o; }
        }
    }
}

constexpr int MEM_KLD = 136, MEM_VLD = 260, MEM_VT_OFF = 256 * MEM_KLD * 2;
DI void mem_phase(const bf16_t* qm, const bf16_t* kvm, bf16_t* ycat, unsigned char* lds) {
    const int tid = opaque_tid();
    const int lane = tid & 63, w = tid >> 6, r = lane & 31, h = lane >> 5;
    bf16_t* Ks = (bf16_t*)lds; bf16_t* Vt = (bf16_t*)(lds + MEM_VT_OFF);
    for (int unit = blockIdx.x; unit < 256; unit += gridDim.x) {
        const int qc = unit & 7, hm = (unit >> 3) & 3, b = unit >> 5;
        bf16x8 qn[8];
        { const bf16_t* qp = qm + (size_t)(b * SEQ + qc * 512 + (w * 2) * 32 + r) * 512 + hm * 128 + 8 * h;
#pragma unroll
          for (int s = 0; s < 8; ++s) qn[s] = *(const bf16x8*)(qp + 16 * s); }
        __syncthreads();
#pragma unroll
        for (int i = 0; i < 8; ++i) {
            const int c = tid + 512 * i, m = c >> 4, dc = (c & 15) * 8;
            const bf16_t* src = kvm + (size_t)(b * MEML + m) * 1024 + hm * 128 + dc;
            const u32x4 kv = *(const u32x4*)src, vx = *(const u32x4*)(src + 512);
            *(u32x4*)(Ks + m * MEM_KLD + dc) = kv;
            bf16_t* vp = Vt + dc * MEM_VLD + m;
            vp[0 * MEM_VLD] = (bf16_t)(vx.x & 0xffffu); vp[1 * MEM_VLD] = (bf16_t)(vx.x >> 16); vp[2 * MEM_VLD] = (bf16_t)(vx.y & 0xffffu); vp[3 * MEM_VLD] = (bf16_t)(vx.y >> 16);
            vp[4 * MEM_VLD] = (bf16_t)(vx.z & 0xffffu); vp[5 * MEM_VLD] = (bf16_t)(vx.z >> 16); vp[6 * MEM_VLD] = (bf16_t)(vx.w & 0xffffu); vp[7 * MEM_VLD] = (bf16_t)(vx.w >> 16);
        }
        __syncthreads();
        for (int qi = 0; qi < 2; ++qi) {
            const int t0 = b * SEQ + qc * 512 + (w * 2 + qi) * 32;
            bf16x8 qf[8];
#pragma unroll
            for (int s = 0; s < 8; ++s) qf[s] = qn[s];
            if (qi == 0) { const bf16_t* qp = qm + (size_t)(t0 + 32 + r) * 512 + hm * 128 + 8 * h;
#pragma unroll
                for (int s = 0; s < 8; ++s) qn[s] = *(const bf16x8*)(qp + 16 * s); }
            float mx = -3e38f;
#pragma unroll 1
            for (int c = 0; c < 8; ++c) {
                f32x16 sc;
#pragma unroll
                for (int i = 0; i < 16; ++i) sc[i] = 0.f;
#pragma unroll
                for (int s = 0; s < 8; ++s) { const bf16x8 kf = *(const bf16x8*)(Ks + (32 * c + r) * MEM_KLD + 16 * s + 8 * h); sc = MFMA32(kf, qf[s], sc); }
#pragma unroll
                for (int i = 0; i < 16; ++i) mx = fmaxf(mx, sc[i]);
            }
            mx = fmaxf(mx, __shfl_xor(mx, 32));
            constexpr float SC = 0.08838834764831845f * 1.4426950408889634f;
            float l = 0.f;
            f32x16 oa[4];
#pragma unroll
            for (int dt = 0; dt < 4; ++dt)
#pragma unroll
                for (int i = 0; i < 16; ++i) oa[dt][i] = 0.f;
#pragma unroll 1
            for (int c = 0; c < 8; ++c) {
                f32x16 sc;
#pragma unroll
                for (int i = 0; i < 16; ++i) sc[i] = 0.f;
#pragma unroll
                for (int s = 0; s < 8; ++s) { const bf16x8 kf = *(const bf16x8*)(Ks + (32 * c + r) * MEM_KLD + 16 * s + 8 * h); sc = MFMA32(kf, qf[s], sc); }
#pragma unroll
                for (int i = 0; i < 16; ++i) { const float pz = exp2f((sc[i] - mx) * SC); sc[i] = pz; l += pz; }
#pragma unroll
                for (int s2 = 0; s2 < 2; ++s2) {
                    const bf16x8 pf = mk8(cvtpk(sc[8 * s2 + 0], sc[8 * s2 + 1]), cvtpk(sc[8 * s2 + 2], sc[8 * s2 + 3]), cvtpk(sc[8 * s2 + 4], sc[8 * s2 + 5]), cvtpk(sc[8 * s2 + 6], sc[8 * s2 + 7]));
#pragma unroll
                    for (int dt = 0; dt < 4; ++dt) {
                        const bf16_t* va = Vt + (32 * dt + r) * MEM_VLD + 32 * c + 16 * s2 + 4 * h;
                        const u32x2 lo = *(const u32x2*)va, hi = *(const u32x2*)(va + 8);
                        oa[dt] = MFMA32(mk8(lo.x, lo.y, hi.x, hi.y), pf, oa[dt]);
                    }
                }
            }
            l += __shfl_xor(l, 32);
            const float inv = 1.f / l;
            bf16_t* yp = ycat + (size_t)(t0 + r) * 2048 + 1536 + hm * 128 + 4 * h;
#pragma unroll
            for (int dt = 0; dt < 4; ++dt)
#pragma unroll
                for (int g4 = 0; g4 < 4; ++g4) { u32x2 o; o.x = cvtpk(oa[dt][4 * g4] * inv, oa[dt][4 * g4 + 1] * inv); o.y = cvtpk(oa[dt][4 * g4 + 2] * inv, oa[dt][4 * g4 + 3] * inv);
                    *(u32x2*)(yp + 32 * dt + 8 * g4) = o; }
        }
    }
}

DI unsigned umax_(unsigned a, unsigned b) { return a > b ? a : b; }
DI unsigned umin_(unsigned a, unsigned b) { return a < b ? a : b; }
DI void cexd(unsigned& a, unsigned& b) { const unsigned mx = umax_(a, b), mn = umin_(a, b); a = mx; b = mn; }
DI void sort16_desc(unsigned (&v)[16]) {
#pragma unroll
    for (int k = 2; k <= 16; k <<= 1)
#pragma unroll
        for (int j = k >> 1; j > 0; j >>= 1)
#pragma unroll
            for (int i = 0; i < 16; ++i) { const int l = i ^ j; if (l > i) { if ((i & k) == 0) cexd(v[i], v[l]); else cexd(v[l], v[i]); } }
}
DI void merge16_desc(unsigned (&a)[16], const unsigned (&b)[16]) {
#pragma unroll
    for (int i = 0; i < 16; ++i) a[i] = umax_(a[i], b[15 - i]);
#pragma unroll
    for (int j = 8; j > 0; j >>= 1)
#pragma unroll
        for (int i = 0; i < 16; ++i) { const int l = i ^ j; if (l > i) cexd(a[i], a[l]); }
}
DI unsigned mono(float f) { const unsigned u = __builtin_bit_cast(unsigned, f); return u ^ ((unsigned)((int)u >> 31) | 0x80000000u); }
DI float demono(unsigned m) { const unsigned t = (unsigned)((int)m >> 31); return __builtin_bit_cast(float, m ^ (~t | 0x80000000u)); }
constexpr int TK_KLD = 136, TK_SCR_OFF = 2 * 128 * TK_KLD * 2;
DI void topk_phase(const bf16_t* qp, const bf16_t* keysb, const float* rstd2, unsigned short* ids, float* gts, unsigned char* lds) {
    const int tid = opaque_tid();
    const int lane = tid & 63, w = tid >> 6, r = lane & 31, h2 = lane >> 5;
    bf16_t* Kl = (bf16_t*)lds;
    unsigned char* scr = lds + TK_SCR_OFF + w * 2048 + lane * 32;
    int staged = -1;
    for (int unit = blockIdx.x; unit < 1024; unit += gridDim.x) {
        const int hd = unit & 7, tile = unit >> 3;
        if (hd != staged) {
            __syncthreads();
#pragma unroll
            for (int i = 0; i < 8; ++i) { const int c = tid + 512 * i, row = c >> 4, dc = (c & 15) * 8;
                *(u32x4*)(Kl + row * TK_KLD + dc) = *(const u32x4*)(keysb + ((size_t)hd * 256 + row) * 128 + dc); }
            __syncthreads();
            staged = hd;
        }
        const int t0 = tile * 256 + w * 32;
        unsigned K0[16], K1[16];
#pragma unroll
        for (int p = 0; p < 2; ++p) {
            const bf16_t* qrow = qp + (size_t)(t0 + r) * 2048 + hd * 256 + p * 128 + 8 * h2;
            bf16x8 qf[8];
#pragma unroll
            for (int s = 0; s < 8; ++s) qf[s] = *(const bf16x8*)(qrow + 16 * s);
            unsigned blk[4][16];
#pragma unroll
            for (int c = 0; c < 4; ++c) {
                f32x16 sc;
#pragma unroll
                for (int i = 0; i < 16; ++i) sc[i] = 0.f;
#pragma unroll
                for (int s = 0; s < 8; ++s) { const bf16x8 kf = *(const bf16x8*)(Kl + (p * 128 + 32 * c + r) * TK_KLD + 16 * s + 8 * h2); sc = MFMA32(kf, qf[s], sc); }
#pragma unroll
                for (int i = 0; i < 16; ++i) blk[c][i] = (mono(sc[i]) & ~0x7Fu) | (unsigned)(32 * c + crow(i, h2));
                sort16_desc(blk[c]);
            }
            merge16_desc(blk[0], blk[1]); merge16_desc(blk[2], blk[3]); merge16_desc(blk[0], blk[2]);
            unsigned oth[16];
#pragma unroll
            for (int i = 0; i < 16; ++i) oth[i] = (unsigned)__shfl_xor((int)blk[0][i], 32);
            merge16_desc(blk[0], oth);
#pragma unroll
            for (int i = 0; i < 16; ++i) { if (p == 0) K0[i] = blk[0][i]; else K1[i] = blk[0][i]; }
        }
#pragma unroll
        for (int q = 0; q < 4; ++q) {
            ((unsigned*)scr)[q] = (K0[4 * q] & 0x7Fu) | ((K0[4 * q + 1] & 0x7Fu) << 8) | ((K0[4 * q + 2] & 0x7Fu) << 16) | ((K0[4 * q + 3] & 0x7Fu) << 24);
            ((unsigned*)scr)[4 + q] = (K1[4 * q] & 0x7Fu) | ((K1[4 * q + 1] & 0x7Fu) << 8) | ((K1[4 * q + 2] & 0x7Fu) << 16) | ((K1[4 * q + 3] & 0x7Fu) << 24);
        }
        float sx[16], sy[16];
#pragma unroll
        for (int i = 0; i < 16; ++i) { const float s0 = demono(K0[i] & ~0x7Fu), s1 = demono(K1[i] & ~0x7Fu); sx[i] = h2 ? s1 : s0; sy[i] = h2 ? s0 : s1; }
        unsigned ca[16], cb[16];
#pragma unroll
        for (int i = 0; i < 16; ++i) { ca[i] = 0u; cb[i] = 0u; }
#define CAND(n, a, b) do { const unsigned key_ = (mono(sx[a] + sy[b]) & ~0xFFu) | (h2 ? (unsigned)(((b) << 4) | (a)) : (unsigned)(((a) << 4) | (b))); if ((n) < 16) ca[(n) & 15] = key_; else cb[(n) & 15] = key_; } while (0)
            CAND(0, 0, 1);
            CAND(1, 0, 2);
            CAND(2, 0, 3);
            CAND(3, 0, 4);
            CAND(4, 0, 5);
            CAND(5, 0, 6);
            CAND(6, 0, 7);
            CAND(7, 0, 8);
            CAND(8, 0, 9);
            CAND(9, 0, 10);
            CAND(10, 0, 11);
            CAND(11, 0, 12);
            CAND(12, 0, 13);
            CAND(13, 0, 14);
            CAND(14, 0, 15);
            CAND(15, 1, 2);
            CAND(16, 1, 3);
            CAND(17, 1, 4);
            CAND(18, 1, 5);
            CAND(19, 1, 6);
            CAND(20, 1, 7);
            CAND(21, 2, 3);
            CAND(22, 2, 4);
#undef CAND
#pragma unroll
        for (int d = 0; d < 4; ++d) { const unsigned key_ = (mono(sx[d] + sy[d]) & ~0xFFu) | (unsigned)((d << 4) | d); cb[7 + d] = h2 ? 0u : key_; }
        sort16_desc(ca); sort16_desc(cb); merge16_desc(ca, cb);
        unsigned fin[16], cpart[16];
#pragma unroll
        for (int i = 0; i < 16; ++i) cpart[i] = (unsigned)__shfl_xor((int)ca[i], 32);
#pragma unroll
        for (int i = 0; i < 16; ++i) fin[i] = umax_(ca[i], cpart[15 - i]);
        const float rs = 1.f / sqrtf(rstd2[t0 + r] * (1.f / D) + EPS);
        float sv[16], mxv = -3e38f;
#pragma unroll
        for (int i = 0; i < 16; ++i) { sv[i] = demono(fin[i] & ~0xFFu) * rs; mxv = fmaxf(mxv, sv[i]); }
        float den = 0.f;
#pragma unroll
        for (int i = 0; i < 16; ++i) { sv[i] = __expf(sv[i] - mxv); den += sv[i]; }
        const float rden = 1.f / den;
        int oid[8]; float og[8];
#pragma unroll
        for (int j = 0; j < 8; ++j) {
            const unsigned wk = fin[j]; og[j] = sv[j] * rden;
            const unsigned a0 = (wk >> 4) & 15u, a1 = wk & 15u;
            oid[j] = (int)scr[a0] * 128 + (int)scr[16 + a1];
        }
        unsigned short* ip = ids + (size_t)(t0 + r) * 128 + hd * 16 + 8 * h2; float* gp = gts + (size_t)(t0 + r) * 128 + hd * 16 + 8 * h2;
        *(u32x4*)ip = (u32x4){(unsigned)oid[0] | ((unsigned)oid[1] << 16), (unsigned)oid[2] | ((unsigned)oid[3] << 16), (unsigned)oid[4] | ((unsigned)oid[5] << 16), (unsigned)oid[6] | ((unsigned)oid[7] << 16)};
        *(f32x4*)gp = (f32x4){og[0], og[1], og[2], og[3]}; *(f32x4*)(gp + 4) = (f32x4){og[4], og[5], og[6], og[7]};
    }
}

typedef _Float16 h2_t __attribute__((ext_vector_type(2)));
template <int CTRL> DI float dpp_f(float v) { return __builtin_bit_cast(float, __builtin_amdgcn_update_dpp(0, __builtin_bit_cast(int, v), CTRL, 0xf, 0xf, true)); }
DI float row16_sum(float v) {
    v += dpp_f<0xB1>(v); v += dpp_f<0x4E>(v); v += dpp_f<0x141>(v); v += dpp_f<0x140>(v); return v; }
DI bf16x2_t as_b2(unsigned w) { return __builtin_bit_cast(bf16x2_t, w); }
DI float dot_row(const u32x4 (&xw)[4][2], const u32x4 (&ru)[4]) {
    float d0 = 0.f, d1 = 0.f;
#pragma unroll
    for (int i = 0; i < 4; ++i)
#pragma unroll
        for (int q = 0; q < 4; ++q) {
            const bf16x2_t z0 = __builtin_amdgcn_cvt_scalef32_pk_bf16_fp8((int)ru[i][q], 1.0f, false), z1 = __builtin_amdgcn_cvt_scalef32_pk_bf16_fp8((int)ru[i][q], 1.0f, true);
            d0 = __builtin_amdgcn_fdot2_f32_bf16(as_b2(xw[i][q >> 1][2 * (q & 1)]), z0, d0, false); d1 = __builtin_amdgcn_fdot2_f32_bf16(as_b2(xw[i][q >> 1][2 * (q & 1) + 1]), z1, d1, false);
        }
    return row16_sum(d0 + d1);
}
DI float swz_xor4(float v) { return __builtin_bit_cast(float, __builtin_amdgcn_ds_swizzle(__builtin_bit_cast(int, v), 0x101F)); }
DI bf16_t* partial_base(unsigned char* ws, int x) { return (bf16_t*)(ws + 42 * MiB + (size_t)x * 8 * MiB); }
template <int VAR>
DI void peer_u2_phase(const bf16_t* x1b, const unsigned char* u8, const unsigned short* ids, bf16_t* part, unsigned char* lds, int lbl, int rnk, int cnt) {
    const int tid = opaque_tid(), lane = tid & 63, wave = tid >> 6, g8 = lane >> 3, s8 = lane & 7;
    constexpr int LST = 132;
    int* lid = (int*)(lds + wave * (2 * 8 * LST * 4)); float* lpa = (float*)(lid + 8 * LST);
    const int stride = cnt * NWAVES * 8;
    const unsigned char* ubase = u8 + lbl * 128;
    const bool b4 = (s8 & 4) != 0, b2 = (s8 & 2) != 0, b1 = (s8 & 1) != 0;
    for (int t0 = (rnk * NWAVES + wave) * 8; t0 < T; t0 += stride) {
#pragma unroll
        for (int j = 0; j < 2; ++j) { const int f = lane * 8 + 512 * j, tk = f >> 7, k = f & 127; const u32x4 w = *(const u32x4*)(ids + (size_t)t0 * 128 + f);
            *(u32x4*)(lid + tk * LST + k) = (u32x4){w.x & 0xffffu, w.x >> 16, w.y & 0xffffu, w.y >> 16}; *(u32x4*)(lid + tk * LST + k + 4) = (u32x4){w.z & 0xffffu, w.z >> 16, w.w & 0xffffu, w.w >> 16}; }
        const size_t xo_ = (size_t)(t0 + g8) * D + lbl * 128 + 16 * s8;
        const u32x4 xa = *(const u32x4*)(x1b + xo_), xb2 = *(const u32x4*)(x1b + xo_ + 8);
        float xf[16];
        xf[0] = bflo(xa.x); xf[1] = bfhi(xa.x); xf[2] = bflo(xa.y); xf[3] = bfhi(xa.y); xf[4] = bflo(xa.z); xf[5] = bfhi(xa.z); xf[6] = bflo(xa.w); xf[7] = bfhi(xa.w);
        xf[8] = bflo(xb2.x); xf[9] = bfhi(xb2.x); xf[10] = bflo(xb2.y); xf[11] = bfhi(xb2.y); xf[12] = bflo(xb2.z); xf[13] = bfhi(xb2.z); xf[14] = bflo(xb2.w); xf[15] = bfhi(xb2.w);
        float xm = 0.f;
#pragma unroll
        for (int e = 0; e < 16; ++e) xm = fmaxf(xm, fabsf(xf[e]));
        xm = fmaxf(xm, dpp_f<0xB1>(xm)); xm = fmaxf(xm, dpp_f<0x4E>(xm)); xm = fmaxf(xm, dpp_f<0x141>(xm));
        const float xinv = xm > 0.f ? 127.f / xm : 0.f, sx = xm * (1.f / 127.f);
        int xq[4];
#pragma unroll
        for (int q = 0; q < 4; ++q) { const int q0 = (int)__builtin_rintf(xf[4 * q] * xinv), q1 = (int)__builtin_rintf(xf[4 * q + 1] * xinv), q2 = (int)__builtin_rintf(xf[4 * q + 2] * xinv), q3 = (int)__builtin_rintf(xf[4 * q + 3] * xinv);
            xq[q] = (int)((unsigned)(q0 & 255) | ((unsigned)(q1 & 255) << 8) | ((unsigned)(q2 & 255) << 16) | ((unsigned)q3 << 24)); }
        const int* myid = lid + g8 * LST; float* mypa = lpa + g8 * LST;
        const unsigned loff = (unsigned)(s8 * 16);
#define U2_FETCH(K8, RW) do { const int kc_ = (K8) < 128 ? (K8) : 120; const u32x4 i0_ = *(const u32x4*)(myid + kc_), i1_ = *(const u32x4*)(myid + kc_ + 4); \
            _Pragma("unroll") for (int i = 0; i < 8; ++i) { const unsigned id_ = i < 4 ? i0_[i & 3] : i1_[i & 3]; \
                if (VAR & 1) RW[i] = (u32x4){id_, id_ * 3u, id_ * 5u, id_ * 7u}; else RW[i] = *(const u32x4*)(ubase + (id_ * (unsigned)D + loff)); } } while (0)
#define U2_REDUCE(K8, RW) do { int pp[8]; \
            _Pragma("unroll") for (int i = 0; i < 8; ++i) { \
                if (VAR & 2) { pp[i] = (int)((RW[i].x ^ RW[i].y ^ RW[i].z ^ RW[i].w ^ xa.x) & 0xffu); continue; } \
                int d_ = 0; \
                _Pragma("unroll") for (int q = 0; q < 4; ++q) d_ = __builtin_amdgcn_sdot4((int)RW[i][q], xq[q], d_, false); \
                pp[i] = d_; } \
            int q4[4], q2[2]; \
            _Pragma("unroll") for (int j = 0; j < 4; ++j) { const int keep = b4 ? pp[j + 4] : pp[j], send = b4 ? pp[j] : pp[j + 4]; q4[j] = keep + __builtin_amdgcn_ds_swizzle(send, 0x101F); } \
            _Pragma("unroll") for (int j = 0; j < 2; ++j) { const int keep = b2 ? q4[j + 2] : q4[j], send = b2 ? q4[j] : q4[j + 2]; q2[j] = keep + __builtin_amdgcn_update_dpp(0, send, 0x4E, 0xf, 0xf, true); } \
            const int keep1 = b1 ? q2[1] : q2[0], send1 = b1 ? q2[0] : q2[1]; \
            mypa[(K8) + s8] = (float)(keep1 + __builtin_amdgcn_update_dpp(0, send1, 0xB1, 0xf, 0xf, true)) * sx;     } while (0)
        u32x4 rwA[8], rwB[8];
        U2_FETCH(0, rwA);
#pragma unroll 1
        for (int k8 = 0; k8 < 128; k8 += 16) {
            U2_FETCH(k8 + 8, rwB);
            U2_REDUCE(k8, rwA);
            U2_FETCH(k8 + 16, rwA);
            U2_REDUCE(k8 + 8, rwB);
        }
#undef U2_FETCH
#undef U2_REDUCE
        bf16_t* pg = part + (size_t)t0 * 128;
#pragma unroll
        for (int j = 0; j < 4; ++j) { const int f = lane * 4 + 256 * j, tk = f >> 7, k = f & 127; const f32x4 v = *(const f32x4*)(lpa + tk * LST + k);
            u32x2 w; w.x = pk2(v.x, v.y); w.y = pk2(v.z, v.w); *(u32x2*)(pg + f) = w; }
    }
}
DI void peer_combine_phase(unsigned char* ws, const float* ssq2, const float* gts, const unsigned short* ids, const float* su, bf16_t* coef) {
    const size_t gt = (size_t)blockIdx.x * NTHREADS + opaque_tid(), NGT = (size_t)gridDim.x * NTHREADS;
    for (size_t i = gt; i < (size_t)T * 32; i += NGT) {
        const int t = (int)(i >> 5);
        f32x4 a = {0.f, 0.f, 0.f, 0.f};
#pragma unroll
        for (int x = 0; x < 8; ++x) { const u32x2 w = ((const u32x2*)partial_base(ws, x))[i]; a += (f32x4){bflo(w.x), bfhi(w.x), bflo(w.y), bfhi(w.y)}; }
        const float rs = __builtin_amdgcn_rsqf(ssq2[t] * (1.f / D) + EPS);
        const f32x4 g = ((const f32x4*)gts)[i]; const u32x2 idw = ((const u32x2*)ids)[i];
        const unsigned i0 = idw.x & 0xffffu, i1 = idw.x >> 16, i2 = idw.y & 0xffffu, i3 = idw.y >> 16;
        u32x2 w; w.x = pk2(g.x * gelu_tanh(a.x * rs * su[i0]) * 0.5f, g.y * gelu_tanh(a.y * rs * su[i1]) * 0.5f); w.y = pk2(g.z * gelu_tanh(a.z * rs * su[i2]) * 0.5f, g.w * gelu_tanh(a.w * rs * su[i3]) * 0.5f);
        ((u32x2*)coef)[i] = w;
    }
}
template <int VAR>
DI void peer_v_phase(const bf16_t* x1in, bf16_t* xout, const unsigned char* v8, const unsigned short* ids, const bf16_t* coef, float* ssqo, unsigned char* lds, int lbl, int rnk, int cnt) {
    const int tid = opaque_tid(), lane = tid & 63, wave = tid >> 6, g8 = lane >> 3, s8 = lane & 7;
    constexpr int LST = 132;
    int* lid = (int*)(lds + wave * (2 * 8 * LST * 4)); float* lco = (float*)(lid + 8 * LST);
    const int stride = cnt * NWAVES * 8;
    const unsigned char* vbase = v8 + lbl * 128;
    for (int t0 = (rnk * NWAVES + wave) * 8; t0 < T; t0 += stride) {
#pragma unroll
        for (int j = 0; j < 2; ++j) { const int f = lane * 8 + 512 * j, tk = f >> 7, k = f & 127;
            const u32x4 w = *(const u32x4*)(ids + (size_t)t0 * 128 + f), cw = *(const u32x4*)(coef + (size_t)t0 * 128 + f);
            *(u32x4*)(lid + tk * LST + k) = (u32x4){w.x & 0xffffu, w.x >> 16, w.y & 0xffffu, w.y >> 16}; *(u32x4*)(lid + tk * LST + k + 4) = (u32x4){w.z & 0xffffu, w.z >> 16, w.w & 0xffffu, w.w >> 16};
            *(f32x4*)(lco + tk * LST + k) = (f32x4){bflo(cw.x), bfhi(cw.x), bflo(cw.y), bfhi(cw.y)}; *(f32x4*)(lco + tk * LST + k + 4) = (f32x4){bflo(cw.z), bfhi(cw.z), bflo(cw.w), bfhi(cw.w)}; }
        f32x2_t acc[8];
#pragma unroll
        for (int j = 0; j < 8; ++j) acc[j] = (f32x2_t){0.f, 0.f};
        const int* myid = lid + g8 * LST; const float* myco = lco + g8 * LST;
        const unsigned loff = (unsigned)(s8 * 16);
#define V_FETCH(K8, RW, CO) do { const int kc_ = (K8) < 128 ? (K8) : 120; const u32x4 i0_ = *(const u32x4*)(myid + kc_), i1_ = *(const u32x4*)(myid + kc_ + 4); \
            const f32x4 c0_ = *(const f32x4*)(myco + kc_), c1_ = *(const f32x4*)(myco + kc_ + 4); \
            _Pragma("unroll") for (int i = 0; i < 8; ++i) { const unsigned id_ = i < 4 ? i0_[i & 3] : i1_[i & 3]; CO[i] = i < 4 ? c0_[i & 3] : c1_[i & 3]; \
                if (VAR & 1) RW[i] = (u32x4){id_, id_ * 3u, id_ * 5u, id_ * 7u}; else RW[i] = *(const u32x4*)(vbase + (id_ * (unsigned)D + loff)); } } while (0)
#define V_ACCUM(RW, CO) do { _Pragma("unroll") for (int i = 0; i < 8; ++i) { const f32x2_t cc = {CO[i], CO[i]}; \
                if (VAR & 2) { acc[i].x += __builtin_bit_cast(float, (RW[i].x ^ RW[i].y ^ RW[i].z ^ RW[i].w) & 0x3fffffffu) * CO[i]; continue; } \
                _Pragma("unroll") for (int q = 0; q < 4; ++q) { const f32x2_t a = __builtin_amdgcn_cvt_pk_f32_fp8((int)RW[i][q], false), b = __builtin_amdgcn_cvt_pk_f32_fp8((int)RW[i][q], true); \
                    acc[2 * q] = __builtin_elementwise_fma(a, cc, acc[2 * q]); acc[2 * q + 1] = __builtin_elementwise_fma(b, cc, acc[2 * q + 1]); } } } while (0)
        u32x4 rwA[8], rwB[8]; float coA[8], coB[8];
        V_FETCH(0, rwA, coA);
#pragma unroll 1
        for (int k8 = 0; k8 < 128; k8 += 16) {
            V_FETCH(k8 + 8, rwB, coB);
            V_ACCUM(rwA, coA);
            V_FETCH(k8 + 16, rwA, coA);
            V_ACCUM(rwB, coB);
        }
#undef V_FETCH
#undef V_ACCUM
        const size_t xo_ = (size_t)(t0 + g8) * D + lbl * 128 + 16 * s8;
        const u32x4 xa = *(const u32x4*)(x1in + xo_), xb2 = *(const u32x4*)(x1in + xo_ + 8);
        float o[16];
        o[0] = bflo(xa.x) + acc[0].x; o[1] = bfhi(xa.x) + acc[0].y; o[2] = bflo(xa.y) + acc[1].x; o[3] = bfhi(xa.y) + acc[1].y; o[4] = bflo(xa.z) + acc[2].x; o[5] = bfhi(xa.z) + acc[2].y; o[6] = bflo(xa.w) + acc[3].x; o[7] = bfhi(xa.w) + acc[3].y;
        o[8] = bflo(xb2.x) + acc[4].x; o[9] = bfhi(xb2.x) + acc[4].y; o[10] = bflo(xb2.y) + acc[5].x; o[11] = bfhi(xb2.y) + acc[5].y; o[12] = bflo(xb2.z) + acc[6].x; o[13] = bfhi(xb2.z) + acc[6].y; o[14] = bflo(xb2.w) + acc[7].x; o[15] = bfhi(xb2.w) + acc[7].y;
        float ss = 0.f;
#pragma unroll
        for (int e = 0; e < 16; ++e) ss += o[e] * o[e];
        ss += dpp_f<0xB1>(ss); ss += dpp_f<0x4E>(ss); ss += dpp_f<0x141>(ss);
        if (s8 == 0) atomicAdd(ssqo + t0 + g8, ss);
        u32x4 w0, w1; w0.x = pk2(o[0], o[1]); w0.y = pk2(o[2], o[3]); w0.z = pk2(o[4], o[5]); w0.w = pk2(o[6], o[7]); w1.x = pk2(o[8], o[9]); w1.y = pk2(o[10], o[11]); w1.z = pk2(o[12], o[13]); w1.w = pk2(o[14], o[15]);
        *(u32x4*)(xout + xo_) = w0; *(u32x4*)(xout + xo_ + 8) = w1;
    }
}
DI void peer_final_phase(const bf16_t* xo, const float* ssqo, const float* gf, float* out) {
    const int tid = opaque_tid(), lane = tid & 63, gw = blockIdx.x * NWAVES + (tid >> 6), NGW = gridDim.x * NWAVES;
    f32x4 g[4];
#pragma unroll
    for (int q = 0; q < 4; ++q) g[q] = *(const f32x4*)(gf + lane * 16 + 4 * q);
    for (int t = gw; t < T; t += NGW) {
        const u32x4 w0 = *(const u32x4*)(xo + (size_t)t * D + lane * 16), w1 = *(const u32x4*)(xo + (size_t)t * D + lane * 16 + 8);
        const float rf = 1.f / sqrtf(ssqo[t] * (1.f / D) + EPS);
        f32x4* po = (f32x4*)(out + (size_t)t * D + lane * 16);
        po[0] = (f32x4){bflo(w0.x), bfhi(w0.x), bflo(w0.y), bfhi(w0.y)} * rf * g[0]; po[1] = (f32x4){bflo(w0.z), bfhi(w0.z), bflo(w0.w), bfhi(w0.w)} * rf * g[1];
        po[2] = (f32x4){bflo(w1.x), bfhi(w1.x), bflo(w1.y), bfhi(w1.y)} * rf * g[2]; po[3] = (f32x4){bflo(w1.z), bfhi(w1.z), bflo(w1.w), bfhi(w1.w)} * rf * g[3];
    }
}

#define LAS __attribute__((address_space(3)))
#define XB_TMO      128
#define XB_XCNT(j)  (256  + 64 * (j))
#define XB_XSUB(j)  (1280 + 64 * (j))
#define XB_XGEN(j)  (2304 + 64 * (j))
#define XB_TOP      3328
#define XB_TOPGEN   3392
#define XCD_BAR_WORDS 3456
#define XB_SPIN_CAP (1u << 18)
DI unsigned xb_ld(unsigned* p)              { return __hip_atomic_load(p, __ATOMIC_RELAXED, __HIP_MEMORY_SCOPE_AGENT); }
DI unsigned xb_add(unsigned* p, unsigned v) { return __hip_atomic_fetch_add(p, v, __ATOMIC_RELAXED, __HIP_MEMORY_SCOPE_AGENT); }
DI unsigned xb_xcc_id() { return (unsigned)__builtin_amdgcn_s_getreg((3 << 11) | 20) & 0xFu; }
#define XB_SPIN(cond, bar) do { unsigned _sp = 0; while (cond) { __builtin_amdgcn_s_sleep(1); \
    if ((++_sp & 255u) == 0u) { if (xb_ld(&(bar)[XB_TMO])) break; if (_sp > XB_SPIN_CAP) { atomicAdd(&(bar)[XB_TMO], 1u); break; } } } } while (0)
struct XcdBarrier { unsigned* bar; unsigned x; volatile LAS unsigned* st; };
DI XcdBarrier xcd_barrier_post(unsigned* bar, volatile LAS unsigned* st) {
    XcdBarrier b; b.bar = bar; b.x = xb_xcc_id(); b.st = st;
    if (threadIdx.x == 0) st[2] = xb_add(&bar[XB_XCNT(b.x)], 1u);
    return b;
}
DI void xcd_barrier_complete(unsigned* bar, unsigned x, unsigned& nloc, unsigned& nx) {
    const unsigned G = gridDim.x * gridDim.y * gridDim.z;
    unsigned sum, cnt, mine, sp = 0u;
    for (;;) {
        sum = 0u; cnt = 0u; mine = 0u;
#pragma unroll
        for (unsigned j = 0; j < 16; ++j) { const unsigned c = xb_ld(&bar[XB_XCNT(j)]); sum += c; cnt += (c > 0u) ? 1u : 0u; mine = (j == x) ? c : mine; }
        if (sum == G) break;
        __builtin_amdgcn_s_sleep(1);
        if ((++sp & 255u) == 0u) { if (xb_ld(&bar[XB_TMO])) break; if (sp > XB_SPIN_CAP) { atomicAdd(&bar[XB_TMO], 1u); break; } }
    }
    nloc = mine > 0u ? mine : 1u; nx = cnt > 0u ? cnt : 1u;
}
DI void xcd_barrier(const XcdBarrier& b) {
    asm volatile("s_waitcnt vmcnt(0)" ::: "memory");
    __syncthreads();
    if (threadIdx.x == 0) {
        unsigned* bar = b.bar;
        __builtin_amdgcn_s_waitcnt(0);
        unsigned nloc = b.st[0], nx = b.st[1];
        if (nloc == 0u) { xcd_barrier_complete(bar, b.x, nloc, nx); b.st[0] = nloc; b.st[1] = nx; }
        const unsigned old = xb_add(&bar[XB_XSUB(b.x)], 1u);
        const unsigned gen = old / nloc;
        if (old + 1u == (gen + 1u) * nloc) {
            __builtin_amdgcn_fence(__ATOMIC_RELEASE, "agent");
            asm volatile("s_waitcnt vmcnt(0)" ::: "memory");
            const unsigned og = xb_add(&bar[XB_TOP], 1u);
            const unsigned tg = og / nx;
            if (og + 1u == (tg + 1u) * nx) xb_add(&bar[XB_TOPGEN], 1u);
            else XB_SPIN(xb_ld(&bar[XB_TOPGEN]) == tg, bar);
            __builtin_amdgcn_fence(__ATOMIC_ACQUIRE, "agent");
            xb_add(&bar[XB_XGEN(b.x)], 1u);
            asm volatile("s_waitcnt vmcnt(0)" ::: "memory");
        } else {
            XB_SPIN(xb_ld(&bar[XB_XGEN(b.x)]) == gen, bar);
            __builtin_amdgcn_fence(__ATOMIC_ACQUIRE, "agent");
            asm volatile("s_waitcnt vmcnt(0)" ::: "memory");
        }
    }
    __syncthreads();
}


constexpr int LDS_BYTES = 147456;
__global__ void __launch_bounds__(NTHREADS, 2) fwd_kernel(Params p) {
    extern __shared__ __attribute__((aligned(16))) unsigned char lds[];
    cg::grid_group grid = cg::this_grid();
    volatile LAS unsigned* bst = (volatile LAS unsigned*)((LAS unsigned char*)lds + (LDS_BYTES - 64));
    if (threadIdx.x < 4) bst[threadIdx.x] = 0u;
    __syncthreads();
    const XcdBarrier xbar = xcd_barrier_post((unsigned*)p.ws, bst);
    const int NGW = gridDim.x * NWAVES, G = gridDim.x, cu = blockIdx.x;
    unsigned char* ws = p.ws;
    PG8_LAS unsigned char* ldsl = (PG8_LAS unsigned char*)lds;
    bf16_t* ycat = (bf16_t*)p.out;

    for (int rep_ = 0; rep_ < (DUP_PHASE == 0 ? 2 : 1); ++rep_) { phase0(p, (float*)lds);
    if (p.use_cg_sync) grid.sync(); else xcd_barrier(xbar); }
    for (int rep_ = 0; rep_ < (DUP_PHASE == 1 ? 2 : 1); ++rep_) {
        EpiZ E{(const float*)(ws + WS_RSTD1), (const float*)(ws + WS_RSTDM), (const float2*)(ws + WS_ROPE), (bf16_t*)(ws + WS_UPOOL), (bf16_t*)(ws + WS_QR), (bf16_t*)(ws + WS_KR), (bf16_t*)(ws + WS_VV), (bf16_t*)(ws + WS_QM), (unsigned char*)(ws + WS_GATES), (bf16_t*)(ws + WS_KVM)};
        SchedZ S{(const char*)(ws + WS_XB), (const char*)(ws + WS_WIN), (const char*)(ws + WS_MEMB), (const char*)(ws + WS_WMKV), G, cu};
        pg8::gemm_phase(ldsl, 1024, 1024, S, E);
    xcd_barrier(xbar); }
    if (DUP_PHASE == 20) pooled_phase((const bf16_t*)(ws + WS_UPOOL), ycat);
    if (DUP_PHASE == 21) swa_phase((const bf16_t*)(ws + WS_QR), (const bf16_t*)(ws + WS_KR), (const bf16_t*)(ws + WS_VV), p.sinks, ycat, lds);
    if (DUP_PHASE == 22) mem_phase((const bf16_t*)(ws + WS_QM), (const bf16_t*)(ws + WS_KVM), ycat, lds);
    pooled_phase((const bf16_t*)(ws + WS_UPOOL), ycat);
    swa_phase((const bf16_t*)(ws + WS_QR), (const bf16_t*)(ws + WS_KR), (const bf16_t*)(ws + WS_VV), p.sinks, ycat, lds);
    mem_phase((const bf16_t*)(ws + WS_QM), (const bf16_t*)(ws + WS_KVM), ycat, lds);
    xcd_barrier(xbar);
    for (int rep_ = 0; rep_ < (DUP_PHASE == 3 ? 2 : 1); ++rep_) {
        EpiGated E{(const unsigned char*)(ws + WS_GATES), (bf16_t*)(ws + WS_MERGED)};
        SchedGated S{(const char*)ycat, (const char*)(ws + WS_WBR), G, cu};
        pg8::gemm_phase(ldsl, 2048, 2048, S, E);
    xcd_barrier(xbar); }
    for (int rep_ = 0; rep_ < (DUP_PHASE == 4 ? 2 : 1); ++rep_) {
        EpiOut E{(const bf16_t*)(ws + WS_XB), (bf16_t*)(ws + WS_X1B), (float*)(ws + WS_RSTD2)};
        SchedPlain S{(const char*)(ws + WS_MERGED), (const char*)(ws + WS_WOUT), 1024, 1024, 128, 4, 16, G, cu};
        pg8::gemm_phase(ldsl, 1024, 1024, S, E);
    xcd_barrier(xbar); }
    for (int rep_ = 0; rep_ < (DUP_PHASE == 5 ? 2 : 1); ++rep_) {
        EpiBf16 E{(bf16_t*)(ws + WS_QP), 2048};
        SchedPlain S{(const char*)(ws + WS_X1B), (const char*)(ws + WS_WQ), 1024, 1024, 128, 8, 16, G, cu};
        pg8::gemm_phase(ldsl, 1024, 1024, S, E);
    xcd_barrier(xbar); }
    for (int rep_ = 0; rep_ < (DUP_PHASE == 6 ? 2 : 1); ++rep_) {
    topk_phase((const bf16_t*)(ws + WS_QP), (const bf16_t*)(ws + WS_KEYS), (const float*)(ws + WS_RSTD2), (unsigned short*)(ws + WS_IDS), (float*)(ws + WS_GTS), lds);
    xcd_barrier(xbar); }
    int lbl, rnk, cnt;
    {
        unsigned* bar = (unsigned*)p.ws; unsigned sum = 0u, mine = 0u; bool ok = xbar.x < 8u;
#pragma unroll
        for (unsigned j = 0; j < 8; ++j) { const unsigned c = xb_ld(&bar[XB_XCNT(j)]); sum += c; ok = ok && (c > 0u); mine = (j == xbar.x) ? c : mine; }
        ok = ok && (sum == (unsigned)G);
        lbl = ok ? (int)xbar.x : (cu & 7); rnk = ok ? (int)bst[2] : (cu >> 3); cnt = ok ? (int)mine : ((G - (cu & 7) + 7) >> 3);
        lbl = __builtin_amdgcn_readfirstlane(lbl); rnk = __builtin_amdgcn_readfirstlane(rnk); cnt = __builtin_amdgcn_readfirstlane(cnt);
    }
    if (DUP_PHASE == 7) {
        peer_u2_phase<PROBE_VAR>((const bf16_t*)(ws + WS_X1B), (const unsigned char*)(ws + WS_U16), (const unsigned short*)(ws + WS_IDS), partial_base(ws, lbl), lds, lbl, rnk, cnt);
        xcd_barrier(xbar); }
    peer_u2_phase<0>((const bf16_t*)(ws + WS_X1B), (const unsigned char*)(ws + WS_U16), (const unsigned short*)(ws + WS_IDS), partial_base(ws, lbl), lds, lbl, rnk, cnt);
    xcd_barrier(xbar);
    peer_combine_phase(ws, (const float*)(ws + WS_RSTD2), (const float*)(ws + WS_GTS), (const unsigned short*)(ws + WS_IDS), (const float*)(ws + WS_SU), (bf16_t*)(ws + WS_COEF));
    xcd_barrier(xbar);
    if (DUP_PHASE == 8) {
        peer_v_phase<PROBE_VAR>((const bf16_t*)(ws + WS_X1B), (bf16_t*)(ws + WS_MERGED), (const unsigned char*)(ws + WS_V16), (const unsigned short*)(ws + WS_IDS), (const bf16_t*)(ws + WS_COEF), (float*)(ws + WS_RSTD1), lds, lbl, rnk, cnt);
        xcd_barrier(xbar); }
    peer_v_phase<0>((const bf16_t*)(ws + WS_X1B), (bf16_t*)(ws + WS_X1B), (const unsigned char*)(ws + WS_V16), (const unsigned short*)(ws + WS_IDS), (const bf16_t*)(ws + WS_COEF), (float*)(ws + WS_SSQO), lds, lbl, rnk, cnt);
    xcd_barrier(xbar);
    for (int rep_ = 0; rep_ < (DUP_PHASE == 9 ? 2 : 1); ++rep_)
    peer_final_phase((const bf16_t*)(ws + WS_X1B), (const float*)(ws + WS_SSQO), p.final_g, p.out);
}

extern "C" void kernel_launch(void* const* d_in, const int* in_sizes, int n_in, void* d_out, int out_size, void* d_ws, size_t ws_size, hipStream_t stream) {
    static int grid_blocks = 0;
    if (grid_blocks == 0) {
        if (n_in != 20 || out_size != T * D || ws_size < WS_END) { fprintf(stderr, "kernel_launch: unexpected shapes: n_in %d out %d ws %zu\n", n_in, out_size, ws_size); grid_blocks = -1; return; }
        int dev = 0, cus = 0, per_cu = 0;
        (void)hipGetDevice(&dev);
        (void)hipDeviceGetAttribute(&cus, hipDeviceAttributeMultiprocessorCount, dev);
        if (hipFuncSetAttribute((const void*)fwd_kernel, hipFuncAttributeMaxDynamicSharedMemorySize, LDS_BYTES) != hipSuccess) { fprintf(stderr, "kernel_launch: hipFuncSetAttribute failed\n"); grid_blocks = -1; return; }
        (void)hipOccupancyMaxActiveBlocksPerMultiprocessor(&per_cu, (const void*)fwd_kernel, NTHREADS, LDS_BYTES);
        if (per_cu < 1) { fprintf(stderr, "kernel_launch: occupancy query says %d blocks per CU\n", per_cu); grid_blocks = -1; return; }
        grid_blocks = cus * per_cu;
        fprintf(stderr, "kernel_launch: cus %d per_cu %d grid %d ws %zu\n", cus, per_cu, grid_blocks, ws_size);
    }
    if (grid_blocks < 0) return;
    Params p{};
    p.x = (const float*)d_in[0]; p.mem = (const float*)d_in[1]; p.pos = (const int*)d_in[2]; p.norm1_g = (const float*)d_in[3]; p.mem_norm_g = (const float*)d_in[4];
    p.w_in = (const float*)d_in[5]; p.w_pool = (const float*)d_in[6]; p.pool_scale = (const float*)d_in[7]; p.sinks = (const float*)d_in[8]; p.w_mem_kv = (const float*)d_in[9];
    p.w_bpool = (const float*)d_in[10]; p.w_bswa = (const float*)d_in[11]; p.w_bmem = (const float*)d_in[12]; p.w_out = (const float*)d_in[13]; p.norm2_g = (const float*)d_in[14];
    p.w_q = (const float*)d_in[15]; p.sub_keys = (const float*)d_in[16]; p.peer_u = (const float*)d_in[17]; p.peer_v = (const float*)d_in[18]; p.final_g = (const float*)d_in[19];
    p.out = (float*)d_out; p.ws = (unsigned char*)d_ws;
    (void)hipMemsetAsync(d_ws, 0, 16384, stream);
    void* args[] = {&p};
    hipError_t e = hipLaunchCooperativeKernel((const void*)fwd_kernel, dim3(grid_blocks), dim3(NTHREADS), args, LDS_BYTES, stream);
    if (e != hipSuccess) fprintf(stderr, "cooperative launch failed: %s (grid %d)\n", hipGetErrorString(e), grid_blocks);
}
```

```cpp
#include <hip/hip_runtime.h>
#include <hip/hip_cooperative_groups.h>
#include <cstdio>
#include <cstdint>
namespace cg = cooperative_groups;

#define DI __device__ __forceinline__
typedef unsigned short bf16_t;
typedef _Float16 f16_t;
typedef short bf16x8 __attribute__((ext_vector_type(8)));
typedef float f32x4 __attribute__((ext_vector_type(4)));
typedef float f32x16 __attribute__((ext_vector_type(16)));
typedef unsigned u32x4 __attribute__((ext_vector_type(4)));
typedef unsigned u32x2 __attribute__((ext_vector_type(2)));
typedef _Float16 f16x4 __attribute__((ext_vector_type(4)));

#ifndef DUP_PHASE
#define DUP_PHASE -1
#endif
#ifndef PROBE_VAR
#define PROBE_VAR 0
#endif
constexpr int D = 1024, BATCH = 8, SEQ = 4096, T = BATCH * SEQ, MEML = 256, TMEM = BATCH * MEML;
constexpr int INW = 5376;
constexpr int NTHREADS = 512, NWAVES = 8;
constexpr int NEXP = 16384;
constexpr float EPS = 1e-6f;

constexpr size_t MiB = 1u << 20;
constexpr size_t WS_WIN = 1 * MiB;
constexpr size_t WS_WBR = 12 * MiB;
constexpr size_t WS_WOUT = 16 * MiB;
constexpr size_t WS_WQ = 18 * MiB;
constexpr size_t WS_KEYS = 22 * MiB;
constexpr size_t WS_WPOOL = 22 * MiB + 512 * 1024;
constexpr size_t WS_RSTD1 = 22 * MiB + 768 * 1024;
constexpr size_t WS_RSTD2 = 22 * MiB + 896 * 1024;
constexpr size_t WS_RSTDM = 23 * MiB;
constexpr size_t WS_SSQO = 23 * MiB + 64 * 1024;
constexpr size_t WS_SU = 23 * MiB + 256 * 1024;
constexpr size_t WS_WMKV = 24 * MiB;
constexpr size_t WS_MEMB = 26 * MiB;
constexpr size_t WS_KVM = 30 * MiB;
constexpr size_t WS_ROPE = 34 * MiB;
constexpr size_t WS_XB = 42 * MiB;
constexpr size_t WS_POOLED = 42 * MiB;
constexpr size_t WS_MERGED = 170 * MiB;
constexpr size_t WS_U16 = 106 * MiB;
constexpr size_t WS_V16 = 138 * MiB;
constexpr size_t WS_UPOOL = 170 * MiB;
constexpr size_t WS_QR = 202 * MiB;
constexpr size_t WS_KR = 266 * MiB;
constexpr size_t WS_VV = 274 * MiB;
constexpr size_t WS_QM = 282 * MiB;
constexpr size_t WS_GATES = 314 * MiB;
constexpr size_t WS_X1B = 234 * MiB;
constexpr size_t WS_QP = 314 * MiB;
constexpr size_t WS_COEF = 314 * MiB;
constexpr size_t WS_IDS = 442 * MiB;
constexpr size_t WS_GTS = 458 * MiB;
constexpr size_t WS_END = 512 * MiB;

struct Params {
    const float* x; const float* mem; const int* pos; const float* norm1_g; const float* mem_norm_g; const float* w_in; const float* w_pool;
    const float* pool_scale; const float* sinks; const float* w_mem_kv; const float* w_bpool; const float* w_bswa; const float* w_bmem; const float* w_out;
    const float* norm2_g; const float* w_q; const float* sub_keys; const float* peer_u; const float* peer_v; const float* final_g;
    float* out; unsigned char* ws;
    int use_cg_sync; int pad_;
};

DI unsigned f2bf(float f) { unsigned u = __builtin_bit_cast(unsigned, f); return (u + 0x7fffu + ((u >> 16) & 1u)) >> 16; }
DI unsigned pk2(float lo, float hi) { return f2bf(lo) | (f2bf(hi) << 16); }
DI float bf2f(bf16_t b) { return __builtin_bit_cast(float, (unsigned)b << 16); }
DI float bflo(unsigned w) { return __builtin_bit_cast(float, w << 16); }
DI float bfhi(unsigned w) { return __builtin_bit_cast(float, w & 0xffff0000u); }
DI float wave_sum(float v) {
#pragma unroll
    for (int o = 1; o < 64; o <<= 1) v += __shfl_xor(v, o);
    return v;
}
DI float wave_max(float v) {
#pragma unroll
    for (int o = 1; o < 64; o <<= 1) v = fmaxf(v, __shfl_xor(v, o));
    return v;
}
DI float gelu_tanh(float x) {
    const float y2 = 1.5957691216057308f * (x + 0.044715f * x * x * x);
    return x * __builtin_amdgcn_rcpf(1.f + __builtin_amdgcn_exp2f(-1.4426950408889634f * y2));
}
DI float sigmoidf(float x) { return __builtin_amdgcn_rcpf(1.f + __builtin_amdgcn_exp2f(-1.4426950408889634f * x)); }

DI int opaque_tid() { int t = threadIdx.x; asm volatile("" : "+v"(t)); return t; }
DI int zperm(int n) {
    if (n < 512 || n >= 1664) return n;
    const int d = (n - 512) & 63, hb = n - d; return hb + 8 * ((d & 31) >> 2) + (d & 3) + 4 * (d >> 5);
}
template <bool ZPERM>
DI void transpose_item(const float* W, int K, int N, bf16_t* WT, int ldt, int roff, int coff, const float* g, float* scr, int item, int lane) {
    const int nblk = N / 32, kb = item / nblk, nb = item % nblk, k0 = 64 * kb, n0 = 32 * nb;
    float tv[32];
#pragma unroll
    for (int i = 0; i < 32; ++i) tv[i] = W[(size_t)(k0 + 2 * i + (lane >> 5)) * N + n0 + (lane & 31)];
#pragma unroll
    for (int i = 0; i < 32; ++i) { const int kk = 2 * i + (lane >> 5); float v = tv[i]; if (g) v *= g[k0 + kk]; scr[kk * 33 + (lane & 31)] = v; }
    asm volatile("s_waitcnt lgkmcnt(0)" ::: "memory");
    const int c = lane & 7;
#pragma unroll
    for (int j = 0; j < 4; ++j) { const int n = (lane >> 3) + 8 * j; const float* s = scr + (8 * c) * 33 + n;
        u32x4 o; o.x = pk2(s[0 * 33], s[1 * 33]); o.y = pk2(s[2 * 33], s[3 * 33]); o.z = pk2(s[4 * 33], s[5 * 33]); o.w = pk2(s[6 * 33], s[7 * 33]);
        const int nd = ZPERM ? zperm(n0 + n) : n0 + n;
        *(u32x4*)(WT + (size_t)(roff + nd) * ldt + coff + k0 + 8 * c) = o; }
    asm volatile("s_waitcnt lgkmcnt(0)" ::: "memory");
}

DI void row_to_bf16_rstd(const float* xrow, bf16_t* orow, float* rstd_out, int lane) {
    const f32x4* xr = (const f32x4*)xrow + lane;
    f32x4 v[4]; float s = 0.f;
#pragma unroll
    for (int j = 0; j < 4; ++j) { v[j] = xr[64 * j]; s += (v[j].x * v[j].x + v[j].y * v[j].y) + (v[j].z * v[j].z + v[j].w * v[j].w); }
    s = wave_sum(s);
    if (lane == 0) *rstd_out = 1.f / sqrtf(s * (1.f / D) + EPS);
    u32x2* o8 = (u32x2*)orow + lane;
#pragma unroll
    for (int j = 0; j < 4; ++j) { u32x2 w; w.x = pk2(v[j].x, v[j].y); w.y = pk2(v[j].z, v[j].w); o8[64 * j] = w; }
}

DI void phase0(const Params& p, float* lds_f) {
    const int tid_ = opaque_tid(), lane = tid_ & 63, wave = tid_ >> 6, gw = blockIdx.x * NWAVES + wave, NGW = gridDim.x * NWAVES;
    unsigned char* ws = p.ws;
    float* scr = lds_f + wave * (64 * 33);
    bf16_t* WinT = (bf16_t*)(ws + WS_WIN); bf16_t* WbrT = (bf16_t*)(ws + WS_WBR); bf16_t* WoutT = (bf16_t*)(ws + WS_WOUT); bf16_t* WqT = (bf16_t*)(ws + WS_WQ);
    bf16_t* WmkvT = (bf16_t*)(ws + WS_WMKV);
    constexpr int I_IN = (D / 64) * (INW / 32), I_BS = (1024 / 64) * (D / 32), I_BM = (512 / 64) * (D / 32), I_OUT = (D / 64) * (D / 32), I_Q = (D / 64) * (2048 / 32), I_MKV = (D / 64) * (D / 32);
    constexpr int NITEMS = I_IN + I_BS + I_BM + I_OUT + I_Q + I_MKV;
    for (int rp_ = 0; rp_ < (DUP_PHASE == 10 ? 2 : 1); ++rp_) {
    for (int it = gw; it < NITEMS; it += NGW) {
        int r = it;
        if (r < I_IN) { transpose_item<true>(p.w_in, D, INW, WinT, D, 0, 0, p.norm1_g, scr, r, lane); continue; } r -= I_IN;
        if (r < I_BS) { transpose_item<false>(p.w_bswa, 1024, D, WbrT, 2048, 0, 512, nullptr, scr, r, lane); continue; } r -= I_BS;
        if (r < I_BM) { transpose_item<false>(p.w_bmem, 512, D, WbrT, 2048, 0, 1536, nullptr, scr, r, lane); continue; } r -= I_BM;
        if (r < I_OUT) { transpose_item<false>(p.w_out, D, D, WoutT, D, 0, 0, nullptr, scr, r, lane); continue; } r -= I_OUT;
        if (r < I_Q) { transpose_item<false>(p.w_q, D, 2048, WqT, D, 0, 0, p.norm2_g, scr, r, lane); continue; } r -= I_Q;
        transpose_item<false>(p.w_mem_kv, D, D, WmkvT, D, 0, 0, p.mem_norm_g, scr, r, lane);
    }
    }
    for (int rp_ = 0; rp_ < (DUP_PHASE == 11 ? 2 : 1); ++rp_) {
    {
        const size_t gt0 = (size_t)gw * 64 + lane, NGT0 = (size_t)NGW * 64;
        for (size_t i = gt0; i < (size_t)512 * 256; i += NGT0) {
            const int n4 = (int)(i & 255), cp = (int)(i >> 8), g = cp >> 7;
            const float* wp = p.w_pool + (size_t)cp * 128; const float* sc = p.pool_scale + g * 128; const f32x4* wb = (const f32x4*)(p.w_bpool + (size_t)(g * 128) * 1024) + n4;
            f32x4 a = {0.f, 0.f, 0.f, 0.f};
#pragma unroll 16
            for (int d = 0; d < 128; ++d) a += wb[(size_t)d * 256] * (wp[d] * sc[d]);
            bf16_t* o = WbrT + (size_t)(4 * n4) * 2048 + cp;
            o[0] = (bf16_t)f2bf(a.x); o[2048] = (bf16_t)f2bf(a.y); o[4096] = (bf16_t)f2bf(a.z); o[6144] = (bf16_t)f2bf(a.w);
        }
    }
    }
    bf16_t* xb = (bf16_t*)(ws + WS_XB); float* rstd1 = (float*)(ws + WS_RSTD1);
    for (int rp_ = 0; rp_ < (DUP_PHASE == 12 ? 2 : 1); ++rp_) {
    for (int m = gw; m < T; m += 4 * NGW) {
        f32x4 v[4][4];
#pragma unroll
        for (int q = 0; q < 4; ++q) { const int mq = (m + q * NGW < T) ? m + q * NGW : m; const f32x4* xr = (const f32x4*)(p.x + (size_t)mq * D) + lane;
#pragma unroll
            for (int j = 0; j < 4; ++j) v[q][j] = xr[64 * j]; }
#pragma unroll
        for (int q = 0; q < 4; ++q) { const int mq = m + q * NGW; float s = 0.f;
#pragma unroll
            for (int j = 0; j < 4; ++j) s += (v[q][j].x * v[q][j].x + v[q][j].y * v[q][j].y) + (v[q][j].z * v[q][j].z + v[q][j].w * v[q][j].w);
            s = wave_sum(s);
            if (mq < T) { if (lane == 0) rstd1[mq] = __builtin_amdgcn_rsqf(s * (1.f / D) + EPS);
                u32x2* o8 = (u32x2*)(xb + (size_t)mq * D) + lane;
#pragma unroll
                for (int j = 0; j < 4; ++j) { u32x2 wv; wv.x = pk2(v[q][j].x, v[q][j].y); wv.y = pk2(v[q][j].z, v[q][j].w); o8[64 * j] = wv; } } }
    }
    }
    bf16_t* memb = (bf16_t*)(ws + WS_MEMB); float* rstdm = (float*)(ws + WS_RSTDM);
    for (int m = gw; m < TMEM; m += NGW) row_to_bf16_rstd(p.mem + (size_t)m * D, memb + (size_t)m * D, rstdm + m, lane);
    const size_t gt = (size_t)gw * 64 + lane, NGT = (size_t)NGW * 64;
    bf16_t* keysb = (bf16_t*)(ws + WS_KEYS);
    for (size_t i = gt; i < (size_t)8 * 2 * 128 * 128 / 4; i += NGT) { const f32x4 v = ((const f32x4*)p.sub_keys)[i]; u32x2 w; w.x = pk2(v.x, v.y); w.y = pk2(v.z, v.w); ((u32x2*)keysb)[i] = w; }
    for (int rp_ = 0; rp_ < (DUP_PHASE == 14 ? 2 : 1); ++rp_) {
    {
        unsigned* u8 = (unsigned*)(ws + WS_U16); unsigned* v8 = (unsigned*)(ws + WS_V16); float* su = (float*)(ws + WS_SU);
        f32x4 g2r[4];
#pragma unroll
        for (int j = 0; j < 4; ++j) g2r[j] = ((const f32x4*)p.norm2_g)[lane + 64 * j];
        for (int r0 = gw; r0 < NEXP; r0 += 2 * NGW) {
            f32x4 au[2][4], av[2][4];
#pragma unroll
            for (int h = 0; h < 2; ++h) { const int r = (r0 + h * NGW < NEXP) ? r0 + h * NGW : r0;
#pragma unroll
                for (int j = 0; j < 4; ++j) { au[h][j] = ((const f32x4*)p.peer_u)[(size_t)r * 256 + lane + 64 * j]; av[h][j] = ((const f32x4*)p.peer_v)[(size_t)r * 256 + lane + 64 * j]; } }
#pragma unroll
            for (int h = 0; h < 2; ++h) { const int r = r0 + h * NGW; if (r >= NEXP) continue;
                float mx = 0.f;
#pragma unroll
                for (int j = 0; j < 4; ++j) { au[h][j] = au[h][j] * g2r[j]; mx = fmaxf(fmaxf(mx, fmaxf(fabsf(au[h][j].x), fabsf(au[h][j].y))), fmaxf(fabsf(au[h][j].z), fabsf(au[h][j].w))); }
                mx = wave_max(mx);
                const float inv = mx > 0.f ? 127.f / mx : 0.f;
                if (lane == 0) su[r] = mx * (1.f / 127.f);
#pragma unroll
                for (int j = 0; j < 4; ++j) { const f32x4 b = av[h][j] * 2.f;
                    const int q0 = (int)__builtin_rintf(au[h][j].x * inv), q1 = (int)__builtin_rintf(au[h][j].y * inv), q2 = (int)__builtin_rintf(au[h][j].z * inv), q3 = (int)__builtin_rintf(au[h][j].w * inv);
                    const unsigned wa = (unsigned)(q0 & 255) | ((unsigned)(q1 & 255) << 8) | ((unsigned)(q2 & 255) << 16) | ((unsigned)q3 << 24);
                    int wb = __builtin_amdgcn_cvt_pk_fp8_f32(b.x, b.y, 0, false); wb = __builtin_amdgcn_cvt_pk_fp8_f32(b.z, b.w, wb, true);
                    u8[(size_t)r * 256 + lane + 64 * j] = wa; v8[(size_t)r * 256 + lane + 64 * j] = (unsigned)wb; } }
        }
    }
    }
    for (size_t i = gt; i < (size_t)T; i += NGT) { ((float*)(ws + WS_RSTD2))[i] = 0.f; ((float*)(ws + WS_SSQO))[i] = 0.f; }
    for (int rp_ = 0; rp_ < (DUP_PHASE == 15 ? 2 : 1); ++rp_) {
    float2* rope = (float2*)(ws + WS_ROPE);
    for (size_t i = gt; i < (size_t)T * 32; i += NGT) {
        const int t = (int)(i >> 5), d = (int)(i & 31);
        const float inv = exp2f(-(float)d * (13.287712379549449f / 32.f));
        const float ang = (float)p.pos[t] * inv;
        const double rev = (double)ang * 0.15915494309189535;
        const float fr = (float)(rev - floor(rev));
        rope[i] = make_float2(__builtin_amdgcn_cosf(fr), __builtin_amdgcn_sinf(fr));
    }
    }
}

namespace pg8 {
#define PG8_LAS __attribute__((address_space(3)))
constexpr int BM = 256, BK = 64, HALF = 128, HTB = HALF * BK * 2, STAGE_BYTES = 8 * HTB, NXCD = 8;
__host__ __device__ __forceinline__ int lds_byte(int r, int c) { const int st = (r >> 4) * 2 + (c >> 5), rr = r & 15, cc = c & 31, ob = rr * 64 + cc * 2; return st * 1024 + (ob ^ (((ob >> 9) & 1) << 5)); }
__host__ __device__ __forceinline__ void stage_rc(int b, int& R, int& C) { const int st = b / 1024, sb = b % 1024, swz = sb ^ (((sb >> 9) & 1) << 5); R = (st >> 1) * 16 + swz / 64; C = (st & 1) * 32 + (swz % 64) / 2; }
__host__ __device__ __forceinline__ int perm32(int rho) { const int n = rho >> 4, i = rho & 15; return 8 * (i >> 2) + 4 * n + (i & 3); }

struct Unit { const char* a; const char* b; int nt, pm, pn, tag; };
DI void tile_of(int L, int nM, int nN, int& pm, int& pn, int WGM = 4) {
    const int nwg = nM * nN; int wgid = L; { const int q = nwg / NXCD, r = nwg % NXCD, xcd = wgid % NXCD, off = wgid / NXCD; wgid = (xcd < r ? xcd * (q + 1) : r * (q + 1) + (xcd - r) * q) + off; }
    const int nig = WGM * nN, gid = wgid / nig, fm = gid * WGM, gsz = (nM - fm) < WGM ? (nM - fm) : WGM;
    pm = fm + ((wgid % nig) % gsz); pn = (wgid % nig) / gsz;
}
template <class Epi, class Sched>
DI void gemm_phase(PG8_LAS unsigned char* lds, int lda, int ldb, const Sched& S, const Epi& E) {
    int tid = threadIdx.x; asm volatile("" : "+v"(tid));
    const int wid = __builtin_amdgcn_readfirstlane(tid >> 6), wr = wid >> 2, wc = wid & 3, lane = tid & 63, fr = lane & 15, fq = lane >> 4;
    unsigned voffA[2], voffB[2];
#pragma unroll
    for (int i = 0; i < 2; ++i) { int R, C; stage_rc(tid * 16 + i * 8192, R, C); const int Rb = (R & ~31) + perm32(R & 31);
        voffA[i] = (unsigned)(R * lda + C) * 2u; voffB[i] = (unsigned)(Rb * ldb + C) * 2u; }
    const size_t kstep = (size_t)(BK * 2);
    const size_t hstepA = (size_t)HALF * lda * 2, hstepB = (size_t)HALF * ldb * 2;
    const unsigned ldsw = (unsigned)wid * 1024u;
    const int aoff = lds_byte(wr * 64 + fr, fq * 8), boff = lds_byte(wc * 32 + fr, fq * 8);
#define PG8_SA(b, h) (((b) * 2 + (h)) * HTB)
#define PG8_SB(b, h) ((4 + (b) * 2 + (h)) * HTB)
#define PG8_STAGE(bufoff, gbase, voff) do { _Pragma("unroll") for (int _i = 0; _i < 2; ++_i) \
        __builtin_amdgcn_global_load_lds((const unsigned*)((const char*)(gbase) + (voff)[_i]), (PG8_LAS unsigned*)(lds + (bufoff) + ldsw + _i * 8192), 16, 0, 0); } while (0)
#define PG8_LDA(dst, b, h) do { _Pragma("unroll") for (int m = 0; m < 4; ++m) _Pragma("unroll") for (int k = 0; k < 2; ++k) dst[m][k] = *(const PG8_LAS bf16x8*)(lds + PG8_SA(b, h) + aoff + m * 2048 + k * 1024); } while (0)
#define PG8_LDB(dst, b, h) do { _Pragma("unroll") for (int n = 0; n < 2; ++n) _Pragma("unroll") for (int k = 0; k < 2; ++k) dst[n][k] = *(const PG8_LAS bf16x8*)(lds + PG8_SB(b, h) + boff + n * 2048 + k * 1024); } while (0)
#define PG8_MMA(ai, bj, At, Bt) do { __builtin_amdgcn_s_setprio(1); _Pragma("unroll") for (int m = 0; m < 4; ++m) _Pragma("unroll") for (int n = 0; n < 2; ++n) _Pragma("unroll") for (int k = 0; k < 2; ++k) \
        acc[ai][bj][m][n] = __builtin_amdgcn_mfma_f32_16x16x32_bf16(Bt[n][k], At[m][k], acc[ai][bj][m][n], 0, 0, 0); __builtin_amdgcn_s_setprio(0); } while (0)
#define PG8_WAIT_V(n) asm volatile("s_waitcnt vmcnt(" #n ")" ::: "memory")
#define PG8_WAIT_L(n) asm volatile("s_waitcnt lgkmcnt(" #n ")" ::: "memory")
#define PG8_BAR __builtin_amdgcn_s_barrier()
#define PG8_SCHED __builtin_amdgcn_sched_barrier(0)
    Unit cur, nxt; int ui = 0;
    if (!S.next(0, cur)) return;
    f32x4 acc[2][2][4][2];
#pragma unroll
    for (int a = 0; a < 2; ++a)
#pragma unroll
        for (int b = 0; b < 2; ++b)
#pragma unroll
            for (int m = 0; m < 4; ++m)
#pragma unroll
                for (int n = 0; n < 2; ++n) acc[a][b][m][n] = (f32x4){0.f, 0.f, 0.f, 0.f};
    bf16x8 At[4][2], B0[2][2], B1[2][2];
    const char* cA = cur.a; const char* cB = cur.b;
    PG8_STAGE(PG8_SB(0, 0), cB, voffB); PG8_STAGE(PG8_SB(0, 1), cB + hstepB, voffB); PG8_STAGE(PG8_SA(0, 0), cA, voffA); PG8_STAGE(PG8_SA(0, 1), cA + hstepA, voffA);
    if (wr == 1) PG8_BAR;
    PG8_WAIT_V(2); PG8_BAR;
    PG8_STAGE(PG8_SB(1, 0), cB + kstep, voffB); PG8_STAGE(PG8_SA(1, 0), cA + kstep, voffA); PG8_STAGE(PG8_SB(1, 1), cB + hstepB + kstep, voffB);
    PG8_WAIT_V(6); PG8_BAR;
    for (;;) {
        const bool has_next = S.next(ui + 1, nxt);
        const char* nA = has_next ? nxt.a : cA; const char* nB = has_next ? nxt.b : cB;
        const int nt = cur.nt;
        for (int t = 0; t < nt; t += 2) {
            const bool last = (t == nt - 2);
            const char* a1 = cA + (size_t)(t + 1) * kstep;
            const char* a2 = last ? nA : cA + (size_t)(t + 2) * kstep; const char* b2 = last ? nB : cB + (size_t)(t + 2) * kstep;
            const char* a3 = a2 + kstep; const char* b3 = b2 + kstep;
            PG8_LDB(B0, 0, 0); PG8_LDB(B1, 0, 1); PG8_SCHED; PG8_LDA(At, 0, 0); PG8_STAGE(PG8_SA(1, 1), a1 + hstepA, voffA);
            PG8_WAIT_V(8); PG8_WAIT_L(0); PG8_BAR; PG8_MMA(0, 0, At, B0); PG8_MMA(0, 1, At, B1); PG8_BAR; PG8_SCHED;
            PG8_LDA(At, 0, 1); PG8_STAGE(PG8_SB(0, 0), b2, voffB); PG8_STAGE(PG8_SB(0, 1), b2 + hstepB, voffB); PG8_STAGE(PG8_SA(0, 0), a2, voffA);
            PG8_WAIT_V(8); PG8_WAIT_L(0); PG8_BAR; PG8_MMA(1, 0, At, B0); PG8_MMA(1, 1, At, B1); PG8_BAR; PG8_SCHED;
            PG8_LDB(B0, 1, 0); PG8_LDB(B1, 1, 1); PG8_SCHED; PG8_LDA(At, 1, 0); PG8_STAGE(PG8_SA(0, 1), a2 + hstepA, voffA);
            PG8_WAIT_V(8); PG8_WAIT_L(0); PG8_BAR; PG8_MMA(0, 0, At, B0); PG8_MMA(0, 1, At, B1); PG8_BAR; PG8_SCHED;
            PG8_LDA(At, 1, 1); PG8_STAGE(PG8_SB(1, 0), b3, voffB); PG8_STAGE(PG8_SB(1, 1), b3 + hstepB, voffB); PG8_STAGE(PG8_SA(1, 0), a3, voffA);
            PG8_WAIT_V(8); PG8_WAIT_L(0); PG8_BAR; PG8_MMA(1, 0, At, B0); PG8_MMA(1, 1, At, B1); PG8_BAR; PG8_SCHED;
        }
        if (wr == 0) PG8_BAR;
        const bool keep_ = E(acc, cur, wr, wc, fr, fq);
        if (!has_next) break;
        if (!keep_)
#pragma unroll
        for (int a = 0; a < 2; ++a)
#pragma unroll
            for (int b = 0; b < 2; ++b)
#pragma unroll
                for (int m = 0; m < 4; ++m)
#pragma unroll
                    for (int n = 0; n < 2; ++n) acc[a][b][m][n] = (f32x4){0.f, 0.f, 0.f, 0.f};
        cur = nxt; cA = nA; cB = nB; ++ui;
        if (wr == 1) PG8_BAR;
    }
    PG8_WAIT_V(0);
    PG8_BAR;
#undef PG8_SA
#undef PG8_SB
#undef PG8_STAGE
#undef PG8_LDA
#undef PG8_LDB
#undef PG8_MMA
#undef PG8_WAIT_V
#undef PG8_WAIT_L
#undef PG8_BAR
#undef PG8_SCHED
}
}
typedef f32x4 acc_t[2][2][4][2];

struct SchedPlain {
    const char* A; const char* Bt; int lda, ldb, nM, nN, nt, G, c;
    DI bool next(int i, pg8::Unit& u) const {
        const long L = (long)i * G + c; if (L >= (long)nM * nN) return false;
        pg8::tile_of((int)L, nM, nN, u.pm, u.pn); u.a = A + (size_t)u.pm * 256 * lda * 2; u.b = Bt + (size_t)u.pn * 256 * ldb * 2; u.nt = nt; u.tag = 0; return true;
    }
};
struct SchedZ {
    const char *xb, *win, *memb, *wmkv; int G, c;
    DI bool next(int i, pg8::Unit& u) const {
        const long L = (long)i * G + c; constexpr int NZ = 128 * 21;
        if (L < NZ) { pg8::tile_of((int)L, 128, 21, u.pm, u.pn); u.a = xb + (size_t)u.pm * 256 * 2048; u.b = win + (size_t)u.pn * 256 * 2048; u.nt = 16; u.tag = 0; return true; }
        const int j = (int)(L - NZ); if (j >= 32) return false;
        u.pm = j >> 2; u.pn = j & 3; u.a = memb + (size_t)u.pm * 256 * 2048; u.b = wmkv + (size_t)u.pn * 256 * 2048; u.nt = 16; u.tag = 1; return true;
    }
};
struct SchedGated {
    const char *ycat, *wbr; int G, c;
    DI bool next(int i, pg8::Unit& u) const {
        const int j = i / 3, b = i - 3 * j; const long L = (long)j * G + c; if (L >= 128 * 4) return false;
        pg8::tile_of((int)L, 128, 4, u.pm, u.pn);
        const int koff = (b == 0) ? 0 : (b == 1 ? 512 : 1536);
        u.a = ycat + ((size_t)u.pm * 256 * 2048 + koff) * 2; u.b = wbr + ((size_t)u.pn * 256 * 2048 + koff) * 2; u.nt = (b == 1) ? 16 : 8; u.tag = b; return true;
    }
};

DI u32x4 pack8(const f32x4& a, const f32x4& b) { u32x4 w; w.x = pk2(a[0], a[1]); w.y = pk2(a[2], a[3]); w.z = pk2(b[0], b[1]); w.w = pk2(b[2], b[3]); return w; }
struct EpiZ {
    const float* rstd1; const float* rstdm; const float2* rope; bf16_t *upool, *qr, *kr, *vv, *qm; unsigned char* gates; bf16_t* kvm;
    DI bool operator()(const acc_t& acc, const pg8::Unit& u, int wr, int wc, int fr_, int fq_) const {
        int l_ = threadIdx.x; asm volatile("" : "+v"(l_)); const int fr = l_ & 15, fq = (l_ >> 4) & 3;
        const int row0 = u.pm * 256 + wr * 64 + fr;
        const float* rsp = (u.tag == 1) ? rstdm : rstd1;
        float rs[2][4];
#pragma unroll
        for (int ai = 0; ai < 2; ++ai)
#pragma unroll
            for (int m = 0; m < 4; ++m) rs[ai][m] = rsp[row0 + ai * 128 + m * 16];
        if (u.tag == 1) {
#pragma unroll
            for (int ai = 0; ai < 2; ++ai)
#pragma unroll
                for (int m = 0; m < 4; ++m) { const int row = row0 + ai * 128 + m * 16;
#pragma unroll
                    for (int bj = 0; bj < 2; ++bj) { const int c = u.pn * 256 + bj * 128 + wc * 32 + 8 * fq;
                        *(u32x4*)(kvm + (size_t)row * 1024 + c) = pack8(acc[ai][bj][m][0] * rs[ai][m], acc[ai][bj][m][1] * rs[ai][m]); } }
            return false;
        }
#pragma unroll
        for (int bj = 0; bj < 2; ++bj) {
            const int cb = u.pn * 256 + bj * 128;
            const int c = cb + wc * 32 + 8 * fq;
            if (cb >= 512 && cb < 1664) {
                const bool isq = cb < 1536; const int rel = isq ? c - 512 : c - 1536; const int hrel = rel & 63, d0 = hrel >> 1, hb = rel - hrel;
                const float sc = isq ? 0.125f : 1.f;
#pragma unroll
                for (int ai = 0; ai < 2; ++ai) {
                    f32x4 cs0[4], cs1[4];
#pragma unroll
                    for (int m = 0; m < 4; ++m) { const int row = row0 + ai * 128 + m * 16;
                        cs0[m] = *(const f32x4*)(rope + (size_t)row * 32 + d0); cs1[m] = *(const f32x4*)(rope + (size_t)row * 32 + d0 + 2); }
#pragma unroll
                    for (int m = 0; m < 4; ++m) { const int row = row0 + ai * 128 + m * 16;
                        const f32x4 v0 = acc[ai][bj][m][0] * rs[ai][m], v1 = acc[ai][bj][m][1] * rs[ai][m], a0 = cs0[m], a1 = cs1[m];
                        f32x4 o1, o2;
                        o1[0] = (v0[0] * a0[0] - v1[0] * a0[1]) * sc; o2[0] = (v1[0] * a0[0] + v0[0] * a0[1]) * sc;
                        o1[1] = (v0[1] * a0[2] - v1[1] * a0[3]) * sc; o2[1] = (v1[1] * a0[2] + v0[1] * a0[3]) * sc;
                        o1[2] = (v0[2] * a1[0] - v1[2] * a1[1]) * sc; o2[2] = (v1[2] * a1[0] + v0[2] * a1[1]) * sc;
                        o1[3] = (v0[3] * a1[2] - v1[3] * a1[3]) * sc; o2[3] = (v1[3] * a1[2] + v0[3] * a1[3]) * sc;
                        bf16_t* dst = isq ? qr + (size_t)row * 1024 + hb + d0 : kr + (size_t)row * 128 + hb + d0;
                        u32x2 w1, w2; w1.x = pk2(o1[0], o1[1]); w1.y = pk2(o1[2], o1[3]); w2.x = pk2(o2[0], o2[1]); w2.y = pk2(o2[2], o2[3]);
                        *(u32x2*)dst = w1; *(u32x2*)(dst + 32) = w2; }
                }
                continue;
            }
#pragma unroll
            for (int ai = 0; ai < 2; ++ai)
#pragma unroll
                for (int m = 0; m < 4; ++m) {
                    const int row = row0 + ai * 128 + m * 16;
                    const f32x4 v0 = acc[ai][bj][m][0] * rs[ai][m], v1 = acc[ai][bj][m][1] * rs[ai][m];
                    if (cb < 512) { *(u32x4*)(upool + (size_t)row * 512 + c) = pack8(v0, v1); }
                    else if (cb < 1792) { *(u32x4*)(vv + (size_t)row * 128 + (c - 1664)) = pack8(v0, v1); }
                    else if (cb < 2304) { *(u32x4*)(qm + (size_t)row * 512 + (c - 1792)) = pack8(v0, v1); }
                    else {
                        u32x2 w = {0u, 0u};
#pragma unroll
                        for (int e = 0; e < 4; ++e) {
                            const float t0 = __builtin_amdgcn_rcpf(__builtin_fmaf(__builtin_amdgcn_exp2f(-1.4426950408889634f * v0[e]), 1.f / 256.f, 1.f / 256.f));
                            const float t1 = __builtin_amdgcn_rcpf(__builtin_fmaf(__builtin_amdgcn_exp2f(-1.4426950408889634f * v1[e]), 1.f / 256.f, 1.f / 256.f));
                            w.x = __builtin_amdgcn_cvt_pk_u8_f32(__builtin_floorf(t0), e, w.x); w.y = __builtin_amdgcn_cvt_pk_u8_f32(__builtin_floorf(t1), e, w.y); }
                        *(u32x2*)(gates + (size_t)row * 3072 + (c - 2304)) = w; }
                }
        }
        return false;
    }
};
struct EpiGated {
    const unsigned char* gates; bf16_t* merged;
    static DI float gv(unsigned w, int e) { return ((float)((w >> (8 * e)) & 255u) + 0.5f) * (1.f / 256.f); }
    DI bool operator()(acc_t& acc, const pg8::Unit& u, int wr, int wc, int fr_, int fq_) const {
        int l_ = threadIdx.x; asm volatile("" : "+v"(l_)); const int fr = l_ & 15, fq = (l_ >> 4) & 3;
        const int row0 = u.pm * 256 + wr * 64 + fr, b = u.tag;
#pragma unroll
        for (int ai = 0; ai < 2; ++ai) {
            u32x2 gq[4][2], gnq[4][2];
#pragma unroll
            for (int m = 0; m < 4; ++m)
#pragma unroll
                for (int bj = 0; bj < 2; ++bj) { const unsigned char* gp = gates + (size_t)(row0 + ai * 128 + m * 16) * 3072 + b * 1024 + u.pn * 256 + bj * 128 + wc * 32 + 8 * fq;
                    gq[m][bj] = *(const u32x2*)gp; if (b < 2) gnq[m][bj] = *(const u32x2*)(gp + 1024); else gnq[m][bj] = gq[m][bj]; }
#pragma unroll
            for (int m = 0; m < 4; ++m) { const int row = row0 + ai * 128 + m * 16;
#pragma unroll
                for (int bj = 0; bj < 2; ++bj) { const int c = u.pn * 256 + bj * 128 + wc * 32 + 8 * fq;
                    const u32x2 g = gq[m][bj], gn = gnq[m][bj];
                    f32x4 s0, s1;
#pragma unroll
                    for (int e = 0; e < 4; ++e) { s0[e] = gv(g.x, e); s1[e] = gv(g.y, e); }
                    if (b < 2) {
#pragma unroll
                        for (int e = 0; e < 4; ++e) { s0[e] *= __builtin_amdgcn_rcpf(gv(gn.x, e)); s1[e] *= __builtin_amdgcn_rcpf(gv(gn.y, e)); }
                        acc[ai][bj][m][0] *= s0; acc[ai][bj][m][1] *= s1; }
                    else *(u32x4*)(merged + (size_t)row * 1024 + c) = pack8(acc[ai][bj][m][0] * s0, acc[ai][bj][m][1] * s1); } }
        }
        return b < 2;
    }
};
struct EpiOut {
    const bf16_t* xb; bf16_t* x1b; float* ssq;
    DI bool operator()(const acc_t& acc, const pg8::Unit& u, int wr, int wc, int fr_, int fq_) const {
        int l_ = threadIdx.x; asm volatile("" : "+v"(l_)); const int fr = l_ & 15, fq = (l_ >> 4) & 3;
        const int row0 = u.pm * 256 + wr * 64 + fr;
#pragma unroll
        for (int ai = 0; ai < 2; ++ai) {
            u32x4 xq[4][2];
#pragma unroll
            for (int m = 0; m < 4; ++m)
#pragma unroll
                for (int bj = 0; bj < 2; ++bj) xq[m][bj] = *(const u32x4*)(xb + (size_t)(row0 + ai * 128 + m * 16) * D + u.pn * 256 + bj * 128 + wc * 32 + 8 * fq);
#pragma unroll
            for (int m = 0; m < 4; ++m) { const int row = row0 + ai * 128 + m * 16; float sq = 0.f;
#pragma unroll
                for (int bj = 0; bj < 2; ++bj) { const size_t o = (size_t)row * D + u.pn * 256 + bj * 128 + wc * 32 + 8 * fq;
                    const u32x4 xw = xq[m][bj];
                    f32x4 v0 = acc[ai][bj][m][0], v1 = acc[ai][bj][m][1];
                    v0[0] += bflo(xw.x); v0[1] += bfhi(xw.x); v0[2] += bflo(xw.y); v0[3] += bfhi(xw.y); v1[0] += bflo(xw.z); v1[1] += bfhi(xw.z); v1[2] += bflo(xw.w); v1[3] += bfhi(xw.w);
                    sq += (v0[0] * v0[0] + v0[1] * v0[1]) + (v0[2] * v0[2] + v0[3] * v0[3]) + (v1[0] * v1[0] + v1[1] * v1[1]) + (v1[2] * v1[2] + v1[3] * v1[3]);
                    *(u32x4*)(x1b + o) = pack8(v0, v1); }
                sq += __shfl_xor(sq, 16); sq += __shfl_xor(sq, 32);
                if (fq == 0) atomicAdd(ssq + row, sq); }
        }
        return false;
    }
};
struct EpiBf16 {
    bf16_t* O; int ldo;
    DI bool operator()(const acc_t& acc, const pg8::Unit& u, int wr, int wc, int fr_, int fq_) const {
        int l_ = threadIdx.x; asm volatile("" : "+v"(l_)); const int fr = l_ & 15, fq = (l_ >> 4) & 3;
        const int row0 = u.pm * 256 + wr * 64 + fr;
#pragma unroll
        for (int ai = 0; ai < 2; ++ai)
#pragma unroll
            for (int m = 0; m < 4; ++m) { const int row = row0 + ai * 128 + m * 16;
#pragma unroll
                for (int bj = 0; bj < 2; ++bj) { const size_t o = (size_t)row * ldo + u.pn * 256 + bj * 128 + wc * 32 + 8 * fq;
                    *(u32x4*)(O + o) = pack8(acc[ai][bj][m][0], acc[ai][bj][m][1]); } }
        return false;
    }
};

DI void unpack8(const u32x4& w, float (&f)[8]) { f[0] = bflo(w.x); f[1] = bfhi(w.x); f[2] = bflo(w.y); f[3] = bfhi(w.y); f[4] = bflo(w.z); f[5] = bfhi(w.z); f[6] = bflo(w.w); f[7] = bfhi(w.w); }
DI void pooled_phase(const bf16_t* upool, bf16_t* pooled) {
    const int tid = opaque_tid(), lane = tid & 63, gw = blockIdx.x * NWAVES + (tid >> 6), NGW = gridDim.x * NWAVES;
    const int c = lane * 8, w = 2 << (lane >> 4);
    for (int task = gw; task < T / 16; task += NGW) {
        const int t0 = task * 16, s0 = t0 & (SEQ - 1);
        const bf16_t* up = upool + (size_t)t0 * 512 + c;
        u32x4 hw[15], nw[16], ow[16];
#pragma unroll
        for (int j = 1; j < 16; ++j) { const int jj = (s0 - j >= 0) ? j : 0; hw[j - 1] = *(const u32x4*)(up - (ptrdiff_t)jj * 512); }
#pragma unroll
        for (int i = 0; i < 16; ++i) { nw[i] = *(const u32x4*)(up + (size_t)i * 512); const int back = (s0 + i - (w - 1) >= 0) ? (w - 1) : 0; ow[i] = *(const u32x4*)(up + (ptrdiff_t)(i - back) * 512); }
        float win[8];
#pragma unroll
        for (int e = 0; e < 8; ++e) win[e] = 0.f;
#pragma unroll
        for (int j = 1; j < 16; ++j) { float f[8]; unpack8(hw[j - 1], f); const float mk = (j < w && s0 - j >= 0) ? 1.f : 0.f;
#pragma unroll
            for (int e = 0; e < 8; ++e) win[e] += mk * f[e]; }
#pragma unroll
        for (int i = 0; i < 16; ++i) {
            const int s = s0 + i;
            float un[8], uo[8];
            unpack8(nw[i], un); unpack8(ow[i], uo);
            const float mo = (s - (w - 1) >= 0) ? 1.f : 0.f;
            const int cnt = (s + 1 < w) ? s + 1 : w; const float ic = __builtin_amdgcn_rcpf((float)cnt);
            float o[8];
#pragma unroll
            for (int e = 0; e < 8; ++e) { const float tot = win[e] + un[e]; o[e] = tot * ic - un[e]; win[e] = tot - mo * uo[e]; }
            u32x4 ov; ov.x = pk2(o[0], o[1]); ov.y = pk2(o[2], o[3]); ov.z = pk2(o[4], o[5]); ov.w = pk2(o[6], o[7]);
            *(u32x4*)(pooled + (size_t)(t0 + i) * 2048 + c) = ov;
        }
    }
}
typedef __bf16 bf16x2_t __attribute__((ext_vector_type(2)));
typedef float f32x2_t __attribute__((ext_vector_type(2)));
DI unsigned cvtpk(float lo, float hi) { f32x2_t v = {lo, hi}; bf16x2_t b = __builtin_convertvector(v, bf16x2_t); return __builtin_bit_cast(unsigned, b); }
DI int crow(int i, int h) { return (i & 3) + 8 * (i >> 2) + 4 * h; }
#define MFMA32(a, b, c) __builtin_amdgcn_mfma_f32_32x32x16_bf16((a), (b), (c), 0, 0, 0)
DI bf16x8 mk8(unsigned a, unsigned b, unsigned c, unsigned d) { u32x4 w = {a, b, c, d}; return __builtin_bit_cast(bf16x8, w); }

constexpr int SWA_KLD = 72, SWA_VLD = 260, SWA_VT_OFF = 256 * SWA_KLD * 2;
DI void swa_phase(const bf16_t* qr, const bf16_t* kr, const bf16_t* vv, const float* sinks, bf16_t* ycat, unsigned char* lds) {
    const int tid = opaque_tid();
    const int lane = tid & 63, w = tid >> 6, r = lane & 31, h = lane >> 5;
    bf16_t* Ks = (bf16_t*)lds; bf16_t* Vt = (bf16_t*)(lds + SWA_VT_OFF);
    for (int unit = blockIdx.x; unit < 512; unit += gridDim.x) {
        const int kvh = unit & 1, nb = (unit >> 1) & 31, b = unit >> 6;
        const int tq0 = b * SEQ + nb * 128, tk0 = tq0 - 128;
        const int hq = kvh * 8 + w; const float sink = sinks[hq];
        bf16x8 qn[4];
        { const bf16_t* qp = qr + (size_t)(tq0 + r) * 1024 + hq * 64 + 8 * h;
#pragma unroll
          for (int s = 0; s < 4; ++s) qn[s] = *(const bf16x8*)(qp + 16 * s); }
        __syncthreads();
#pragma unroll
        for (int i = 0; i < 4; ++i) {
            const int c = tid + 512 * i, kb = c >> 3, dc = (c & 7) * 8;
            u32x4 kv = {0u, 0u, 0u, 0u}, vx = {0u, 0u, 0u, 0u};
            if (nb > 0 || kb >= 128) { kv = *(const u32x4*)(kr + (size_t)(tk0 + kb) * 128 + kvh * 64 + dc); vx = *(const u32x4*)(vv + (size_t)(tk0 + kb) * 128 + kvh * 64 + dc); }
            *(u32x4*)(Ks + kb * SWA_KLD + dc) = kv;
            bf16_t* vp = Vt + dc * SWA_VLD + kb;
            vp[0 * SWA_VLD] = (bf16_t)(vx.x & 0xffffu); vp[1 * SWA_VLD] = (bf16_t)(vx.x >> 16); vp[2 * SWA_VLD] = (bf16_t)(vx.y & 0xffffu); vp[3 * SWA_VLD] = (bf16_t)(vx.y >> 16);
            vp[4 * SWA_VLD] = (bf16_t)(vx.z & 0xffffu); vp[5 * SWA_VLD] = (bf16_t)(vx.z >> 16); vp[6 * SWA_VLD] = (bf16_t)(vx.w & 0xffffu); vp[7 * SWA_VLD] = (bf16_t)(vx.w >> 16);
        }
        __syncthreads();
        for (int qt = 0; qt < 4; ++qt) {
            bf16x8 qf[4];
#pragma unroll
            for (int s = 0; s < 4; ++s) qf[s] = qn[s];
            if (qt < 3) { const bf16_t* qp = qr + (size_t)(tq0 + 32 * (qt + 1) + r) * 1024 + hq * 64 + 8 * h;
#pragma unroll
                for (int s = 0; s < 4; ++s) qn[s] = *(const bf16x8*)(qp + 16 * s); }
            f32x16 sa[5];
#pragma unroll
            for (int c = 0; c < 5; ++c) {
#pragma unroll
                for (int i = 0; i < 16; ++i) sa[c][i] = 0.f;
#pragma unroll
                for (int s = 0; s < 4; ++s) { const bf16x8 kf = *(const bf16x8*)(Ks + (32 * (qt + c) + r) * SWA_KLD + 16 * s + 8 * h); sa[c] = MFMA32(kf, qf[s], sa[c]); }
            }
            float mx = sink;
#pragma unroll
            for (int c = 0; c < 5; ++c)
#pragma unroll
                for (int i = 0; i < 16; ++i) {
                    const int kk = 32 * c + crow(i, h);
                    bool vis = (c == 0) ? (kk > r) : ((c == 4) ? (kk - 128 <= r) : true);
                    if (nb == 0) vis = vis && (32 * qt + kk >= 128);
                    const float s = vis ? sa[c][i] : -1e30f; sa[c][i] = s; mx = fmaxf(mx, s);
                }
            mx = fmaxf(mx, __shfl_xor(mx, 32));
            float l = 0.f;
#pragma unroll
            for (int c = 0; c < 5; ++c)
#pragma unroll
                for (int i = 0; i < 16; ++i) { const float pz = __expf(sa[c][i] - mx); sa[c][i] = pz; l += pz; }
            l += __shfl_xor(l, 32); l += __expf(sink - mx);
            const float inv = 1.f / l;
            f32x16 oa[2];
#pragma unroll
            for (int i = 0; i < 16; ++i) { oa[0][i] = 0.f; oa[1][i] = 0.f; }
#pragma unroll
            for (int c = 0; c < 5; ++c)
#pragma unroll
                for (int s2 = 0; s2 < 2; ++s2) {
                    const bf16x8 pf = mk8(cvtpk(sa[c][8 * s2 + 0], sa[c][8 * s2 + 1]), cvtpk(sa[c][8 * s2 + 2], sa[c][8 * s2 + 3]), cvtpk(sa[c][8 * s2 + 4], sa[c][8 * s2 + 5]), cvtpk(sa[c][8 * s2 + 6], sa[c][8 * s2 + 7]));
#pragma unroll
                    for (int dt = 0; dt < 2; ++dt) {
                        const bf16_t* va = Vt + (32 * dt + r) * SWA_VLD + 32 * (qt + c) + 16 * s2 + 4 * h;
                        const u32x2 lo = *(const u32x2*)va, hi = *(const u32x2*)(va + 8);
                        oa[dt] = MFMA32(mk8(lo.x, lo.y, hi.x, hi.y), pf, oa[dt]);
                    }
                }
            bf16_t* yp = ycat + (size_t)(tq0 + 32 * qt + r) * 2048 + 512 + hq * 64 + 4 * h;
#pragma unroll
            for (int dt = 0; dt < 2; ++dt)
#pragma unroll
                for (int g4 = 0; g4 < 4; ++g4) { u32x2 o; o.x = cvtpk(oa[dt][4 * g4] * inv, oa[dt][4 * g4 + 1] * inv); o.y = cvtpk(oa[dt][4 * g4 + 2] * inv, oa[dt][4 * g4 + 3] * inv);
                    *(u32x2*)(yp + 32 * dt + 8 * g4) = o; }
        }
    }
}

constexpr int MEM_KLD = 136, MEM_VLD = 260, MEM_VT_OFF = 256 * MEM_KLD * 2;
DI void mem_phase(const bf16_t* qm, const bf16_t* kvm, bf16_t* ycat, unsigned char* lds) {
    const int tid = opaque_tid();
    const int lane = tid & 63, w = tid >> 6, r = lane & 31, h = lane >> 5;
    bf16_t* Ks = (bf16_t*)lds; bf16_t* Vt = (bf16_t*)(lds + MEM_VT_OFF);
    for (int unit = blockIdx.x; unit < 256; unit += gridDim.x) {
        const int qc = unit & 7, hm = (unit >> 3) & 3, b = unit >> 5;
        bf16x8 qn[8];
        { const bf16_t* qp = qm + (size_t)(b * SEQ + qc * 512 + (w * 2) * 32 + r) * 512 + hm * 128 + 8 * h;
#pragma unroll
          for (int s = 0; s < 8; ++s) qn[s] = *(const bf16x8*)(qp + 16 * s); }
        __syncthreads();
#pragma unroll
        for (int i = 0; i < 8; ++i) {
            const int c = tid + 512 * i, m = c >> 4, dc = (c & 15) * 8;
            const bf16_t* src = kvm + (size_t)(b * MEML + m) * 1024 + hm * 128 + dc;
            const u32x4 kv = *(const u32x4*)src, vx = *(const u32x4*)(src + 512);
            *(u32x4*)(Ks + m * MEM_KLD + dc) = kv;
            bf16_t* vp = Vt + dc * MEM_VLD + m;
            vp[0 * MEM_VLD] = (bf16_t)(vx.x & 0xffffu); vp[1 * MEM_VLD] = (bf16_t)(vx.x >> 16); vp[2 * MEM_VLD] = (bf16_t)(vx.y & 0xffffu); vp[3 * MEM_VLD] = (bf16_t)(vx.y >> 16);
            vp[4 * MEM_VLD] = (bf16_t)(vx.z & 0xffffu); vp[5 * MEM_VLD] = (bf16_t)(vx.z >> 16); vp[6 * MEM_VLD] = (bf16_t)(vx.w & 0xffffu); vp[7 * MEM_VLD] = (bf16_t)(vx.w >> 16);
        }
        __syncthreads();
        for (int qi = 0; qi < 2; ++qi) {
            const int t0 = b * SEQ + qc * 512 + (w * 2 + qi) * 32;
            bf16x8 qf[8];
#pragma unroll
            for (int s = 0; s < 8; ++s) qf[s] = qn[s];
            if (qi == 0) { const bf16_t* qp = qm + (size_t)(t0 + 32 + r) * 512 + hm * 128 + 8 * h;
#pragma unroll
                for (int s = 0; s < 8; ++s) qn[s] = *(const bf16x8*)(qp + 16 * s); }
            float mx = -3e38f;
#pragma unroll 1
            for (int c = 0; c < 8; ++c) {
                f32x16 sc;
#pragma unroll
                for (int i = 0; i < 16; ++i) sc[i] = 0.f;
#pragma unroll
                for (int s = 0; s < 8; ++s) { const bf16x8 kf = *(const bf16x8*)(Ks + (32 * c + r) * MEM_KLD + 16 * s + 8 * h); sc = MFMA32(kf, qf[s], sc); }
#pragma unroll
                for (int i = 0; i < 16; ++i) mx = fmaxf(mx, sc[i]);
            }
            mx = fmaxf(mx, __shfl_xor(mx, 32));
            constexpr float SC = 0.08838834764831845f * 1.4426950408889634f;
            float l = 0.f;
            f32x16 oa[4];
#pragma unroll
            for (int dt = 0; dt < 4; ++dt)
#pragma unroll
                for (int i = 0; i < 16; ++i) oa[dt][i] = 0.f;
#pragma unroll 1
            for (int c = 0; c < 8; ++c) {
                f32x16 sc;
#pragma unroll
                for (int i = 0; i < 16; ++i) sc[i] = 0.f;
#pragma unroll
                for (int s = 0; s < 8; ++s) { const bf16x8 kf = *(const bf16x8*)(Ks + (32 * c + r) * MEM_KLD + 16 * s + 8 * h); sc = MFMA32(kf, qf[s], sc); }
#pragma unroll
                for (int i = 0; i < 16; ++i) { const float pz = exp2f((sc[i] - mx) * SC); sc[i] = pz; l += pz; }
#pragma unroll
                for (int s2 = 0; s2 < 2; ++s2) {
                    const bf16x8 pf = mk8(cvtpk(sc[8 * s2 + 0], sc[8 * s2 + 1]), cvtpk(sc[8 * s2 + 2], sc[8 * s2 + 3]), cvtpk(sc[8 * s2 + 4], sc[8 * s2 + 5]), cvtpk(sc[8 * s2 + 6], sc[8 * s2 + 7]));
#pragma unroll
                    for (int dt = 0; dt < 4; ++dt) {
                        const bf16_t* va = Vt + (32 * dt + r) * MEM_VLD + 32 * c + 16 * s2 + 4 * h;
                        const u32x2 lo = *(const u32x2*)va, hi = *(const u32x2*)(va + 8);
                        oa[dt] = MFMA32(mk8(lo.x, lo.y, hi.x, hi.y), pf, oa[dt]);
                    }
                }
            }
            l += __shfl_xor(l, 32);
            const float inv = 1.f / l;
            bf16_t* yp = ycat + (size_t)(t0 + r) * 2048 + 1536 + hm * 128 + 4 * h;
#pragma unroll
            for (int dt = 0; dt < 4; ++dt)
#pragma unroll
                for (int g4 = 0; g4 < 4; ++g4) { u32x2 o; o.x = cvtpk(oa[dt][4 * g4] * inv, oa[dt][4 * g4 + 1] * inv); o.y = cvtpk(oa[dt][4 * g4 + 2] * inv, oa[dt][4 * g4 + 3] * inv);
                    *(u32x2*)(yp + 32 * dt + 8 * g4) = o; }
        }
    }
}

DI unsigned umax_(unsigned a, unsigned b) { return a > b ? a : b; }
DI unsigned umin_(unsigned a, unsigned b) { return a < b ? a : b; }
DI void cexd(unsigned& a, unsigned& b) { const unsigned mx = umax_(a, b), mn = umin_(a, b); a = mx; b = mn; }
DI void sort16_desc(unsigned (&v)[16]) {
#pragma unroll
    for (int k = 2; k <= 16; k <<= 1)
#pragma unroll
        for (int j = k >> 1; j > 0; j >>= 1)
#pragma unroll
            for (int i = 0; i < 16; ++i) { const int l = i ^ j; if (l > i) { if ((i & k) == 0) cexd(v[i], v[l]); else cexd(v[l], v[i]); } }
}
DI void merge16_desc(unsigned (&a)[16], const unsigned (&b)[16]) {
#pragma unroll
    for (int i = 0; i < 16; ++i) a[i] = umax_(a[i], b[15 - i]);
#pragma unroll
    for (int j = 8; j > 0; j >>= 1)
#pragma unroll
        for (int i = 0; i < 16; ++i) { const int l = i ^ j; if (l > i) cexd(a[i], a[l]); }
}
DI unsigned mono(float f) { const unsigned u = __builtin_bit_cast(unsigned, f); return u ^ ((unsigned)((int)u >> 31) | 0x80000000u); }
DI float demono(unsigned m) { const unsigned t = (unsigned)((int)m >> 31); return __builtin_bit_cast(float, m ^ (~t | 0x80000000u)); }
constexpr int TK_KLD = 136, TK_SCR_OFF = 2 * 128 * TK_KLD * 2;
DI void topk_phase(const bf16_t* qp, const bf16_t* keysb, const float* rstd2, unsigned short* ids, float* gts, unsigned char* lds) {
    const int tid = opaque_tid();
    const int lane = tid & 63, w = tid >> 6, r = lane & 31, h2 = lane >> 5;
    bf16_t* Kl = (bf16_t*)lds;
    unsigned char* scr = lds + TK_SCR_OFF + w * 2048 + lane * 32;
    int staged = -1;
    for (int unit = blockIdx.x; unit < 1024; unit += gridDim.x) {
        const int hd = unit & 7, tile = unit >> 3;
        if (hd != staged) {
            __syncthreads();
#pragma unroll
            for (int i = 0; i < 8; ++i) { const int c = tid + 512 * i, row = c >> 4, dc = (c & 15) * 8;
                *(u32x4*)(Kl + row * TK_KLD + dc) = *(const u32x4*)(keysb + ((size_t)hd * 256 + row) * 128 + dc); }
            __syncthreads();
            staged = hd;
        }
        const int t0 = tile * 256 + w * 32;
        unsigned K0[16], K1[16];
#pragma unroll
        for (int p = 0; p < 2; ++p) {
            const bf16_t* qrow = qp + (size_t)(t0 + r) * 2048 + hd * 256 + p * 128 + 8 * h2;
            bf16x8 qf[8];
#pragma unroll
            for (int s = 0; s < 8; ++s) qf[s] = *(const bf16x8*)(qrow + 16 * s);
            unsigned blk[4][16];
#pragma unroll
            for (int c = 0; c < 4; ++c) {
                f32x16 sc;
#pragma unroll
                for (int i = 0; i < 16; ++i) sc[i] = 0.f;
#pragma unroll
                for (int s = 0; s < 8; ++s) { const bf16x8 kf = *(const bf16x8*)(Kl + (p * 128 + 32 * c + r) * TK_KLD + 16 * s + 8 * h2); sc = MFMA32(kf, qf[s], sc); }
#pragma unroll
                for (int i = 0; i < 16; ++i) blk[c][i] = (mono(sc[i]) & ~0x7Fu) | (unsigned)(32 * c + crow(i, h2));
                sort16_desc(blk[c]);
            }
            merge16_desc(blk[0], blk[1]); merge16_desc(blk[2], blk[3]); merge16_desc(blk[0], blk[2]);
            unsigned oth[16];
#pragma unroll
            for (int i = 0; i < 16; ++i) oth[i] = (unsigned)__shfl_xor((int)blk[0][i], 32);
            merge16_desc(blk[0], oth);
#pragma unroll
            for (int i = 0; i < 16; ++i) { if (p == 0) K0[i] = blk[0][i]; else K1[i] = blk[0][i]; }
        }
#pragma unroll
        for (int q = 0; q < 4; ++q) {
            ((unsigned*)scr)[q] = (K0[4 * q] & 0x7Fu) | ((K0[4 * q + 1] & 0x7Fu) << 8) | ((K0[4 * q + 2] & 0x7Fu) << 16) | ((K0[4 * q + 3] & 0x7Fu) << 24);
            ((unsigned*)scr)[4 + q] = (K1[4 * q] & 0x7Fu) | ((K1[4 * q + 1] & 0x7Fu) << 8) | ((K1[4 * q + 2] & 0x7Fu) << 16) | ((K1[4 * q + 3] & 0x7Fu) << 24);
        }
        float sx[16], sy[16];
#pragma unroll
        for (int i = 0; i < 16; ++i) { const float s0 = demono(K0[i] & ~0x7Fu), s1 = demono(K1[i] & ~0x7Fu); sx[i] = h2 ? s1 : s0; sy[i] = h2 ? s0 : s1; }
        unsigned ca[16], cb[16];
#pragma unroll
        for (int i = 0; i < 16; ++i) { ca[i] = 0u; cb[i] = 0u; }
#define CAND(n, a, b) do { const unsigned key_ = (mono(sx[a] + sy[b]) & ~0xFFu) | (h2 ? (unsigned)(((b) << 4) | (a)) : (unsigned)(((a) << 4) | (b))); if ((n) < 16) ca[(n) & 15] = key_; else cb[(n) & 15] = key_; } while (0)
            CAND(0, 0, 1);
            CAND(1, 0, 2);
            CAND(2, 0, 3);
            CAND(3, 0, 4);
            CAND(4, 0, 5);
            CAND(5, 0, 6);
            CAND(6, 0, 7);
            CAND(7, 0, 8);
            CAND(8, 0, 9);
            CAND(9, 0, 10);
            CAND(10, 0, 11);
            CAND(11, 0, 12);
            CAND(12, 0, 13);
            CAND(13, 0, 14);
            CAND(14, 0, 15);
            CAND(15, 1, 2);
            CAND(16, 1, 3);
            CAND(17, 1, 4);
            CAND(18, 1, 5);
            CAND(19, 1, 6);
            CAND(20, 1, 7);
            CAND(21, 2, 3);
            CAND(22, 2, 4);
#undef CAND
#pragma unroll
        for (int d = 0; d < 4; ++d) { const unsigned key_ = (mono(sx[d] + sy[d]) & ~0xFFu) | (unsigned)((d << 4) | d); cb[7 + d] = h2 ? 0u : key_; }
        sort16_desc(ca); sort16_desc(cb); merge16_desc(ca, cb);
        unsigned fin[16], cpart[16];
#pragma unroll
        for (int i = 0; i < 16; ++i) cpart[i] = (unsigned)__shfl_xor((int)ca[i], 32);
#pragma unroll
        for (int i = 0; i < 16; ++i) fin[i] = umax_(ca[i], cpart[15 - i]);
        const float rs = 1.f / sqrtf(rstd2[t0 + r] * (1.f / D) + EPS);
        float sv[16], mxv = -3e38f;
#pragma unroll
        for (int i = 0; i < 16; ++i) { sv[i] = demono(fin[i] & ~0xFFu) * rs; mxv = fmaxf(mxv, sv[i]); }
        float den = 0.f;
#pragma unroll
        for (int i = 0; i < 16; ++i) { sv[i] = __expf(sv[i] - mxv); den += sv[i]; }
        const float rden = 1.f / den;
        int oid[8]; float og[8];
#pragma unroll
        for (int j = 0; j < 8; ++j) {
            const unsigned wk = fin[j]; og[j] = sv[j] * rden;
            const unsigned a0 = (wk >> 4) & 15u, a1 = wk & 15u;
            oid[j] = (int)scr[a0] * 128 + (int)scr[16 + a1];
        }
        unsigned short* ip = ids + (size_t)(t0 + r) * 128 + hd * 16 + 8 * h2; float* gp = gts + (size_t)(t0 + r) * 128 + hd * 16 + 8 * h2;
        *(u32x4*)ip = (u32x4){(unsigned)oid[0] | ((unsigned)oid[1] << 16), (unsigned)oid[2] | ((unsigned)oid[3] << 16), (unsigned)oid[4] | ((unsigned)oid[5] << 16), (unsigned)oid[6] | ((unsigned)oid[7] << 16)};
        *(f32x4*)gp = (f32x4){og[0], og[1], og[2], og[3]}; *(f32x4*)(gp + 4) = (f32x4){og[4], og[5], og[6], og[7]};
    }
}

typedef _Float16 h2_t __attribute__((ext_vector_type(2)));
template <int CTRL> DI float dpp_f(float v) { return __builtin_bit_cast(float, __builtin_amdgcn_update_dpp(0, __builtin_bit_cast(int, v), CTRL, 0xf, 0xf, true)); }
DI float row16_sum(float v) {
    v += dpp_f<0xB1>(v); v += dpp_f<0x4E>(v); v += dpp_f<0x141>(v); v += dpp_f<0x140>(v); return v; }
DI bf16x2_t as_b2(unsigned w) { return __builtin_bit_cast(bf16x2_t, w); }
DI float dot_row(const u32x4 (&xw)[4][2], const u32x4 (&ru)[4]) {
    float d0 = 0.f, d1 = 0.f;
#pragma unroll
    for (int i = 0; i < 4; ++i)
#pragma unroll
        for (int q = 0; q < 4; ++q) {
            const bf16x2_t z0 = __builtin_amdgcn_cvt_scalef32_pk_bf16_fp8((int)ru[i][q], 1.0f, false), z1 = __builtin_amdgcn_cvt_scalef32_pk_bf16_fp8((int)ru[i][q], 1.0f, true);
            d0 = __builtin_amdgcn_fdot2_f32_bf16(as_b2(xw[i][q >> 1][2 * (q & 1)]), z0, d0, false); d1 = __builtin_amdgcn_fdot2_f32_bf16(as_b2(xw[i][q >> 1][2 * (q & 1) + 1]), z1, d1, false);
        }
    return row16_sum(d0 + d1);
}
DI float swz_xor4(float v) { return __builtin_bit_cast(float, __builtin_amdgcn_ds_swizzle(__builtin_bit_cast(int, v), 0x101F)); }
DI bf16_t* partial_base(unsigned char* ws, int x) { return (bf16_t*)(ws + 42 * MiB + (size_t)x * 8 * MiB); }
template <int VAR>
DI void peer_u2_phase(const bf16_t* x1b, const unsigned char* u8, const unsigned short* ids, bf16_t* part, unsigned char* lds, int lbl, int rnk, int cnt) {
    const int tid = opaque_tid(), lane = tid & 63, wave = tid >> 6, g8 = lane >> 3, s8 = lane & 7;
    constexpr int LST = 132;
    int* lid = (int*)(lds + wave * (2 * 8 * LST * 4)); float* lpa = (float*)(lid + 8 * LST);
    const int stride = cnt * NWAVES * 8;
    const unsigned char* ubase = u8 + lbl * 128;
    const bool b4 = (s8 & 4) != 0, b2 = (s8 & 2) != 0, b1 = (s8 & 1) != 0;
    for (int t0 = (rnk * NWAVES + wave) * 8; t0 < T; t0 += stride) {
#pragma unroll
        for (int j = 0; j < 2; ++j) { const int f = lane * 8 + 512 * j, tk = f >> 7, k = f & 127; const u32x4 w = *(const u32x4*)(ids + (size_t)t0 * 128 + f);
            *(u32x4*)(lid + tk * LST + k) = (u32x4){w.x & 0xffffu, w.x >> 16, w.y & 0xffffu, w.y >> 16}; *(u32x4*)(lid + tk * LST + k + 4) = (u32x4){w.z & 0xffffu, w.z >> 16, w.w & 0xffffu, w.w >> 16}; }
        const size_t xo_ = (size_t)(t0 + g8) * D + lbl * 128 + 16 * s8;
        const u32x4 xa = *(const u32x4*)(x1b + xo_), xb2 = *(const u32x4*)(x1b + xo_ + 8);
        float xf[16];
        xf[0] = bflo(xa.x); xf[1] = bfhi(xa.x); xf[2] = bflo(xa.y); xf[3] = bfhi(xa.y); xf[4] = bflo(xa.z); xf[5] = bfhi(xa.z); xf[6] = bflo(xa.w); xf[7] = bfhi(xa.w);
        xf[8] = bflo(xb2.x); xf[9] = bfhi(xb2.x); xf[10] = bflo(xb2.y); xf[11] = bfhi(xb2.y); xf[12] = bflo(xb2.z); xf[13] = bfhi(xb2.z); xf[14] = bflo(xb2.w); xf[15] = bfhi(xb2.w);
        float xm = 0.f;
#pragma unroll
        for (int e = 0; e < 16; ++e) xm = fmaxf(xm, fabsf(xf[e]));
        xm = fmaxf(xm, dpp_f<0xB1>(xm)); xm = fmaxf(xm, dpp_f<0x4E>(xm)); xm = fmaxf(xm, dpp_f<0x141>(xm));
        const float xinv = xm > 0.f ? 127.f / xm : 0.f, sx = xm * (1.f / 127.f);
        int xq[4];
#pragma unroll
        for (int q = 0; q < 4; ++q) { const int q0 = (int)__builtin_rintf(xf[4 * q] * xinv), q1 = (int)__builtin_rintf(xf[4 * q + 1] * xinv), q2 = (int)__builtin_rintf(xf[4 * q + 2] * xinv), q3 = (int)__builtin_rintf(xf[4 * q + 3] * xinv);
            xq[q] = (int)((unsigned)(q0 & 255) | ((unsigned)(q1 & 255) << 8) | ((unsigned)(q2 & 255) << 16) | ((unsigned)q3 << 24)); }
        const int* myid = lid + g8 * LST; float* mypa = lpa + g8 * LST;
        const unsigned loff = (unsigned)(s8 * 16);
#define U2_FETCH(K8, RW) do { const int kc_ = (K8) < 128 ? (K8) : 120; const u32x4 i0_ = *(const u32x4*)(myid + kc_), i1_ = *(const u32x4*)(myid + kc_ + 4); \
            _Pragma("unroll") for (int i = 0; i < 8; ++i) { const unsigned id_ = i < 4 ? i0_[i & 3] : i1_[i & 3]; \
                if (VAR & 1) RW[i] = (u32x4){id_, id_ * 3u, id_ * 5u, id_ * 7u}; else RW[i] = *(const u32x4*)(ubase + (id_ * (unsigned)D + loff)); } } while (0)
#define U2_REDUCE(K8, RW) do { int pp[8]; \
            _Pragma("unroll") for (int i = 0; i < 8; ++i) { \
                if (VAR & 2) { pp[i] = (int)((RW[i].x ^ RW[i].y ^ RW[i].z ^ RW[i].w ^ xa.x) & 0xffu); continue; } \
                int d_ = 0; \
                _Pragma("unroll") for (int q = 0; q < 4; ++q) d_ = __builtin_amdgcn_sdot4((int)RW[i][q], xq[q], d_, false); \
                pp[i] = d_; } \
            int q4[4], q2[2]; \
            _Pragma("unroll") for (int j = 0; j < 4; ++j) { const int keep = b4 ? pp[j + 4] : pp[j], send = b4 ? pp[j] : pp[j + 4]; q4[j] = keep + __builtin_amdgcn_ds_swizzle(send, 0x101F); } \
            _Pragma("unroll") for (int j = 0; j < 2; ++j) { const int keep = b2 ? q4[j + 2] : q4[j], send = b2 ? q4[j] : q4[j + 2]; q2[j] = keep + __builtin_amdgcn_update_dpp(0, send, 0x4E, 0xf, 0xf, true); } \
            const int keep1 = b1 ? q2[1] : q2[0], send1 = b1 ? q2[0] : q2[1]; \
            mypa[(K8) + s8] = (float)(keep1 + __builtin_amdgcn_update_dpp(0, send1, 0xB1, 0xf, 0xf, true)) * sx;     } while (0)
        u32x4 rwA[8], rwB[8];
        U2_FETCH(0, rwA);
#pragma unroll 1
        for (int k8 = 0; k8 < 128; k8 += 16) {
            U2_FETCH(k8 + 8, rwB);
            U2_REDUCE(k8, rwA);
            U2_FETCH(k8 + 16, rwA);
            U2_REDUCE(k8 + 8, rwB);
        }
#undef U2_FETCH
#undef U2_REDUCE
        bf16_t* pg = part + (size_t)t0 * 128;
#pragma unroll
        for (int j = 0; j < 4; ++j) { const int f = lane * 4 + 256 * j, tk = f >> 7, k = f & 127; const f32x4 v = *(const f32x4*)(lpa + tk * LST + k);
            u32x2 w; w.x = pk2(v.x, v.y); w.y = pk2(v.z, v.w); *(u32x2*)(pg + f) = w; }
    }
}
DI void peer_combine_phase(unsigned char* ws, const float* ssq2, const float* gts, const unsigned short* ids, const float* su, bf16_t* coef) {
    const size_t gt = (size_t)blockIdx.x * NTHREADS + opaque_tid(), NGT = (size_t)gridDim.x * NTHREADS;
    for (size_t i = gt; i < (size_t)T * 32; i += NGT) {
        const int t = (int)(i >> 5);
        f32x4 a = {0.f, 0.f, 0.f, 0.f};
#pragma unroll
        for (int x = 0; x < 8; ++x) { const u32x2 w = ((const u32x2*)partial_base(ws, x))[i]; a += (f32x4){bflo(w.x), bfhi(w.x), bflo(w.y), bfhi(w.y)}; }
        const float rs = __builtin_amdgcn_rsqf(ssq2[t] * (1.f / D) + EPS);
        const f32x4 g = ((const f32x4*)gts)[i]; const u32x2 idw = ((const u32x2*)ids)[i];
        const unsigned i0 = idw.x & 0xffffu, i1 = idw.x >> 16, i2 = idw.y & 0xffffu, i3 = idw.y >> 16;
        u32x2 w; w.x = pk2(g.x * gelu_tanh(a.x * rs * su[i0]) * 0.5f, g.y * gelu_tanh(a.y * rs * su[i1]) * 0.5f); w.y = pk2(g.z * gelu_tanh(a.z * rs * su[i2]) * 0.5f, g.w * gelu_tanh(a.w * rs * su[i3]) * 0.5f);
        ((u32x2*)coef)[i] = w;
    }
}
template <int VAR>
DI void peer_v_phase(const bf16_t* x1in, bf16_t* xout, const unsigned char* v8, const unsigned short* ids, const bf16_t* coef, float* ssqo, unsigned char* lds, int lbl, int rnk, int cnt) {
    const int tid = opaque_tid(), lane = tid & 63, wave = tid >> 6, g8 = lane >> 3, s8 = lane & 7;
    constexpr int LST = 132;
    int* lid = (int*)(lds + wave * (2 * 8 * LST * 4)); float* lco = (float*)(lid + 8 * LST);
    const int stride = cnt * NWAVES * 8;
    const unsigned char* vbase = v8 + lbl * 128;
    for (int t0 = (rnk * NWAVES + wave) * 8; t0 < T; t0 += stride) {
#pragma unroll
        for (int j = 0; j < 2; ++j) { const int f = lane * 8 + 512 * j, tk = f >> 7, k = f & 127;
            const u32x4 w = *(const u32x4*)(ids + (size_t)t0 * 128 + f), cw = *(const u32x4*)(coef + (size_t)t0 * 128 + f);
            *(u32x4*)(lid + tk * LST + k) = (u32x4){w.x & 0xffffu, w.x >> 16, w.y & 0xffffu, w.y >> 16}; *(u32x4*)(lid + tk * LST + k + 4) = (u32x4){w.z & 0xffffu, w.z >> 16, w.w & 0xffffu, w.w >> 16};
            *(f32x4*)(lco + tk * LST + k) = (f32x4){bflo(cw.x), bfhi(cw.x), bflo(cw.y), bfhi(cw.y)}; *(f32x4*)(lco + tk * LST + k + 4) = (f32x4){bflo(cw.z), bfhi(cw.z), bflo(cw.w), bfhi(cw.w)}; }
        h2_t acc[8];
#pragma unroll
        for (int j = 0; j < 8; ++j) acc[j] = (h2_t){(f16_t)0.f, (f16_t)0.f};
        const int* myid = lid + g8 * LST; const float* myco = lco + g8 * LST;
        const unsigned loff = (unsigned)(s8 * 16);
#define V_FETCH(K8, RW, CO) do { const int kc_ = (K8) < 128 ? (K8) : 120; const u32x4 i0_ = *(const u32x4*)(myid + kc_), i1_ = *(const u32x4*)(myid + kc_ + 4); \
            const f32x4 c0_ = *(const f32x4*)(myco + kc_), c1_ = *(const f32x4*)(myco + kc_ + 4); \
            _Pragma("unroll") for (int i = 0; i < 8; ++i) { const unsigned id_ = i < 4 ? i0_[i & 3] : i1_[i & 3]; CO[i] = i < 4 ? c0_[i & 3] : c1_[i & 3]; \
                if (VAR & 1) RW[i] = (u32x4){id_, id_ * 3u, id_ * 5u, id_ * 7u}; else RW[i] = *(const u32x4*)(vbase + (id_ * (unsigned)D + loff)); } } while (0)
#define V_ACCUM(RW, CO) do { _Pragma("unroll") for (int i = 0; i < 8; ++i) { const h2_t cc = {(f16_t)CO[i], (f16_t)CO[i]}; \
                if (VAR & 2) { acc[i].x += (f16_t)(__builtin_bit_cast(float, (RW[i].x ^ RW[i].y ^ RW[i].z ^ RW[i].w) & 0x3fffffffu) * CO[i]); continue; } \
                _Pragma("unroll") for (int q = 0; q < 4; ++q) { const h2_t a = __builtin_amdgcn_cvt_scalef32_pk_f16_fp8((int)RW[i][q], 1.0f, false), b = __builtin_amdgcn_cvt_scalef32_pk_f16_fp8((int)RW[i][q], 1.0f, true); \
                    acc[2 * q] = __builtin_elementwise_fma(a, cc, acc[2 * q]); acc[2 * q + 1] = __builtin_elementwise_fma(b, cc, acc[2 * q + 1]); } } } while (0)
        u32x4 rwA[8], rwB[8]; float coA[8], coB[8];
        V_FETCH(0, rwA, coA);
#pragma unroll 1
        for (int k8 = 0; k8 < 128; k8 += 16) {
            V_FETCH(k8 + 8, rwB, coB);
            V_ACCUM(rwA, coA);
            V_FETCH(k8 + 16, rwA, coA);
            V_ACCUM(rwB, coB);
        }
#undef V_FETCH
#undef V_ACCUM
        const size_t xo_ = (size_t)(t0 + g8) * D + lbl * 128 + 16 * s8;
        const u32x4 xa = *(const u32x4*)(x1in + xo_), xb2 = *(const u32x4*)(x1in + xo_ + 8);
        float o[16];
        o[0] = bflo(xa.x) + (float)acc[0].x; o[1] = bfhi(xa.x) + (float)acc[0].y; o[2] = bflo(xa.y) + (float)acc[1].x; o[3] = bfhi(xa.y) + (float)acc[1].y; o[4] = bflo(xa.z) + (float)acc[2].x; o[5] = bfhi(xa.z) + (float)acc[2].y; o[6] = bflo(xa.w) + (float)acc[3].x; o[7] = bfhi(xa.w) + (float)acc[3].y;
        o[8] = bflo(xb2.x) + (float)acc[4].x; o[9] = bfhi(xb2.x) + (float)acc[4].y; o[10] = bflo(xb2.y) + (float)acc[5].x; o[11] = bfhi(xb2.y) + (float)acc[5].y; o[12] = bflo(xb2.z) + (float)acc[6].x; o[13] = bfhi(xb2.z) + (float)acc[6].y; o[14] = bflo(xb2.w) + (float)acc[7].x; o[15] = bfhi(xb2.w) + (float)acc[7].y;
        float ss = 0.f;
#pragma unroll
        for (int e = 0; e < 16; ++e) ss += o[e] * o[e];
        ss += dpp_f<0xB1>(ss); ss += dpp_f<0x4E>(ss); ss += dpp_f<0x141>(ss);
        if (s8 == 0) atomicAdd(ssqo + t0 + g8, ss);
        u32x4 w0, w1; w0.x = pk2(o[0], o[1]); w0.y = pk2(o[2], o[3]); w0.z = pk2(o[4], o[5]); w0.w = pk2(o[6], o[7]); w1.x = pk2(o[8], o[9]); w1.y = pk2(o[10], o[11]); w1.z = pk2(o[12], o[13]); w1.w = pk2(o[14], o[15]);
        *(u32x4*)(xout + xo_) = w0; *(u32x4*)(xout + xo_ + 8) = w1;
    }
}
DI void peer_final_phase(const bf16_t* xo, const float* ssqo, const float* gf, float* out) {
    const int tid = opaque_tid(), lane = tid & 63, gw = blockIdx.x * NWAVES + (tid >> 6), NGW = gridDim.x * NWAVES;
    f32x4 g[4];
#pragma unroll
    for (int q = 0; q < 4; ++q) g[q] = *(const f32x4*)(gf + lane * 16 + 4 * q);
    for (int t = gw; t < T; t += NGW) {
        const u32x4 w0 = *(const u32x4*)(xo + (size_t)t * D + lane * 16), w1 = *(const u32x4*)(xo + (size_t)t * D + lane * 16 + 8);
        const float rf = 1.f / sqrtf(ssqo[t] * (1.f / D) + EPS);
        f32x4* po = (f32x4*)(out + (size_t)t * D + lane * 16);
        po[0] = (f32x4){bflo(w0.x), bfhi(w0.x), bflo(w0.y), bfhi(w0.y)} * rf * g[0]; po[1] = (f32x4){bflo(w0.z), bfhi(w0.z), bflo(w0.w), bfhi(w0.w)} * rf * g[1];
        po[2] = (f32x4){bflo(w1.x), bfhi(w1.x), bflo(w1.y), bfhi(w1.y)} * rf * g[2]; po[3] = (f32x4){bflo(w1.z), bfhi(w1.z), bflo(w1.w), bfhi(w1.w)} * rf * g[3];
    }
}

#define LAS __attribute__((address_space(3)))
#define XB_TMO      128
#define XB_XCNT(j)  (256  + 64 * (j))
#define XB_XSUB(j)  (1280 + 64 * (j))
#define XB_XGEN(j)  (2304 + 64 * (j))
#define XB_TOP      3328
#define XB_TOPGEN   3392
#define XCD_BAR_WORDS 3456
#define XB_SPIN_CAP (1u << 18)
DI unsigned xb_ld(unsigned* p)              { return __hip_atomic_load(p, __ATOMIC_RELAXED, __HIP_MEMORY_SCOPE_AGENT); }
DI unsigned xb_add(unsigned* p, unsigned v) { return __hip_atomic_fetch_add(p, v, __ATOMIC_RELAXED, __HIP_MEMORY_SCOPE_AGENT); }
DI unsigned xb_xcc_id() { return (unsigned)__builtin_amdgcn_s_getreg((3 << 11) | 20) & 0xFu; }
#define XB_SPIN(cond, bar) do { unsigned _sp = 0; while (cond) { __builtin_amdgcn_s_sleep(1); \
    if ((++_sp & 255u) == 0u) { if (xb_ld(&(bar)[XB_TMO])) break; if (_sp > XB_SPIN_CAP) { atomicAdd(&(bar)[XB_TMO], 1u); break; } } } } while (0)
struct XcdBarrier { unsigned* bar; unsigned x; volatile LAS unsigned* st; };
DI XcdBarrier xcd_barrier_post(unsigned* bar, volatile LAS unsigned* st) {
    XcdBarrier b; b.bar = bar; b.x = xb_xcc_id(); b.st = st;
    if (threadIdx.x == 0) st[2] = xb_add(&bar[XB_XCNT(b.x)], 1u);
    return b;
}
DI void xcd_barrier_complete(unsigned* bar, unsigned x, unsigned& nloc, unsigned& nx) {
    const unsigned G = gridDim.x * gridDim.y * gridDim.z;
    unsigned sum, cnt, mine, sp = 0u;
    for (;;) {
        sum = 0u; cnt = 0u; mine = 0u;
#pragma unroll
        for (unsigned j = 0; j < 16; ++j) { const unsigned c = xb_ld(&bar[XB_XCNT(j)]); sum += c; cnt += (c > 0u) ? 1u : 0u; mine = (j == x) ? c : mine; }
        if (sum == G) break;
        __builtin_amdgcn_s_sleep(1);
        if ((++sp & 255u) == 0u) { if (xb_ld(&bar[XB_TMO])) break; if (sp > XB_SPIN_CAP) { atomicAdd(&bar[XB_TMO], 1u); break; } }
    }
    nloc = mine > 0u ? mine : 1u; nx = cnt > 0u ? cnt : 1u;
}
DI void xcd_barrier(const XcdBarrier& b) {
    asm volatile("s_waitcnt vmcnt(0)" ::: "memory");
    __syncthreads();
    if (threadIdx.x == 0) {
        unsigned* bar = b.bar;
        __builtin_amdgcn_s_waitcnt(0);
        unsigned nloc = b.st[0], nx = b.st[1];
        if (nloc == 0u) { xcd_barrier_complete(bar, b.x, nloc, nx); b.st[0] = nloc; b.st[1] = nx; }
        const unsigned old = xb_add(&bar[XB_XSUB(b.x)], 1u);
        const unsigned gen = old / nloc;
        if (old + 1u == (gen + 1u) * nloc) {
            __builtin_amdgcn_fence(__ATOMIC_RELEASE, "agent");
            asm volatile("s_waitcnt vmcnt(0)" ::: "memory");
            const unsigned og = xb_add(&bar[XB_TOP], 1u);
            const unsigned tg = og / nx;
            if (og + 1u == (tg + 1u) * nx) xb_add(&bar[XB_TOPGEN], 1u);
            else XB_SPIN(xb_ld(&bar[XB_TOPGEN]) == tg, bar);
            __builtin_amdgcn_fence(__ATOMIC_ACQUIRE, "agent");
            xb_add(&bar[XB_XGEN(b.x)], 1u);
            asm volatile("s_waitcnt vmcnt(0)" ::: "memory");
        } else {
            XB_SPIN(xb_ld(&bar[XB_XGEN(b.x)]) == gen, bar);
            __builtin_amdgcn_fence(__ATOMIC_ACQUIRE, "agent");
            asm volatile("s_waitcnt vmcnt(0)" ::: "memory");
        }
    }
    __syncthreads();
}


constexpr int LDS_BYTES = 147456;
__global__ void __launch_bounds__(NTHREADS, 2) fwd_kernel(Params p) {
    extern __shared__ __attribute__((aligned(16))) unsigned char lds[];
    cg::grid_group grid = cg::this_grid();
    volatile LAS unsigned* bst = (volatile LAS unsigned*)((LAS unsigned char*)lds + (LDS_BYTES - 64));
    if (threadIdx.x < 4) bst[threadIdx.x] = 0u;
    __syncthreads();
    const XcdBarrier xbar = xcd_barrier_post((unsigned*)p.ws, bst);
    const int NGW = gridDim.x * NWAVES, G = gridDim.x, cu = blockIdx.x;
    unsigned char* ws = p.ws;
    PG8_LAS unsigned char* ldsl = (PG8_LAS unsigned char*)lds;
    bf16_t* ycat = (bf16_t*)p.out;

    for (int rep_ = 0; rep_ < (DUP_PHASE == 0 ? 2 : 1); ++rep_) { phase0(p, (float*)lds);
    if (p.use_cg_sync) grid.sync(); else xcd_barrier(xbar); }
    for (int rep_ = 0; rep_ < (DUP_PHASE == 1 ? 2 : 1); ++rep_) {
        EpiZ E{(const float*)(ws + WS_RSTD1), (const float*)(ws + WS_RSTDM), (const float2*)(ws + WS_ROPE), (bf16_t*)(ws + WS_UPOOL), (bf16_t*)(ws + WS_QR), (bf16_t*)(ws + WS_KR), (bf16_t*)(ws + WS_VV), (bf16_t*)(ws + WS_QM), (unsigned char*)(ws + WS_GATES), (bf16_t*)(ws + WS_KVM)};
        SchedZ S{(const char*)(ws + WS_XB), (const char*)(ws + WS_WIN), (const char*)(ws + WS_MEMB), (const char*)(ws + WS_WMKV), G, cu};
        pg8::gemm_phase(ldsl, 1024, 1024, S, E);
    xcd_barrier(xbar); }
    if (DUP_PHASE == 20) pooled_phase((const bf16_t*)(ws + WS_UPOOL), ycat);
    if (DUP_PHASE == 21) swa_phase((const bf16_t*)(ws + WS_QR), (const bf16_t*)(ws + WS_KR), (const bf16_t*)(ws + WS_VV), p.sinks, ycat, lds);
    if (DUP_PHASE == 22) mem_phase((const bf16_t*)(ws + WS_QM), (const bf16_t*)(ws + WS_KVM), ycat, lds);
    pooled_phase((const bf16_t*)(ws + WS_UPOOL), ycat);
    swa_phase((const bf16_t*)(ws + WS_QR), (const bf16_t*)(ws + WS_KR), (const bf16_t*)(ws + WS_VV), p.sinks, ycat, lds);
    mem_phase((const bf16_t*)(ws + WS_QM), (const bf16_t*)(ws + WS_KVM), ycat, lds);
    xcd_barrier(xbar);
    for (int rep_ = 0; rep_ < (DUP_PHASE == 3 ? 2 : 1); ++rep_) {
        EpiGated E{(const unsigned char*)(ws + WS_GATES), (bf16_t*)(ws + WS_MERGED)};
        SchedGated S{(const char*)ycat, (const char*)(ws + WS_WBR), G, cu};
        pg8::gemm_phase(ldsl, 2048, 2048, S, E);
    xcd_barrier(xbar); }
    for (int rep_ = 0; rep_ < (DUP_PHASE == 4 ? 2 : 1); ++rep_) {
        EpiOut E{(const bf16_t*)(ws + WS_XB), (DUP_PHASE == 4 && rep_ == 0) ? (bf16_t*)(ws + WS_QP) : (bf16_t*)(ws + WS_X1B), (DUP_PHASE == 4 && rep_ == 0) ? (float*)(ws + WS_RSTD1) : (float*)(ws + WS_RSTD2)};
        SchedPlain S{(const char*)(ws + WS_MERGED), (const char*)(ws + WS_WOUT), 1024, 1024, 128, 4, 16, G, cu};
        pg8::gemm_phase(ldsl, 1024, 1024, S, E);
    xcd_barrier(xbar); }
    for (int rep_ = 0; rep_ < (DUP_PHASE == 5 ? 2 : 1); ++rep_) {
        EpiBf16 E{(bf16_t*)(ws + WS_QP), 2048};
        SchedPlain S{(const char*)(ws + WS_X1B), (const char*)(ws + WS_WQ), 1024, 1024, 128, 8, 16, G, cu};
        pg8::gemm_phase(ldsl, 1024, 1024, S, E);
    xcd_barrier(xbar); }
    for (int rep_ = 0; rep_ < (DUP_PHASE == 6 ? 2 : 1); ++rep_) {
    topk_phase((const bf16_t*)(ws + WS_QP), (const bf16_t*)(ws + WS_KEYS), (const float*)(ws + WS_RSTD2), (unsigned short*)(ws + WS_IDS), (float*)(ws + WS_GTS), lds);
    xcd_barrier(xbar); }
    int lbl, rnk, cnt;
    {
        unsigned* bar = (unsigned*)p.ws; unsigned sum = 0u, mine = 0u; bool ok = xbar.x < 8u;
#pragma unroll
        for (unsigned j = 0; j < 8; ++j) { const unsigned c = xb_ld(&bar[XB_XCNT(j)]); sum += c; ok = ok && (c > 0u); mine = (j == xbar.x) ? c : mine; }
        ok = ok && (sum == (unsigned)G);
        lbl = ok ? (int)xbar.x : (cu & 7); rnk = ok ? (int)bst[2] : (cu >> 3); cnt = ok ? (int)mine : ((G - (cu & 7) + 7) >> 3);
        lbl = __builtin_amdgcn_readfirstlane(lbl); rnk = __builtin_amdgcn_readfirstlane(rnk); cnt = __builtin_amdgcn_readfirstlane(cnt);
    }
    if (DUP_PHASE == 7) {
        peer_u2_phase<PROBE_VAR>((const bf16_t*)(ws + WS_X1B), (const unsigned char*)(ws + WS_U16), (const unsigned short*)(ws + WS_IDS), partial_base(ws, lbl), lds, lbl, rnk, cnt);
        xcd_barrier(xbar); }
    peer_u2_phase<0>((const bf16_t*)(ws + WS_X1B), (const unsigned char*)(ws + WS_U16), (const unsigned short*)(ws + WS_IDS), partial_base(ws, lbl), lds, lbl, rnk, cnt);
    xcd_barrier(xbar);
    peer_combine_phase(ws, (const float*)(ws + WS_RSTD2), (const float*)(ws + WS_GTS), (const unsigned short*)(ws + WS_IDS), (const float*)(ws + WS_SU), (bf16_t*)(ws + WS_COEF));
    xcd_barrier(xbar);
    if (DUP_PHASE == 8) {
        peer_v_phase<PROBE_VAR>((const bf16_t*)(ws + WS_X1B), (bf16_t*)(ws + WS_MERGED), (const unsigned char*)(ws + WS_V16), (const unsigned short*)(ws + WS_IDS), (const bf16_t*)(ws + WS_COEF), (float*)(ws + WS_RSTD1), lds, lbl, rnk, cnt);
        xcd_barrier(xbar); }
    peer_v_phase<0>((const bf16_t*)(ws + WS_X1B), (bf16_t*)(ws + WS_X1B), (const unsigned char*)(ws + WS_V16), (const unsigned short*)(ws + WS_IDS), (const bf16_t*)(ws + WS_COEF), (float*)(ws + WS_SSQO), lds, lbl, rnk, cnt);
    xcd_barrier(xbar);
    for (int rep_ = 0; rep_ < (DUP_PHASE == 9 ? 2 : 1); ++rep_)
    peer_final_phase((const bf16_t*)(ws + WS_X1B), (const float*)(ws + WS_SSQO), p.final_g, p.out);
}

extern "C" void kernel_launch(void* const* d_in, const int* in_sizes, int n_in, void* d_out, int out_size, void* d_ws, size_t ws_size, hipStream_t stream) {
    static int grid_blocks = 0;
    if (grid_blocks == 0) {
        if (n_in != 20 || out_size != T * D || ws_size < WS_END) { fprintf(stderr, "kernel_launch: unexpected shapes: n_in %d out %d ws %zu\n", n_in, out_size, ws_size); grid_blocks = -1; return; }
        int dev = 0, cus = 0, per_cu = 0;
        (void)hipGetDevice(&dev);
        (void)hipDeviceGetAttribute(&cus, hipDeviceAttributeMultiprocessorCount, dev);
        if (hipFuncSetAttribute((const void*)fwd_kernel, hipFuncAttributeMaxDynamicSharedMemorySize, LDS_BYTES) != hipSuccess) { fprintf(stderr, "kernel_launch: hipFuncSetAttribute failed\n"); grid_blocks = -1; return; }
        (void)hipOccupancyMaxActiveBlocksPerMultiprocessor(&per_cu, (const void*)fwd_kernel, NTHREADS, LDS_BYTES);
        if (per_cu < 1) { fprintf(stderr, "kernel_launch: occupancy query says %d blocks per CU\n", per_cu); grid_blocks = -1; return; }
        grid_blocks = cus * per_cu;
        fprintf(stderr, "kernel_launch: cus %d per_cu %d grid %d ws %zu\n", cus, per_cu, grid_blocks, ws_size);
    }
    if (grid_blocks < 0) return;
    Params p{};
    p.x = (const float*)d_in[0]; p.mem = (const float*)d_in[1]; p.pos = (const int*)d_in[2]; p.norm1_g = (const float*)d_in[3]; p.mem_norm_g = (const float*)d_in[4];
    p.w_in = (const float*)d_in[5]; p.w_pool = (const float*)d_in[6]; p.pool_scale = (const float*)d_in[7]; p.sinks = (const float*)d_in[8]; p.w_mem_kv = (const float*)d_in[9];
    p.w_bpool = (const float*)d_in[10]; p.w_bswa = (const float*)d_in[11]; p.w_bmem = (const float*)d_in[12]; p.w_out = (const float*)d_in[13]; p.norm2_g = (const float*)d_in[14];
    p.w_q = (const float*)d_in[15]; p.sub_keys = (const float*)d_in[16]; p.peer_u = (const float*)d_in[17]; p.peer_v = (const float*)d_in[18]; p.final_g = (const float*)d_in[19];
    p.out = (float*)d_out; p.ws = (unsigned char*)d_ws;
    (void)hipMemsetAsync(d_ws, 0, 16384, stream);
    void* args[] = {&p};
    hipError_t e = hipLaunchCooperativeKernel((const void*)fwd_kernel, dim3(grid_blocks), dim3(NTHREADS), args, LDS_BYTES, stream);
    if (e != hipSuccess) fprintf(stderr, "cooperative launch failed: %s (grid %d)\n", hipGetErrorString(e), grid_blocks);
}
```

```cpp
#include <hip/hip_runtime.h>
#include <hip/hip_cooperative_groups.h>
#include <cstdio>
#include <cstdint>
namespace cg = cooperative_groups;

#define DI __device__ __forceinline__
typedef unsigned short bf16_t;
typedef _Float16 f16_t;
typedef short bf16x8 __attribute__((ext_vector_type(8)));
typedef float f32x4 __attribute__((ext_vector_type(4)));
typedef float f32x16 __attribute__((ext_vector_type(16)));
typedef unsigned u32x4 __attribute__((ext_vector_type(4)));
typedef unsigned u32x2 __attribute__((ext_vector_type(2)));
typedef _Float16 f16x4 __attribute__((ext_vector_type(4)));

#ifndef DUP_PHASE
#define DUP_PHASE -1
#endif
#ifndef PROBE_VAR
#define PROBE_VAR 0
#endif
constexpr int D = 1024, BATCH = 8, SEQ = 4096, T = BATCH * SEQ, MEML = 256, TMEM = BATCH * MEML;
constexpr int INW = 5376;
constexpr int NTHREADS = 512, NWAVES = 8;
constexpr int NEXP = 16384;
constexpr float EPS = 1e-6f;

constexpr size_t MiB = 1u << 20;
constexpr size_t WS_WIN = 1 * MiB;
constexpr size_t WS_WBR = 12 * MiB;
constexpr size_t WS_WOUT = 16 * MiB;
constexpr size_t WS_WQ = 18 * MiB;
constexpr size_t WS_KEYS = 22 * MiB;
constexpr size_t WS_WPOOL = 22 * MiB + 512 * 1024;
constexpr size_t WS_RSTD1 = 22 * MiB + 768 * 1024;
constexpr size_t WS_RSTD2 = 22 * MiB + 896 * 1024;
constexpr size_t WS_RSTDM = 23 * MiB;
constexpr size_t WS_SSQO = 23 * MiB + 64 * 1024;
constexpr size_t WS_SU = 23 * MiB + 256 * 1024;
constexpr size_t WS_WMKV = 24 * MiB;
constexpr size_t WS_MEMB = 26 * MiB;
constexpr size_t WS_KVM = 30 * MiB;
constexpr size_t WS_ROPE = 34 * MiB;
constexpr size_t WS_XB = 42 * MiB;
constexpr size_t WS_POOLED = 42 * MiB;
constexpr size_t WS_MERGED = 170 * MiB;
constexpr size_t WS_U16 = 106 * MiB;
constexpr size_t WS_V16 = 138 * MiB;
constexpr size_t WS_UPOOL = 170 * MiB;
constexpr size_t WS_QR = 202 * MiB;
constexpr size_t WS_KR = 266 * MiB;
constexpr size_t WS_VV = 274 * MiB;
constexpr size_t WS_QM = 282 * MiB;
constexpr size_t WS_GATES = 314 * MiB;
constexpr size_t WS_X1B = 234 * MiB;
constexpr size_t WS_QP = 314 * MiB;
constexpr size_t WS_COEF = 314 * MiB;
constexpr size_t WS_IDS = 442 * MiB;
constexpr size_t WS_GTS = 458 * MiB;
constexpr size_t WS_END = 512 * MiB;

struct Params {
    const float* x; const float* mem; const int* pos; const float* norm1_g; const float* mem_norm_g; const float* w_in; const float* w_pool;
    const float* pool_scale; const float* sinks; const float* w_mem_kv; const float* w_bpool; const float* w_bswa; const float* w_bmem; const float* w_out;
    const float* norm2_g; const float* w_q; const float* sub_keys; const float* peer_u; const float* peer_v; const float* final_g;
    float* out; unsigned char* ws;
    int use_cg_sync; int pad_;
};

DI unsigned f2bf(float f) { unsigned u = __builtin_bit_cast(unsigned, f); return (u + 0x7fffu + ((u >> 16) & 1u)) >> 16; }
DI unsigned pk2(float lo, float hi) { return f2bf(lo) | (f2bf(hi) << 16); }
DI float bf2f(bf16_t b) { return __builtin_bit_cast(float, (unsigned)b << 16); }
DI float bflo(unsigned w) { return __builtin_bit_cast(float, w << 16); }
DI float bfhi(unsigned w) { return __builtin_bit_cast(float, w & 0xffff0000u); }
DI float wave_sum(float v) {
#pragma unroll
    for (int o = 1; o < 64; o <<= 1) v += __shfl_xor(v, o);
    return v;
}
DI float wave_max(float v) {
#pragma unroll
    for (int o = 1; o < 64; o <<= 1) v = fmaxf(v, __shfl_xor(v, o));
    return v;
}
DI float gelu_tanh(float x) {
    const float y2 = 1.5957691216057308f * (x + 0.044715f * x * x * x);
    return x * __builtin_amdgcn_rcpf(1.f + __builtin_amdgcn_exp2f(-1.4426950408889634f * y2));
}
DI float sigmoidf(float x) { return __builtin_amdgcn_rcpf(1.f + __builtin_amdgcn_exp2f(-1.4426950408889634f * x)); }

DI int opaque_tid() { int t = threadIdx.x; asm volatile("" : "+v"(t)); return t; }
DI int zperm(int n) {
    if (n < 512 || n >= 1664) return n;
    const int d = (n - 512) & 63, hb = n - d; return hb + 8 * ((d & 31) >> 2) + (d & 3) + 4 * (d >> 5);
}
template <bool ZPERM>
DI void transpose_item(const float* W, int K, int N, bf16_t* WT, int ldt, int roff, int coff, const float* g, float* scr, int item, int lane) {
    const int nblk = N / 32, kb = item / nblk, nb = item % nblk, k0 = 64 * kb, n0 = 32 * nb;
    float tv[32];
#pragma unroll
    for (int i = 0; i < 32; ++i) tv[i] = W[(size_t)(k0 + 2 * i + (lane >> 5)) * N + n0 + (lane & 31)];
#pragma unroll
    for (int i = 0; i < 32; ++i) { const int kk = 2 * i + (lane >> 5); float v = tv[i]; if (g) v *= g[k0 + kk]; scr[kk * 33 + (lane & 31)] = v; }
    asm volatile("s_waitcnt lgkmcnt(0)" ::: "memory");
    const int c = lane & 7;
#pragma unroll
    for (int j = 0; j < 4; ++j) { const int n = (lane >> 3) + 8 * j; const float* s = scr + (8 * c) * 33 + n;
        u32x4 o; o.x = pk2(s[0 * 33], s[1 * 33]); o.y = pk2(s[2 * 33], s[3 * 33]); o.z = pk2(s[4 * 33], s[5 * 33]); o.w = pk2(s[6 * 33], s[7 * 33]);
        const int nd = ZPERM ? zperm(n0 + n) : n0 + n;
        *(u32x4*)(WT + (size_t)(roff + nd) * ldt + coff + k0 + 8 * c) = o; }
    asm volatile("s_waitcnt lgkmcnt(0)" ::: "memory");
}

DI void row_to_bf16_rstd(const float* xrow, bf16_t* orow, float* rstd_out, int lane) {
    const f32x4* xr = (const f32x4*)xrow + lane;
    f32x4 v[4]; float s = 0.f;
#pragma unroll
    for (int j = 0; j < 4; ++j) { v[j] = xr[64 * j]; s += (v[j].x * v[j].x + v[j].y * v[j].y) + (v[j].z * v[j].z + v[j].w * v[j].w); }
    s = wave_sum(s);
    if (lane == 0) *rstd_out = 1.f / sqrtf(s * (1.f / D) + EPS);
    u32x2* o8 = (u32x2*)orow + lane;
#pragma unroll
    for (int j = 0; j < 4; ++j) { u32x2 w; w.x = pk2(v[j].x, v[j].y); w.y = pk2(v[j].z, v[j].w); o8[64 * j] = w; }
}

DI void phase0(const Params& p, float* lds_f) {
    const int tid_ = opaque_tid(), lane = tid_ & 63, wave = tid_ >> 6, gw = blockIdx.x * NWAVES + wave, NGW = gridDim.x * NWAVES;
    unsigned char* ws = p.ws;
    float* scr = lds_f + wave * (64 * 33);
    bf16_t* WinT = (bf16_t*)(ws + WS_WIN); bf16_t* WbrT = (bf16_t*)(ws + WS_WBR); bf16_t* WoutT = (bf16_t*)(ws + WS_WOUT); bf16_t* WqT = (bf16_t*)(ws + WS_WQ);
    bf16_t* WmkvT = (bf16_t*)(ws + WS_WMKV);
    constexpr int I_IN = (D / 64) * (INW / 32), I_BS = (1024 / 64) * (D / 32), I_BM = (512 / 64) * (D / 32), I_OUT = (D / 64) * (D / 32), I_Q = (D / 64) * (2048 / 32), I_MKV = (D / 64) * (D / 32);
    constexpr int NITEMS = I_IN + I_BS + I_BM + I_OUT + I_Q + I_MKV;
    for (int rp_ = 0; rp_ < (DUP_PHASE == 10 ? 2 : 1); ++rp_) {
    for (int it = gw; it < NITEMS; it += NGW) {
        int r = it;
        if (r < I_IN) { transpose_item<true>(p.w_in, D, INW, WinT, D, 0, 0, p.norm1_g, scr, r, lane); continue; } r -= I_IN;
        if (r < I_BS) { transpose_item<false>(p.w_bswa, 1024, D, WbrT, 2048, 0, 512, nullptr, scr, r, lane); continue; } r -= I_BS;
        if (r < I_BM) { transpose_item<false>(p.w_bmem, 512, D, WbrT, 2048, 0, 1536, nullptr, scr, r, lane); continue; } r -= I_BM;
        if (r < I_OUT) { transpose_item<false>(p.w_out, D, D, WoutT, D, 0, 0, nullptr, scr, r, lane); continue; } r -= I_OUT;
        if (r < I_Q) { transpose_item<false>(p.w_q, D, 2048, WqT, D, 0, 0, p.norm2_g, scr, r, lane); continue; } r -= I_Q;
        transpose_item<false>(p.w_mem_kv, D, D, WmkvT, D, 0, 0, p.mem_norm_g, scr, r, lane);
    }
    }
    for (int rp_ = 0; rp_ < (DUP_PHASE == 11 ? 2 : 1); ++rp_) {
    {
        const size_t gt0 = (size_t)gw * 64 + lane, NGT0 = (size_t)NGW * 64;
        for (size_t i = gt0; i < (size_t)512 * 256; i += NGT0) {
            const int n4 = (int)(i & 255), cp = (int)(i >> 8), g = cp >> 7;
            const float* wp = p.w_pool + (size_t)cp * 128; const float* sc = p.pool_scale + g * 128; const f32x4* wb = (const f32x4*)(p.w_bpool + (size_t)(g * 128) * 1024) + n4;
            f32x4 a = {0.f, 0.f, 0.f, 0.f};
#pragma unroll 16
            for (int d = 0; d < 128; ++d) a += wb[(size_t)d * 256] * (wp[d] * sc[d]);
            bf16_t* o = WbrT + (size_t)(4 * n4) * 2048 + cp;
            o[0] = (bf16_t)f2bf(a.x); o[2048] = (bf16_t)f2bf(a.y); o[4096] = (bf16_t)f2bf(a.z); o[6144] = (bf16_t)f2bf(a.w);
        }
    }
    }
    bf16_t* xb = (bf16_t*)(ws + WS_XB); float* rstd1 = (float*)(ws + WS_RSTD1);
    for (int rp_ = 0; rp_ < (DUP_PHASE == 12 ? 2 : 1); ++rp_) {
    for (int m = gw; m < T; m += 4 * NGW) {
        f32x4 v[4][4];
#pragma unroll
        for (int q = 0; q < 4; ++q) { const int mq = (m + q * NGW < T) ? m + q * NGW : m; const f32x4* xr = (const f32x4*)(p.x + (size_t)mq * D) + lane;
#pragma unroll
            for (int j = 0; j < 4; ++j) v[q][j] = xr[64 * j]; }
#pragma unroll
        for (int q = 0; q < 4; ++q) { const int mq = m + q * NGW; float s = 0.f;
#pragma unroll
            for (int j = 0; j < 4; ++j) s += (v[q][j].x * v[q][j].x + v[q][j].y * v[q][j].y) + (v[q][j].z * v[q][j].z + v[q][j].w * v[q][j].w);
            s = wave_sum(s);
            if (mq < T) { if (lane == 0) rstd1[mq] = __builtin_amdgcn_rsqf(s * (1.f / D) + EPS);
                u32x2* o8 = (u32x2*)(xb + (size_t)mq * D) + lane;
#pragma unroll
                for (int j = 0; j < 4; ++j) { u32x2 wv; wv.x = pk2(v[q][j].x, v[q][j].y); wv.y = pk2(v[q][j].z, v[q][j].w); o8[64 * j] = wv; } } }
    }
    }
    bf16_t* memb = (bf16_t*)(ws + WS_MEMB); float* rstdm = (float*)(ws + WS_RSTDM);
    for (int m = gw; m < TMEM; m += NGW) row_to_bf16_rstd(p.mem + (size_t)m * D, memb + (size_t)m * D, rstdm + m, lane);
    const size_t gt = (size_t)gw * 64 + lane, NGT = (size_t)NGW * 64;
    bf16_t* keysb = (bf16_t*)(ws + WS_KEYS);
    for (size_t i = gt; i < (size_t)8 * 2 * 128 * 128 / 4; i += NGT) { const f32x4 v = ((const f32x4*)p.sub_keys)[i]; u32x2 w; w.x = pk2(v.x, v.y); w.y = pk2(v.z, v.w); ((u32x2*)keysb)[i] = w; }
    for (int rp_ = 0; rp_ < (DUP_PHASE == 14 ? 2 : 1); ++rp_) {
    {
        unsigned* u8 = (unsigned*)(ws + WS_U16); unsigned* v8 = (unsigned*)(ws + WS_V16); float* su = (float*)(ws + WS_SU);
        f32x4 g2r[4];
#pragma unroll
        for (int j = 0; j < 4; ++j) g2r[j] = ((const f32x4*)p.norm2_g)[lane + 64 * j];
        for (int r0 = gw; r0 < NEXP; r0 += 2 * NGW) {
            f32x4 au[2][4], av[2][4];
#pragma unroll
            for (int h = 0; h < 2; ++h) { const int r = (r0 + h * NGW < NEXP) ? r0 + h * NGW : r0;
#pragma unroll
                for (int j = 0; j < 4; ++j) { au[h][j] = ((const f32x4*)p.peer_u)[(size_t)r * 256 + lane + 64 * j]; av[h][j] = ((const f32x4*)p.peer_v)[(size_t)r * 256 + lane + 64 * j]; } }
#pragma unroll
            for (int h = 0; h < 2; ++h) { const int r = r0 + h * NGW; if (r >= NEXP) continue;
                float mx = 0.f;
#pragma unroll
                for (int j = 0; j < 4; ++j) { au[h][j] = au[h][j] * g2r[j]; mx = fmaxf(fmaxf(mx, fmaxf(fabsf(au[h][j].x), fabsf(au[h][j].y))), fmaxf(fabsf(au[h][j].z), fabsf(au[h][j].w))); }
                mx = wave_max(mx);
                const float inv = mx > 0.f ? 127.f / mx : 0.f;
                if (lane == 0) su[r] = mx * (1.f / 127.f);
#pragma unroll
                for (int j = 0; j < 4; ++j) { const f32x4 b = av[h][j] * 2.f;
                    const int q0 = (int)__builtin_rintf(au[h][j].x * inv), q1 = (int)__builtin_rintf(au[h][j].y * inv), q2 = (int)__builtin_rintf(au[h][j].z * inv), q3 = (int)__builtin_rintf(au[h][j].w * inv);
                    const unsigned wa = (unsigned)(q0 & 255) | ((unsigned)(q1 & 255) << 8) | ((unsigned)(q2 & 255) << 16) | ((unsigned)q3 << 24);
                    int wb = __builtin_amdgcn_cvt_pk_fp8_f32(b.x, b.y, 0, false); wb = __builtin_amdgcn_cvt_pk_fp8_f32(b.z, b.w, wb, true);
                    u8[(size_t)r * 256 + lane + 64 * j] = wa; v8[(size_t)r * 256 + lane + 64 * j] = (unsigned)wb; } }
        }
    }
    }
    for (size_t i = gt; i < (size_t)T; i += NGT) { ((float*)(ws + WS_RSTD2))[i] = 0.f; ((float*)(ws + WS_SSQO))[i] = 0.f; }
    for (int rp_ = 0; rp_ < (DUP_PHASE == 15 ? 2 : 1); ++rp_) {
    float2* rope = (float2*)(ws + WS_ROPE);
    for (size_t i = gt; i < (size_t)T * 32; i += NGT) {
        const int t = (int)(i >> 5), d = (int)(i & 31);
        const float inv = exp2f(-(float)d * (13.287712379549449f / 32.f));
        const float ang = (float)p.pos[t] * inv;
        const double rev = (double)ang * 0.15915494309189535;
        const float fr = (float)(rev - floor(rev));
        rope[i] = make_float2(__builtin_amdgcn_cosf(fr), __builtin_amdgcn_sinf(fr));
    }
    }
}

namespace pg8 {
#define PG8_LAS __attribute__((address_space(3)))
constexpr int BM = 256, BK = 64, HALF = 128, HTB = HALF * BK * 2, STAGE_BYTES = 8 * HTB, NXCD = 8;
__host__ __device__ __forceinline__ int lds_byte(int r, int c) { const int st = (r >> 4) * 2 + (c >> 5), rr = r & 15, cc = c & 31, ob = rr * 64 + cc * 2; return st * 1024 + (ob ^ (((ob >> 9) & 1) << 5)); }
__host__ __device__ __forceinline__ void stage_rc(int b, int& R, int& C) { const int st = b / 1024, sb = b % 1024, swz = sb ^ (((sb >> 9) & 1) << 5); R = (st >> 1) * 16 + swz / 64; C = (st & 1) * 32 + (swz % 64) / 2; }
__host__ __device__ __forceinline__ int perm32(int rho) { const int n = rho >> 4, i = rho & 15; return 8 * (i >> 2) + 4 * n + (i & 3); }

struct Unit { const char* a; const char* b; int nt, pm, pn, tag; };
DI void tile_of(int L, int nM, int nN, int& pm, int& pn, int WGM = 4) {
    const int nwg = nM * nN; int wgid = L; { const int q = nwg / NXCD, r = nwg % NXCD, xcd = wgid % NXCD, off = wgid / NXCD; wgid = (xcd < r ? xcd * (q + 1) : r * (q + 1) + (xcd - r) * q) + off; }
    const int nig = WGM * nN, gid = wgid / nig, fm = gid * WGM, gsz = (nM - fm) < WGM ? (nM - fm) : WGM;
    pm = fm + ((wgid % nig) % gsz); pn = (wgid % nig) / gsz;
}
template <class Epi, class Sched>
DI void gemm_phase(PG8_LAS unsigned char* lds, int lda, int ldb, const Sched& S, const Epi& E) {
    int tid = threadIdx.x; asm volatile("" : "+v"(tid));
    const int wid = __builtin_amdgcn_readfirstlane(tid >> 6), wr = wid >> 2, wc = wid & 3, lane = tid & 63, fr = lane & 15, fq = lane >> 4;
    unsigned voffA[2], voffB[2];
#pragma unroll
    for (int i = 0; i < 2; ++i) { int R, C; stage_rc(tid * 16 + i * 8192, R, C); const int Rb = 64 * (R >> 5) + perm32(R & 31);
        voffA[i] = (unsigned)(R * lda + C) * 2u; voffB[i] = (unsigned)(Rb * ldb + C) * 2u; }
    const size_t kstep = (size_t)(BK * 2);
    const size_t hstepA = (size_t)HALF * lda * 2, hstepB = (size_t)32 * ldb * 2;
    const unsigned ldsw = (unsigned)wid * 1024u;
    const int aoff = lds_byte(wr * 64 + fr, fq * 8), boff = lds_byte(wc * 32 + fr, fq * 8);
#define PG8_SA(b, h) (((b) * 2 + (h)) * HTB)
#define PG8_SB(b, h) ((4 + (b) * 2 + (h)) * HTB)
#define PG8_STAGE(bufoff, gbase, voff) do { _Pragma("unroll") for (int _i = 0; _i < 2; ++_i) \
        __builtin_amdgcn_global_load_lds((const unsigned*)((const char*)(gbase) + (voff)[_i]), (PG8_LAS unsigned*)(lds + (bufoff) + ldsw + _i * 8192), 16, 0, 0); } while (0)
#define PG8_LDA(dst, b, h) do { _Pragma("unroll") for (int m = 0; m < 4; ++m) _Pragma("unroll") for (int k = 0; k < 2; ++k) dst[m][k] = *(const PG8_LAS bf16x8*)(lds + PG8_SA(b, h) + aoff + m * 2048 + k * 1024); } while (0)
#define PG8_LDB(dst, b, h) do { _Pragma("unroll") for (int n = 0; n < 2; ++n) _Pragma("unroll") for (int k = 0; k < 2; ++k) dst[n][k] = *(const PG8_LAS bf16x8*)(lds + PG8_SB(b, h) + boff + n * 2048 + k * 1024); } while (0)
#define PG8_MMA(ai, bj, At, Bt) do { __builtin_amdgcn_s_setprio(1); _Pragma("unroll") for (int m = 0; m < 4; ++m) _Pragma("unroll") for (int n = 0; n < 2; ++n) _Pragma("unroll") for (int k = 0; k < 2; ++k) \
        acc[ai][bj][m][n] = __builtin_amdgcn_mfma_f32_16x16x32_bf16(Bt[n][k], At[m][k], acc[ai][bj][m][n], 0, 0, 0); __builtin_amdgcn_s_setprio(0); } while (0)
#define PG8_WAIT_V(n) asm volatile("s_waitcnt vmcnt(" #n ")" ::: "memory")
#define PG8_WAIT_L(n) asm volatile("s_waitcnt lgkmcnt(" #n ")" ::: "memory")
#define PG8_BAR __builtin_amdgcn_s_barrier()
#define PG8_SCHED __builtin_amdgcn_sched_barrier(0)
    Unit cur, nxt; int ui = 0;
    if (!S.next(0, cur)) return;
    f32x4 acc[2][2][4][2];
#pragma unroll
    for (int a = 0; a < 2; ++a)
#pragma unroll
        for (int b = 0; b < 2; ++b)
#pragma unroll
            for (int m = 0; m < 4; ++m)
#pragma unroll
                for (int n = 0; n < 2; ++n) acc[a][b][m][n] = (f32x4){0.f, 0.f, 0.f, 0.f};
    bf16x8 At[4][2], B0[2][2], B1[2][2];
    const char* cA = cur.a; const char* cB = cur.b;
    PG8_STAGE(PG8_SB(0, 0), cB, voffB); PG8_STAGE(PG8_SB(0, 1), cB + hstepB, voffB); PG8_STAGE(PG8_SA(0, 0), cA, voffA); PG8_STAGE(PG8_SA(0, 1), cA + hstepA, voffA);
    if (wr == 1) PG8_BAR;
    PG8_WAIT_V(2); PG8_BAR;
    PG8_STAGE(PG8_SB(1, 0), cB + kstep, voffB); PG8_STAGE(PG8_SA(1, 0), cA + kstep, voffA); PG8_STAGE(PG8_SB(1, 1), cB + hstepB + kstep, voffB);
    PG8_WAIT_V(6); PG8_BAR;
    for (;;) {
        const bool has_next = S.next(ui + 1, nxt);
        const char* nA = has_next ? nxt.a : cA; const char* nB = has_next ? nxt.b : cB;
        const int nt = cur.nt;
        for (int t = 0; t < nt; t += 2) {
            const bool last = (t == nt - 2);
            const char* a1 = cA + (size_t)(t + 1) * kstep;
            const char* a2 = last ? nA : cA + (size_t)(t + 2) * kstep; const char* b2 = last ? nB : cB + (size_t)(t + 2) * kstep;
            const char* a3 = a2 + kstep; const char* b3 = b2 + kstep;
            PG8_LDB(B0, 0, 0); PG8_LDB(B1, 0, 1); PG8_SCHED; PG8_LDA(At, 0, 0); PG8_STAGE(PG8_SA(1, 1), a1 + hstepA, voffA);
            PG8_WAIT_V(8); PG8_WAIT_L(0); PG8_BAR; PG8_MMA(0, 0, At, B0); PG8_MMA(0, 1, At, B1); PG8_BAR; PG8_SCHED;
            PG8_LDA(At, 0, 1); PG8_STAGE(PG8_SB(0, 0), b2, voffB); PG8_STAGE(PG8_SB(0, 1), b2 + hstepB, voffB); PG8_STAGE(PG8_SA(0, 0), a2, voffA);
            PG8_WAIT_V(8); PG8_WAIT_L(0); PG8_BAR; PG8_MMA(1, 0, At, B0); PG8_MMA(1, 1, At, B1); PG8_BAR; PG8_SCHED;
            PG8_LDB(B0, 1, 0); PG8_LDB(B1, 1, 1); PG8_SCHED; PG8_LDA(At, 1, 0); PG8_STAGE(PG8_SA(0, 1), a2 + hstepA, voffA);
            PG8_WAIT_V(8); PG8_WAIT_L(0); PG8_BAR; PG8_MMA(0, 0, At, B0); PG8_MMA(0, 1, At, B1); PG8_BAR; PG8_SCHED;
            PG8_LDA(At, 1, 1); PG8_STAGE(PG8_SB(1, 0), b3, voffB); PG8_STAGE(PG8_SB(1, 1), b3 + hstepB, voffB); PG8_STAGE(PG8_SA(1, 0), a3, voffA);
            PG8_WAIT_V(8); PG8_WAIT_L(0); PG8_BAR; PG8_MMA(1, 0, At, B0); PG8_MMA(1, 1, At, B1); PG8_BAR; PG8_SCHED;
        }
        if (wr == 0) PG8_BAR;
        const bool keep_ = E(acc, cur, wr, wc, fr, fq);
        if (!has_next) break;
        if (!keep_)
#pragma unroll
        for (int a = 0; a < 2; ++a)
#pragma unroll
            for (int b = 0; b < 2; ++b)
#pragma unroll
                for (int m = 0; m < 4; ++m)
#pragma unroll
                    for (int n = 0; n < 2; ++n) acc[a][b][m][n] = (f32x4){0.f, 0.f, 0.f, 0.f};
        cur = nxt; cA = nA; cB = nB; ++ui;
        if (wr == 1) PG8_BAR;
    }
    PG8_WAIT_V(0);
    PG8_BAR;
#undef PG8_SA
#undef PG8_SB
#undef PG8_STAGE
#undef PG8_LDA
#undef PG8_LDB
#undef PG8_MMA
#undef PG8_WAIT_V
#undef PG8_WAIT_L
#undef PG8_BAR
#undef PG8_SCHED
}
}
typedef f32x4 acc_t[2][2][4][2];

struct SchedPlain {
    const char* A; const char* Bt; int lda, ldb, nM, nN, nt, G, c;
    DI bool next(int i, pg8::Unit& u) const {
        const long L = (long)i * G + c; if (L >= (long)nM * nN) return false;
        pg8::tile_of((int)L, nM, nN, u.pm, u.pn); u.a = A + (size_t)u.pm * 256 * lda * 2; u.b = Bt + (size_t)u.pn * 256 * ldb * 2; u.nt = nt; u.tag = 0; return true;
    }
};
struct SchedZ {
    const char *xb, *win, *memb, *wmkv; int G, c;
    DI bool next(int i, pg8::Unit& u) const {
        const long L = (long)i * G + c; constexpr int NZ = 128 * 21;
        if (L < NZ) { pg8::tile_of((int)L, 128, 21, u.pm, u.pn); u.a = xb + (size_t)u.pm * 256 * 2048; u.b = win + (size_t)u.pn * 256 * 2048; u.nt = 16; u.tag = 0; return true; }
        const int j = (int)(L - NZ); if (j >= 32) return false;
        u.pm = j >> 2; u.pn = j & 3; u.a = memb + (size_t)u.pm * 256 * 2048; u.b = wmkv + (size_t)u.pn * 256 * 2048; u.nt = 16; u.tag = 1; return true;
    }
};
struct SchedGated {
    const char *ycat, *wbr; int G, c;
    DI bool next(int i, pg8::Unit& u) const {
        const int j = i / 3, b = i - 3 * j; const long L = (long)j * G + c; if (L >= 128 * 4) return false;
        pg8::tile_of((int)L, 128, 4, u.pm, u.pn);
        const int koff = (b == 0) ? 0 : (b == 1 ? 512 : 1536);
        u.a = ycat + ((size_t)u.pm * 256 * 2048 + koff) * 2; u.b = wbr + ((size_t)u.pn * 256 * 2048 + koff) * 2; u.nt = (b == 1) ? 16 : 8; u.tag = b; return true;
    }
};

template <int CTRL> DI unsigned dpp_u(unsigned v) { return (unsigned)__builtin_amdgcn_update_dpp(0, (int)v, CTRL, 0xf, 0xf, false); }
DI void store_lines16(bf16_t* blk  , size_t ld, int fr, const u32x4& P0, const u32x4& P1) {
    const bool lo = fr < 8;
    const u32x4 X = lo ? P1 : P0;
    u32x4 Y; Y.x = dpp_u<0x128>(X.x); Y.y = dpp_u<0x128>(X.y); Y.z = dpp_u<0x128>(X.z); Y.w = dpp_u<0x128>(X.w);
    const u32x4 A = lo ? P0 : Y, B = lo ? Y : P1;
    bf16_t* pa = blk + (size_t)(fr & 7) * ld + 32 * (fr >> 3);
    *(u32x4*)pa = A; *(u32x4*)(pa + 8 * ld) = B;
}
DI void store_lines8(unsigned char* blk  , size_t ld, int fr, const u32x2& P0, const u32x2& P1) {
    const bool lo = fr < 8;
    const u32x2 X = lo ? P1 : P0;
    u32x2 Y; Y.x = dpp_u<0x128>(X.x); Y.y = dpp_u<0x128>(X.y);
    const u32x2 A = lo ? P0 : Y, B = lo ? Y : P1;
    unsigned char* pa = blk + (size_t)(fr & 7) * ld + 32 * (fr >> 3);
    *(u32x2*)pa = A; *(u32x2*)(pa + 8 * ld) = B;
}
DI u32x4 pack8(const f32x4& a, const f32x4& b) { u32x4 w; w.x = pk2(a[0], a[1]); w.y = pk2(a[2], a[3]); w.z = pk2(b[0], b[1]); w.w = pk2(b[2], b[3]); return w; }
struct EpiZ {
    const float* rstd1; const float* rstdm; const float2* rope; bf16_t *upool, *qr, *kr, *vv, *qm; unsigned char* gates; bf16_t* kvm;
    DI bool operator()(const acc_t& acc, const pg8::Unit& u, int wr, int wc, int fr_, int fq_) const {
        int l_ = threadIdx.x; asm volatile("" : "+v"(l_)); const int fr = l_ & 15, fq = (l_ >> 4) & 3;
        const int row0 = u.pm * 256 + wr * 64 + fr;
        const float* rsp = (u.tag == 1) ? rstdm : rstd1;
        float rs[2][4];
#pragma unroll
        for (int ai = 0; ai < 2; ++ai)
#pragma unroll
            for (int m = 0; m < 4; ++m) rs[ai][m] = rsp[row0 + ai * 128 + m * 16];
        if (u.tag == 1) {
            bf16_t* tile = kvm + (size_t)(u.pm * 256 + wr * 64) * 1024 + u.pn * 256 + wc * 64 + 8 * fq;
#pragma unroll
            for (int ai = 0; ai < 2; ++ai)
#pragma unroll
                for (int m = 0; m < 4; ++m) store_lines16(tile + (size_t)(ai * 128 + m * 16) * 1024, 1024, fr, pack8(acc[ai][0][m][0] * rs[ai][m], acc[ai][0][m][1] * rs[ai][m]), pack8(acc[ai][1][m][0] * rs[ai][m], acc[ai][1][m][1] * rs[ai][m]));
            return false;
        }
        const int cb = u.pn * 256 + wc * 64;
        if (cb >= 512 && cb < 1664) {
#pragma unroll
            for (int bj = 0; bj < 2; ++bj) {
                const int c = cb + bj * 32 + 8 * fq;
                const bool isq = cb < 1536; const int rel = isq ? c - 512 : c - 1536; const int hrel = rel & 63, d0 = hrel >> 1, hb = rel - hrel;
                const float sc = isq ? 0.125f : 1.f;
#pragma unroll
                for (int ai = 0; ai < 2; ++ai) {
                    f32x4 cs0[4], cs1[4];
#pragma unroll
                    for (int m = 0; m < 4; ++m) { const int row = row0 + ai * 128 + m * 16;
                        cs0[m] = *(const f32x4*)(rope + (size_t)row * 32 + d0); cs1[m] = *(const f32x4*)(rope + (size_t)row * 32 + d0 + 2); }
#pragma unroll
                    for (int m = 0; m < 4; ++m) { const int row = row0 + ai * 128 + m * 16;
                        const f32x4 v0 = acc[ai][bj][m][0] * rs[ai][m], v1 = acc[ai][bj][m][1] * rs[ai][m], a0 = cs0[m], a1 = cs1[m];
                        f32x4 o1, o2;
                        o1[0] = (v0[0] * a0[0] - v1[0] * a0[1]) * sc; o2[0] = (v1[0] * a0[0] + v0[0] * a0[1]) * sc;
                        o1[1] = (v0[1] * a0[2] - v1[1] * a0[3]) * sc; o2[1] = (v1[1] * a0[2] + v0[1] * a0[3]) * sc;
                        o1[2] = (v0[2] * a1[0] - v1[2] * a1[1]) * sc; o2[2] = (v1[2] * a1[0] + v0[2] * a1[1]) * sc;
                        o1[3] = (v0[3] * a1[2] - v1[3] * a1[3]) * sc; o2[3] = (v1[3] * a1[2] + v0[3] * a1[3]) * sc;
                        bf16_t* dst = isq ? qr + (size_t)row * 1024 + hb + d0 : kr + (size_t)row * 128 + hb + d0;
                        u32x2 w1, w2; w1.x = pk2(o1[0], o1[1]); w1.y = pk2(o1[2], o1[3]); w2.x = pk2(o2[0], o2[1]); w2.y = pk2(o2[2], o2[3]);
                        *(u32x2*)dst = w1; *(u32x2*)(dst + 32) = w2; }
                }
            }
        } else if (cb >= 2304) {
            unsigned char* tile = gates + (size_t)(u.pm * 256 + wr * 64) * 3072 + (cb - 2304) + 8 * fq;
#pragma unroll
            for (int ai = 0; ai < 2; ++ai)
#pragma unroll
                for (int m = 0; m < 4; ++m) {
                    u32x2 wq[2];
#pragma unroll
                    for (int bj = 0; bj < 2; ++bj) { const f32x4 v0 = acc[ai][bj][m][0] * rs[ai][m], v1 = acc[ai][bj][m][1] * rs[ai][m]; u32x2 w = {0u, 0u};
#pragma unroll
                        for (int e = 0; e < 4; ++e) {
                            const float t0 = __builtin_amdgcn_rcpf(__builtin_fmaf(__builtin_amdgcn_exp2f(-1.4426950408889634f * v0[e]), 1.f / 256.f, 1.f / 256.f));
                            const float t1 = __builtin_amdgcn_rcpf(__builtin_fmaf(__builtin_amdgcn_exp2f(-1.4426950408889634f * v1[e]), 1.f / 256.f, 1.f / 256.f));
                            w.x = __builtin_amdgcn_cvt_pk_u8_f32(__builtin_floorf(t0), e, w.x); w.y = __builtin_amdgcn_cvt_pk_u8_f32(__builtin_floorf(t1), e, w.y); }
                        wq[bj] = w; }
                    store_lines8(tile + (size_t)(ai * 128 + m * 16) * 3072, 3072, fr, wq[0], wq[1]);
                }
        } else {
            bf16_t* dstp; size_t ld;
            if (cb < 512) { dstp = upool + cb; ld = 512; } else if (cb < 1792) { dstp = vv + (cb - 1664); ld = 128; } else { dstp = qm + (cb - 1792); ld = 512; }
            bf16_t* tile = dstp + (size_t)(u.pm * 256 + wr * 64) * ld + 8 * fq;
#pragma unroll
            for (int ai = 0; ai < 2; ++ai)
#pragma unroll
                for (int m = 0; m < 4; ++m) store_lines16(tile + (size_t)(ai * 128 + m * 16) * ld, ld, fr, pack8(acc[ai][0][m][0] * rs[ai][m], acc[ai][0][m][1] * rs[ai][m]), pack8(acc[ai][1][m][0] * rs[ai][m], acc[ai][1][m][1] * rs[ai][m]));
        }
        return false;
    }
};
struct EpiGated {
    const unsigned char* gates; bf16_t* merged;
    static DI float gv(unsigned w, int e) { return ((float)((w >> (8 * e)) & 255u) + 0.5f) * (1.f / 256.f); }
    DI bool operator()(acc_t& acc, const pg8::Unit& u, int wr, int wc, int fr_, int fq_) const {
        int l_ = threadIdx.x; asm volatile("" : "+v"(l_)); const int fr = l_ & 15, fq = (l_ >> 4) & 3;
        const int row0 = u.pm * 256 + wr * 64 + fr, b = u.tag;
#pragma unroll
        for (int ai = 0; ai < 2; ++ai) {
            u32x2 gq[4][2], gnq[4][2];
#pragma unroll
            for (int m = 0; m < 4; ++m)
#pragma unroll
                for (int bj = 0; bj < 2; ++bj) { const unsigned char* gp = gates + (size_t)(row0 + ai * 128 + m * 16) * 3072 + b * 1024 + u.pn * 256 + wc * 64 + bj * 32 + 8 * fq;
                    gq[m][bj] = *(const u32x2*)gp; if (b < 2) gnq[m][bj] = *(const u32x2*)(gp + 1024); else gnq[m][bj] = gq[m][bj]; }
#pragma unroll
            for (int m = 0; m < 4; ++m) { const int row = row0 + ai * 128 + m * 16;
#pragma unroll
                for (int bj = 0; bj < 2; ++bj) { const int c = u.pn * 256 + wc * 64 + bj * 32 + 8 * fq;
                    const u32x2 g = gq[m][bj], gn = gnq[m][bj];
                    f32x4 s0, s1;
#pragma unroll
                    for (int e = 0; e < 4; ++e) { s0[e] = gv(g.x, e); s1[e] = gv(g.y, e); }
                    if (b < 2) {
#pragma unroll
                        for (int e = 0; e < 4; ++e) { s0[e] *= __builtin_amdgcn_rcpf(gv(gn.x, e)); s1[e] *= __builtin_amdgcn_rcpf(gv(gn.y, e)); }
                        acc[ai][bj][m][0] *= s0; acc[ai][bj][m][1] *= s1; }
                    else { acc[ai][bj][m][0] *= s0; acc[ai][bj][m][1] *= s1; } }
                if (b == 2) store_lines16(merged + (size_t)(u.pm * 256 + wr * 64 + ai * 128 + m * 16) * 1024 + u.pn * 256 + wc * 64 + 8 * fq, 1024, fr, pack8(acc[ai][0][m][0], acc[ai][0][m][1]), pack8(acc[ai][1][m][0], acc[ai][1][m][1])); }
        }
        return b < 2;
    }
};
struct EpiOut {
    const bf16_t* xb; bf16_t* x1b; float* ssq;
    DI bool operator()(const acc_t& acc, const pg8::Unit& u, int wr, int wc, int fr_, int fq_) const {
        int l_ = threadIdx.x; asm volatile("" : "+v"(l_)); const int fr = l_ & 15, fq = (l_ >> 4) & 3;
        const int row0 = u.pm * 256 + wr * 64 + fr;
#pragma unroll
        for (int ai = 0; ai < 2; ++ai) {
            u32x4 xq[4][2];
#pragma unroll
            for (int m = 0; m < 4; ++m)
#pragma unroll
                for (int bj = 0; bj < 2; ++bj) xq[m][bj] = *(const u32x4*)(xb + (size_t)(row0 + ai * 128 + m * 16) * D + u.pn * 256 + wc * 64 + bj * 32 + 8 * fq);
#pragma unroll
            for (int m = 0; m < 4; ++m) { const int row = row0 + ai * 128 + m * 16; float sq = 0.f; u32x4 pk[2];
#pragma unroll
                for (int bj = 0; bj < 2; ++bj) { const size_t o = (size_t)row * D + u.pn * 256 + wc * 64 + bj * 32 + 8 * fq;
                    const u32x4 xw = xq[m][bj];
                    f32x4 v0 = acc[ai][bj][m][0], v1 = acc[ai][bj][m][1];
                    v0[0] += bflo(xw.x); v0[1] += bfhi(xw.x); v0[2] += bflo(xw.y); v0[3] += bfhi(xw.y); v1[0] += bflo(xw.z); v1[1] += bfhi(xw.z); v1[2] += bflo(xw.w); v1[3] += bfhi(xw.w);
                    sq += (v0[0] * v0[0] + v0[1] * v0[1]) + (v0[2] * v0[2] + v0[3] * v0[3]) + (v1[0] * v1[0] + v1[1] * v1[1]) + (v1[2] * v1[2] + v1[3] * v1[3]);
                    pk[bj] = pack8(v0, v1); }
                store_lines16(x1b + (size_t)(u.pm * 256 + wr * 64 + ai * 128 + m * 16) * D + u.pn * 256 + wc * 64 + 8 * fq, D, fr, pk[0], pk[1]);
                sq += __shfl_xor(sq, 16); sq += __shfl_xor(sq, 32);
                if (fq == 0) atomicAdd(ssq + row, sq); }
        }
        return false;
    }
};
struct EpiBf16 {
    bf16_t* O; int ldo;
    DI bool operator()(const acc_t& acc, const pg8::Unit& u, int wr, int wc, int fr_, int fq_) const {
        int l_ = threadIdx.x; asm volatile("" : "+v"(l_)); const int fr = l_ & 15, fq = (l_ >> 4) & 3;
        bf16_t* tile = O + (size_t)(u.pm * 256 + wr * 64) * ldo + u.pn * 256 + wc * 64 + 8 * fq;
#pragma unroll
        for (int ai = 0; ai < 2; ++ai)
#pragma unroll
            for (int m = 0; m < 4; ++m) store_lines16(tile + (size_t)(ai * 128 + m * 16) * ldo, (size_t)ldo, fr, pack8(acc[ai][0][m][0], acc[ai][0][m][1]), pack8(acc[ai][1][m][0], acc[ai][1][m][1]));
        return false;
    }
};

DI void unpack8(const u32x4& w, float (&f)[8]) { f[0] = bflo(w.x); f[1] = bfhi(w.x); f[2] = bflo(w.y); f[3] = bfhi(w.y); f[4] = bflo(w.z); f[5] = bfhi(w.z); f[6] = bflo(w.w); f[7] = bfhi(w.w); }
DI void pooled_phase(const bf16_t* upool, bf16_t* pooled) {
    const int tid = opaque_tid(), lane = tid & 63, gw = blockIdx.x * NWAVES + (tid >> 6), NGW = gridDim.x * NWAVES;
    const int c = lane * 8, w = 2 << (lane >> 4);
    for (int task = gw; task < T / 16; task += NGW) {
        const int t0 = task * 16, s0 = t0 & (SEQ - 1);
        const bf16_t* up = upool + (size_t)t0 * 512 + c;
        u32x4 hw[15], nw[16], ow[16];
#pragma unroll
        for (int j = 1; j < 16; ++j) { const int jj = (s0 - j >= 0) ? j : 0; hw[j - 1] = *(const u32x4*)(up - (ptrdiff_t)jj * 512); }
#pragma unroll
        for (int i = 0; i < 16; ++i) { nw[i] = *(const u32x4*)(up + (size_t)i * 512); const int back = (s0 + i - (w - 1) >= 0) ? (w - 1) : 0; ow[i] = *(const u32x4*)(up + (ptrdiff_t)(i - back) * 512); }
        float win[8];
#pragma unroll
        for (int e = 0; e < 8; ++e) win[e] = 0.f;
#pragma unroll
        for (int j = 1; j < 16; ++j) { float f[8]; unpack8(hw[j - 1], f); const float mk = (j < w && s0 - j >= 0) ? 1.f : 0.f;
#pragma unroll
            for (int e = 0; e < 8; ++e) win[e] += mk * f[e]; }
#pragma unroll
        for (int i = 0; i < 16; ++i) {
            const int s = s0 + i;
            float un[8], uo[8];
            unpack8(nw[i], un); unpack8(ow[i], uo);
            const float mo = (s - (w - 1) >= 0) ? 1.f : 0.f;
            const int cnt = (s + 1 < w) ? s + 1 : w; const float ic = __builtin_amdgcn_rcpf((float)cnt);
            float o[8];
#pragma unroll
            for (int e = 0; e < 8; ++e) { const float tot = win[e] + un[e]; o[e] = tot * ic - un[e]; win[e] = tot - mo * uo[e]; }
            u32x4 ov; ov.x = pk2(o[0], o[1]); ov.y = pk2(o[2], o[3]); ov.z = pk2(o[4], o[5]); ov.w = pk2(o[6], o[7]);
            *(u32x4*)(pooled + (size_t)(t0 + i) * 2048 + c) = ov;
        }
    }
}
typedef __bf16 bf16x2_t __attribute__((ext_vector_type(2)));
typedef float f32x2_t __attribute__((ext_vector_type(2)));
DI unsigned cvtpk(float lo, float hi) { f32x2_t v = {lo, hi}; bf16x2_t b = __builtin_convertvector(v, bf16x2_t); return __builtin_bit_cast(unsigned, b); }
DI int crow(int i, int h) { return (i & 3) + 8 * (i >> 2) + 4 * h; }
#define MFMA32(a, b, c) __builtin_amdgcn_mfma_f32_32x32x16_bf16((a), (b), (c), 0, 0, 0)
DI bf16x8 mk8(unsigned a, unsigned b, unsigned c, unsigned d) { u32x4 w = {a, b, c, d}; return __builtin_bit_cast(bf16x8, w); }

constexpr int SWA_KLD = 72, SWA_VLD = 260, SWA_VT_OFF = 256 * SWA_KLD * 2;
DI void swa_phase(const bf16_t* qr, const bf16_t* kr, const bf16_t* vv, const float* sinks, bf16_t* ycat, unsigned char* lds) {
    const int tid = opaque_tid();
    const int lane = tid & 63, w = tid >> 6, r = lane & 31, h = lane >> 5;
    bf16_t* Ks = (bf16_t*)lds; bf16_t* Vt = (bf16_t*)(lds + SWA_VT_OFF);
    for (int unit = blockIdx.x; unit < 512; unit += gridDim.x) {
        const int kvh = unit & 1, nb = (unit >> 1) & 31, b = unit >> 6;
        const int tq0 = b * SEQ + nb * 128, tk0 = tq0 - 128;
        const int hq = kvh * 8 + w; const float sink = sinks[hq];
        bf16x8 qn[4];
        { const bf16_t* qp = qr + (size_t)(tq0 + r) * 1024 + hq * 64 + 8 * h;
#pragma unroll
          for (int s = 0; s < 4; ++s) qn[s] = *(const bf16x8*)(qp + 16 * s); }
        __syncthreads();
#pragma unroll
        for (int i = 0; i < 4; ++i) {
            const int c = tid + 512 * i, kb = c >> 3, dc = (c & 7) * 8;
            u32x4 kv = {0u, 0u, 0u, 0u}, vx = {0u, 0u, 0u, 0u};
            if (nb > 0 || kb >= 128) { kv = *(const u32x4*)(kr + (size_t)(tk0 + kb) * 128 + kvh * 64 + dc); vx = *(const u32x4*)(vv + (size_t)(tk0 + kb) * 128 + kvh * 64 + dc); }
            *(u32x4*)(Ks + kb * SWA_KLD + dc) = kv;
            bf16_t* vp = Vt + dc * SWA_VLD + kb;
            vp[0 * SWA_VLD] = (bf16_t)(vx.x & 0xffffu); vp[1 * SWA_VLD] = (bf16_t)(vx.x >> 16); vp[2 * SWA_VLD] = (bf16_t)(vx.y & 0xffffu); vp[3 * SWA_VLD] = (bf16_t)(vx.y >> 16);
            vp[4 * SWA_VLD] = (bf16_t)(vx.z & 0xffffu); vp[5 * SWA_VLD] = (bf16_t)(vx.z >> 16); vp[6 * SWA_VLD] = (bf16_t)(vx.w & 0xffffu); vp[7 * SWA_VLD] = (bf16_t)(vx.w >> 16);
        }
        __syncthreads();
        for (int qt = 0; qt < 4; ++qt) {
            bf16x8 qf[4];
#pragma unroll
            for (int s = 0; s < 4; ++s) qf[s] = qn[s];
            if (qt < 3) { const bf16_t* qp = qr + (size_t)(tq0 + 32 * (qt + 1) + r) * 1024 + hq * 64 + 8 * h;
#pragma unroll
                for (int s = 0; s < 4; ++s) qn[s] = *(const bf16x8*)(qp + 16 * s); }
            f32x16 sa[5];
#pragma unroll
            for (int c = 0; c < 5; ++c) {
#pragma unroll
                for (int i = 0; i < 16; ++i) sa[c][i] = 0.f;
#pragma unroll
                for (int s = 0; s < 4; ++s) { const bf16x8 kf = *(const bf16x8*)(Ks + (32 * (qt + c) + r) * SWA_KLD + 16 * s + 8 * h); sa[c] = MFMA32(kf, qf[s], sa[c]); }
            }
            float mx = sink;
#pragma unroll
            for (int c = 0; c < 5; ++c)
#pragma unroll
                for (int i = 0; i < 16; ++i) {
                    const int kk = 32 * c + crow(i, h);
                    bool vis = (c == 0) ? (kk > r) : ((c == 4) ? (kk - 128 <= r) : true);
                    if (nb == 0) vis = vis && (32 * qt + kk >= 128);
                    const float s = vis ? sa[c][i] : -1e30f; sa[c][i] = s; mx = fmaxf(mx, s);
                }
            mx = fmaxf(mx, __shfl_xor(mx, 32));
            float l = 0.f;
#pragma unroll
            for (int c = 0; c < 5; ++c)
#pragma unroll
                for (int i = 0; i < 16; ++i) { const float pz = __expf(sa[c][i] - mx); sa[c][i] = pz; l += pz; }
            l += __shfl_xor(l, 32); l += __expf(sink - mx);
            const float inv = 1.f / l;
            f32x16 oa[2];
#pragma unroll
            for (int i = 0; i < 16; ++i) { oa[0][i] = 0.f; oa[1][i] = 0.f; }
#pragma unroll
            for (int c = 0; c < 5; ++c)
#pragma unroll
                for (int s2 = 0; s2 < 2; ++s2) {
                    const bf16x8 pf = mk8(cvtpk(sa[c][8 * s2 + 0], sa[c][8 * s2 + 1]), cvtpk(sa[c][8 * s2 + 2], sa[c][8 * s2 + 3]), cvtpk(sa[c][8 * s2 + 4], sa[c][8 * s2 + 5]), cvtpk(sa[c][8 * s2 + 6], sa[c][8 * s2 + 7]));
#pragma unroll
                    for (int dt = 0; dt < 2; ++dt) {
                        const bf16_t* va = Vt + (32 * dt + r) * SWA_VLD + 32 * (qt + c) + 16 * s2 + 4 * h;
                        const u32x2 lo = *(const u32x2*)va, hi = *(const u32x2*)(va + 8);
                        oa[dt] = MFMA32(mk8(lo.x, lo.y, hi.x, hi.y), pf, oa[dt]);
                    }
                }
            bf16_t* yp = ycat + (size_t)(tq0 + 32 * qt + r) * 2048 + 512 + hq * 64 + 4 * h;
#pragma unroll
            for (int dt = 0; dt < 2; ++dt)
#pragma unroll
                for (int g4 = 0; g4 < 4; ++g4) { u32x2 o; o.x = cvtpk(oa[dt][4 * g4] * inv, oa[dt][4 * g4 + 1] * inv); o.y = cvtpk(oa[dt][4 * g4 + 2] * inv, oa[dt][4 * g4 + 3] * inv);
                    *(u32x2*)(yp + 32 * dt + 8 * g4) = o; }
        }
    }
}

constexpr int MEM_KLD = 136, MEM_VLD = 260, MEM_VT_OFF = 256 * MEM_KLD * 2;
DI void mem_phase(const bf16_t* qm, const bf16_t* kvm, bf16_t* ycat, unsigned char* lds) {
    const int tid = opaque_tid();
    const int lane = tid & 63, w = tid >> 6, r = lane & 31, h = lane >> 5;
    bf16_t* Ks = (bf16_t*)lds; bf16_t* Vt = (bf16_t*)(lds + MEM_VT_OFF);
    for (int unit = blockIdx.x; unit < 256; unit += gridDim.x) {
        const int qc = unit & 7, hm = (unit >> 3) & 3, b = unit >> 5;
        bf16x8 qn[8];
        { const bf16_t* qp = qm + (size_t)(b * SEQ + qc * 512 + (w * 2) * 32 + r) * 512 + hm * 128 + 8 * h;
#pragma unroll
          for (int s = 0; s < 8; ++s) qn[s] = *(const bf16x8*)(qp + 16 * s); }
        __syncthreads();
#pragma unroll
        for (int i = 0; i < 8; ++i) {
            const int c = tid + 512 * i, m = c >> 4, dc = (c & 15) * 8;
            const bf16_t* src = kvm + (size_t)(b * MEML + m) * 1024 + hm * 128 + dc;
            const u32x4 kv = *(const u32x4*)src, vx = *(const u32x4*)(src + 512);
            *(u32x4*)(Ks + m * MEM_KLD + dc) = kv;
            bf16_t* vp = Vt + dc * MEM_VLD + m;
            vp[0 * MEM_VLD] = (bf16_t)(vx.x & 0xffffu); vp[1 * MEM_VLD] = (bf16_t)(vx.x >> 16); vp[2 * MEM_VLD] = (bf16_t)(vx.y & 0xffffu); vp[3 * MEM_VLD] = (bf16_t)(vx.y >> 16);
            vp[4 * MEM_VLD] = (bf16_t)(vx.z & 0xffffu); vp[5 * MEM_VLD] = (bf16_t)(vx.z >> 16); vp[6 * MEM_VLD] = (bf16_t)(vx.w & 0xffffu); vp[7 * MEM_VLD] = (bf16_t)(vx.w >> 16);
        }
        __syncthreads();
        for (int qi = 0; qi < 2; ++qi) {
            const int t0 = b * SEQ + qc * 512 + (w * 2 + qi) * 32;
            bf16x8 qf[8];
#pragma unroll
            for (int s = 0; s < 8; ++s) qf[s] = qn[s];
            if (qi == 0) { const bf16_t* qp = qm + (size_t)(t0 + 32 + r) * 512 + hm * 128 + 8 * h;
#pragma unroll
                for (int s = 0; s < 8; ++s) qn[s] = *(const bf16x8*)(qp + 16 * s); }
            float mx = -3e38f;
#pragma unroll 1
            for (int c = 0; c < 8; ++c) {
                f32x16 sc;
#pragma unroll
                for (int i = 0; i < 16; ++i) sc[i] = 0.f;
#pragma unroll
                for (int s = 0; s < 8; ++s) { const bf16x8 kf = *(const bf16x8*)(Ks + (32 * c + r) * MEM_KLD + 16 * s + 8 * h); sc = MFMA32(kf, qf[s], sc); }
#pragma unroll
                for (int i = 0; i < 16; ++i) mx = fmaxf(mx, sc[i]);
            }
            mx = fmaxf(mx, __shfl_xor(mx, 32));
            constexpr float SC = 0.08838834764831845f * 1.4426950408889634f;
            float l = 0.f;
            f32x16 oa[4];
#pragma unroll
            for (int dt = 0; dt < 4; ++dt)
#pragma unroll
                for (int i = 0; i < 16; ++i) oa[dt][i] = 0.f;
#pragma unroll 1
            for (int c = 0; c < 8; ++c) {
                f32x16 sc;
#pragma unroll
                for (int i = 0; i < 16; ++i) sc[i] = 0.f;
#pragma unroll
                for (int s = 0; s < 8; ++s) { const bf16x8 kf = *(const bf16x8*)(Ks + (32 * c + r) * MEM_KLD + 16 * s + 8 * h); sc = MFMA32(kf, qf[s], sc); }
#pragma unroll
                for (int i = 0; i < 16; ++i) { const float pz = exp2f((sc[i] - mx) * SC); sc[i] = pz; l += pz; }
#pragma unroll
                for (int s2 = 0; s2 < 2; ++s2) {
                    const bf16x8 pf = mk8(cvtpk(sc[8 * s2 + 0], sc[8 * s2 + 1]), cvtpk(sc[8 * s2 + 2], sc[8 * s2 + 3]), cvtpk(sc[8 * s2 + 4], sc[8 * s2 + 5]), cvtpk(sc[8 * s2 + 6], sc[8 * s2 + 7]));
#pragma unroll
                    for (int dt = 0; dt < 4; ++dt) {
                        const bf16_t* va = Vt + (32 * dt + r) * MEM_VLD + 32 * c + 16 * s2 + 4 * h;
                        const u32x2 lo = *(const u32x2*)va, hi = *(const u32x2*)(va + 8);
                        oa[dt] = MFMA32(mk8(lo.x, lo.y, hi.x, hi.y), pf, oa[dt]);
                    }
                }
            }
            l += __shfl_xor(l, 32);
            const float inv = 1.f / l;
            bf16_t* yp = ycat + (size_t)(t0 + r) * 2048 + 1536 + hm * 128 + 4 * h;
#pragma unroll
            for (int dt = 0; dt < 4; ++dt)
#pragma unroll
                for (int g4 = 0; g4 < 4; ++g4) { u32x2 o; o.x = cvtpk(oa[dt][4 * g4] * inv, oa[dt][4 * g4 + 1] * inv); o.y = cvtpk(oa[dt][4 * g4 + 2] * inv, oa[dt][4 * g4 + 3] * inv);
                    *(u32x2*)(yp + 32 * dt + 8 * g4) = o; }
        }
    }
}

DI unsigned umax_(unsigned a, unsigned b) { return a > b ? a : b; }
DI unsigned umin_(unsigned a, unsigned b) { return a < b ? a : b; }
DI void cexd(unsigned& a, unsigned& b) { const unsigned mx = umax_(a, b), mn = umin_(a, b); a = mx; b = mn; }
DI void sort16_desc(unsigned (&v)[16]) {
#pragma unroll
    for (int k = 2; k <= 16; k <<= 1)
#pragma unroll
        for (int j = k >> 1; j > 0; j >>= 1)
#pragma unroll
            for (int i = 0; i < 16; ++i) { const int l = i ^ j; if (l > i) { if ((i & k) == 0) cexd(v[i], v[l]); else cexd(v[l], v[i]); } }
}
DI void merge16_desc(unsigned (&a)[16], const unsigned (&b)[16]) {
#pragma unroll
    for (int i = 0; i < 16; ++i) a[i] = umax_(a[i], b[15 - i]);
#pragma unroll
    for (int j = 8; j > 0; j >>= 1)
#pragma unroll
        for (int i = 0; i < 16; ++i) { const int l = i ^ j; if (l > i) cexd(a[i], a[l]); }
}
DI unsigned mono(float f) { const unsigned u = __builtin_bit_cast(unsigned, f); return u ^ ((unsigned)((int)u >> 31) | 0x80000000u); }
DI float demono(unsigned m) { const unsigned t = (unsigned)((int)m >> 31); return __builtin_bit_cast(float, m ^ (~t | 0x80000000u)); }
constexpr int TK_KLD = 136, TK_SCR_OFF = 2 * 128 * TK_KLD * 2;
DI void topk_phase(const bf16_t* qp, const bf16_t* keysb, const float* rstd2, unsigned short* ids, float* gts, unsigned char* lds) {
    const int tid = opaque_tid();
    const int lane = tid & 63, w = tid >> 6, r = lane & 31, h2 = lane >> 5;
    bf16_t* Kl = (bf16_t*)lds;
    unsigned char* scr = lds + TK_SCR_OFF + w * 2048 + lane * 32;
    int staged = -1;
    for (int unit = blockIdx.x; unit < 1024; unit += gridDim.x) {
        const int hd = unit & 7, tile = unit >> 3;
        if (hd != staged) {
            __syncthreads();
#pragma unroll
            for (int i = 0; i < 8; ++i) { const int c = tid + 512 * i, row = c >> 4, dc = (c & 15) * 8;
                *(u32x4*)(Kl + row * TK_KLD + dc) = *(const u32x4*)(keysb + ((size_t)hd * 256 + row) * 128 + dc); }
            __syncthreads();
            staged = hd;
        }
        const int t0 = tile * 256 + w * 32;
        unsigned K0[16], K1[16];
#pragma unroll
        for (int p = 0; p < 2; ++p) {
            const bf16_t* qrow = qp + (size_t)(t0 + r) * 2048 + hd * 256 + p * 128 + 8 * h2;
            bf16x8 qf[8];
#pragma unroll
            for (int s = 0; s < 8; ++s) qf[s] = *(const bf16x8*)(qrow + 16 * s);
            unsigned blk[4][16];
#pragma unroll
            for (int c = 0; c < 4; ++c) {
                f32x16 sc;
#pragma unroll
                for (int i = 0; i < 16; ++i) sc[i] = 0.f;
#pragma unroll
                for (int s = 0; s < 8; ++s) { const bf16x8 kf = *(const bf16x8*)(Kl + (p * 128 + 32 * c + r) * TK_KLD + 16 * s + 8 * h2); sc = MFMA32(kf, qf[s], sc); }
#pragma unroll
                for (int i = 0; i < 16; ++i) blk[c][i] = (mono(sc[i]) & ~0x7Fu) | (unsigned)(32 * c + crow(i, h2));
                sort16_desc(blk[c]);
            }
            merge16_desc(blk[0], blk[1]); merge16_desc(blk[2], blk[3]); merge16_desc(blk[0], blk[2]);
            unsigned oth[16];
#pragma unroll
            for (int i = 0; i < 16; ++i) oth[i] = (unsigned)__shfl_xor((int)blk[0][i], 32);
            merge16_desc(blk[0], oth);
#pragma unroll
            for (int i = 0; i < 16; ++i) { if (p == 0) K0[i] = blk[0][i]; else K1[i] = blk[0][i]; }
        }
#pragma unroll
        for (int q = 0; q < 4; ++q) {
            ((unsigned*)scr)[q] = (K0[4 * q] & 0x7Fu) | ((K0[4 * q + 1] & 0x7Fu) << 8) | ((K0[4 * q + 2] & 0x7Fu) << 16) | ((K0[4 * q + 3] & 0x7Fu) << 24);
            ((unsigned*)scr)[4 + q] = (K1[4 * q] & 0x7Fu) | ((K1[4 * q + 1] & 0x7Fu) << 8) | ((K1[4 * q + 2] & 0x7Fu) << 16) | ((K1[4 * q + 3] & 0x7Fu) << 24);
        }
        float sx[16], sy[16];
#pragma unroll
        for (int i = 0; i < 16; ++i) { const float s0 = demono(K0[i] & ~0x7Fu), s1 = demono(K1[i] & ~0x7Fu); sx[i] = h2 ? s1 : s0; sy[i] = h2 ? s0 : s1; }
        unsigned ca[16], cb[16];
#pragma unroll
        for (int i = 0; i < 16; ++i) { ca[i] = 0u; cb[i] = 0u; }
#define CAND(n, a, b) do { const unsigned key_ = (mono(sx[a] + sy[b]) & ~0xFFu) | (h2 ? (unsigned)(((b) << 4) | (a)) : (unsigned)(((a) << 4) | (b))); if ((n) < 16) ca[(n) & 15] = key_; else cb[(n) & 15] = key_; } while (0)
            CAND(0, 0, 1);
            CAND(1, 0, 2);
            CAND(2, 0, 3);
            CAND(3, 0, 4);
            CAND(4, 0, 5);
            CAND(5, 0, 6);
            CAND(6, 0, 7);
            CAND(7, 0, 8);
            CAND(8, 0, 9);
            CAND(9, 0, 10);
            CAND(10, 0, 11);
            CAND(11, 0, 12);
            CAND(12, 0, 13);
            CAND(13, 0, 14);
            CAND(14, 0, 15);
            CAND(15, 1, 2);
            CAND(16, 1, 3);
            CAND(17, 1, 4);
            CAND(18, 1, 5);
            CAND(19, 1, 6);
            CAND(20, 1, 7);
            CAND(21, 2, 3);
            CAND(22, 2, 4);
#undef CAND
#pragma unroll
        for (int d = 0; d < 4; ++d) { const unsigned key_ = (mono(sx[d] + sy[d]) & ~0xFFu) | (unsigned)((d << 4) | d); cb[7 + d] = h2 ? 0u : key_; }
        sort16_desc(ca); sort16_desc(cb); merge16_desc(ca, cb);
        unsigned fin[16], cpart[16];
#pragma unroll
        for (int i = 0; i < 16; ++i) cpart[i] = (unsigned)__shfl_xor((int)ca[i], 32);
#pragma unroll
        for (int i = 0; i < 16; ++i) fin[i] = umax_(ca[i], cpart[15 - i]);
        const float rs = 1.f / sqrtf(rstd2[t0 + r] * (1.f / D) + EPS);
        float sv[16], mxv = -3e38f;
#pragma unroll
        for (int i = 0; i < 16; ++i) { sv[i] = demono(fin[i] & ~0xFFu) * rs; mxv = fmaxf(mxv, sv[i]); }
        float den = 0.f;
#pragma unroll
        for (int i = 0; i < 16; ++i) { sv[i] = __expf(sv[i] - mxv); den += sv[i]; }
        const float rden = 1.f / den;
        int oid[8]; float og[8];
#pragma unroll
        for (int j = 0; j < 8; ++j) {
            const unsigned wk = fin[j]; og[j] = sv[j] * rden;
            const unsigned a0 = (wk >> 4) & 15u, a1 = wk & 15u;
            oid[j] = (int)scr[a0] * 128 + (int)scr[16 + a1];
        }
        unsigned short* ip = ids + (size_t)(t0 + r) * 128 + hd * 16 + 8 * h2; float* gp = gts + (size_t)(t0 + r) * 128 + hd * 16 + 8 * h2;
        *(u32x4*)ip = (u32x4){(unsigned)oid[0] | ((unsigned)oid[1] << 16), (unsigned)oid[2] | ((unsigned)oid[3] << 16), (unsigned)oid[4] | ((unsigned)oid[5] << 16), (unsigned)oid[6] | ((unsigned)oid[7] << 16)};
        *(f32x4*)gp = (f32x4){og[0], og[1], og[2], og[3]}; *(f32x4*)(gp + 4) = (f32x4){og[4], og[5], og[6], og[7]};
    }
}

typedef _Float16 h2_t __attribute__((ext_vector_type(2)));
template <int CTRL> DI float dpp_f(float v) { return __builtin_bit_cast(float, __builtin_amdgcn_update_dpp(0, __builtin_bit_cast(int, v), CTRL, 0xf, 0xf, true)); }
DI float row16_sum(float v) {
    v += dpp_f<0xB1>(v); v += dpp_f<0x4E>(v); v += dpp_f<0x141>(v); v += dpp_f<0x140>(v); return v; }
DI bf16x2_t as_b2(unsigned w) { return __builtin_bit_cast(bf16x2_t, w); }
DI float dot_row(const u32x4 (&xw)[4][2], const u32x4 (&ru)[4]) {
    float d0 = 0.f, d1 = 0.f;
#pragma unroll
    for (int i = 0; i < 4; ++i)
#pragma unroll
        for (int q = 0; q < 4; ++q) {
            const bf16x2_t z0 = __builtin_amdgcn_cvt_scalef32_pk_bf16_fp8((int)ru[i][q], 1.0f, false), z1 = __builtin_amdgcn_cvt_scalef32_pk_bf16_fp8((int)ru[i][q], 1.0f, true);
            d0 = __builtin_amdgcn_fdot2_f32_bf16(as_b2(xw[i][q >> 1][2 * (q & 1)]), z0, d0, false); d1 = __builtin_amdgcn_fdot2_f32_bf16(as_b2(xw[i][q >> 1][2 * (q & 1) + 1]), z1, d1, false);
        }
    return row16_sum(d0 + d1);
}
DI float swz_xor4(float v) { return __builtin_bit_cast(float, __builtin_amdgcn_ds_swizzle(__builtin_bit_cast(int, v), 0x101F)); }
DI bf16_t* partial_base(unsigned char* ws, int x) { return (bf16_t*)(ws + 42 * MiB + (size_t)x * 8 * MiB); }
template <int VAR>
DI void peer_u2_phase(const bf16_t* x1b, const unsigned char* u8, const unsigned short* ids, bf16_t* part, unsigned char* lds, int lbl, int rnk, int cnt) {
    const int tid = opaque_tid(), lane = tid & 63, wave = tid >> 6, g8 = lane >> 3, s8 = lane & 7;
    constexpr int LST = 132;
    int* lid = (int*)(lds + wave * (2 * 8 * LST * 4)); float* lpa = (float*)(lid + 8 * LST);
    const int stride = cnt * NWAVES * 8;
    const unsigned char* ubase = u8 + lbl * 128;
    const bool b4 = (s8 & 4) != 0, b2 = (s8 & 2) != 0, b1 = (s8 & 1) != 0;
    for (int t0 = (rnk * NWAVES + wave) * 8; t0 < T; t0 += stride) {
#pragma unroll
        for (int j = 0; j < 2; ++j) { const int f = lane * 8 + 512 * j, tk = f >> 7, k = f & 127; const u32x4 w = *(const u32x4*)(ids + (size_t)t0 * 128 + f);
            *(u32x4*)(lid + tk * LST + k) = (u32x4){w.x & 0xffffu, w.x >> 16, w.y & 0xffffu, w.y >> 16}; *(u32x4*)(lid + tk * LST + k + 4) = (u32x4){w.z & 0xffffu, w.z >> 16, w.w & 0xffffu, w.w >> 16}; }
        const size_t xo_ = (size_t)(t0 + g8) * D + lbl * 128 + 16 * s8;
        const u32x4 xa = *(const u32x4*)(x1b + xo_), xb2 = *(const u32x4*)(x1b + xo_ + 8);
        float xf[16];
        xf[0] = bflo(xa.x); xf[1] = bfhi(xa.x); xf[2] = bflo(xa.y); xf[3] = bfhi(xa.y); xf[4] = bflo(xa.z); xf[5] = bfhi(xa.z); xf[6] = bflo(xa.w); xf[7] = bfhi(xa.w);
        xf[8] = bflo(xb2.x); xf[9] = bfhi(xb2.x); xf[10] = bflo(xb2.y); xf[11] = bfhi(xb2.y); xf[12] = bflo(xb2.z); xf[13] = bfhi(xb2.z); xf[14] = bflo(xb2.w); xf[15] = bfhi(xb2.w);
        float xm = 0.f;
#pragma unroll
        for (int e = 0; e < 16; ++e) xm = fmaxf(xm, fabsf(xf[e]));
        xm = fmaxf(xm, dpp_f<0xB1>(xm)); xm = fmaxf(xm, dpp_f<0x4E>(xm)); xm = fmaxf(xm, dpp_f<0x141>(xm));
        const float xinv = xm > 0.f ? 127.f / xm : 0.f, sx = xm * (1.f / 127.f);
        int xq[4];
#pragma unroll
        for (int q = 0; q < 4; ++q) { const int q0 = (int)__builtin_rintf(xf[4 * q] * xinv), q1 = (int)__builtin_rintf(xf[4 * q + 1] * xinv), q2 = (int)__builtin_rintf(xf[4 * q + 2] * xinv), q3 = (int)__builtin_rintf(xf[4 * q + 3] * xinv);
            xq[q] = (int)((unsigned)(q0 & 255) | ((unsigned)(q1 & 255) << 8) | ((unsigned)(q2 & 255) << 16) | ((unsigned)q3 << 24)); }
        const int* myid = lid + g8 * LST; float* mypa = lpa + g8 * LST;
        const unsigned loff = (unsigned)(s8 * 16);
#define U2_FETCH(K8, RW) do { const int kc_ = (K8) < 128 ? (K8) : 120; const u32x4 i0_ = *(const u32x4*)(myid + kc_), i1_ = *(const u32x4*)(myid + kc_ + 4); \
            _Pragma("unroll") for (int i = 0; i < 8; ++i) { const unsigned id_ = i < 4 ? i0_[i & 3] : i1_[i & 3]; \
                if (VAR & 1) RW[i] = (u32x4){id_, id_ * 3u, id_ * 5u, id_ * 7u}; else RW[i] = *(const u32x4*)(ubase + (id_ * (unsigned)D + loff)); } } while (0)
#define U2_REDUCE(K8, RW) do { int pp[8]; \
            _Pragma("unroll") for (int i = 0; i < 8; ++i) { \
                if (VAR & 2) { pp[i] = (int)((RW[i].x ^ RW[i].y ^ RW[i].z ^ RW[i].w ^ xa.x) & 0xffu); continue; } \
                int d_ = 0; \
                _Pragma("unroll") for (int q = 0; q < 4; ++q) d_ = __builtin_amdgcn_sdot4((int)RW[i][q], xq[q], d_, false); \
                pp[i] = d_; } \
            int q4[4], q2[2]; \
            _Pragma("unroll") for (int j = 0; j < 4; ++j) { const int keep = b4 ? pp[j + 4] : pp[j], send = b4 ? pp[j] : pp[j + 4]; q4[j] = keep + __builtin_amdgcn_ds_swizzle(send, 0x101F); } \
            _Pragma("unroll") for (int j = 0; j < 2; ++j) { const int keep = b2 ? q4[j + 2] : q4[j], send = b2 ? q4[j] : q4[j + 2]; q2[j] = keep + __builtin_amdgcn_update_dpp(0, send, 0x4E, 0xf, 0xf, true); } \
            const int keep1 = b1 ? q2[1] : q2[0], send1 = b1 ? q2[0] : q2[1]; \
            mypa[(K8) + s8] = (float)(keep1 + __builtin_amdgcn_update_dpp(0, send1, 0xB1, 0xf, 0xf, true)) * sx;     } while (0)
        u32x4 rwA[8], rwB[8];
        U2_FETCH(0, rwA);
#pragma unroll 1
        for (int k8 = 0; k8 < 128; k8 += 16) {
            U2_FETCH(k8 + 8, rwB);
            U2_REDUCE(k8, rwA);
            U2_FETCH(k8 + 16, rwA);
            U2_REDUCE(k8 + 8, rwB);
        }
#undef U2_FETCH
#undef U2_REDUCE
        bf16_t* pg = part + (size_t)t0 * 128;
#pragma unroll
        for (int j = 0; j < 4; ++j) { const int f = lane * 4 + 256 * j, tk = f >> 7, k = f & 127; const f32x4 v = *(const f32x4*)(lpa + tk * LST + k);
            u32x2 w; w.x = pk2(v.x, v.y); w.y = pk2(v.z, v.w); *(u32x2*)(pg + f) = w; }
    }
}
DI void peer_combine_phase(unsigned char* ws, const float* ssq2, const float* gts, const unsigned short* ids, const float* su, bf16_t* coef) {
    const size_t gt = (size_t)blockIdx.x * NTHREADS + opaque_tid(), NGT = (size_t)gridDim.x * NTHREADS;
    for (size_t i = gt; i < (size_t)T * 32; i += NGT) {
        const int t = (int)(i >> 5);
        f32x4 a = {0.f, 0.f, 0.f, 0.f};
#pragma unroll
        for (int x = 0; x < 8; ++x) { const u32x2 w = ((const u32x2*)partial_base(ws, x))[i]; a += (f32x4){bflo(w.x), bfhi(w.x), bflo(w.y), bfhi(w.y)}; }
        const float rs = __builtin_amdgcn_rsqf(ssq2[t] * (1.f / D) + EPS);
        const f32x4 g = ((const f32x4*)gts)[i]; const u32x2 idw = ((const u32x2*)ids)[i];
        const unsigned i0 = idw.x & 0xffffu, i1 = idw.x >> 16, i2 = idw.y & 0xffffu, i3 = idw.y >> 16;
        u32x2 w; w.x = pk2(g.x * gelu_tanh(a.x * rs * su[i0]) * 0.5f, g.y * gelu_tanh(a.y * rs * su[i1]) * 0.5f); w.y = pk2(g.z * gelu_tanh(a.z * rs * su[i2]) * 0.5f, g.w * gelu_tanh(a.w * rs * su[i3]) * 0.5f);
        ((u32x2*)coef)[i] = w;
    }
}
template <int VAR>
DI void peer_v_phase(const bf16_t* x1in, bf16_t* xout, const unsigned char* v8, const unsigned short* ids, const bf16_t* coef, float* ssqo, unsigned char* lds, int lbl, int rnk, int cnt) {
    const int tid = opaque_tid(), lane = tid & 63, wave = tid >> 6, g8 = lane >> 3, s8 = lane & 7;
    constexpr int LST = 132;
    int* lid = (int*)(lds + wave * (2 * 8 * LST * 4)); float* lco = (float*)(lid + 8 * LST);
    const int stride = cnt * NWAVES * 8;
    const unsigned char* vbase = v8 + lbl * 128;
    for (int t0 = (rnk * NWAVES + wave) * 8; t0 < T; t0 += stride) {
#pragma unroll
        for (int j = 0; j < 2; ++j) { const int f = lane * 8 + 512 * j, tk = f >> 7, k = f & 127;
            const u32x4 w = *(const u32x4*)(ids + (size_t)t0 * 128 + f), cw = *(const u32x4*)(coef + (size_t)t0 * 128 + f);
            *(u32x4*)(lid + tk * LST + k) = (u32x4){w.x & 0xffffu, w.x >> 16, w.y & 0xffffu, w.y >> 16}; *(u32x4*)(lid + tk * LST + k + 4) = (u32x4){w.z & 0xffffu, w.z >> 16, w.w & 0xffffu, w.w >> 16};
            *(f32x4*)(lco + tk * LST + k) = (f32x4){bflo(cw.x), bfhi(cw.x), bflo(cw.y), bfhi(cw.y)}; *(f32x4*)(lco + tk * LST + k + 4) = (f32x4){bflo(cw.z), bfhi(cw.z), bflo(cw.w), bfhi(cw.w)}; }
        h2_t acc[8];
#pragma unroll
        for (int j = 0; j < 8; ++j) acc[j] = (h2_t){(f16_t)0.f, (f16_t)0.f};
        const int* myid = lid + g8 * LST; const float* myco = lco + g8 * LST;
        const unsigned loff = (unsigned)(s8 * 16);
#define V_FETCH(K8, RW, CO) do { const int kc_ = (K8) < 128 ? (K8) : 120; const u32x4 i0_ = *(const u32x4*)(myid + kc_), i1_ = *(const u32x4*)(myid + kc_ + 4); \
            const f32x4 c0_ = *(const f32x4*)(myco + kc_), c1_ = *(const f32x4*)(myco + kc_ + 4); \
            _Pragma("unroll") for (int i = 0; i < 8; ++i) { const unsigned id_ = i < 4 ? i0_[i & 3] : i1_[i & 3]; CO[i] = i < 4 ? c0_[i & 3] : c1_[i & 3]; \
                if (VAR & 1) RW[i] = (u32x4){id_, id_ * 3u, id_ * 5u, id_ * 7u}; else RW[i] = *(const u32x4*)(vbase + (id_ * (unsigned)D + loff)); } } while (0)
#define V_ACCUM(RW, CO) do { _Pragma("unroll") for (int i = 0; i < 8; ++i) { const h2_t cc = {(f16_t)CO[i], (f16_t)CO[i]}; \
                if (VAR & 2) { acc[i].x += (f16_t)(__builtin_bit_cast(float, (RW[i].x ^ RW[i].y ^ RW[i].z ^ RW[i].w) & 0x3fffffffu) * CO[i]); continue; } \
                _Pragma("unroll") for (int q = 0; q < 4; ++q) { const h2_t a = __builtin_amdgcn_cvt_scalef32_pk_f16_fp8((int)RW[i][q], 1.0f, false), b = __builtin_amdgcn_cvt_scalef32_pk_f16_fp8((int)RW[i][q], 1.0f, true); \
                    acc[2 * q] = __builtin_elementwise_fma(a, cc, acc[2 * q]); acc[2 * q + 1] = __builtin_elementwise_fma(b, cc, acc[2 * q + 1]); } } } while (0)
        u32x4 rwA[8], rwB[8]; float coA[8], coB[8];
        V_FETCH(0, rwA, coA);
#pragma unroll 1
        for (int k8 = 0; k8 < 128; k8 += 16) {
            V_FETCH(k8 + 8, rwB, coB);
            V_ACCUM(rwA, coA);
            V_FETCH(k8 + 16, rwA, coA);
            V_ACCUM(rwB, coB);
        }
#undef V_FETCH
#undef V_ACCUM
        const size_t xo_ = (size_t)(t0 + g8) * D + lbl * 128 + 16 * s8;
        const u32x4 xa = *(const u32x4*)(x1in + xo_), xb2 = *(const u32x4*)(x1in + xo_ + 8);
        float o[16];
        o[0] = bflo(xa.x) + (float)acc[0].x; o[1] = bfhi(xa.x) + (float)acc[0].y; o[2] = bflo(xa.y) + (float)acc[1].x; o[3] = bfhi(xa.y) + (float)acc[1].y; o[4] = bflo(xa.z) + (float)acc[2].x; o[5] = bfhi(xa.z) + (float)acc[2].y; o[6] = bflo(xa.w) + (float)acc[3].x; o[7] = bfhi(xa.w) + (float)acc[3].y;
        o[8] = bflo(xb2.x) + (float)acc[4].x; o[9] = bfhi(xb2.x) + (float)acc[4].y; o[10] = bflo(xb2.y) + (float)acc[5].x; o[11] = bfhi(xb2.y) + (float)acc[5].y; o[12] = bflo(xb2.z) + (float)acc[6].x; o[13] = bfhi(xb2.z) + (float)acc[6].y; o[14] = bflo(xb2.w) + (float)acc[7].x; o[15] = bfhi(xb2.w) + (float)acc[7].y;
        float ss = 0.f;
#pragma unroll
        for (int e = 0; e < 16; ++e) ss += o[e] * o[e];
        ss += dpp_f<0xB1>(ss); ss += dpp_f<0x4E>(ss); ss += dpp_f<0x141>(ss);
        if (s8 == 0) atomicAdd(ssqo + t0 + g8, ss);
        u32x4 w0, w1; w0.x = pk2(o[0], o[1]); w0.y = pk2(o[2], o[3]); w0.z = pk2(o[4], o[5]); w0.w = pk2(o[6], o[7]); w1.x = pk2(o[8], o[9]); w1.y = pk2(o[10], o[11]); w1.z = pk2(o[12], o[13]); w1.w = pk2(o[14], o[15]);
        *(u32x4*)(xout + xo_) = w0; *(u32x4*)(xout + xo_ + 8) = w1;
    }
}
DI void peer_final_phase(const bf16_t* xo, const float* ssqo, const float* gf, float* out) {
    const int tid = opaque_tid(), lane = tid & 63, gw = blockIdx.x * NWAVES + (tid >> 6), NGW = gridDim.x * NWAVES;
    f32x4 g[4];
#pragma unroll
    for (int q = 0; q < 4; ++q) g[q] = *(const f32x4*)(gf + lane * 16 + 4 * q);
    for (int t = gw; t < T; t += NGW) {
        const u32x4 w0 = *(const u32x4*)(xo + (size_t)t * D + lane * 16), w1 = *(const u32x4*)(xo + (size_t)t * D + lane * 16 + 8);
        const float rf = 1.f / sqrtf(ssqo[t] * (1.f / D) + EPS);
        f32x4* po = (f32x4*)(out + (size_t)t * D + lane * 16);
        po[0] = (f32x4){bflo(w0.x), bfhi(w0.x), bflo(w0.y), bfhi(w0.y)} * rf * g[0]; po[1] = (f32x4){bflo(w0.z), bfhi(w0.z), bflo(w0.w), bfhi(w0.w)} * rf * g[1];
        po[2] = (f32x4){bflo(w1.x), bfhi(w1.x), bflo(w1.y), bfhi(w1.y)} * rf * g[2]; po[3] = (f32x4){bflo(w1.z), bfhi(w1.z), bflo(w1.w), bfhi(w1.w)} * rf * g[3];
    }
}

#define LAS __attribute__((address_space(3)))
#define XB_TMO      128
#define XB_XCNT(j)  (256  + 64 * (j))
#define XB_XSUB(j)  (1280 + 64 * (j))
#define XB_XGEN(j)  (2304 + 64 * (j))
#define XB_TOP      3328
#define XB_TOPGEN   3392
#define XCD_BAR_WORDS 3456
#define XB_SPIN_CAP (1u << 18)
DI unsigned xb_ld(unsigned* p)              { return __hip_atomic_load(p, __ATOMIC_RELAXED, __HIP_MEMORY_SCOPE_AGENT); }
DI unsigned xb_add(unsigned* p, unsigned v) { return __hip_atomic_fetch_add(p, v, __ATOMIC_RELAXED, __HIP_MEMORY_SCOPE_AGENT); }
DI unsigned xb_xcc_id() { return (unsigned)__builtin_amdgcn_s_getreg((3 << 11) | 20) & 0xFu; }
#define XB_SPIN(cond, bar) do { unsigned _sp = 0; while (cond) { __builtin_amdgcn_s_sleep(1); \
    if ((++_sp & 255u) == 0u) { if (xb_ld(&(bar)[XB_TMO])) break; if (_sp > XB_SPIN_CAP) { atomicAdd(&(bar)[XB_TMO], 1u); break; } } } } while (0)
struct XcdBarrier { unsigned* bar; unsigned x; volatile LAS unsigned* st; };
DI XcdBarrier xcd_barrier_post(unsigned* bar, volatile LAS unsigned* st) {
    XcdBarrier b; b.bar = bar; b.x = xb_xcc_id(); b.st = st;
    if (threadIdx.x == 0) st[2] = xb_add(&bar[XB_XCNT(b.x)], 1u);
    return b;
}
DI void xcd_barrier_complete(unsigned* bar, unsigned x, unsigned& nloc, unsigned& nx) {
    const unsigned G = gridDim.x * gridDim.y * gridDim.z;
    unsigned sum, cnt, mine, sp = 0u;
    for (;;) {
        sum = 0u; cnt = 0u; mine = 0u;
#pragma unroll
        for (unsigned j = 0; j < 16; ++j) { const unsigned c = xb_ld(&bar[XB_XCNT(j)]); sum += c; cnt += (c > 0u) ? 1u : 0u; mine = (j == x) ? c : mine; }
        if (sum == G) break;
        __builtin_amdgcn_s_sleep(1);
        if ((++sp & 255u) == 0u) { if (xb_ld(&bar[XB_TMO])) break; if (sp > XB_SPIN_CAP) { atomicAdd(&bar[XB_TMO], 1u); break; } }
    }
    nloc = mine > 0u ? mine : 1u; nx = cnt > 0u ? cnt : 1u;
}
DI void xcd_barrier(const XcdBarrier& b) {
    asm volatile("s_waitcnt vmcnt(0)" ::: "memory");
    __syncthreads();
    if (threadIdx.x == 0) {
        unsigned* bar = b.bar;
        __builtin_amdgcn_s_waitcnt(0);
        unsigned nloc = b.st[0], nx = b.st[1];
        if (nloc == 0u) { xcd_barrier_complete(bar, b.x, nloc, nx); b.st[0] = nloc; b.st[1] = nx; }
        const unsigned old = xb_add(&bar[XB_XSUB(b.x)], 1u);
        const unsigned gen = old / nloc;
        if (old + 1u == (gen + 1u) * nloc) {
            __builtin_amdgcn_fence(__ATOMIC_RELEASE, "agent");
            asm volatile("s_waitcnt vmcnt(0)" ::: "memory");
            const unsigned og = xb_add(&bar[XB_TOP], 1u);
            const unsigned tg = og / nx;
            if (og + 1u == (tg + 1u) * nx) xb_add(&bar[XB_TOPGEN], 1u);
            else XB_SPIN(xb_ld(&bar[XB_TOPGEN]) == tg, bar);
            __builtin_amdgcn_fence(__ATOMIC_ACQUIRE, "agent");
            xb_add(&bar[XB_XGEN(b.x)], 1u);
            asm volatile("s_waitcnt vmcnt(0)" ::: "memory");
        } else {
            XB_SPIN(xb_ld(&bar[XB_XGEN(b.x)]) == gen, bar);
            __builtin_amdgcn_fence(__ATOMIC_ACQUIRE, "agent");
            asm volatile("s_waitcnt vmcnt(0)" ::: "memory");
        }
    }
    __syncthreads();
}


constexpr int LDS_BYTES = 147456;
__global__ void __launch_bounds__(NTHREADS, 2) fwd_kernel(Params p) {
    extern __shared__ __attribute__((aligned(16))) unsigned char lds[];
    cg::grid_group grid = cg::this_grid();
    volatile LAS unsigned* bst = (volatile LAS unsigned*)((LAS unsigned char*)lds + (LDS_BYTES - 64));
    if (threadIdx.x < 4) bst[threadIdx.x] = 0u;
    __syncthreads();
    const XcdBarrier xbar = xcd_barrier_post((unsigned*)p.ws, bst);
    const int NGW = gridDim.x * NWAVES, G = gridDim.x, cu = blockIdx.x;
    unsigned char* ws = p.ws;
    PG8_LAS unsigned char* ldsl = (PG8_LAS unsigned char*)lds;
    bf16_t* ycat = (bf16_t*)p.out;

    for (int rep_ = 0; rep_ < (DUP_PHASE == 0 ? 2 : 1); ++rep_) { phase0(p, (float*)lds);
    if (p.use_cg_sync) grid.sync(); else xcd_barrier(xbar); }
    for (int rep_ = 0; rep_ < (DUP_PHASE == 1 ? 2 : 1); ++rep_) {
        EpiZ E{(const float*)(ws + WS_RSTD1), (const float*)(ws + WS_RSTDM), (const float2*)(ws + WS_ROPE), (bf16_t*)(ws + WS_UPOOL), (bf16_t*)(ws + WS_QR), (bf16_t*)(ws + WS_KR), (bf16_t*)(ws + WS_VV), (bf16_t*)(ws + WS_QM), (unsigned char*)(ws + WS_GATES), (bf16_t*)(ws + WS_KVM)};
        SchedZ S{(const char*)(ws + WS_XB), (const char*)(ws + WS_WIN), (const char*)(ws + WS_MEMB), (const char*)(ws + WS_WMKV), G, cu};
        pg8::gemm_phase(ldsl, 1024, 1024, S, E);
    xcd_barrier(xbar); }
    if (DUP_PHASE == 20) pooled_phase((const bf16_t*)(ws + WS_UPOOL), ycat);
    if (DUP_PHASE == 21) swa_phase((const bf16_t*)(ws + WS_QR), (const bf16_t*)(ws + WS_KR), (const bf16_t*)(ws + WS_VV), p.sinks, ycat, lds);
    if (DUP_PHASE == 22) mem_phase((const bf16_t*)(ws + WS_QM), (const bf16_t*)(ws + WS_KVM), ycat, lds);
    pooled_phase((const bf16_t*)(ws + WS_UPOOL), ycat);
    swa_phase((const bf16_t*)(ws + WS_QR), (const bf16_t*)(ws + WS_KR), (const bf16_t*)(ws + WS_VV), p.sinks, ycat, lds);
    mem_phase((const bf16_t*)(ws + WS_QM), (const bf16_t*)(ws + WS_KVM), ycat, lds);
    xcd_barrier(xbar);
    for (int rep_ = 0; rep_ < (DUP_PHASE == 3 ? 2 : 1); ++rep_) {
        EpiGated E{(const unsigned char*)(ws + WS_GATES), (bf16_t*)(ws + WS_MERGED)};
        SchedGated S{(const char*)ycat, (const char*)(ws + WS_WBR), G, cu};
        pg8::gemm_phase(ldsl, 2048, 2048, S, E);
    xcd_barrier(xbar); }
    for (int rep_ = 0; rep_ < (DUP_PHASE == 4 ? 2 : 1); ++rep_) {
        EpiOut E{(const bf16_t*)(ws + WS_XB), (DUP_PHASE == 4 && rep_ == 0) ? (bf16_t*)(ws + WS_QP) : (bf16_t*)(ws + WS_X1B), (DUP_PHASE == 4 && rep_ == 0) ? (float*)(ws + WS_RSTD1) : (float*)(ws + WS_RSTD2)};
        SchedPlain S{(const char*)(ws + WS_MERGED), (const char*)(ws + WS_WOUT), 1024, 1024, 128, 4, 16, G, cu};
        pg8::gemm_phase(ldsl, 1024, 1024, S, E);
    xcd_barrier(xbar); }
    for (int rep_ = 0; rep_ < (DUP_PHASE == 5 ? 2 : 1); ++rep_) {
        EpiBf16 E{(bf16_t*)(ws + WS_QP), 2048};
        SchedPlain S{(const char*)(ws + WS_X1B), (const char*)(ws + WS_WQ), 1024, 1024, 128, 8, 16, G, cu};
        pg8::gemm_phase(ldsl, 1024, 1024, S, E);
    xcd_barrier(xbar); }
    for (int rep_ = 0; rep_ < (DUP_PHASE == 6 ? 2 : 1); ++rep_) {
    topk_phase((const bf16_t*)(ws + WS_QP), (const bf16_t*)(ws + WS_KEYS), (const float*)(ws + WS_RSTD2), (unsigned short*)(ws + WS_IDS), (float*)(ws + WS_GTS), lds);
    xcd_barrier(xbar); }
    int lbl, rnk, cnt;
    {
        unsigned* bar = (unsigned*)p.ws; unsigned sum = 0u, mine = 0u; bool ok = xbar.x < 8u;
#pragma unroll
        for (unsigned j = 0; j < 8; ++j) { const unsigned c = xb_ld(&bar[XB_XCNT(j)]); sum += c; ok = ok && (c > 0u); mine = (j == xbar.x) ? c : mine; }
        ok = ok && (sum == (unsigned)G);
        lbl = ok ? (int)xbar.x : (cu & 7); rnk = ok ? (int)bst[2] : (cu >> 3); cnt = ok ? (int)mine : ((G - (cu & 7) + 7) >> 3);
        lbl = __builtin_amdgcn_readfirstlane(lbl); rnk = __builtin_amdgcn_readfirstlane(rnk); cnt = __builtin_amdgcn_readfirstlane(cnt);
    }
    if (DUP_PHASE == 7) {
        peer_u2_phase<PROBE_VAR>((const bf16_t*)(ws + WS_X1B), (const unsigned char*)(ws + WS_U16), (const unsigned short*)(ws + WS_IDS), partial_base(ws, lbl), lds, lbl, rnk, cnt);
        xcd_barrier(xbar); }
    peer_u2_phase<0>((const bf16_t*)(ws + WS_X1B), (const unsigned char*)(ws + WS_U16), (const unsigned short*)(ws + WS_IDS), partial_base(ws, lbl), lds, lbl, rnk, cnt);
    xcd_barrier(xbar);
    peer_combine_phase(ws, (const float*)(ws + WS_RSTD2), (const float*)(ws + WS_GTS), (const unsigned short*)(ws + WS_IDS), (const float*)(ws + WS_SU), (bf16_t*)(ws + WS_COEF));
    xcd_barrier(xbar);
    if (DUP_PHASE == 8) {
        peer_v_phase<PROBE_VAR>((const bf16_t*)(ws + WS_X1B), (bf16_t*)(ws + WS_MERGED), (const unsigned char*)(ws + WS_V16), (const unsigned short*)(ws + WS_IDS), (const bf16_t*)(ws + WS_COEF), (float*)(ws + WS_RSTD1), lds, lbl, rnk, cnt);
        xcd_barrier(xbar); }
    peer_v_phase<0>((const bf16_t*)(ws + WS_X1B), (bf16_t*)(ws + WS_X1B), (const unsigned char*)(ws + WS_V16), (const unsigned short*)(ws + WS_IDS), (const bf16_t*)(ws + WS_COEF), (float*)(ws + WS_SSQO), lds, lbl, rnk, cnt);
    xcd_barrier(xbar);
    for (int rep_ = 0; rep_ < (DUP_PHASE == 9 ? 2 : 1); ++rep_)
    peer_final_phase((const bf16_t*)(ws + WS_X1B), (const float*)(ws + WS_SSQO), p.final_g, p.out);
}

extern "C" void kernel_launch(void* const* d_in, const int* in_sizes, int n_in, void* d_out, int out_size, void* d_ws, size_t ws_size, hipStream_t stream) {
    static int grid_blocks = 0;
    if (grid_blocks == 0) {
        if (n_in != 20 || out_size != T * D || ws_size < WS_END) { fprintf(stderr, "kernel_launch: unexpected shapes: n_in %d out %d ws %zu\n", n_in, out_size, ws_size); grid_blocks = -1; return; }
        int dev = 0, cus = 0, per_cu = 0;
        (void)hipGetDevice(&dev);
        (void)hipDeviceGetAttribute(&cus, hipDeviceAttributeMultiprocessorCount, dev);
        if (hipFuncSetAttribute((const void*)fwd_kernel, hipFuncAttributeMaxDynamicSharedMemorySize, LDS_BYTES) != hipSuccess) { fprintf(stderr, "kernel_launch: hipFuncSetAttribute failed\n"); grid_blocks = -1; return; }
        (void)hipOccupancyMaxActiveBlocksPerMultiprocessor(&per_cu, (const void*)fwd_kernel, NTHREADS, LDS_BYTES);
        if (per_cu < 1) { fprintf(stderr, "kernel_launch: occupancy query says %d blocks per CU\n", per_cu); grid_blocks = -1; return; }
        grid_blocks = cus * per_cu;
        fprintf(stderr, "kernel_launch: cus %d per_cu %d grid %d ws %zu\n", cus, per_cu, grid_blocks, ws_size);
    }
    if (grid_blocks < 0) return;
    Params p{};
    p.x = (const float*)d_in[0]; p.mem = (const float*)d_in[1]; p.pos = (const int*)d_in[2]; p.norm1_g = (const float*)d_in[3]; p.mem_norm_g = (const float*)d_in[4];
    p.w_in = (const float*)d_in[5]; p.w_pool = (const float*)d_in[6]; p.pool_scale = (const float*)d_in[7]; p.sinks = (const float*)d_in[8]; p.w_mem_kv = (const float*)d_in[9];
    p.w_bpool = (const float*)d_in[10]; p.w_bswa = (const float*)d_in[11]; p.w_bmem = (const float*)d_in[12]; p.w_out = (const float*)d_in[13]; p.norm2_g = (const float*)d_in[14];
    p.w_q = (const float*)d_in[15]; p.sub_keys = (const float*)d_in[16]; p.peer_u = (const float*)d_in[17]; p.peer_v = (const float*)d_in[18]; p.final_g = (const float*)d_in[19];
    p.out = (float*)d_out; p.ws = (unsigned char*)d_ws;
    (void)hipMemsetAsync(d_ws, 0, 16384, stream);
    void* args[] = {&p};
    hipError_t e = hipLaunchCooperativeKernel((const void*)fwd_kernel, dim3(grid_blocks), dim3(NTHREADS), args, LDS_BYTES, stream);
    if (e != hipSuccess) fprintf(stderr, "cooperative launch failed: %s (grid %d)\n", hipGetErrorString(e), grid_blocks);
}
```

```cpp
#include <hip/hip_runtime.h>
#include <hip/hip_cooperative_groups.h>
#include <cstdio>
#include <cstdint>
namespace cg = cooperative_groups;

#define DI __device__ __forceinline__
typedef unsigned short bf16_t;
typedef _Float16 f16_t;
typedef short bf16x8 __attribute__((ext_vector_type(8)));
typedef float f32x4 __attribute__((ext_vector_type(4)));
typedef float f32x16 __attribute__((ext_vector_type(16)));
typedef unsigned u32x4 __attribute__((ext_vector_type(4)));
typedef unsigned u32x2 __attribute__((ext_vector_type(2)));
typedef _Float16 f16x4 __attribute__((ext_vector_type(4)));

#ifndef DUP_PHASE
#define DUP_PHASE -1
#endif
#ifndef PROBE_VAR
#define PROBE_VAR 0
#endif
constexpr int D = 1024, BATCH = 8, SEQ = 4096, T = BATCH * SEQ, MEML = 256, TMEM = BATCH * MEML;
constexpr int INW = 5376;
constexpr int NTHREADS = 512, NWAVES = 8;
constexpr int NEXP = 16384;
constexpr float EPS = 1e-6f;

constexpr size_t MiB = 1u << 20;
constexpr size_t WS_WIN = 1 * MiB;
constexpr size_t WS_WBR = 12 * MiB;
constexpr size_t WS_WOUT = 16 * MiB;
constexpr size_t WS_WQ = 18 * MiB;
constexpr size_t WS_KEYS = 22 * MiB;
constexpr size_t WS_WPOOL = 22 * MiB + 512 * 1024;
constexpr size_t WS_RSTD1 = 22 * MiB + 768 * 1024;
constexpr size_t WS_RSTD2 = 22 * MiB + 896 * 1024;
constexpr size_t WS_RSTDM = 23 * MiB;
constexpr size_t WS_SSQO = 23 * MiB + 64 * 1024;
constexpr size_t WS_SU = 23 * MiB + 256 * 1024;
constexpr size_t WS_WMKV = 24 * MiB;
constexpr size_t WS_MEMB = 26 * MiB;
constexpr size_t WS_KVM = 30 * MiB;
constexpr size_t WS_ROPE = 34 * MiB;
constexpr size_t WS_XB = 42 * MiB;
constexpr size_t WS_POOLED = 42 * MiB;
constexpr size_t WS_MERGED = 170 * MiB;
constexpr size_t WS_U16 = 106 * MiB;
constexpr size_t WS_V16 = 138 * MiB;
constexpr size_t WS_UPOOL = 170 * MiB;
constexpr size_t WS_QR = 202 * MiB;
constexpr size_t WS_KR = 266 * MiB;
constexpr size_t WS_VV = 274 * MiB;
constexpr size_t WS_QM = 282 * MiB;
constexpr size_t WS_GATES = 314 * MiB;
constexpr size_t WS_X1B = 234 * MiB;
constexpr size_t WS_QP = 314 * MiB;
constexpr size_t WS_COEF = 314 * MiB;
constexpr size_t WS_IDS = 442 * MiB;
constexpr size_t WS_GTS = 458 * MiB;
constexpr size_t WS_END = 512 * MiB;

struct Params {
    const float* x; const float* mem; const int* pos; const float* norm1_g; const float* mem_norm_g; const float* w_in; const float* w_pool;
    const float* pool_scale; const float* sinks; const float* w_mem_kv; const float* w_bpool; const float* w_bswa; const float* w_bmem; const float* w_out;
    const float* norm2_g; const float* w_q; const float* sub_keys; const float* peer_u; const float* peer_v; const float* final_g;
    float* out; unsigned char* ws;
    int use_cg_sync; int pad_;
};

DI unsigned f2bf(float f) { unsigned u = __builtin_bit_cast(unsigned, f); return (u + 0x7fffu + ((u >> 16) & 1u)) >> 16; }
DI unsigned pk2(float lo, float hi) { return f2bf(lo) | (f2bf(hi) << 16); }
DI float bf2f(bf16_t b) { return __builtin_bit_cast(float, (unsigned)b << 16); }
DI float bflo(unsigned w) { return __builtin_bit_cast(float, w << 16); }
DI float bfhi(unsigned w) { return __builtin_bit_cast(float, w & 0xffff0000u); }
DI float wave_sum(float v) {
#pragma unroll
    for (int o = 1; o < 64; o <<= 1) v += __shfl_xor(v, o);
    return v;
}
DI float wave_max(float v) {
#pragma unroll
    for (int o = 1; o < 64; o <<= 1) v = fmaxf(v, __shfl_xor(v, o));
    return v;
}
DI float gelu_tanh(float x) {
    const float y2 = 1.5957691216057308f * (x + 0.044715f * x * x * x);
    return x * __builtin_amdgcn_rcpf(1.f + __builtin_amdgcn_exp2f(-1.4426950408889634f * y2));
}
DI float sigmoidf(float x) { return __builtin_amdgcn_rcpf(1.f + __builtin_amdgcn_exp2f(-1.4426950408889634f * x)); }

DI int opaque_tid() { int t = threadIdx.x; asm volatile("" : "+v"(t)); return t; }
DI int zperm(int n) {
    if (n < 512 || n >= 1664) return n;
    const int d = (n - 512) & 63, hb = n - d; return hb + 8 * ((d & 31) >> 2) + (d & 3) + 4 * (d >> 5);
}
template <bool ZPERM>
DI void transpose_item(const float* W, int K, int N, bf16_t* WT, int ldt, int roff, int coff, const float* g, float* scr, int item, int lane) {
    const int nblk = N / 32, kb = item / nblk, nb = item % nblk, k0 = 64 * kb, n0 = 32 * nb;
    float tv[32];
#pragma unroll
    for (int i = 0; i < 32; ++i) tv[i] = W[(size_t)(k0 + 2 * i + (lane >> 5)) * N + n0 + (lane & 31)];
#pragma unroll
    for (int i = 0; i < 32; ++i) { const int kk = 2 * i + (lane >> 5); float v = tv[i]; if (g) v *= g[k0 + kk]; scr[kk * 33 + (lane & 31)] = v; }
    asm volatile("s_waitcnt lgkmcnt(0)" ::: "memory");
    const int c = lane & 7;
#pragma unroll
    for (int j = 0; j < 4; ++j) { const int n = (lane >> 3) + 8 * j; const float* s = scr + (8 * c) * 33 + n;
        u32x4 o; o.x = pk2(s[0 * 33], s[1 * 33]); o.y = pk2(s[2 * 33], s[3 * 33]); o.z = pk2(s[4 * 33], s[5 * 33]); o.w = pk2(s[6 * 33], s[7 * 33]);
        const int nd = ZPERM ? zperm(n0 + n) : n0 + n;
        *(u32x4*)(WT + (size_t)(roff + nd) * ldt + coff + k0 + 8 * c) = o; }
    asm volatile("s_waitcnt lgkmcnt(0)" ::: "memory");
}

DI void row_to_bf16_rstd(const float* xrow, bf16_t* orow, float* rstd_out, int lane) {
    const f32x4* xr = (const f32x4*)xrow + lane;
    f32x4 v[4]; float s = 0.f;
#pragma unroll
    for (int j = 0; j < 4; ++j) { v[j] = xr[64 * j]; s += (v[j].x * v[j].x + v[j].y * v[j].y) + (v[j].z * v[j].z + v[j].w * v[j].w); }
    s = wave_sum(s);
    if (lane == 0) *rstd_out = 1.f / sqrtf(s * (1.f / D) + EPS);
    u32x2* o8 = (u32x2*)orow + lane;
#pragma unroll
    for (int j = 0; j < 4; ++j) { u32x2 w; w.x = pk2(v[j].x, v[j].y); w.y = pk2(v[j].z, v[j].w); o8[64 * j] = w; }
}

DI void phase0(const Params& p, float* lds_f) {
    const int tid_ = opaque_tid(), lane = tid_ & 63, wave = tid_ >> 6, gw = blockIdx.x * NWAVES + wave, NGW = gridDim.x * NWAVES;
    unsigned char* ws = p.ws;
    float* scr = lds_f + wave * (64 * 33);
    bf16_t* WinT = (bf16_t*)(ws + WS_WIN); bf16_t* WbrT = (bf16_t*)(ws + WS_WBR); bf16_t* WoutT = (bf16_t*)(ws + WS_WOUT); bf16_t* WqT = (bf16_t*)(ws + WS_WQ);
    bf16_t* WmkvT = (bf16_t*)(ws + WS_WMKV);
    constexpr int I_IN = (D / 64) * (INW / 32), I_BS = (1024 / 64) * (D / 32), I_BM = (512 / 64) * (D / 32), I_OUT = (D / 64) * (D / 32), I_Q = (D / 64) * (2048 / 32), I_MKV = (D / 64) * (D / 32);
    constexpr int NITEMS = I_IN + I_BS + I_BM + I_OUT + I_Q + I_MKV;
    for (int rp_ = 0; rp_ < (DUP_PHASE == 10 ? 2 : 1); ++rp_) {
    for (int it = gw; it < NITEMS; it += NGW) {
        int r = it;
        if (r < I_IN) { transpose_item<true>(p.w_in, D, INW, WinT, D, 0, 0, p.norm1_g, scr, r, lane); continue; } r -= I_IN;
        if (r < I_BS) { transpose_item<false>(p.w_bswa, 1024, D, WbrT, 2048, 0, 512, nullptr, scr, r, lane); continue; } r -= I_BS;
        if (r < I_BM) { transpose_item<false>(p.w_bmem, 512, D, WbrT, 2048, 0, 1536, nullptr, scr, r, lane); continue; } r -= I_BM;
        if (r < I_OUT) { transpose_item<false>(p.w_out, D, D, WoutT, D, 0, 0, nullptr, scr, r, lane); continue; } r -= I_OUT;
        if (r < I_Q) { transpose_item<false>(p.w_q, D, 2048, WqT, D, 0, 0, p.norm2_g, scr, r, lane); continue; } r -= I_Q;
        transpose_item<false>(p.w_mem_kv, D, D, WmkvT, D, 0, 0, p.mem_norm_g, scr, r, lane);
    }
    }
    for (int rp_ = 0; rp_ < (DUP_PHASE == 11 ? 2 : 1); ++rp_) {
    {
        const size_t gt0 = (size_t)gw * 64 + lane, NGT0 = (size_t)NGW * 64;
        for (size_t i = gt0; i < (size_t)512 * 256; i += NGT0) {
            const int n4 = (int)(i & 255), cp = (int)(i >> 8), g = cp >> 7;
            const float* wp = p.w_pool + (size_t)cp * 128; const float* sc = p.pool_scale + g * 128; const f32x4* wb = (const f32x4*)(p.w_bpool + (size_t)(g * 128) * 1024) + n4;
            f32x4 a = {0.f, 0.f, 0.f, 0.f};
#pragma unroll 16
            for (int d = 0; d < 128; ++d) a += wb[(size_t)d * 256] * (wp[d] * sc[d]);
            bf16_t* o = WbrT + (size_t)(4 * n4) * 2048 + cp;
            o[0] = (bf16_t)f2bf(a.x); o[2048] = (bf16_t)f2bf(a.y); o[4096] = (bf16_t)f2bf(a.z); o[6144] = (bf16_t)f2bf(a.w);
        }
    }
    }
    bf16_t* xb = (bf16_t*)(ws + WS_XB); float* rstd1 = (float*)(ws + WS_RSTD1);
    for (int rp_ = 0; rp_ < (DUP_PHASE == 12 ? 2 : 1); ++rp_) {
    for (int m = gw; m < T; m += 4 * NGW) {
        f32x4 v[4][4];
#pragma unroll
        for (int q = 0; q < 4; ++q) { const int mq = (m + q * NGW < T) ? m + q * NGW : m; const f32x4* xr = (const f32x4*)(p.x + (size_t)mq * D) + lane;
#pragma unroll
            for (int j = 0; j < 4; ++j) v[q][j] = xr[64 * j]; }
#pragma unroll
        for (int q = 0; q < 4; ++q) { const int mq = m + q * NGW; float s = 0.f;
#pragma unroll
            for (int j = 0; j < 4; ++j) s += (v[q][j].x * v[q][j].x + v[q][j].y * v[q][j].y) + (v[q][j].z * v[q][j].z + v[q][j].w * v[q][j].w);
            s = wave_sum(s);
            if (mq < T) { if (lane == 0) rstd1[mq] = __builtin_amdgcn_rsqf(s * (1.f / D) + EPS);
                u32x2* o8 = (u32x2*)(xb + (size_t)mq * D) + lane;
#pragma unroll
                for (int j = 0; j < 4; ++j) { u32x2 wv; wv.x = pk2(v[q][j].x, v[q][j].y); wv.y = pk2(v[q][j].z, v[q][j].w); o8[64 * j] = wv; } } }
    }
    }
    bf16_t* memb = (bf16_t*)(ws + WS_MEMB); float* rstdm = (float*)(ws + WS_RSTDM);
    for (int m = gw; m < TMEM; m += NGW) row_to_bf16_rstd(p.mem + (size_t)m * D, memb + (size_t)m * D, rstdm + m, lane);
    const size_t gt = (size_t)gw * 64 + lane, NGT = (size_t)NGW * 64;
    bf16_t* keysb = (bf16_t*)(ws + WS_KEYS);
    for (size_t i = gt; i < (size_t)8 * 2 * 128 * 128 / 4; i += NGT) { const f32x4 v = ((const f32x4*)p.sub_keys)[i]; u32x2 w; w.x = pk2(v.x, v.y); w.y = pk2(v.z, v.w); ((u32x2*)keysb)[i] = w; }
    for (int rp_ = 0; rp_ < (DUP_PHASE == 14 ? 2 : 1); ++rp_) {
    {
        unsigned* u8 = (unsigned*)(ws + WS_U16); unsigned* v8 = (unsigned*)(ws + WS_V16); float* su = (float*)(ws + WS_SU);
        f32x4 g2r[4];
#pragma unroll
        for (int j = 0; j < 4; ++j) g2r[j] = ((const f32x4*)p.norm2_g)[lane + 64 * j];
        for (int r0 = gw; r0 < NEXP; r0 += 2 * NGW) {
            f32x4 au[2][4], av[2][4];
#pragma unroll
            for (int h = 0; h < 2; ++h) { const int r = (r0 + h * NGW < NEXP) ? r0 + h * NGW : r0;
#pragma unroll
                for (int j = 0; j < 4; ++j) { au[h][j] = ((const f32x4*)p.peer_u)[(size_t)r * 256 + lane + 64 * j]; av[h][j] = ((const f32x4*)p.peer_v)[(size_t)r * 256 + lane + 64 * j]; } }
#pragma unroll
            for (int h = 0; h < 2; ++h) { const int r = r0 + h * NGW; if (r >= NEXP) continue;
                float mx = 0.f;
#pragma unroll
                for (int j = 0; j < 4; ++j) { au[h][j] = au[h][j] * g2r[j]; mx = fmaxf(fmaxf(mx, fmaxf(fabsf(au[h][j].x), fabsf(au[h][j].y))), fmaxf(fabsf(au[h][j].z), fabsf(au[h][j].w))); }
                mx = wave_max(mx);
                const float inv = mx > 0.f ? 7.f / mx : 0.f;
                if (lane == 0) su[r] = mx * (1.f / 7.f) * (1.f / 16.f);
#pragma unroll
                for (int j = 0; j < 4; ++j) { const f32x4 b = av[h][j] * 2.f;
                    const int ob = (lane & 1) ? 0 : 8;
                    const int q0 = (int)__builtin_rintf(au[h][j].x * inv) + ob, q1 = (int)__builtin_rintf(au[h][j].y * inv) + ob, q2 = (int)__builtin_rintf(au[h][j].z * inv) + ob, q3 = (int)__builtin_rintf(au[h][j].w * inv) + ob;
                    const unsigned pkn = (unsigned)(q0 & 15) | ((unsigned)(q1 & 15) << 8) | ((unsigned)(q2 & 15) << 16) | ((unsigned)(q3 & 15) << 24);
                    const unsigned nb = (unsigned)__builtin_amdgcn_update_dpp(0, (int)pkn, 0xB1, 0xf, 0xf, false);
                    const unsigned wa = pkn | (nb << 4);
                    int wb = __builtin_amdgcn_cvt_pk_fp8_f32(b.x, b.y, 0, false); wb = __builtin_amdgcn_cvt_pk_fp8_f32(b.z, b.w, wb, true);
                    if (!(lane & 1)) u8[(size_t)r * 128 + ((lane + 64 * j) >> 1)] = wa;
                    v8[(size_t)r * 256 + lane + 64 * j] = (unsigned)wb; } }
        }
    }
    }
    for (size_t i = gt; i < (size_t)T; i += NGT) { ((float*)(ws + WS_RSTD2))[i] = 0.f; ((float*)(ws + WS_SSQO))[i] = 0.f; }
    for (int rp_ = 0; rp_ < (DUP_PHASE == 15 ? 2 : 1); ++rp_) {
    float2* rope = (float2*)(ws + WS_ROPE);
    for (size_t i = gt; i < (size_t)T * 32; i += NGT) {
        const int t = (int)(i >> 5), d = (int)(i & 31);
        const float inv = exp2f(-(float)d * (13.287712379549449f / 32.f));
        const float ang = (float)p.pos[t] * inv;
        const double rev = (double)ang * 0.15915494309189535;
        const float fr = (float)(rev - floor(rev));
        rope[i] = make_float2(__builtin_amdgcn_cosf(fr), __builtin_amdgcn_sinf(fr));
    }
    }
}

namespace pg8 {
#define PG8_LAS __attribute__((address_space(3)))
constexpr int BM = 256, BK = 64, HALF = 128, HTB = HALF * BK * 2, STAGE_BYTES = 8 * HTB, NXCD = 8;
__host__ __device__ __forceinline__ int lds_byte(int r, int c) { const int st = (r >> 4) * 2 + (c >> 5), rr = r & 15, cc = c & 31, ob = rr * 64 + cc * 2; return st * 1024 + (ob ^ (((ob >> 9) & 1) << 5)); }
__host__ __device__ __forceinline__ void stage_rc(int b, int& R, int& C) { const int st = b / 1024, sb = b % 1024, swz = sb ^ (((sb >> 9) & 1) << 5); R = (st >> 1) * 16 + swz / 64; C = (st & 1) * 32 + (swz % 64) / 2; }
__host__ __device__ __forceinline__ int perm32(int rho) { const int n = rho >> 4, i = rho & 15; return 8 * (i >> 2) + 4 * n + (i & 3); }

struct Unit { const char* a; const char* b; int nt, pm, pn, tag; };
DI void tile_of(int L, int nM, int nN, int& pm, int& pn, int WGM = 4) {
    const int nwg = nM * nN; int wgid = L; { const int q = nwg / NXCD, r = nwg % NXCD, xcd = wgid % NXCD, off = wgid / NXCD; wgid = (xcd < r ? xcd * (q + 1) : r * (q + 1) + (xcd - r) * q) + off; }
    const int nig = WGM * nN, gid = wgid / nig, fm = gid * WGM, gsz = (nM - fm) < WGM ? (nM - fm) : WGM;
    pm = fm + ((wgid % nig) % gsz); pn = (wgid % nig) / gsz;
}
template <class Epi, class Sched>
DI void gemm_phase(PG8_LAS unsigned char* lds, int lda, int ldb, const Sched& S, const Epi& E) {
    int tid = threadIdx.x; asm volatile("" : "+v"(tid));
    const int wid = __builtin_amdgcn_readfirstlane(tid >> 6), wr = wid >> 2, wc = wid & 3, lane = tid & 63, fr = lane & 15, fq = lane >> 4;
    unsigned voffA[2], voffB[2];
#pragma unroll
    for (int i = 0; i < 2; ++i) { int R, C; stage_rc(tid * 16 + i * 8192, R, C); const int Rb = 64 * (R >> 5) + perm32(R & 31);
        voffA[i] = (unsigned)(R * lda + C) * 2u; voffB[i] = (unsigned)(Rb * ldb + C) * 2u; }
    const size_t kstep = (size_t)(BK * 2);
    const size_t hstepA = (size_t)HALF * lda * 2, hstepB = (size_t)32 * ldb * 2;
    const unsigned ldsw = (unsigned)wid * 1024u;
    const int aoff = lds_byte(wr * 64 + fr, fq * 8), boff = lds_byte(wc * 32 + fr, fq * 8);
#define PG8_SA(b, h) (((b) * 2 + (h)) * HTB)
#define PG8_SB(b, h) ((4 + (b) * 2 + (h)) * HTB)
#define PG8_STAGE(bufoff, gbase, voff) do { _Pragma("unroll") for (int _i = 0; _i < 2; ++_i) \
        __builtin_amdgcn_global_load_lds((const unsigned*)((const char*)(gbase) + (voff)[_i]), (PG8_LAS unsigned*)(lds + (bufoff) + ldsw + _i * 8192), 16, 0, 0); } while (0)
#define PG8_LDA(dst, b, h) do { _Pragma("unroll") for (int m = 0; m < 4; ++m) _Pragma("unroll") for (int k = 0; k < 2; ++k) dst[m][k] = *(const PG8_LAS bf16x8*)(lds + PG8_SA(b, h) + aoff + m * 2048 + k * 1024); } while (0)
#define PG8_LDB(dst, b, h) do { _Pragma("unroll") for (int n = 0; n < 2; ++n) _Pragma("unroll") for (int k = 0; k < 2; ++k) dst[n][k] = *(const PG8_LAS bf16x8*)(lds + PG8_SB(b, h) + boff + n * 2048 + k * 1024); } while (0)
#define PG8_MMA(ai, bj, At, Bt) do { __builtin_amdgcn_s_setprio(1); _Pragma("unroll") for (int m = 0; m < 4; ++m) _Pragma("unroll") for (int n = 0; n < 2; ++n) _Pragma("unroll") for (int k = 0; k < 2; ++k) \
        acc[ai][bj][m][n] = __builtin_amdgcn_mfma_f32_16x16x32_bf16(Bt[n][k], At[m][k], acc[ai][bj][m][n], 0, 0, 0); __builtin_amdgcn_s_setprio(0); } while (0)
#define PG8_WAIT_V(n) asm volatile("s_waitcnt vmcnt(" #n ")" ::: "memory")
#define PG8_WAIT_L(n) asm volatile("s_waitcnt lgkmcnt(" #n ")" ::: "memory")
#define PG8_BAR __builtin_amdgcn_s_barrier()
#define PG8_SCHED __builtin_amdgcn_sched_barrier(0)
    Unit cur, nxt; int ui = 0;
    if (!S.next(0, cur)) return;
    f32x4 acc[2][2][4][2];
#pragma unroll
    for (int a = 0; a < 2; ++a)
#pragma unroll
        for (int b = 0; b < 2; ++b)
#pragma unroll
            for (int m = 0; m < 4; ++m)
#pragma unroll
                for (int n = 0; n < 2; ++n) acc[a][b][m][n] = (f32x4){0.f, 0.f, 0.f, 0.f};
    bf16x8 At[4][2], B0[2][2], B1[2][2];
    const char* cA = cur.a; const char* cB = cur.b;
    PG8_STAGE(PG8_SB(0, 0), cB, voffB); PG8_STAGE(PG8_SB(0, 1), cB + hstepB, voffB); PG8_STAGE(PG8_SA(0, 0), cA, voffA); PG8_STAGE(PG8_SA(0, 1), cA + hstepA, voffA);
    if (wr == 1) PG8_BAR;
    PG8_WAIT_V(2); PG8_BAR;
    PG8_STAGE(PG8_SB(1, 0), cB + kstep, voffB); PG8_STAGE(PG8_SA(1, 0), cA + kstep, voffA); PG8_STAGE(PG8_SB(1, 1), cB + hstepB + kstep, voffB);
    PG8_WAIT_V(6); PG8_BAR;
    for (;;) {
        const bool has_next = S.next(ui + 1, nxt);
        const char* nA = has_next ? nxt.a : cA; const char* nB = has_next ? nxt.b : cB;
        const int nt = cur.nt;
        for (int t = 0; t < nt; t += 2) {
            const bool last = (t == nt - 2);
            const char* a1 = cA + (size_t)(t + 1) * kstep;
            const char* a2 = last ? nA : cA + (size_t)(t + 2) * kstep; const char* b2 = last ? nB : cB + (size_t)(t + 2) * kstep;
            const char* a3 = a2 + kstep; const char* b3 = b2 + kstep;
            PG8_LDB(B0, 0, 0); PG8_LDB(B1, 0, 1); PG8_SCHED; PG8_LDA(At, 0, 0); PG8_STAGE(PG8_SA(1, 1), a1 + hstepA, voffA);
            PG8_WAIT_V(8); PG8_WAIT_L(0); PG8_BAR; PG8_MMA(0, 0, At, B0); PG8_MMA(0, 1, At, B1); PG8_BAR; PG8_SCHED;
            PG8_LDA(At, 0, 1); PG8_STAGE(PG8_SB(0, 0), b2, voffB); PG8_STAGE(PG8_SB(0, 1), b2 + hstepB, voffB); PG8_STAGE(PG8_SA(0, 0), a2, voffA);
            PG8_WAIT_V(8); PG8_WAIT_L(0); PG8_BAR; PG8_MMA(1, 0, At, B0); PG8_MMA(1, 1, At, B1); PG8_BAR; PG8_SCHED;
            PG8_LDB(B0, 1, 0); PG8_LDB(B1, 1, 1); PG8_SCHED; PG8_LDA(At, 1, 0); PG8_STAGE(PG8_SA(0, 1), a2 + hstepA, voffA);
            PG8_WAIT_V(8); PG8_WAIT_L(0); PG8_BAR; PG8_MMA(0, 0, At, B0); PG8_MMA(0, 1, At, B1); PG8_BAR; PG8_SCHED;
            PG8_LDA(At, 1, 1); PG8_STAGE(PG8_SB(1, 0), b3, voffB); PG8_STAGE(PG8_SB(1, 1), b3 + hstepB, voffB); PG8_STAGE(PG8_SA(1, 0), a3, voffA);
            PG8_WAIT_V(8); PG8_WAIT_L(0); PG8_BAR; PG8_MMA(1, 0, At, B0); PG8_MMA(1, 1, At, B1); PG8_BAR; PG8_SCHED;
        }
        if (wr == 0) PG8_BAR;
        const bool keep_ = E(acc, cur, wr, wc, fr, fq);
        if (!has_next) break;
        if (!keep_)
#pragma unroll
        for (int a = 0; a < 2; ++a)
#pragma unroll
            for (int b = 0; b < 2; ++b)
#pragma unroll
                for (int m = 0; m < 4; ++m)
#pragma unroll
                    for (int n = 0; n < 2; ++n) acc[a][b][m][n] = (f32x4){0.f, 0.f, 0.f, 0.f};
        cur = nxt; cA = nA; cB = nB; ++ui;
        if (wr == 1) PG8_BAR;
    }
    PG8_WAIT_V(0);
    PG8_BAR;
#undef PG8_SA
#undef PG8_SB
#undef PG8_STAGE
#undef PG8_LDA
#undef PG8_LDB
#undef PG8_MMA
#undef PG8_WAIT_V
#undef PG8_WAIT_L
#undef PG8_BAR
#undef PG8_SCHED
}
}
typedef f32x4 acc_t[2][2][4][2];

struct SchedPlain {
    const char* A; const char* Bt; int lda, ldb, nM, nN, nt, G, c;
    DI bool next(int i, pg8::Unit& u) const {
        const long L = (long)i * G + c; if (L >= (long)nM * nN) return false;
        pg8::tile_of((int)L, nM, nN, u.pm, u.pn); u.a = A + (size_t)u.pm * 256 * lda * 2; u.b = Bt + (size_t)u.pn * 256 * ldb * 2; u.nt = nt; u.tag = 0; return true;
    }
};
struct SchedZ {
    const char *xb, *win, *memb, *wmkv; int G, c;
    DI bool next(int i, pg8::Unit& u) const {
        const long L = (long)i * G + c; constexpr int NZ = 128 * 21;
        if (L < NZ) { pg8::tile_of((int)L, 128, 21, u.pm, u.pn); u.a = xb + (size_t)u.pm * 256 * 2048; u.b = win + (size_t)u.pn * 256 * 2048; u.nt = 16; u.tag = 0; return true; }
        const int j = (int)(L - NZ); if (j >= 32) return false;
        u.pm = j >> 2; u.pn = j & 3; u.a = memb + (size_t)u.pm * 256 * 2048; u.b = wmkv + (size_t)u.pn * 256 * 2048; u.nt = 16; u.tag = 1; return true;
    }
};
struct SchedGated {
    const char *ycat, *wbr; int G, c;
    DI bool next(int i, pg8::Unit& u) const {
        const int j = i / 3, b = i - 3 * j; const long L = (long)j * G + c; if (L >= 128 * 4) return false;
        pg8::tile_of((int)L, 128, 4, u.pm, u.pn);
        const int koff = (b == 0) ? 0 : (b == 1 ? 512 : 1536);
        u.a = ycat + ((size_t)u.pm * 256 * 2048 + koff) * 2; u.b = wbr + ((size_t)u.pn * 256 * 2048 + koff) * 2; u.nt = (b == 1) ? 16 : 8; u.tag = b; return true;
    }
};

template <int CTRL> DI unsigned dpp_u(unsigned v) { return (unsigned)__builtin_amdgcn_update_dpp(0, (int)v, CTRL, 0xf, 0xf, false); }
DI void store_lines16(bf16_t* blk  , size_t ld, int fr, const u32x4& P0, const u32x4& P1) {
    const bool lo = fr < 8;
    const u32x4 X = lo ? P1 : P0;
    u32x4 Y; Y.x = dpp_u<0x128>(X.x); Y.y = dpp_u<0x128>(X.y); Y.z = dpp_u<0x128>(X.z); Y.w = dpp_u<0x128>(X.w);
    const u32x4 A = lo ? P0 : Y, B = lo ? Y : P1;
    bf16_t* pa = blk + (size_t)(fr & 7) * ld + 32 * (fr >> 3);
    *(u32x4*)pa = A; *(u32x4*)(pa + 8 * ld) = B;
}
DI void store_lines8(unsigned char* blk  , size_t ld, int fr, const u32x2& P0, const u32x2& P1) {
    const bool lo = fr < 8;
    const u32x2 X = lo ? P1 : P0;
    u32x2 Y; Y.x = dpp_u<0x128>(X.x); Y.y = dpp_u<0x128>(X.y);
    const u32x2 A = lo ? P0 : Y, B = lo ? Y : P1;
    unsigned char* pa = blk + (size_t)(fr & 7) * ld + 32 * (fr >> 3);
    *(u32x2*)pa = A; *(u32x2*)(pa + 8 * ld) = B;
}
DI u32x4 pack8(const f32x4& a, const f32x4& b) { u32x4 w; w.x = pk2(a[0], a[1]); w.y = pk2(a[2], a[3]); w.z = pk2(b[0], b[1]); w.w = pk2(b[2], b[3]); return w; }
struct EpiZ {
    const float* rstd1; const float* rstdm; const float2* rope; bf16_t *upool, *qr, *kr, *vv, *qm; unsigned char* gates; bf16_t* kvm;
    DI bool operator()(const acc_t& acc, const pg8::Unit& u, int wr, int wc, int fr_, int fq_) const {
        int l_ = threadIdx.x; asm volatile("" : "+v"(l_)); const int fr = l_ & 15, fq = (l_ >> 4) & 3;
        const int row0 = u.pm * 256 + wr * 64 + fr;
        const float* rsp = (u.tag == 1) ? rstdm : rstd1;
        float rs[2][4];
#pragma unroll
        for (int ai = 0; ai < 2; ++ai)
#pragma unroll
            for (int m = 0; m < 4; ++m) rs[ai][m] = rsp[row0 + ai * 128 + m * 16];
        if (u.tag == 1) {
            bf16_t* tile = kvm + (size_t)(u.pm * 256 + wr * 64) * 1024 + u.pn * 256 + wc * 64 + 8 * fq;
#pragma unroll
            for (int ai = 0; ai < 2; ++ai)
#pragma unroll
                for (int m = 0; m < 4; ++m) store_lines16(tile + (size_t)(ai * 128 + m * 16) * 1024, 1024, fr, pack8(acc[ai][0][m][0] * rs[ai][m], acc[ai][0][m][1] * rs[ai][m]), pack8(acc[ai][1][m][0] * rs[ai][m], acc[ai][1][m][1] * rs[ai][m]));
            return false;
        }
        const int cb = u.pn * 256 + wc * 64;
        if (cb >= 512 && cb < 1664) {
#pragma unroll
            for (int bj = 0; bj < 2; ++bj) {
                const int c = cb + bj * 32 + 8 * fq;
                const bool isq = cb < 1536; const int rel = isq ? c - 512 : c - 1536; const int hrel = rel & 63, d0 = hrel >> 1, hb = rel - hrel;
                const float sc = isq ? 0.125f : 1.f;
#pragma unroll
                for (int ai = 0; ai < 2; ++ai) {
                    f32x4 cs0[4], cs1[4];
#pragma unroll
                    for (int m = 0; m < 4; ++m) { const int row = row0 + ai * 128 + m * 16;
                        cs0[m] = *(const f32x4*)(rope + (size_t)row * 32 + d0); cs1[m] = *(const f32x4*)(rope + (size_t)row * 32 + d0 + 2); }
#pragma unroll
                    for (int m = 0; m < 4; ++m) { const int row = row0 + ai * 128 + m * 16;
                        const f32x4 v0 = acc[ai][bj][m][0] * rs[ai][m], v1 = acc[ai][bj][m][1] * rs[ai][m], a0 = cs0[m], a1 = cs1[m];
                        f32x4 o1, o2;
                        o1[0] = (v0[0] * a0[0] - v1[0] * a0[1]) * sc; o2[0] = (v1[0] * a0[0] + v0[0] * a0[1]) * sc;
                        o1[1] = (v0[1] * a0[2] - v1[1] * a0[3]) * sc; o2[1] = (v1[1] * a0[2] + v0[1] * a0[3]) * sc;
                        o1[2] = (v0[2] * a1[0] - v1[2] * a1[1]) * sc; o2[2] = (v1[2] * a1[0] + v0[2] * a1[1]) * sc;
                        o1[3] = (v0[3] * a1[2] - v1[3] * a1[3]) * sc; o2[3] = (v1[3] * a1[2] + v0[3] * a1[3]) * sc;
                        bf16_t* dst = isq ? qr + (size_t)row * 1024 + hb + d0 : kr + (size_t)row * 128 + hb + d0;
                        u32x2 w1, w2; w1.x = pk2(o1[0], o1[1]); w1.y = pk2(o1[2], o1[3]); w2.x = pk2(o2[0], o2[1]); w2.y = pk2(o2[2], o2[3]);
                        *(u32x2*)dst = w1; *(u32x2*)(dst + 32) = w2; }
                }
            }
        } else if (cb >= 2304) {
            unsigned char* tile = gates + (size_t)(u.pm * 256 + wr * 64) * 3072 + (cb - 2304) + 8 * fq;
#pragma unroll
            for (int ai = 0; ai < 2; ++ai)
#pragma unroll
                for (int m = 0; m < 4; ++m) {
                    u32x2 wq[2];
#pragma unroll
                    for (int bj = 0; bj < 2; ++bj) { const f32x4 v0 = acc[ai][bj][m][0] * rs[ai][m], v1 = acc[ai][bj][m][1] * rs[ai][m]; u32x2 w = {0u, 0u};
#pragma unroll
                        for (int e = 0; e < 4; ++e) {
                            const float t0 = __builtin_amdgcn_rcpf(__builtin_fmaf(__builtin_amdgcn_exp2f(-1.4426950408889634f * v0[e]), 1.f / 256.f, 1.f / 256.f));
                            const float t1 = __builtin_amdgcn_rcpf(__builtin_fmaf(__builtin_amdgcn_exp2f(-1.4426950408889634f * v1[e]), 1.f / 256.f, 1.f / 256.f));
                            w.x = __builtin_amdgcn_cvt_pk_u8_f32(__builtin_floorf(t0), e, w.x); w.y = __builtin_amdgcn_cvt_pk_u8_f32(__builtin_floorf(t1), e, w.y); }
                        wq[bj] = w; }
                    store_lines8(tile + (size_t)(ai * 128 + m * 16) * 3072, 3072, fr, wq[0], wq[1]);
                }
        } else {
            bf16_t* dstp; size_t ld;
            if (cb < 512) { dstp = upool + cb; ld = 512; } else if (cb < 1792) { dstp = vv + (cb - 1664); ld = 128; } else { dstp = qm + (cb - 1792); ld = 512; }
            bf16_t* tile = dstp + (size_t)(u.pm * 256 + wr * 64) * ld + 8 * fq;
#pragma unroll
            for (int ai = 0; ai < 2; ++ai)
#pragma unroll
                for (int m = 0; m < 4; ++m) store_lines16(tile + (size_t)(ai * 128 + m * 16) * ld, ld, fr, pack8(acc[ai][0][m][0] * rs[ai][m], acc[ai][0][m][1] * rs[ai][m]), pack8(acc[ai][1][m][0] * rs[ai][m], acc[ai][1][m][1] * rs[ai][m]));
        }
        return false;
    }
};
struct EpiGated {
    const unsigned char* gates; bf16_t* merged;
    static DI float gv(unsigned w, int e) { return ((float)((w >> (8 * e)) & 255u) + 0.5f) * (1.f / 256.f); }
    DI bool operator()(acc_t& acc, const pg8::Unit& u, int wr, int wc, int fr_, int fq_) const {
        int l_ = threadIdx.x; asm volatile("" : "+v"(l_)); const int fr = l_ & 15, fq = (l_ >> 4) & 3;
        const int row0 = u.pm * 256 + wr * 64 + fr, b = u.tag;
#pragma unroll
        for (int ai = 0; ai < 2; ++ai) {
            u32x2 gq[4][2], gnq[4][2];
#pragma unroll
            for (int m = 0; m < 4; ++m)
#pragma unroll
                for (int bj = 0; bj < 2; ++bj) { const unsigned char* gp = gates + (size_t)(row0 + ai * 128 + m * 16) * 3072 + b * 1024 + u.pn * 256 + wc * 64 + bj * 32 + 8 * fq;
                    gq[m][bj] = *(const u32x2*)gp; if (b < 2) gnq[m][bj] = *(const u32x2*)(gp + 1024); else gnq[m][bj] = gq[m][bj]; }
#pragma unroll
            for (int m = 0; m < 4; ++m) { const int row = row0 + ai * 128 + m * 16;
#pragma unroll
                for (int bj = 0; bj < 2; ++bj) { const int c = u.pn * 256 + wc * 64 + bj * 32 + 8 * fq;
                    const u32x2 g = gq[m][bj], gn = gnq[m][bj];
                    f32x4 s0, s1;
#pragma unroll
                    for (int e = 0; e < 4; ++e) { s0[e] = gv(g.x, e); s1[e] = gv(g.y, e); }
                    if (b < 2) {
#pragma unroll
                        for (int e = 0; e < 4; ++e) { s0[e] *= __builtin_amdgcn_rcpf(gv(gn.x, e)); s1[e] *= __builtin_amdgcn_rcpf(gv(gn.y, e)); }
                        acc[ai][bj][m][0] *= s0; acc[ai][bj][m][1] *= s1; }
                    else { acc[ai][bj][m][0] *= s0; acc[ai][bj][m][1] *= s1; } }
                if (b == 2) store_lines16(merged + (size_t)(u.pm * 256 + wr * 64 + ai * 128 + m * 16) * 1024 + u.pn * 256 + wc * 64 + 8 * fq, 1024, fr, pack8(acc[ai][0][m][0], acc[ai][0][m][1]), pack8(acc[ai][1][m][0], acc[ai][1][m][1])); }
        }
        return b < 2;
    }
};
struct EpiOut {
    const bf16_t* xb; bf16_t* x1b; float* ssq;
    DI bool operator()(const acc_t& acc, const pg8::Unit& u, int wr, int wc, int fr_, int fq_) const {
        int l_ = threadIdx.x; asm volatile("" : "+v"(l_)); const int fr = l_ & 15, fq = (l_ >> 4) & 3;
        const int row0 = u.pm * 256 + wr * 64 + fr;
#pragma unroll
        for (int ai = 0; ai < 2; ++ai) {
            u32x4 xq[4][2];
#pragma unroll
            for (int m = 0; m < 4; ++m)
#pragma unroll
                for (int bj = 0; bj < 2; ++bj) xq[m][bj] = *(const u32x4*)(xb + (size_t)(row0 + ai * 128 + m * 16) * D + u.pn * 256 + wc * 64 + bj * 32 + 8 * fq);
#pragma unroll
            for (int m = 0; m < 4; ++m) { const int row = row0 + ai * 128 + m * 16; float sq = 0.f; u32x4 pk[2];
#pragma unroll
                for (int bj = 0; bj < 2; ++bj) { const size_t o = (size_t)row * D + u.pn * 256 + wc * 64 + bj * 32 + 8 * fq;
                    const u32x4 xw = xq[m][bj];
                    f32x4 v0 = acc[ai][bj][m][0], v1 = acc[ai][bj][m][1];
                    v0[0] += bflo(xw.x); v0[1] += bfhi(xw.x); v0[2] += bflo(xw.y); v0[3] += bfhi(xw.y); v1[0] += bflo(xw.z); v1[1] += bfhi(xw.z); v1[2] += bflo(xw.w); v1[3] += bfhi(xw.w);
                    sq += (v0[0] * v0[0] + v0[1] * v0[1]) + (v0[2] * v0[2] + v0[3] * v0[3]) + (v1[0] * v1[0] + v1[1] * v1[1]) + (v1[2] * v1[2] + v1[3] * v1[3]);
                    pk[bj] = pack8(v0, v1); }
                store_lines16(x1b + (size_t)(u.pm * 256 + wr * 64 + ai * 128 + m * 16) * D + u.pn * 256 + wc * 64 + 8 * fq, D, fr, pk[0], pk[1]);
                sq += __shfl_xor(sq, 16); sq += __shfl_xor(sq, 32);
                if (fq == 0) atomicAdd(ssq + row, sq); }
        }
        return false;
    }
};
struct EpiBf16 {
    bf16_t* O; int ldo;
    DI bool operator()(const acc_t& acc, const pg8::Unit& u, int wr, int wc, int fr_, int fq_) const {
        int l_ = threadIdx.x; asm volatile("" : "+v"(l_)); const int fr = l_ & 15, fq = (l_ >> 4) & 3;
        bf16_t* tile = O + (size_t)(u.pm * 256 + wr * 64) * ldo + u.pn * 256 + wc * 64 + 8 * fq;
#pragma unroll
        for (int ai = 0; ai < 2; ++ai)
#pragma unroll
            for (int m = 0; m < 4; ++m) store_lines16(tile + (size_t)(ai * 128 + m * 16) * ldo, (size_t)ldo, fr, pack8(acc[ai][0][m][0], acc[ai][0][m][1]), pack8(acc[ai][1][m][0], acc[ai][1][m][1]));
        return false;
    }
};

DI void unpack8(const u32x4& w, float (&f)[8]) { f[0] = bflo(w.x); f[1] = bfhi(w.x); f[2] = bflo(w.y); f[3] = bfhi(w.y); f[4] = bflo(w.z); f[5] = bfhi(w.z); f[6] = bflo(w.w); f[7] = bfhi(w.w); }
DI void pooled_phase(const bf16_t* upool, bf16_t* pooled) {
    const int tid = opaque_tid(), lane = tid & 63, gw = blockIdx.x * NWAVES + (tid >> 6), NGW = gridDim.x * NWAVES;
    const int c = lane * 8, w = 2 << (lane >> 4);
    for (int task = gw; task < T / 16; task += NGW) {
        const int t0 = task * 16, s0 = t0 & (SEQ - 1);
        const bf16_t* up = upool + (size_t)t0 * 512 + c;
        u32x4 hw[15], nw[16], ow[16];
#pragma unroll
        for (int j = 1; j < 16; ++j) { const int jj = (s0 - j >= 0) ? j : 0; hw[j - 1] = *(const u32x4*)(up - (ptrdiff_t)jj * 512); }
#pragma unroll
        for (int i = 0; i < 16; ++i) { nw[i] = *(const u32x4*)(up + (size_t)i * 512); const int back = (s0 + i - (w - 1) >= 0) ? (w - 1) : 0; ow[i] = *(const u32x4*)(up + (ptrdiff_t)(i - back) * 512); }
        float win[8];
#pragma unroll
        for (int e = 0; e < 8; ++e) win[e] = 0.f;
#pragma unroll
        for (int j = 1; j < 16; ++j) { float f[8]; unpack8(hw[j - 1], f); const float mk = (j < w && s0 - j >= 0) ? 1.f : 0.f;
#pragma unroll
            for (int e = 0; e < 8; ++e) win[e] += mk * f[e]; }
#pragma unroll
        for (int i = 0; i < 16; ++i) {
            const int s = s0 + i;
            float un[8], uo[8];
            unpack8(nw[i], un); unpack8(ow[i], uo);
            const float mo = (s - (w - 1) >= 0) ? 1.f : 0.f;
            const int cnt = (s + 1 < w) ? s + 1 : w; const float ic = __builtin_amdgcn_rcpf((float)cnt);
            float o[8];
#pragma unroll
            for (int e = 0; e < 8; ++e) { const float tot = win[e] + un[e]; o[e] = tot * ic - un[e]; win[e] = tot - mo * uo[e]; }
            u32x4 ov; ov.x = pk2(o[0], o[1]); ov.y = pk2(o[2], o[3]); ov.z = pk2(o[4], o[5]); ov.w = pk2(o[6], o[7]);
            *(u32x4*)(pooled + (size_t)(t0 + i) * 2048 + c) = ov;
        }
    }
}
typedef __bf16 bf16x2_t __attribute__((ext_vector_type(2)));
typedef float f32x2_t __attribute__((ext_vector_type(2)));
DI unsigned cvtpk(float lo, float hi) { f32x2_t v = {lo, hi}; bf16x2_t b = __builtin_convertvector(v, bf16x2_t); return __builtin_bit_cast(unsigned, b); }
DI int crow(int i, int h) { return (i & 3) + 8 * (i >> 2) + 4 * h; }
#define MFMA32(a, b, c) __builtin_amdgcn_mfma_f32_32x32x16_bf16((a), (b), (c), 0, 0, 0)
DI bf16x8 mk8(unsigned a, unsigned b, unsigned c, unsigned d) { u32x4 w = {a, b, c, d}; return __builtin_bit_cast(bf16x8, w); }

constexpr int SWA_KLD = 72, SWA_VLD = 260, SWA_VT_OFF = 256 * SWA_KLD * 2;
DI void swa_phase(const bf16_t* qr, const bf16_t* kr, const bf16_t* vv, const float* sinks, bf16_t* ycat, unsigned char* lds) {
    const int tid = opaque_tid();
    const int lane = tid & 63, w = tid >> 6, r = lane & 31, h = lane >> 5;
    bf16_t* Ks = (bf16_t*)lds; bf16_t* Vt = (bf16_t*)(lds + SWA_VT_OFF);
    for (int unit = blockIdx.x; unit < 512; unit += gridDim.x) {
        const int kvh = unit & 1, nb = (unit >> 1) & 31, b = unit >> 6;
        const int tq0 = b * SEQ + nb * 128, tk0 = tq0 - 128;
        const int hq = kvh * 8 + w; const float sink = sinks[hq];
        bf16x8 qn[4];
        { const bf16_t* qp = qr + (size_t)(tq0 + r) * 1024 + hq * 64 + 8 * h;
#pragma unroll
          for (int s = 0; s < 4; ++s) qn[s] = *(const bf16x8*)(qp + 16 * s); }
        __syncthreads();
#pragma unroll
        for (int i = 0; i < 4; ++i) {
            const int c = tid + 512 * i, kb = c >> 3, dc = (c & 7) * 8;
            u32x4 kv = {0u, 0u, 0u, 0u}, vx = {0u, 0u, 0u, 0u};
            if (nb > 0 || kb >= 128) { kv = *(const u32x4*)(kr + (size_t)(tk0 + kb) * 128 + kvh * 64 + dc); vx = *(const u32x4*)(vv + (size_t)(tk0 + kb) * 128 + kvh * 64 + dc); }
            *(u32x4*)(Ks + kb * SWA_KLD + dc) = kv;
            bf16_t* vp = Vt + dc * SWA_VLD + kb;
            vp[0 * SWA_VLD] = (bf16_t)(vx.x & 0xffffu); vp[1 * SWA_VLD] = (bf16_t)(vx.x >> 16); vp[2 * SWA_VLD] = (bf16_t)(vx.y & 0xffffu); vp[3 * SWA_VLD] = (bf16_t)(vx.y >> 16);
            vp[4 * SWA_VLD] = (bf16_t)(vx.z & 0xffffu); vp[5 * SWA_VLD] = (bf16_t)(vx.z >> 16); vp[6 * SWA_VLD] = (bf16_t)(vx.w & 0xffffu); vp[7 * SWA_VLD] = (bf16_t)(vx.w >> 16);
        }
        __syncthreads();
        for (int qt = 0; qt < 4; ++qt) {
            bf16x8 qf[4];
#pragma unroll
            for (int s = 0; s < 4; ++s) qf[s] = qn[s];
            if (qt < 3) { const bf16_t* qp = qr + (size_t)(tq0 + 32 * (qt + 1) + r) * 1024 + hq * 64 + 8 * h;
#pragma unroll
                for (int s = 0; s < 4; ++s) qn[s] = *(const bf16x8*)(qp + 16 * s); }
            f32x16 sa[5];
#pragma unroll
            for (int c = 0; c < 5; ++c) {
#pragma unroll
                for (int i = 0; i < 16; ++i) sa[c][i] = 0.f;
#pragma unroll
                for (int s = 0; s < 4; ++s) { const bf16x8 kf = *(const bf16x8*)(Ks + (32 * (qt + c) + r) * SWA_KLD + 16 * s + 8 * h); sa[c] = MFMA32(kf, qf[s], sa[c]); }
            }
            float mx = sink;
#pragma unroll
            for (int c = 0; c < 5; ++c)
#pragma unroll
                for (int i = 0; i < 16; ++i) {
                    const int kk = 32 * c + crow(i, h);
                    bool vis = (c == 0) ? (kk > r) : ((c == 4) ? (kk - 128 <= r) : true);
                    if (nb == 0) vis = vis && (32 * qt + kk >= 128);
                    const float s = vis ? sa[c][i] : -1e30f; sa[c][i] = s; mx = fmaxf(mx, s);
                }
            mx = fmaxf(mx, __shfl_xor(mx, 32));
            float l = 0.f;
#pragma unroll
            for (int c = 0; c < 5; ++c)
#pragma unroll
                for (int i = 0; i < 16; ++i) { const float pz = __expf(sa[c][i] - mx); sa[c][i] = pz; l += pz; }
            l += __shfl_xor(l, 32); l += __expf(sink - mx);
            const float inv = 1.f / l;
            f32x16 oa[2];
#pragma unroll
            for (int i = 0; i < 16; ++i) { oa[0][i] = 0.f; oa[1][i] = 0.f; }
#pragma unroll
            for (int c = 0; c < 5; ++c)
#pragma unroll
                for (int s2 = 0; s2 < 2; ++s2) {
                    const bf16x8 pf = mk8(cvtpk(sa[c][8 * s2 + 0], sa[c][8 * s2 + 1]), cvtpk(sa[c][8 * s2 + 2], sa[c][8 * s2 + 3]), cvtpk(sa[c][8 * s2 + 4], sa[c][8 * s2 + 5]), cvtpk(sa[c][8 * s2 + 6], sa[c][8 * s2 + 7]));
#pragma unroll
                    for (int dt = 0; dt < 2; ++dt) {
                        const bf16_t* va = Vt + (32 * dt + r) * SWA_VLD + 32 * (qt + c) + 16 * s2 + 4 * h;
                        const u32x2 lo = *(const u32x2*)va, hi = *(const u32x2*)(va + 8);
                        oa[dt] = MFMA32(mk8(lo.x, lo.y, hi.x, hi.y), pf, oa[dt]);
                    }
                }
            bf16_t* yp = ycat + (size_t)(tq0 + 32 * qt + r) * 2048 + 512 + hq * 64 + 4 * h;
#pragma unroll
            for (int dt = 0; dt < 2; ++dt)
#pragma unroll
                for (int g4 = 0; g4 < 4; ++g4) { u32x2 o; o.x = cvtpk(oa[dt][4 * g4] * inv, oa[dt][4 * g4 + 1] * inv); o.y = cvtpk(oa[dt][4 * g4 + 2] * inv, oa[dt][4 * g4 + 3] * inv);
                    *(u32x2*)(yp + 32 * dt + 8 * g4) = o; }
        }
    }
}

constexpr int MEM_KLD = 136, MEM_VLD = 260, MEM_VT_OFF = 256 * MEM_KLD * 2;
DI void mem_phase(const bf16_t* qm, const bf16_t* kvm, bf16_t* ycat, unsigned char* lds) {
    const int tid = opaque_tid();
    const int lane = tid & 63, w = tid >> 6, r = lane & 31, h = lane >> 5;
    bf16_t* Ks = (bf16_t*)lds; bf16_t* Vt = (bf16_t*)(lds + MEM_VT_OFF);
    for (int unit = blockIdx.x; unit < 256; unit += gridDim.x) {
        const int qc = unit & 7, hm = (unit >> 3) & 3, b = unit >> 5;
        bf16x8 qn[8];
        { const bf16_t* qp = qm + (size_t)(b * SEQ + qc * 512 + (w * 2) * 32 + r) * 512 + hm * 128 + 8 * h;
#pragma unroll
          for (int s = 0; s < 8; ++s) qn[s] = *(const bf16x8*)(qp + 16 * s); }
        __syncthreads();
#pragma unroll
        for (int i = 0; i < 8; ++i) {
            const int c = tid + 512 * i, m = c >> 4, dc = (c & 15) * 8;
            const bf16_t* src = kvm + (size_t)(b * MEML + m) * 1024 + hm * 128 + dc;
            const u32x4 kv = *(const u32x4*)src, vx = *(const u32x4*)(src + 512);
            *(u32x4*)(Ks + m * MEM_KLD + dc) = kv;
            bf16_t* vp = Vt + dc * MEM_VLD + m;
            vp[0 * MEM_VLD] = (bf16_t)(vx.x & 0xffffu); vp[1 * MEM_VLD] = (bf16_t)(vx.x >> 16); vp[2 * MEM_VLD] = (bf16_t)(vx.y & 0xffffu); vp[3 * MEM_VLD] = (bf16_t)(vx.y >> 16);
            vp[4 * MEM_VLD] = (bf16_t)(vx.z & 0xffffu); vp[5 * MEM_VLD] = (bf16_t)(vx.z >> 16); vp[6 * MEM_VLD] = (bf16_t)(vx.w & 0xffffu); vp[7 * MEM_VLD] = (bf16_t)(vx.w >> 16);
        }
        __syncthreads();
        for (int qi = 0; qi < 2; ++qi) {
            const int t0 = b * SEQ + qc * 512 + (w * 2 + qi) * 32;
            bf16x8 qf[8];
#pragma unroll
            for (int s = 0; s < 8; ++s) qf[s] = qn[s];
            if (qi == 0) { const bf16_t* qp = qm + (size_t)(t0 + 32 + r) * 512 + hm * 128 + 8 * h;
#pragma unroll
                for (int s = 0; s < 8; ++s) qn[s] = *(const bf16x8*)(qp + 16 * s); }
            float mx = -3e38f;
#pragma unroll 1
            for (int c = 0; c < 8; ++c) {
                f32x16 sc;
#pragma unroll
                for (int i = 0; i < 16; ++i) sc[i] = 0.f;
#pragma unroll
                for (int s = 0; s < 8; ++s) { const bf16x8 kf = *(const bf16x8*)(Ks + (32 * c + r) * MEM_KLD + 16 * s + 8 * h); sc = MFMA32(kf, qf[s], sc); }
#pragma unroll
                for (int i = 0; i < 16; ++i) mx = fmaxf(mx, sc[i]);
            }
            mx = fmaxf(mx, __shfl_xor(mx, 32));
            constexpr float SC = 0.08838834764831845f * 1.4426950408889634f;
            float l = 0.f;
            f32x16 oa[4];
#pragma unroll
            for (int dt = 0; dt < 4; ++dt)
#pragma unroll
                for (int i = 0; i < 16; ++i) oa[dt][i] = 0.f;
#pragma unroll 1
            for (int c = 0; c < 8; ++c) {
                f32x16 sc;
#pragma unroll
                for (int i = 0; i < 16; ++i) sc[i] = 0.f;
#pragma unroll
                for (int s = 0; s < 8; ++s) { const bf16x8 kf = *(const bf16x8*)(Ks + (32 * c + r) * MEM_KLD + 16 * s + 8 * h); sc = MFMA32(kf, qf[s], sc); }
#pragma unroll
                for (int i = 0; i < 16; ++i) { const float pz = exp2f((sc[i] - mx) * SC); sc[i] = pz; l += pz; }
#pragma unroll
                for (int s2 = 0; s2 < 2; ++s2) {
                    const bf16x8 pf = mk8(cvtpk(sc[8 * s2 + 0], sc[8 * s2 + 1]), cvtpk(sc[8 * s2 + 2], sc[8 * s2 + 3]), cvtpk(sc[8 * s2 + 4], sc[8 * s2 + 5]), cvtpk(sc[8 * s2 + 6], sc[8 * s2 + 7]));
#pragma unroll
                    for (int dt = 0; dt < 4; ++dt) {
                        const bf16_t* va = Vt + (32 * dt + r) * MEM_VLD + 32 * c + 16 * s2 + 4 * h;
                        const u32x2 lo = *(const u32x2*)va, hi = *(const u32x2*)(va + 8);
                        oa[dt] = MFMA32(mk8(lo.x, lo.y, hi.x, hi.y), pf, oa[dt]);
                    }
                }
            }
            l += __shfl_xor(l, 32);
            const float inv = 1.f / l;
            bf16_t* yp = ycat + (size_t)(t0 + r) * 2048 + 1536 + hm * 128 + 4 * h;
#pragma unroll
            for (int dt = 0; dt < 4; ++dt)
#pragma unroll
                for (int g4 = 0; g4 < 4; ++g4) { u32x2 o; o.x = cvtpk(oa[dt][4 * g4] * inv, oa[dt][4 * g4 + 1] * inv); o.y = cvtpk(oa[dt][4 * g4 + 2] * inv, oa[dt][4 * g4 + 3] * inv);
                    *(u32x2*)(yp + 32 * dt + 8 * g4) = o; }
        }
    }
}

DI unsigned umax_(unsigned a, unsigned b) { return a > b ? a : b; }
DI unsigned umin_(unsigned a, unsigned b) { return a < b ? a : b; }
DI void cexd(unsigned& a, unsigned& b) { const unsigned mx = umax_(a, b), mn = umin_(a, b); a = mx; b = mn; }
DI void sort16_desc(unsigned (&v)[16]) {
#pragma unroll
    for (int k = 2; k <= 16; k <<= 1)
#pragma unroll
        for (int j = k >> 1; j > 0; j >>= 1)
#pragma unroll
            for (int i = 0; i < 16; ++i) { const int l = i ^ j; if (l > i) { if ((i & k) == 0) cexd(v[i], v[l]); else cexd(v[l], v[i]); } }
}
DI void merge16_desc(unsigned (&a)[16], const unsigned (&b)[16]) {
#pragma unroll
    for (int i = 0; i < 16; ++i) a[i] = umax_(a[i], b[15 - i]);
#pragma unroll
    for (int j = 8; j > 0; j >>= 1)
#pragma unroll
        for (int i = 0; i < 16; ++i) { const int l = i ^ j; if (l > i) cexd(a[i], a[l]); }
}
DI unsigned mono(float f) { const unsigned u = __builtin_bit_cast(unsigned, f); return u ^ ((unsigned)((int)u >> 31) | 0x80000000u); }
DI float demono(unsigned m) { const unsigned t = (unsigned)((int)m >> 31); return __builtin_bit_cast(float, m ^ (~t | 0x80000000u)); }
constexpr int TK_KLD = 136, TK_SCR_OFF = 2 * 128 * TK_KLD * 2;
DI void topk_phase(const bf16_t* qp, const bf16_t* keysb, const float* rstd2, unsigned short* ids, float* gts, unsigned char* lds) {
    const int tid = opaque_tid();
    const int lane = tid & 63, w = tid >> 6, r = lane & 31, h2 = lane >> 5;
    bf16_t* Kl = (bf16_t*)lds;
    unsigned char* scr = lds + TK_SCR_OFF + w * 2048 + lane * 32;
    int staged = -1;
    for (int unit = blockIdx.x; unit < 1024; unit += gridDim.x) {
        const int hd = unit & 7, tile = unit >> 3;
        if (hd != staged) {
            __syncthreads();
#pragma unroll
            for (int i = 0; i < 8; ++i) { const int c = tid + 512 * i, row = c >> 4, dc = (c & 15) * 8;
                *(u32x4*)(Kl + row * TK_KLD + dc) = *(const u32x4*)(keysb + ((size_t)hd * 256 + row) * 128 + dc); }
            __syncthreads();
            staged = hd;
        }
        const int t0 = tile * 256 + w * 32;
        unsigned K0[16], K1[16];
#pragma unroll
        for (int p = 0; p < 2; ++p) {
            const bf16_t* qrow = qp + (size_t)(t0 + r) * 2048 + hd * 256 + p * 128 + 8 * h2;
            bf16x8 qf[8];
#pragma unroll
            for (int s = 0; s < 8; ++s) qf[s] = *(const bf16x8*)(qrow + 16 * s);
            unsigned blk[4][16];
#pragma unroll
            for (int c = 0; c < 4; ++c) {
                f32x16 sc;
#pragma unroll
                for (int i = 0; i < 16; ++i) sc[i] = 0.f;
#pragma unroll
                for (int s = 0; s < 8; ++s) { const bf16x8 kf = *(const bf16x8*)(Kl + (p * 128 + 32 * c + r) * TK_KLD + 16 * s + 8 * h2); sc = MFMA32(kf, qf[s], sc); }
#pragma unroll
                for (int i = 0; i < 16; ++i) blk[c][i] = (mono(sc[i]) & ~0x7Fu) | (unsigned)(32 * c + crow(i, h2));
                sort16_desc(blk[c]);
            }
            merge16_desc(blk[0], blk[1]); merge16_desc(blk[2], blk[3]); merge16_desc(blk[0], blk[2]);
            unsigned oth[16];
#pragma unroll
            for (int i = 0; i < 16; ++i) oth[i] = (unsigned)__shfl_xor((int)blk[0][i], 32);
            merge16_desc(blk[0], oth);
#pragma unroll
            for (int i = 0; i < 16; ++i) { if (p == 0) K0[i] = blk[0][i]; else K1[i] = blk[0][i]; }
        }
#pragma unroll
        for (int q = 0; q < 4; ++q) {
            ((unsigned*)scr)[q] = (K0[4 * q] & 0x7Fu) | ((K0[4 * q + 1] & 0x7Fu) << 8) | ((K0[4 * q + 2] & 0x7Fu) << 16) | ((K0[4 * q + 3] & 0x7Fu) << 24);
            ((unsigned*)scr)[4 + q] = (K1[4 * q] & 0x7Fu) | ((K1[4 * q + 1] & 0x7Fu) << 8) | ((K1[4 * q + 2] & 0x7Fu) << 16) | ((K1[4 * q + 3] & 0x7Fu) << 24);
        }
        float sx[16], sy[16];
#pragma unroll
        for (int i = 0; i < 16; ++i) { const float s0 = demono(K0[i] & ~0x7Fu), s1 = demono(K1[i] & ~0x7Fu); sx[i] = h2 ? s1 : s0; sy[i] = h2 ? s0 : s1; }
        unsigned ca[16], cb[16];
#pragma unroll
        for (int i = 0; i < 16; ++i) { ca[i] = 0u; cb[i] = 0u; }
#define CAND(n, a, b) do { const unsigned key_ = (mono(sx[a] + sy[b]) & ~0xFFu) | (h2 ? (unsigned)(((b) << 4) | (a)) : (unsigned)(((a) << 4) | (b))); if ((n) < 16) ca[(n) & 15] = key_; else cb[(n) & 15] = key_; } while (0)
            CAND(0, 0, 1);
            CAND(1, 0, 2);
            CAND(2, 0, 3);
            CAND(3, 0, 4);
            CAND(4, 0, 5);
            CAND(5, 0, 6);
            CAND(6, 0, 7);
            CAND(7, 0, 8);
            CAND(8, 0, 9);
            CAND(9, 0, 10);
            CAND(10, 0, 11);
            CAND(11, 0, 12);
            CAND(12, 0, 13);
            CAND(13, 0, 14);
            CAND(14, 0, 15);
            CAND(15, 1, 2);
            CAND(16, 1, 3);
            CAND(17, 1, 4);
            CAND(18, 1, 5);
            CAND(19, 1, 6);
            CAND(20, 1, 7);
            CAND(21, 2, 3);
            CAND(22, 2, 4);
#undef CAND
#pragma unroll
        for (int d = 0; d < 4; ++d) { const unsigned key_ = (mono(sx[d] + sy[d]) & ~0xFFu) | (unsigned)((d << 4) | d); cb[7 + d] = h2 ? 0u : key_; }
        sort16_desc(ca); sort16_desc(cb); merge16_desc(ca, cb);
        unsigned fin[16], cpart[16];
#pragma unroll
        for (int i = 0; i < 16; ++i) cpart[i] = (unsigned)__shfl_xor((int)ca[i], 32);
#pragma unroll
        for (int i = 0; i < 16; ++i) fin[i] = umax_(ca[i], cpart[15 - i]);
        const float rs = 1.f / sqrtf(rstd2[t0 + r] * (1.f / D) + EPS);
        float sv[16], mxv = -3e38f;
#pragma unroll
        for (int i = 0; i < 16; ++i) { sv[i] = demono(fin[i] & ~0xFFu) * rs; mxv = fmaxf(mxv, sv[i]); }
        float den = 0.f;
#pragma unroll
        for (int i = 0; i < 16; ++i) { sv[i] = __expf(sv[i] - mxv); den += sv[i]; }
        const float rden = 1.f / den;
        int oid[8]; float og[8];
#pragma unroll
        for (int j = 0; j < 8; ++j) {
            const unsigned wk = fin[j]; og[j] = sv[j] * rden;
            const unsigned a0 = (wk >> 4) & 15u, a1 = wk & 15u;
            oid[j] = (int)scr[a0] * 128 + (int)scr[16 + a1];
        }
        unsigned short* ip = ids + (size_t)(t0 + r) * 128 + hd * 16 + 8 * h2; float* gp = gts + (size_t)(t0 + r) * 128 + hd * 16 + 8 * h2;
        *(u32x4*)ip = (u32x4){(unsigned)oid[0] | ((unsigned)oid[1] << 16), (unsigned)oid[2] | ((unsigned)oid[3] << 16), (unsigned)oid[4] | ((unsigned)oid[5] << 16), (unsigned)oid[6] | ((unsigned)oid[7] << 16)};
        *(f32x4*)gp = (f32x4){og[0], og[1], og[2], og[3]}; *(f32x4*)(gp + 4) = (f32x4){og[4], og[5], og[6], og[7]};
    }
}

typedef _Float16 h2_t __attribute__((ext_vector_type(2)));
template <int CTRL> DI float dpp_f(float v) { return __builtin_bit_cast(float, __builtin_amdgcn_update_dpp(0, __builtin_bit_cast(int, v), CTRL, 0xf, 0xf, true)); }
DI float row16_sum(float v) {
    v += dpp_f<0xB1>(v); v += dpp_f<0x4E>(v); v += dpp_f<0x141>(v); v += dpp_f<0x140>(v); return v; }
DI bf16x2_t as_b2(unsigned w) { return __builtin_bit_cast(bf16x2_t, w); }
DI float dot_row(const u32x4 (&xw)[4][2], const u32x4 (&ru)[4]) {
    float d0 = 0.f, d1 = 0.f;
#pragma unroll
    for (int i = 0; i < 4; ++i)
#pragma unroll
        for (int q = 0; q < 4; ++q) {
            const bf16x2_t z0 = __builtin_amdgcn_cvt_scalef32_pk_bf16_fp8((int)ru[i][q], 1.0f, false), z1 = __builtin_amdgcn_cvt_scalef32_pk_bf16_fp8((int)ru[i][q], 1.0f, true);
            d0 = __builtin_amdgcn_fdot2_f32_bf16(as_b2(xw[i][q >> 1][2 * (q & 1)]), z0, d0, false); d1 = __builtin_amdgcn_fdot2_f32_bf16(as_b2(xw[i][q >> 1][2 * (q & 1) + 1]), z1, d1, false);
        }
    return row16_sum(d0 + d1);
}
DI float swz_xor4(float v) { return __builtin_bit_cast(float, __builtin_amdgcn_ds_swizzle(__builtin_bit_cast(int, v), 0x101F)); }
DI bf16_t* partial_base(unsigned char* ws, int x) { return (bf16_t*)(ws + 42 * MiB + (size_t)x * 8 * MiB); }
template <int VAR>
DI void peer_u2_phase(const bf16_t* x1b, const unsigned char* u8, const unsigned short* ids, bf16_t* part, unsigned char* lds, int lbl, int rnk, int cnt) {
    const int tid = opaque_tid(), lane = tid & 63, wave = tid >> 6, g8 = lane >> 3, s8 = lane & 7;
    constexpr int LST = 132;
    int* lid = (int*)(lds + wave * (2 * 8 * LST * 4)); float* lpa = (float*)(lid + 8 * LST);
    const int stride = cnt * NWAVES * 8;
    const int sl = lbl & 3, hf = lbl >> 2;
    const unsigned char* ubase = u8 + sl * 128;
    const bool b4 = (s8 & 4) != 0, b2 = (s8 & 2) != 0, b1 = (s8 & 1) != 0;
    for (int t0 = hf * (T / 2) + (rnk * NWAVES + wave) * 8; t0 < (hf + 1) * (T / 2); t0 += stride) {
#pragma unroll
        for (int j = 0; j < 2; ++j) { const int f = lane * 8 + 512 * j, tk = f >> 7, k = f & 127; const u32x4 w = *(const u32x4*)(ids + (size_t)t0 * 128 + f);
            *(u32x4*)(lid + tk * LST + k) = (u32x4){w.x & 0xffffu, w.x >> 16, w.y & 0xffffu, w.y >> 16}; *(u32x4*)(lid + tk * LST + k + 4) = (u32x4){w.z & 0xffffu, w.z >> 16, w.w & 0xffffu, w.w >> 16}; }
        const size_t xo_ = (size_t)(t0 + g8) * D + sl * 256 + 32 * s8;
        u32x4 xr[4];
#pragma unroll
        for (int q = 0; q < 4; ++q) xr[q] = *(const u32x4*)(x1b + xo_ + 8 * q);
        float xm = 0.f;
#pragma unroll
        for (int q = 0; q < 4; ++q) { xm = fmaxf(fmaxf(xm, fmaxf(fabsf(bflo(xr[q].x)), fabsf(bfhi(xr[q].x)))), fmaxf(fabsf(bflo(xr[q].y)), fabsf(bfhi(xr[q].y))));
            xm = fmaxf(fmaxf(xm, fmaxf(fabsf(bflo(xr[q].z)), fabsf(bfhi(xr[q].z)))), fmaxf(fabsf(bflo(xr[q].w)), fabsf(bfhi(xr[q].w)))); }
        xm = fmaxf(xm, dpp_f<0xB1>(xm)); xm = fmaxf(xm, dpp_f<0x4E>(xm)); xm = fmaxf(xm, dpp_f<0x141>(xm));
        const float xinv = xm > 0.f ? 127.f / xm : 0.f, sx = xm * (1.f / 127.f);
        int xq[8];
#pragma unroll
        for (int q = 0; q < 4; ++q) {
            const int q0 = (int)__builtin_rintf(bflo(xr[q].x) * xinv), q1 = (int)__builtin_rintf(bfhi(xr[q].x) * xinv), q2 = (int)__builtin_rintf(bflo(xr[q].y) * xinv), q3 = (int)__builtin_rintf(bfhi(xr[q].y) * xinv);
            const int q4 = (int)__builtin_rintf(bflo(xr[q].z) * xinv), q5 = (int)__builtin_rintf(bfhi(xr[q].z) * xinv), q6 = (int)__builtin_rintf(bflo(xr[q].w) * xinv), q7 = (int)__builtin_rintf(bfhi(xr[q].w) * xinv);
            xq[2 * q] = (int)((unsigned)(q0 & 255) | ((unsigned)(q1 & 255) << 8) | ((unsigned)(q2 & 255) << 16) | ((unsigned)q3 << 24));
            xq[2 * q + 1] = (int)((unsigned)(q4 & 255) | ((unsigned)(q5 & 255) << 8) | ((unsigned)(q6 & 255) << 16) | ((unsigned)q7 << 24)); }
        int sxlo = 0;
#pragma unroll
        for (int q = 0; q < 4; ++q) sxlo = __builtin_amdgcn_sdot4(xq[2 * q], 0x01010101, sxlo, false);
        const int dh0 = -128 * sxlo;
        const int* myid = lid + g8 * LST; float* mypa = lpa + g8 * LST;
        const unsigned loff = (unsigned)(s8 * 16);
#define U2_FETCH(K8, RW) do { const int kc_ = (K8) < 128 ? (K8) : 120; const u32x4 i0_ = *(const u32x4*)(myid + kc_), i1_ = *(const u32x4*)(myid + kc_ + 4); \
            _Pragma("unroll") for (int i = 0; i < 8; ++i) { const unsigned id_ = i < 4 ? i0_[i & 3] : i1_[i & 3]; \
                if (VAR & 1) RW[i] = (u32x4){id_, id_ * 3u, id_ * 5u, id_ * 7u}; else RW[i] = *(const u32x4*)(ubase + (id_ * 512u + loff)); } } while (0)
#define U2_REDUCE(K8, RW) do { int pp[8]; \
            _Pragma("unroll") for (int i = 0; i < 8; ++i) { \
                if (VAR & 2) { pp[i] = (int)((RW[i].x ^ RW[i].y ^ RW[i].z ^ RW[i].w ^ xr[0].x) & 0xffu); continue; } \
                int dl_ = 0, dh_ = dh0; \
                _Pragma("unroll") for (int q = 0; q < 4; ++q) { dl_ = __builtin_amdgcn_sdot4((int)(RW[i][q] & 0x0F0F0F0Fu), xq[2 * q], dl_, false); dh_ = __builtin_amdgcn_sdot4((int)(RW[i][q] & 0xF0F0F0F0u), xq[2 * q + 1], dh_, false); } \
                pp[i] = (dl_ << 4) + dh_; } \
            int q4[4], q2[2]; \
            _Pragma("unroll") for (int j = 0; j < 4; ++j) { const int keep = b4 ? pp[j + 4] : pp[j], send = b4 ? pp[j] : pp[j + 4]; q4[j] = keep + __builtin_amdgcn_ds_swizzle(send, 0x101F); } \
            _Pragma("unroll") for (int j = 0; j < 2; ++j) { const int keep = b2 ? q4[j + 2] : q4[j], send = b2 ? q4[j] : q4[j + 2]; q2[j] = keep + __builtin_amdgcn_update_dpp(0, send, 0x4E, 0xf, 0xf, true); } \
            const int keep1 = b1 ? q2[1] : q2[0], send1 = b1 ? q2[0] : q2[1]; \
            mypa[(K8) + s8] = (float)(keep1 + __builtin_amdgcn_update_dpp(0, send1, 0xB1, 0xf, 0xf, true)) * sx;     } while (0)
        u32x4 rwA[8], rwB[8];
        U2_FETCH(0, rwA);
#pragma unroll 1
        for (int k8 = 0; k8 < 128; k8 += 16) {
            U2_FETCH(k8 + 8, rwB);
            U2_REDUCE(k8, rwA);
            U2_FETCH(k8 + 16, rwA);
            U2_REDUCE(k8 + 8, rwB);
        }
#undef U2_FETCH
#undef U2_REDUCE
        bf16_t* pg = part + (size_t)t0 * 128;
#pragma unroll
        for (int j = 0; j < 4; ++j) { const int f = lane * 4 + 256 * j, tk = f >> 7, k = f & 127; const f32x4 v = *(const f32x4*)(lpa + tk * LST + k);
            u32x2 w; w.x = pk2(v.x, v.y); w.y = pk2(v.z, v.w); *(u32x2*)(pg + f) = w; }
    }
}
DI void peer_combine_phase(unsigned char* ws, const float* ssq2, const float* gts, const unsigned short* ids, const float* su, bf16_t* coef) {
    const size_t gt = (size_t)blockIdx.x * NTHREADS + opaque_tid(), NGT = (size_t)gridDim.x * NTHREADS;
    for (size_t i = gt; i < (size_t)T * 32; i += NGT) {
        const int t = (int)(i >> 5);
        f32x4 a = {0.f, 0.f, 0.f, 0.f};
#pragma unroll
        for (int x = 0; x < 4; ++x) { const u32x2 w = ((const u32x2*)partial_base(ws, x))[i]; a += (f32x4){bflo(w.x), bfhi(w.x), bflo(w.y), bfhi(w.y)}; }
        const float rs = __builtin_amdgcn_rsqf(ssq2[t] * (1.f / D) + EPS);
        const f32x4 g = ((const f32x4*)gts)[i]; const u32x2 idw = ((const u32x2*)ids)[i];
        const unsigned i0 = idw.x & 0xffffu, i1 = idw.x >> 16, i2 = idw.y & 0xffffu, i3 = idw.y >> 16;
        u32x2 w; w.x = pk2(g.x * gelu_tanh(a.x * rs * su[i0]) * 0.5f, g.y * gelu_tanh(a.y * rs * su[i1]) * 0.5f); w.y = pk2(g.z * gelu_tanh(a.z * rs * su[i2]) * 0.5f, g.w * gelu_tanh(a.w * rs * su[i3]) * 0.5f);
        ((u32x2*)coef)[i] = w;
    }
}
template <int VAR>
DI void peer_v_phase(const bf16_t* x1in, bf16_t* xout, const unsigned char* v8, const unsigned short* ids, const bf16_t* coef, float* ssqo, unsigned char* lds, int lbl, int rnk, int cnt) {
    const int tid = opaque_tid(), lane = tid & 63, wave = tid >> 6, g8 = lane >> 3, s8 = lane & 7;
    constexpr int LST = 132;
    int* lid = (int*)(lds + wave * (2 * 8 * LST * 4)); float* lco = (float*)(lid + 8 * LST);
    const int stride = cnt * NWAVES * 8;
    const unsigned char* vbase = v8 + lbl * 128;
    for (int t0 = (rnk * NWAVES + wave) * 8; t0 < T; t0 += stride) {
#pragma unroll
        for (int j = 0; j < 2; ++j) { const int f = lane * 8 + 512 * j, tk = f >> 7, k = f & 127;
            const u32x4 w = *(const u32x4*)(ids + (size_t)t0 * 128 + f), cw = *(const u32x4*)(coef + (size_t)t0 * 128 + f);
            *(u32x4*)(lid + tk * LST + k) = (u32x4){w.x & 0xffffu, w.x >> 16, w.y & 0xffffu, w.y >> 16}; *(u32x4*)(lid + tk * LST + k + 4) = (u32x4){w.z & 0xffffu, w.z >> 16, w.w & 0xffffu, w.w >> 16};
            *(f32x4*)(lco + tk * LST + k) = (f32x4){bflo(cw.x), bfhi(cw.x), bflo(cw.y), bfhi(cw.y)}; *(f32x4*)(lco + tk * LST + k + 4) = (f32x4){bflo(cw.z), bfhi(cw.z), bflo(cw.w), bfhi(cw.w)}; }
        h2_t acc[8];
#pragma unroll
        for (int j = 0; j < 8; ++j) acc[j] = (h2_t){(f16_t)0.f, (f16_t)0.f};
        const int* myid = lid + g8 * LST; const float* myco = lco + g8 * LST;
        const unsigned loff = (unsigned)(s8 * 16);
#define V_FETCH(K8, RW, CO) do { const int kc_ = (K8) < 128 ? (K8) : 120; const u32x4 i0_ = *(const u32x4*)(myid + kc_), i1_ = *(const u32x4*)(myid + kc_ + 4); \
            const f32x4 c0_ = *(const f32x4*)(myco + kc_), c1_ = *(const f32x4*)(myco + kc_ + 4); \
            _Pragma("unroll") for (int i = 0; i < 8; ++i) { const unsigned id_ = i < 4 ? i0_[i & 3] : i1_[i & 3]; CO[i] = i < 4 ? c0_[i & 3] : c1_[i & 3]; \
                if (VAR & 1) RW[i] = (u32x4){id_, id_ * 3u, id_ * 5u, id_ * 7u}; else RW[i] = *(const u32x4*)(vbase + (id_ * (unsigned)D + loff)); } } while (0)
#define V_ACCUM(RW, CO) do { _Pragma("unroll") for (int i = 0; i < 8; ++i) { const h2_t cc = {(f16_t)CO[i], (f16_t)CO[i]}; \
                if (VAR & 2) { acc[i].x += (f16_t)(__builtin_bit_cast(float, (RW[i].x ^ RW[i].y ^ RW[i].z ^ RW[i].w) & 0x3fffffffu) * CO[i]); continue; } \
                _Pragma("unroll") for (int q = 0; q < 4; ++q) { const h2_t a = __builtin_amdgcn_cvt_scalef32_pk_f16_fp8((int)RW[i][q], 1.0f, false), b = __builtin_amdgcn_cvt_scalef32_pk_f16_fp8((int)RW[i][q], 1.0f, true); \
                    acc[2 * q] = __builtin_elementwise_fma(a, cc, acc[2 * q]); acc[2 * q + 1] = __builtin_elementwise_fma(b, cc, acc[2 * q + 1]); } } } while (0)
        u32x4 rwA[8], rwB[8]; float coA[8], coB[8];
        V_FETCH(0, rwA, coA);
#pragma unroll 1
        for (int k8 = 0; k8 < 128; k8 += 16) {
            V_FETCH(k8 + 8, rwB, coB);
            V_ACCUM(rwA, coA);
            V_FETCH(k8 + 16, rwA, coA);
            V_ACCUM(rwB, coB);
        }
#undef V_FETCH
#undef V_ACCUM
        const size_t xo_ = (size_t)(t0 + g8) * D + lbl * 128 + 16 * s8;
        const u32x4 xa = *(const u32x4*)(x1in + xo_), xb2 = *(const u32x4*)(x1in + xo_ + 8);
        float o[16];
        o[0] = bflo(xa.x) + (float)acc[0].x; o[1] = bfhi(xa.x) + (float)acc[0].y; o[2] = bflo(xa.y) + (float)acc[1].x; o[3] = bfhi(xa.y) + (float)acc[1].y; o[4] = bflo(xa.z) + (float)acc[2].x; o[5] = bfhi(xa.z) + (float)acc[2].y; o[6] = bflo(xa.w) + (float)acc[3].x; o[7] = bfhi(xa.w) + (float)acc[3].y;
        o[8] = bflo(xb2.x) + (float)acc[4].x; o[9] = bfhi(xb2.x) + (float)acc[4].y; o[10] = bflo(xb2.y) + (float)acc[5].x; o[11] = bfhi(xb2.y) + (float)acc[5].y; o[12] = bflo(xb2.z) + (float)acc[6].x; o[13] = bfhi(xb2.z) + (float)acc[6].y; o[14] = bflo(xb2.w) + (float)acc[7].x; o[15] = bfhi(xb2.w) + (float)acc[7].y;
        float ss = 0.f;
#pragma unroll
        for (int e = 0; e < 16; ++e) ss += o[e] * o[e];
        ss += dpp_f<0xB1>(ss); ss += dpp_f<0x4E>(ss); ss += dpp_f<0x141>(ss);
        if (s8 == 0) atomicAdd(ssqo + t0 + g8, ss);
        u32x4 w0, w1; w0.x = pk2(o[0], o[1]); w0.y = pk2(o[2], o[3]); w0.z = pk2(o[4], o[5]); w0.w = pk2(o[6], o[7]); w1.x = pk2(o[8], o[9]); w1.y = pk2(o[10], o[11]); w1.z = pk2(o[12], o[13]); w1.w = pk2(o[14], o[15]);
        *(u32x4*)(xout + xo_) = w0; *(u32x4*)(xout + xo_ + 8) = w1;
    }
}
DI void peer_final_phase(const bf16_t* xo, const float* ssqo, const float* gf, float* out) {
    const int tid = opaque_tid(), lane = tid & 63, gw = blockIdx.x * NWAVES + (tid >> 6), NGW = gridDim.x * NWAVES;
    f32x4 g[4];
#pragma unroll
    for (int q = 0; q < 4; ++q) g[q] = *(const f32x4*)(gf + lane * 16 + 4 * q);
    for (int t = gw; t < T; t += NGW) {
        const u32x4 w0 = *(const u32x4*)(xo + (size_t)t * D + lane * 16), w1 = *(const u32x4*)(xo + (size_t)t * D + lane * 16 + 8);
        const float rf = 1.f / sqrtf(ssqo[t] * (1.f / D) + EPS);
        f32x4* po = (f32x4*)(out + (size_t)t * D + lane * 16);
        po[0] = (f32x4){bflo(w0.x), bfhi(w0.x), bflo(w0.y), bfhi(w0.y)} * rf * g[0]; po[1] = (f32x4){bflo(w0.z), bfhi(w0.z), bflo(w0.w), bfhi(w0.w)} * rf * g[1];
        po[2] = (f32x4){bflo(w1.x), bfhi(w1.x), bflo(w1.y), bfhi(w1.y)} * rf * g[2]; po[3] = (f32x4){bflo(w1.z), bfhi(w1.z), bflo(w1.w), bfhi(w1.w)} * rf * g[3];
    }
}

#define LAS __attribute__((address_space(3)))
#define XB_TMO      128
#define XB_XCNT(j)  (256  + 64 * (j))
#define XB_XSUB(j)  (1280 + 64 * (j))
#define XB_XGEN(j)  (2304 + 64 * (j))
#define XB_TOP      3328
#define XB_TOPGEN   3392
#define XCD_BAR_WORDS 3456
#define XB_SPIN_CAP (1u << 18)
DI unsigned xb_ld(unsigned* p)              { return __hip_atomic_load(p, __ATOMIC_RELAXED, __HIP_MEMORY_SCOPE_AGENT); }
DI unsigned xb_add(unsigned* p, unsigned v) { return __hip_atomic_fetch_add(p, v, __ATOMIC_RELAXED, __HIP_MEMORY_SCOPE_AGENT); }
DI unsigned xb_xcc_id() { return (unsigned)__builtin_amdgcn_s_getreg((3 << 11) | 20) & 0xFu; }
#define XB_SPIN(cond, bar) do { unsigned _sp = 0; while (cond) { __builtin_amdgcn_s_sleep(1); \
    if ((++_sp & 255u) == 0u) { if (xb_ld(&(bar)[XB_TMO])) break; if (_sp > XB_SPIN_CAP) { atomicAdd(&(bar)[XB_TMO], 1u); break; } } } } while (0)
struct XcdBarrier { unsigned* bar; unsigned x; volatile LAS unsigned* st; };
DI XcdBarrier xcd_barrier_post(unsigned* bar, volatile LAS unsigned* st) {
    XcdBarrier b; b.bar = bar; b.x = xb_xcc_id(); b.st = st;
    if (threadIdx.x == 0) st[2] = xb_add(&bar[XB_XCNT(b.x)], 1u);
    return b;
}
DI void xcd_barrier_complete(unsigned* bar, unsigned x, unsigned& nloc, unsigned& nx) {
    const unsigned G = gridDim.x * gridDim.y * gridDim.z;
    unsigned sum, cnt, mine, sp = 0u;
    for (;;) {
        sum = 0u; cnt = 0u; mine = 0u;
#pragma unroll
        for (unsigned j = 0; j < 16; ++j) { const unsigned c = xb_ld(&bar[XB_XCNT(j)]); sum += c; cnt += (c > 0u) ? 1u : 0u; mine = (j == x) ? c : mine; }
        if (sum == G) break;
        __builtin_amdgcn_s_sleep(1);
        if ((++sp & 255u) == 0u) { if (xb_ld(&bar[XB_TMO])) break; if (sp > XB_SPIN_CAP) { atomicAdd(&bar[XB_TMO], 1u); break; } }
    }
    nloc = mine > 0u ? mine : 1u; nx = cnt > 0u ? cnt : 1u;
}
DI void xcd_barrier(const XcdBarrier& b) {
    asm volatile("s_waitcnt vmcnt(0)" ::: "memory");
    __syncthreads();
    if (threadIdx.x == 0) {
        unsigned* bar = b.bar;
        __builtin_amdgcn_s_waitcnt(0);
        unsigned nloc = b.st[0], nx = b.st[1];
        if (nloc == 0u) { xcd_barrier_complete(bar, b.x, nloc, nx); b.st[0] = nloc; b.st[1] = nx; }
        const unsigned old = xb_add(&bar[XB_XSUB(b.x)], 1u);
        const unsigned gen = old / nloc;
        if (old + 1u == (gen + 1u) * nloc) {
            __builtin_amdgcn_fence(__ATOMIC_RELEASE, "agent");
            asm volatile("s_waitcnt vmcnt(0)" ::: "memory");
            const unsigned og = xb_add(&bar[XB_TOP], 1u);
            const unsigned tg = og / nx;
            if (og + 1u == (tg + 1u) * nx) xb_add(&bar[XB_TOPGEN], 1u);
            else XB_SPIN(xb_ld(&bar[XB_TOPGEN]) == tg, bar);
            __builtin_amdgcn_fence(__ATOMIC_ACQUIRE, "agent");
            xb_add(&bar[XB_XGEN(b.x)], 1u);
            asm volatile("s_waitcnt vmcnt(0)" ::: "memory");
        } else {
            XB_SPIN(xb_ld(&bar[XB_XGEN(b.x)]) == gen, bar);
            __builtin_amdgcn_fence(__ATOMIC_ACQUIRE, "agent");
            asm volatile("s_waitcnt vmcnt(0)" ::: "memory");
        }
    }
    __syncthreads();
}


constexpr int LDS_BYTES = 147456;
__global__ void __launch_bounds__(NTHREADS, 2) fwd_kernel(Params p) {
    extern __shared__ __attribute__((aligned(16))) unsigned char lds[];
    cg::grid_group grid = cg::this_grid();
    volatile LAS unsigned* bst = (volatile LAS unsigned*)((LAS unsigned char*)lds + (LDS_BYTES - 64));
    if (threadIdx.x < 4) bst[threadIdx.x] = 0u;
    __syncthreads();
    const XcdBarrier xbar = xcd_barrier_post((unsigned*)p.ws, bst);
    const int NGW = gridDim.x * NWAVES, G = gridDim.x, cu = blockIdx.x;
    unsigned char* ws = p.ws;
    PG8_LAS unsigned char* ldsl = (PG8_LAS unsigned char*)lds;
    bf16_t* ycat = (bf16_t*)p.out;

    for (int rep_ = 0; rep_ < (DUP_PHASE == 0 ? 2 : 1); ++rep_) { phase0(p, (float*)lds);
    if (p.use_cg_sync) grid.sync(); else xcd_barrier(xbar); }
    for (int rep_ = 0; rep_ < (DUP_PHASE == 1 ? 2 : 1); ++rep_) {
        EpiZ E{(const float*)(ws + WS_RSTD1), (const float*)(ws + WS_RSTDM), (const float2*)(ws + WS_ROPE), (bf16_t*)(ws + WS_UPOOL), (bf16_t*)(ws + WS_QR), (bf16_t*)(ws + WS_KR), (bf16_t*)(ws + WS_VV), (bf16_t*)(ws + WS_QM), (unsigned char*)(ws + WS_GATES), (bf16_t*)(ws + WS_KVM)};
        SchedZ S{(const char*)(ws + WS_XB), (const char*)(ws + WS_WIN), (const char*)(ws + WS_MEMB), (const char*)(ws + WS_WMKV), G, cu};
        pg8::gemm_phase(ldsl, 1024, 1024, S, E);
    xcd_barrier(xbar); }
    if (DUP_PHASE == 20) pooled_phase((const bf16_t*)(ws + WS_UPOOL), ycat);
    if (DUP_PHASE == 21) swa_phase((const bf16_t*)(ws + WS_QR), (const bf16_t*)(ws + WS_KR), (const bf16_t*)(ws + WS_VV), p.sinks, ycat, lds);
    if (DUP_PHASE == 22) mem_phase((const bf16_t*)(ws + WS_QM), (const bf16_t*)(ws + WS_KVM), ycat, lds);
    pooled_phase((const bf16_t*)(ws + WS_UPOOL), ycat);
    swa_phase((const bf16_t*)(ws + WS_QR), (const bf16_t*)(ws + WS_KR), (const bf16_t*)(ws + WS_VV), p.sinks, ycat, lds);
    mem_phase((const bf16_t*)(ws + WS_QM), (const bf16_t*)(ws + WS_KVM), ycat, lds);
    xcd_barrier(xbar);
    for (int rep_ = 0; rep_ < (DUP_PHASE == 3 ? 2 : 1); ++rep_) {
        EpiGated E{(const unsigned char*)(ws + WS_GATES), (bf16_t*)(ws + WS_MERGED)};
        SchedGated S{(const char*)ycat, (const char*)(ws + WS_WBR), G, cu};
        pg8::gemm_phase(ldsl, 2048, 2048, S, E);
    xcd_barrier(xbar); }
    for (int rep_ = 0; rep_ < (DUP_PHASE == 4 ? 2 : 1); ++rep_) {
        EpiOut E{(const bf16_t*)(ws + WS_XB), (DUP_PHASE == 4 && rep_ == 0) ? (bf16_t*)(ws + WS_QP) : (bf16_t*)(ws + WS_X1B), (DUP_PHASE == 4 && rep_ == 0) ? (float*)(ws + WS_RSTD1) : (float*)(ws + WS_RSTD2)};
        SchedPlain S{(const char*)(ws + WS_MERGED), (const char*)(ws + WS_WOUT), 1024, 1024, 128, 4, 16, G, cu};
        pg8::gemm_phase(ldsl, 1024, 1024, S, E);
    xcd_barrier(xbar); }
    for (int rep_ = 0; rep_ < (DUP_PHASE == 5 ? 2 : 1); ++rep_) {
        EpiBf16 E{(bf16_t*)(ws + WS_QP), 2048};
        SchedPlain S{(const char*)(ws + WS_X1B), (const char*)(ws + WS_WQ), 1024, 1024, 128, 8, 16, G, cu};
        pg8::gemm_phase(ldsl, 1024, 1024, S, E);
    xcd_barrier(xbar); }
    for (int rep_ = 0; rep_ < (DUP_PHASE == 6 ? 2 : 1); ++rep_) {
    topk_phase((const bf16_t*)(ws + WS_QP), (const bf16_t*)(ws + WS_KEYS), (const float*)(ws + WS_RSTD2), (unsigned short*)(ws + WS_IDS), (float*)(ws + WS_GTS), lds);
    xcd_barrier(xbar); }
    int lbl, rnk, cnt;
    {
        unsigned* bar = (unsigned*)p.ws; unsigned sum = 0u, mine = 0u; bool ok = xbar.x < 8u;
#pragma unroll
        for (unsigned j = 0; j < 8; ++j) { const unsigned c = xb_ld(&bar[XB_XCNT(j)]); sum += c; ok = ok && (c > 0u); mine = (j == xbar.x) ? c : mine; }
        ok = ok && (sum == (unsigned)G);
        lbl = ok ? (int)xbar.x : (cu & 7); rnk = ok ? (int)bst[2] : (cu >> 3); cnt = ok ? (int)mine : ((G - (cu & 7) + 7) >> 3);
        lbl = __builtin_amdgcn_readfirstlane(lbl); rnk = __builtin_amdgcn_readfirstlane(rnk); cnt = __builtin_amdgcn_readfirstlane(cnt);
    }
    if (DUP_PHASE == 7) {
        peer_u2_phase<PROBE_VAR>((const bf16_t*)(ws + WS_X1B), (const unsigned char*)(ws + WS_U16), (const unsigned short*)(ws + WS_IDS), partial_base(ws, lbl & 3), lds, lbl, rnk, cnt);
        xcd_barrier(xbar); }
    peer_u2_phase<0>((const bf16_t*)(ws + WS_X1B), (const unsigned char*)(ws + WS_U16), (const unsigned short*)(ws + WS_IDS), partial_base(ws, lbl & 3), lds, lbl, rnk, cnt);
    xcd_barrier(xbar);
    peer_combine_phase(ws, (const float*)(ws + WS_RSTD2), (const float*)(ws + WS_GTS), (const unsigned short*)(ws + WS_IDS), (const float*)(ws + WS_SU), (bf16_t*)(ws + WS_COEF));
    xcd_barrier(xbar);
    if (DUP_PHASE == 8) {
        peer_v_phase<PROBE_VAR>((const bf16_t*)(ws + WS_X1B), (bf16_t*)(ws + WS_MERGED), (const unsigned char*)(ws + WS_V16), (const unsigned short*)(ws + WS_IDS), (const bf16_t*)(ws + WS_COEF), (float*)(ws + WS_RSTD1), lds, lbl, rnk, cnt);
        xcd_barrier(xbar); }
    peer_v_phase<0>((const bf16_t*)(ws + WS_X1B), (bf16_t*)(ws + WS_X1B), (const unsigned char*)(ws + WS_V16), (const unsigned short*)(ws + WS_IDS), (const bf16_t*)(ws + WS_COEF), (float*)(ws + WS_SSQO), lds, lbl, rnk, cnt);
    xcd_barrier(xbar);
    for (int rep_ = 0; rep_ < (DUP_PHASE == 9 ? 2 : 1); ++rep_)
    peer_final_phase((const bf16_t*)(ws + WS_X1B), (const float*)(ws + WS_SSQO), p.final_g, p.out);
}

extern "C" void kernel_launch(void* const* d_in, const int* in_sizes, int n_in, void* d_out, int out_size, void* d_ws, size_t ws_size, hipStream_t stream) {
    static int grid_blocks = 0;
    if (grid_blocks == 0) {
        if (n_in != 20 || out_size != T * D || ws_size < WS_END) { fprintf(stderr, "kernel_launch: unexpected shapes: n_in %d out %d ws %zu\n", n_in, out_size, ws_size); grid_blocks = -1; return; }
        int dev = 0, cus = 0, per_cu = 0;
        (void)hipGetDevice(&dev);
        (void)hipDeviceGetAttribute(&cus, hipDeviceAttributeMultiprocessorCount, dev);
        if (hipFuncSetAttribute((const void*)fwd_kernel, hipFuncAttributeMaxDynamicSharedMemorySize, LDS_BYTES) != hipSuccess) { fprintf(stderr, "kernel_launch: hipFuncSetAttribute failed\n"); grid_blocks = -1; return; }
        (void)hipOccupancyMaxActiveBlocksPerMultiprocessor(&per_cu, (const void*)fwd_kernel, NTHREADS, LDS_BYTES);
        if (per_cu < 1) { fprintf(stderr, "kernel_launch: occupancy query says %d blocks per CU\n", per_cu); grid_blocks = -1; return; }
        grid_blocks = cus * per_cu;
        fprintf(stderr, "kernel_launch: cus %d per_cu %d grid %d ws %zu\n", cus, per_cu, grid_blocks, ws_size);
    }
    if (grid_blocks < 0) return;
    Params p{};
    p.x = (const float*)d_in[0]; p.mem = (const float*)d_in[1]; p.pos = (const int*)d_in[2]; p.norm1_g = (const float*)d_in[3]; p.mem_norm_g = (const float*)d_in[4];
    p.w_in = (const float*)d_in[5]; p.w_pool = (const float*)d_in[6]; p.pool_scale = (const float*)d_in[7]; p.sinks = (const float*)d_in[8]; p.w_mem_kv = (const float*)d_in[9];
    p.w_bpool = (const float*)d_in[10]; p.w_bswa = (const float*)d_in[11]; p.w_bmem = (const float*)d_in[12]; p.w_out = (const float*)d_in[13]; p.norm2_g = (const float*)d_in[14];
    p.w_q = (const float*)d_in[15]; p.sub_keys = (const float*)d_in[16]; p.peer_u = (const float*)d_in[17]; p.peer_v = (const float*)d_in[18]; p.final_g = (const float*)d_in[19];
    p.out = (float*)d_out; p.ws = (unsigned char*)d_ws;
    (void)hipMemsetAsync(d_ws, 0, 16384, stream);
    void* args[] = {&p};
    hipError_t e = hipLaunchCooperativeKernel((const void*)fwd_kernel, dim3(grid_blocks), dim3(NTHREADS), args, LDS_BYTES, stream);
    if (e != hipSuccess) fprintf(stderr, "cooperative launch failed: %s (grid %d)\n", hipGetErrorString(e), grid_blocks);
}
```

```cpp
#include <hip/hip_runtime.h>
#include <hip/hip_cooperative_groups.h>
#include <cstdio>
#include <cstdint>
namespace cg = cooperative_groups;

#define DI __device__ __forceinline__
typedef unsigned short bf16_t;
typedef _Float16 f16_t;
typedef short bf16x8 __attribute__((ext_vector_type(8)));
typedef float f32x4 __attribute__((ext_vector_type(4)));
typedef float f32x16 __attribute__((ext_vector_type(16)));
typedef unsigned u32x4 __attribute__((ext_vector_type(4)));
typedef unsigned u32x2 __attribute__((ext_vector_type(2)));
typedef _Float16 f16x4 __attribute__((ext_vector_type(4)));

#ifndef DUP_PHASE
#define DUP_PHASE -1
#endif
#ifndef PROBE_VAR
#define PROBE_VAR 0
#endif
constexpr int D = 1024, BATCH = 8, SEQ = 4096, T = BATCH * SEQ, MEML = 256, TMEM = BATCH * MEML;
constexpr int INW = 5376;
constexpr int NTHREADS = 512, NWAVES = 8;
constexpr int NEXP = 16384;
constexpr float EPS = 1e-6f;

constexpr size_t MiB = 1u << 20;
constexpr size_t WS_WIN = 1 * MiB;
constexpr size_t WS_WBR = 12 * MiB;
constexpr size_t WS_WOUT = 16 * MiB;
constexpr size_t WS_WQ = 18 * MiB;
constexpr size_t WS_KEYS = 22 * MiB;
constexpr size_t WS_WPOOL = 22 * MiB + 512 * 1024;
constexpr size_t WS_RSTD1 = 22 * MiB + 768 * 1024;
constexpr size_t WS_RSTD2 = 22 * MiB + 896 * 1024;
constexpr size_t WS_RSTDM = 23 * MiB;
constexpr size_t WS_SSQO = 23 * MiB + 64 * 1024;
constexpr size_t WS_SV = 23 * MiB + 320 * 1024;
constexpr size_t WS_SU = 23 * MiB + 256 * 1024;
constexpr size_t WS_WMKV = 24 * MiB;
constexpr size_t WS_MEMB = 26 * MiB;
constexpr size_t WS_KVM = 30 * MiB;
constexpr size_t WS_ROPE = 34 * MiB;
constexpr size_t WS_XB = 42 * MiB;
constexpr size_t WS_POOLED = 42 * MiB;
constexpr size_t WS_MERGED = 170 * MiB;
constexpr size_t WS_U16 = 106 * MiB;
constexpr size_t WS_V16 = 138 * MiB;
constexpr size_t WS_UPOOL = 170 * MiB;
constexpr size_t WS_QR = 202 * MiB;
constexpr size_t WS_KR = 266 * MiB;
constexpr size_t WS_VV = 274 * MiB;
constexpr size_t WS_QM = 282 * MiB;
constexpr size_t WS_GATES = 314 * MiB;
constexpr size_t WS_X1B = 234 * MiB;
constexpr size_t WS_QP = 314 * MiB;
constexpr size_t WS_COEF = 314 * MiB;
constexpr size_t WS_IDS = 442 * MiB;
constexpr size_t WS_GTS = 458 * MiB;
constexpr size_t WS_END = 512 * MiB;

struct Params {
    const float* x; const float* mem; const int* pos; const float* norm1_g; const float* mem_norm_g; const float* w_in; const float* w_pool;
    const float* pool_scale; const float* sinks; const float* w_mem_kv; const float* w_bpool; const float* w_bswa; const float* w_bmem; const float* w_out;
    const float* norm2_g; const float* w_q; const float* sub_keys; const float* peer_u; const float* peer_v; const float* final_g;
    float* out; unsigned char* ws;
    int use_cg_sync; int pad_;
};

DI unsigned f2bf(float f) { unsigned u = __builtin_bit_cast(unsigned, f); return (u + 0x7fffu + ((u >> 16) & 1u)) >> 16; }
DI unsigned pk2(float lo, float hi) { return f2bf(lo) | (f2bf(hi) << 16); }
DI float bf2f(bf16_t b) { return __builtin_bit_cast(float, (unsigned)b << 16); }
DI float bflo(unsigned w) { return __builtin_bit_cast(float, w << 16); }
DI float bfhi(unsigned w) { return __builtin_bit_cast(float, w & 0xffff0000u); }
DI float wave_sum(float v) {
#pragma unroll
    for (int o = 1; o < 64; o <<= 1) v += __shfl_xor(v, o);
    return v;
}
DI float wave_max(float v) {
#pragma unroll
    for (int o = 1; o < 64; o <<= 1) v = fmaxf(v, __shfl_xor(v, o));
    return v;
}
DI float gelu_tanh(float x) {
    const float y2 = 1.5957691216057308f * (x + 0.044715f * x * x * x);
    return x * __builtin_amdgcn_rcpf(1.f + __builtin_amdgcn_exp2f(-1.4426950408889634f * y2));
}
DI float sigmoidf(float x) { return __builtin_amdgcn_rcpf(1.f + __builtin_amdgcn_exp2f(-1.4426950408889634f * x)); }

DI int opaque_tid() { int t = threadIdx.x; asm volatile("" : "+v"(t)); return t; }
DI int zperm(int n) {
    if (n < 512 || n >= 1664) return n;
    const int d = (n - 512) & 63, hb = n - d; return hb + 8 * ((d & 31) >> 2) + (d & 3) + 4 * (d >> 5);
}
template <bool ZPERM>
DI void transpose_item(const float* W, int K, int N, bf16_t* WT, int ldt, int roff, int coff, const float* g, float* scr, int item, int lane) {
    const int nblk = N / 32, kb = item / nblk, nb = item % nblk, k0 = 64 * kb, n0 = 32 * nb;
    float tv[32];
#pragma unroll
    for (int i = 0; i < 32; ++i) tv[i] = W[(size_t)(k0 + 2 * i + (lane >> 5)) * N + n0 + (lane & 31)];
#pragma unroll
    for (int i = 0; i < 32; ++i) { const int kk = 2 * i + (lane >> 5); float v = tv[i]; if (g) v *= g[k0 + kk]; scr[kk * 33 + (lane & 31)] = v; }
    asm volatile("s_waitcnt lgkmcnt(0)" ::: "memory");
    const int c = lane & 7;
#pragma unroll
    for (int j = 0; j < 4; ++j) { const int n = (lane >> 3) + 8 * j; const float* s = scr + (8 * c) * 33 + n;
        u32x4 o; o.x = pk2(s[0 * 33], s[1 * 33]); o.y = pk2(s[2 * 33], s[3 * 33]); o.z = pk2(s[4 * 33], s[5 * 33]); o.w = pk2(s[6 * 33], s[7 * 33]);
        const int nd = ZPERM ? zperm(n0 + n) : n0 + n;
        *(u32x4*)(WT + (size_t)(roff + nd) * ldt + coff + k0 + 8 * c) = o; }
    asm volatile("s_waitcnt lgkmcnt(0)" ::: "memory");
}

DI void row_to_bf16_rstd(const float* xrow, bf16_t* orow, float* rstd_out, int lane) {
    const f32x4* xr = (const f32x4*)xrow + lane;
    f32x4 v[4]; float s = 0.f;
#pragma unroll
    for (int j = 0; j < 4; ++j) { v[j] = xr[64 * j]; s += (v[j].x * v[j].x + v[j].y * v[j].y) + (v[j].z * v[j].z + v[j].w * v[j].w); }
    s = wave_sum(s);
    if (lane == 0) *rstd_out = 1.f / sqrtf(s * (1.f / D) + EPS);
    u32x2* o8 = (u32x2*)orow + lane;
#pragma unroll
    for (int j = 0; j < 4; ++j) { u32x2 w; w.x = pk2(v[j].x, v[j].y); w.y = pk2(v[j].z, v[j].w); o8[64 * j] = w; }
}

DI void phase0(const Params& p, float* lds_f) {
    const int tid_ = opaque_tid(), lane = tid_ & 63, wave = tid_ >> 6, gw = blockIdx.x * NWAVES + wave, NGW = gridDim.x * NWAVES;
    unsigned char* ws = p.ws;
    float* scr = lds_f + wave * (64 * 33);
    bf16_t* WinT = (bf16_t*)(ws + WS_WIN); bf16_t* WbrT = (bf16_t*)(ws + WS_WBR); bf16_t* WoutT = (bf16_t*)(ws + WS_WOUT); bf16_t* WqT = (bf16_t*)(ws + WS_WQ);
    bf16_t* WmkvT = (bf16_t*)(ws + WS_WMKV);
    constexpr int I_IN = (D / 64) * (INW / 32), I_BS = (1024 / 64) * (D / 32), I_BM = (512 / 64) * (D / 32), I_OUT = (D / 64) * (D / 32), I_Q = (D / 64) * (2048 / 32), I_MKV = (D / 64) * (D / 32);
    constexpr int NITEMS = I_IN + I_BS + I_BM + I_OUT + I_Q + I_MKV;
    for (int rp_ = 0; rp_ < (DUP_PHASE == 10 ? 2 : 1); ++rp_) {
    for (int it = gw; it < NITEMS; it += NGW) {
        int r = it;
        if (r < I_IN) { transpose_item<true>(p.w_in, D, INW, WinT, D, 0, 0, p.norm1_g, scr, r, lane); continue; } r -= I_IN;
        if (r < I_BS) { transpose_item<false>(p.w_bswa, 1024, D, WbrT, 2048, 0, 512, nullptr, scr, r, lane); continue; } r -= I_BS;
        if (r < I_BM) { transpose_item<false>(p.w_bmem, 512, D, WbrT, 2048, 0, 1536, nullptr, scr, r, lane); continue; } r -= I_BM;
        if (r < I_OUT) { transpose_item<false>(p.w_out, D, D, WoutT, D, 0, 0, nullptr, scr, r, lane); continue; } r -= I_OUT;
        if (r < I_Q) { transpose_item<false>(p.w_q, D, 2048, WqT, D, 0, 0, p.norm2_g, scr, r, lane); continue; } r -= I_Q;
        transpose_item<false>(p.w_mem_kv, D, D, WmkvT, D, 0, 0, p.mem_norm_g, scr, r, lane);
    }
    }
    for (int rp_ = 0; rp_ < (DUP_PHASE == 11 ? 2 : 1); ++rp_) {
    {
        const size_t gt0 = (size_t)gw * 64 + lane, NGT0 = (size_t)NGW * 64;
        for (size_t i = gt0; i < (size_t)512 * 256; i += NGT0) {
            const int n4 = (int)(i & 255), cp = (int)(i >> 8), g = cp >> 7;
            const float* wp = p.w_pool + (size_t)cp * 128; const float* sc = p.pool_scale + g * 128; const f32x4* wb = (const f32x4*)(p.w_bpool + (size_t)(g * 128) * 1024) + n4;
            f32x4 a = {0.f, 0.f, 0.f, 0.f};
#pragma unroll 16
            for (int d = 0; d < 128; ++d) a += wb[(size_t)d * 256] * (wp[d] * sc[d]);
            bf16_t* o = WbrT + (size_t)(4 * n4) * 2048 + cp;
            o[0] = (bf16_t)f2bf(a.x); o[2048] = (bf16_t)f2bf(a.y); o[4096] = (bf16_t)f2bf(a.z); o[6144] = (bf16_t)f2bf(a.w);
        }
    }
    }
    bf16_t* xb = (bf16_t*)(ws + WS_XB); float* rstd1 = (float*)(ws + WS_RSTD1);
    for (int rp_ = 0; rp_ < (DUP_PHASE == 12 ? 2 : 1); ++rp_) {
    for (int m = gw; m < T; m += 4 * NGW) {
        f32x4 v[4][4];
#pragma unroll
        for (int q = 0; q < 4; ++q) { const int mq = (m + q * NGW < T) ? m + q * NGW : m; const f32x4* xr = (const f32x4*)(p.x + (size_t)mq * D) + lane;
#pragma unroll
            for (int j = 0; j < 4; ++j) v[q][j] = xr[64 * j]; }
#pragma unroll
        for (int q = 0; q < 4; ++q) { const int mq = m + q * NGW; float s = 0.f;
#pragma unroll
            for (int j = 0; j < 4; ++j) s += (v[q][j].x * v[q][j].x + v[q][j].y * v[q][j].y) + (v[q][j].z * v[q][j].z + v[q][j].w * v[q][j].w);
            s = wave_sum(s);
            if (mq < T) { if (lane == 0) rstd1[mq] = __builtin_amdgcn_rsqf(s * (1.f / D) + EPS);
                u32x2* o8 = (u32x2*)(xb + (size_t)mq * D) + lane;
#pragma unroll
                for (int j = 0; j < 4; ++j) { u32x2 wv; wv.x = pk2(v[q][j].x, v[q][j].y); wv.y = pk2(v[q][j].z, v[q][j].w); o8[64 * j] = wv; } } }
    }
    }
    bf16_t* memb = (bf16_t*)(ws + WS_MEMB); float* rstdm = (float*)(ws + WS_RSTDM);
    for (int m = gw; m < TMEM; m += NGW) row_to_bf16_rstd(p.mem + (size_t)m * D, memb + (size_t)m * D, rstdm + m, lane);
    const size_t gt = (size_t)gw * 64 + lane, NGT = (size_t)NGW * 64;
    bf16_t* keysb = (bf16_t*)(ws + WS_KEYS);
    for (size_t i = gt; i < (size_t)8 * 2 * 128 * 128 / 4; i += NGT) { const f32x4 v = ((const f32x4*)p.sub_keys)[i]; u32x2 w; w.x = pk2(v.x, v.y); w.y = pk2(v.z, v.w); ((u32x2*)keysb)[i] = w; }
    for (int rp_ = 0; rp_ < (DUP_PHASE == 14 ? 2 : 1); ++rp_) {
    {
        unsigned* u8 = (unsigned*)(ws + WS_U16); unsigned* v8 = (unsigned*)(ws + WS_V16); float* su = (float*)(ws + WS_SU); float* sv = (float*)(ws + WS_SV);
        f32x4 g2r[4];
#pragma unroll
        for (int j = 0; j < 4; ++j) g2r[j] = ((const f32x4*)p.norm2_g)[lane + 64 * j];
        for (int r0 = gw; r0 < NEXP; r0 += 2 * NGW) {
            f32x4 au[2][4], av[2][4];
#pragma unroll
            for (int h = 0; h < 2; ++h) { const int r = (r0 + h * NGW < NEXP) ? r0 + h * NGW : r0;
#pragma unroll
                for (int j = 0; j < 4; ++j) { au[h][j] = ((const f32x4*)p.peer_u)[(size_t)r * 256 + lane + 64 * j]; av[h][j] = ((const f32x4*)p.peer_v)[(size_t)r * 256 + lane + 64 * j]; } }
#pragma unroll
            for (int h = 0; h < 2; ++h) { const int r = r0 + h * NGW; if (r >= NEXP) continue;
                float sq = 0.f;
#pragma unroll
                for (int j = 0; j < 4; ++j) { au[h][j] = au[h][j] * g2r[j]; sq += au[h][j].x * au[h][j].x + au[h][j].y * au[h][j].y + au[h][j].z * au[h][j].z + au[h][j].w * au[h][j].w; }
                sq = wave_sum(sq);
                const float stp = 0.3352f * sqrtf(sq * (1.f / D)), inv = stp > 0.f ? 1.f / stp : 0.f;
                if (lane == 0) su[r] = stp * (1.f / 16.f);
                float sqv = 0.f;
#pragma unroll
                for (int j = 0; j < 4; ++j) sqv += av[h][j].x * av[h][j].x + av[h][j].y * av[h][j].y + av[h][j].z * av[h][j].z + av[h][j].w * av[h][j].w;
                sqv = wave_sum(sqv);
                const float svr = 0.48f * sqrtf(sqv * (1.f / D)), ivr = svr > 0.f ? 1.f / svr : 0.f;
                if (lane == 0) sv[r] = svr;
#pragma unroll
                for (int j = 0; j < 4; ++j) { const f32x4 b = av[h][j] * ivr;
                    const int ob = (lane & 1) ? 0 : 8;
                    const int q0 = (int)fminf(fmaxf(floorf(au[h][j].x * inv), -8.f), 7.f) + ob, q1 = (int)fminf(fmaxf(floorf(au[h][j].y * inv), -8.f), 7.f) + ob, q2 = (int)fminf(fmaxf(floorf(au[h][j].z * inv), -8.f), 7.f) + ob, q3 = (int)fminf(fmaxf(floorf(au[h][j].w * inv), -8.f), 7.f) + ob;
                    const unsigned pkn = (unsigned)(q0 & 15) | ((unsigned)(q1 & 15) << 8) | ((unsigned)(q2 & 15) << 16) | ((unsigned)(q3 & 15) << 24);
                    const unsigned nb = (unsigned)__builtin_amdgcn_update_dpp(0, (int)pkn, 0xB1, 0xf, 0xf, false);
                    const unsigned wa = pkn | (nb << 4);
                    unsigned wb = __builtin_amdgcn_cvt_scalef32_pk_fp4_f32(0u, b.x, b.y, 1.0f, 0); wb = __builtin_amdgcn_cvt_scalef32_pk_fp4_f32(wb, b.z, b.w, 1.0f, 1);
                    const unsigned nbv = (unsigned)__builtin_amdgcn_update_dpp(0, (int)wb, 0xB1, 0xf, 0xf, false);
                    if (!(lane & 1)) { u8[(size_t)r * 128 + ((lane + 64 * j) >> 1)] = wa; v8[(size_t)r * 128 + ((lane + 64 * j) >> 1)] = (wb & 0xffffu) | (nbv << 16); } } }
        }
    }
    }
    for (size_t i = gt; i < (size_t)T; i += NGT) { ((float*)(ws + WS_RSTD2))[i] = 0.f; ((float*)(ws + WS_SSQO))[i] = 0.f; }
    for (int rp_ = 0; rp_ < (DUP_PHASE == 15 ? 2 : 1); ++rp_) {
    float2* rope = (float2*)(ws + WS_ROPE);
    for (size_t i = gt; i < (size_t)T * 32; i += NGT) {
        const int t = (int)(i >> 5), d = (int)(i & 31);
        const float inv = exp2f(-(float)d * (13.287712379549449f / 32.f));
        const float ang = (float)p.pos[t] * inv;
        const double rev = (double)ang * 0.15915494309189535;
        const float fr = (float)(rev - floor(rev));
        rope[i] = make_float2(__builtin_amdgcn_cosf(fr), __builtin_amdgcn_sinf(fr));
    }
    }
}

namespace pg8 {
#define PG8_LAS __attribute__((address_space(3)))
constexpr int BM = 256, BK = 64, HALF = 128, HTB = HALF * BK * 2, STAGE_BYTES = 8 * HTB, NXCD = 8;
__host__ __device__ __forceinline__ int lds_byte(int r, int c) { const int st = (r >> 4) * 2 + (c >> 5), rr = r & 15, cc = c & 31, ob = rr * 64 + cc * 2; return st * 1024 + (ob ^ (((ob >> 9) & 1) << 5)); }
__host__ __device__ __forceinline__ void stage_rc(int b, int& R, int& C) { const int st = b / 1024, sb = b % 1024, swz = sb ^ (((sb >> 9) & 1) << 5); R = (st >> 1) * 16 + swz / 64; C = (st & 1) * 32 + (swz % 64) / 2; }
__host__ __device__ __forceinline__ int perm32(int rho) { const int n = rho >> 4, i = rho & 15; return 8 * (i >> 2) + 4 * n + (i & 3); }

struct Unit { const char* a; const char* b; int nt, pm, pn, tag; };
DI void tile_of(int L, int nM, int nN, int& pm, int& pn, int WGM = 4) {
    const int nwg = nM * nN; int wgid = L; { const int q = nwg / NXCD, r = nwg % NXCD, xcd = wgid % NXCD, off = wgid / NXCD; wgid = (xcd < r ? xcd * (q + 1) : r * (q + 1) + (xcd - r) * q) + off; }
    const int nig = WGM * nN, gid = wgid / nig, fm = gid * WGM, gsz = (nM - fm) < WGM ? (nM - fm) : WGM;
    pm = fm + ((wgid % nig) % gsz); pn = (wgid % nig) / gsz;
}
template <class Epi, class Sched>
DI void gemm_phase(PG8_LAS unsigned char* lds, int lda, int ldb, const Sched& S, const Epi& E) {
    int tid = threadIdx.x; asm volatile("" : "+v"(tid));
    const int wid = __builtin_amdgcn_readfirstlane(tid >> 6), wr = wid >> 2, wc = wid & 3, lane = tid & 63, fr = lane & 15, fq = lane >> 4;
    unsigned voffA[2], voffB[2];
#pragma unroll
    for (int i = 0; i < 2; ++i) { int R, C; stage_rc(tid * 16 + i * 8192, R, C); const int Rb = 64 * (R >> 5) + perm32(R & 31);
        voffA[i] = (unsigned)(R * lda + C) * 2u; voffB[i] = (unsigned)(Rb * ldb + C) * 2u; }
    const size_t kstep = (size_t)(BK * 2);
    const size_t hstepA = (size_t)HALF * lda * 2, hstepB = (size_t)32 * ldb * 2;
    const unsigned ldsw = (unsigned)wid * 1024u;
    const int aoff = lds_byte(wr * 64 + fr, fq * 8), boff = lds_byte(wc * 32 + fr, fq * 8);
#define PG8_SA(b, h) (((b) * 2 + (h)) * HTB)
#define PG8_SB(b, h) ((4 + (b) * 2 + (h)) * HTB)
#define PG8_STAGE(bufoff, gbase, voff) do { _Pragma("unroll") for (int _i = 0; _i < 2; ++_i) \
        __builtin_amdgcn_global_load_lds((const unsigned*)((const char*)(gbase) + (voff)[_i]), (PG8_LAS unsigned*)(lds + (bufoff) + ldsw + _i * 8192), 16, 0, 0); } while (0)
#define PG8_LDA(dst, b, h) do { _Pragma("unroll") for (int m = 0; m < 4; ++m) _Pragma("unroll") for (int k = 0; k < 2; ++k) dst[m][k] = *(const PG8_LAS bf16x8*)(lds + PG8_SA(b, h) + aoff + m * 2048 + k * 1024); } while (0)
#define PG8_LDB(dst, b, h) do { _Pragma("unroll") for (int n = 0; n < 2; ++n) _Pragma("unroll") for (int k = 0; k < 2; ++k) dst[n][k] = *(const PG8_LAS bf16x8*)(lds + PG8_SB(b, h) + boff + n * 2048 + k * 1024); } while (0)
#define PG8_MMA(ai, bj, At, Bt) do { __builtin_amdgcn_s_setprio(1); _Pragma("unroll") for (int m = 0; m < 4; ++m) _Pragma("unroll") for (int n = 0; n < 2; ++n) _Pragma("unroll") for (int k = 0; k < 2; ++k) \
        acc[ai][bj][m][n] = __builtin_amdgcn_mfma_f32_16x16x32_bf16(Bt[n][k], At[m][k], acc[ai][bj][m][n], 0, 0, 0); __builtin_amdgcn_s_setprio(0); } while (0)
#define PG8_WAIT_V(n) asm volatile("s_waitcnt vmcnt(" #n ")" ::: "memory")
#define PG8_WAIT_L(n) asm volatile("s_waitcnt lgkmcnt(" #n ")" ::: "memory")
#define PG8_BAR __builtin_amdgcn_s_barrier()
#define PG8_SCHED __builtin_amdgcn_sched_barrier(0)
    Unit cur, nxt; int ui = 0;
    if (!S.next(0, cur)) return;
    f32x4 acc[2][2][4][2];
#pragma unroll
    for (int a = 0; a < 2; ++a)
#pragma unroll
        for (int b = 0; b < 2; ++b)
#pragma unroll
            for (int m = 0; m < 4; ++m)
#pragma unroll
                for (int n = 0; n < 2; ++n) acc[a][b][m][n] = (f32x4){0.f, 0.f, 0.f, 0.f};
    bf16x8 At[4][2], B0[2][2], B1[2][2];
    const char* cA = cur.a; const char* cB = cur.b;
    PG8_STAGE(PG8_SB(0, 0), cB, voffB); PG8_STAGE(PG8_SB(0, 1), cB + hstepB, voffB); PG8_STAGE(PG8_SA(0, 0), cA, voffA); PG8_STAGE(PG8_SA(0, 1), cA + hstepA, voffA);
    if (wr == 1) PG8_BAR;
    PG8_WAIT_V(2); PG8_BAR;
    PG8_STAGE(PG8_SB(1, 0), cB + kstep, voffB); PG8_STAGE(PG8_SA(1, 0), cA + kstep, voffA); PG8_STAGE(PG8_SB(1, 1), cB + hstepB + kstep, voffB);
    PG8_WAIT_V(6); PG8_BAR;
    for (;;) {
        const bool has_next = S.next(ui + 1, nxt);
        const char* nA = has_next ? nxt.a : cA; const char* nB = has_next ? nxt.b : cB;
        const int nt = cur.nt;
        for (int t = 0; t < nt; t += 2) {
            const bool last = (t == nt - 2);
            const char* a1 = cA + (size_t)(t + 1) * kstep;
            const char* a2 = last ? nA : cA + (size_t)(t + 2) * kstep; const char* b2 = last ? nB : cB + (size_t)(t + 2) * kstep;
            const char* a3 = a2 + kstep; const char* b3 = b2 + kstep;
            PG8_LDB(B0, 0, 0); PG8_LDB(B1, 0, 1); PG8_SCHED; PG8_LDA(At, 0, 0); PG8_STAGE(PG8_SA(1, 1), a1 + hstepA, voffA);
            PG8_WAIT_V(8); PG8_WAIT_L(0); PG8_BAR; PG8_MMA(0, 0, At, B0); PG8_MMA(0, 1, At, B1); PG8_BAR; PG8_SCHED;
            PG8_LDA(At, 0, 1); PG8_STAGE(PG8_SB(0, 0), b2, voffB); PG8_STAGE(PG8_SB(0, 1), b2 + hstepB, voffB); PG8_STAGE(PG8_SA(0, 0), a2, voffA);
            PG8_WAIT_V(8); PG8_WAIT_L(0); PG8_BAR; PG8_MMA(1, 0, At, B0); PG8_MMA(1, 1, At, B1); PG8_BAR; PG8_SCHED;
            PG8_LDB(B0, 1, 0); PG8_LDB(B1, 1, 1); PG8_SCHED; PG8_LDA(At, 1, 0); PG8_STAGE(PG8_SA(0, 1), a2 + hstepA, voffA);
            PG8_WAIT_V(8); PG8_WAIT_L(0); PG8_BAR; PG8_MMA(0, 0, At, B0); PG8_MMA(0, 1, At, B1); PG8_BAR; PG8_SCHED;
            PG8_LDA(At, 1, 1); PG8_STAGE(PG8_SB(1, 0), b3, voffB); PG8_STAGE(PG8_SB(1, 1), b3 + hstepB, voffB); PG8_STAGE(PG8_SA(1, 0), a3, voffA);
            PG8_WAIT_V(8); PG8_WAIT_L(0); PG8_BAR; PG8_MMA(1, 0, At, B0); PG8_MMA(1, 1, At, B1); PG8_BAR; PG8_SCHED;
        }
        if (wr == 0) PG8_BAR;
        const bool keep_ = E(acc, cur, wr, wc, fr, fq);
        if (!has_next) break;
        if (!keep_)
#pragma unroll
        for (int a = 0; a < 2; ++a)
#pragma unroll
            for (int b = 0; b < 2; ++b)
#pragma unroll
                for (int m = 0; m < 4; ++m)
#pragma unroll
                    for (int n = 0; n < 2; ++n) acc[a][b][m][n] = (f32x4){0.f, 0.f, 0.f, 0.f};
        cur = nxt; cA = nA; cB = nB; ++ui;
        if (wr == 1) PG8_BAR;
    }
    PG8_WAIT_V(0);
    PG8_BAR;
#undef PG8_SA
#undef PG8_SB
#undef PG8_STAGE
#undef PG8_LDA
#undef PG8_LDB
#undef PG8_MMA
#undef PG8_WAIT_V
#undef PG8_WAIT_L
#undef PG8_BAR
#undef PG8_SCHED
}
}
typedef f32x4 acc_t[2][2][4][2];

struct SchedPlain {
    const char* A; const char* Bt; int lda, ldb, nM, nN, nt, G, c;
    DI bool next(int i, pg8::Unit& u) const {
        const long L = (long)i * G + c; if (L >= (long)nM * nN) return false;
        pg8::tile_of((int)L, nM, nN, u.pm, u.pn); u.a = A + (size_t)u.pm * 256 * lda * 2; u.b = Bt + (size_t)u.pn * 256 * ldb * 2; u.nt = nt; u.tag = 0; return true;
    }
};
struct SchedZ {
    const char *xb, *win, *memb, *wmkv; int G, c;
    DI bool next(int i, pg8::Unit& u) const {
        const long L = (long)i * G + c; constexpr int NZ = 128 * 21;
        if (L < NZ) { pg8::tile_of((int)L, 128, 21, u.pm, u.pn); u.a = xb + (size_t)u.pm * 256 * 2048; u.b = win + (size_t)u.pn * 256 * 2048; u.nt = 16; u.tag = 0; return true; }
        const int j = (int)(L - NZ); if (j >= 32) return false;
        u.pm = j >> 2; u.pn = j & 3; u.a = memb + (size_t)u.pm * 256 * 2048; u.b = wmkv + (size_t)u.pn * 256 * 2048; u.nt = 16; u.tag = 1; return true;
    }
};
struct SchedGated {
    const char *ycat, *wbr; int G, c;
    DI bool next(int i, pg8::Unit& u) const {
        const int j = i / 3, b = i - 3 * j; const long L = (long)j * G + c; if (L >= 128 * 4) return false;
        pg8::tile_of((int)L, 128, 4, u.pm, u.pn);
        const int koff = (b == 0) ? 0 : (b == 1 ? 512 : 1536);
        u.a = ycat + ((size_t)u.pm * 256 * 2048 + koff) * 2; u.b = wbr + ((size_t)u.pn * 256 * 2048 + koff) * 2; u.nt = (b == 1) ? 16 : 8; u.tag = b; return true;
    }
};

template <int CTRL> DI unsigned dpp_u(unsigned v) { return (unsigned)__builtin_amdgcn_update_dpp(0, (int)v, CTRL, 0xf, 0xf, false); }
DI void store_lines16(bf16_t* blk  , size_t ld, int fr, const u32x4& P0, const u32x4& P1) {
    const bool lo = fr < 8;
    const u32x4 X = lo ? P1 : P0;
    u32x4 Y; Y.x = dpp_u<0x128>(X.x); Y.y = dpp_u<0x128>(X.y); Y.z = dpp_u<0x128>(X.z); Y.w = dpp_u<0x128>(X.w);
    const u32x4 A = lo ? P0 : Y, B = lo ? Y : P1;
    bf16_t* pa = blk + (size_t)(fr & 7) * ld + 32 * (fr >> 3);
    *(u32x4*)pa = A; *(u32x4*)(pa + 8 * ld) = B;
}
DI void store_lines8(unsigned char* blk  , size_t ld, int fr, const u32x2& P0, const u32x2& P1) {
    const bool lo = fr < 8;
    const u32x2 X = lo ? P1 : P0;
    u32x2 Y; Y.x = dpp_u<0x128>(X.x); Y.y = dpp_u<0x128>(X.y);
    const u32x2 A = lo ? P0 : Y, B = lo ? Y : P1;
    unsigned char* pa = blk + (size_t)(fr & 7) * ld + 32 * (fr >> 3);
    *(u32x2*)pa = A; *(u32x2*)(pa + 8 * ld) = B;
}
DI u32x4 pack8(const f32x4& a, const f32x4& b) { u32x4 w; w.x = pk2(a[0], a[1]); w.y = pk2(a[2], a[3]); w.z = pk2(b[0], b[1]); w.w = pk2(b[2], b[3]); return w; }
struct EpiZ {
    const float* rstd1; const float* rstdm; const float2* rope; bf16_t *upool, *qr, *kr, *vv, *qm; unsigned char* gates; bf16_t* kvm;
    DI bool operator()(const acc_t& acc, const pg8::Unit& u, int wr, int wc, int fr_, int fq_) const {
        int l_ = threadIdx.x; asm volatile("" : "+v"(l_)); const int fr = l_ & 15, fq = (l_ >> 4) & 3;
        const int row0 = u.pm * 256 + wr * 64 + fr;
        const float* rsp = (u.tag == 1) ? rstdm : rstd1;
        float rs[2][4];
#pragma unroll
        for (int ai = 0; ai < 2; ++ai)
#pragma unroll
            for (int m = 0; m < 4; ++m) rs[ai][m] = rsp[row0 + ai * 128 + m * 16];
        if (u.tag == 1) {
            bf16_t* tile = kvm + (size_t)(u.pm * 256 + wr * 64) * 1024 + u.pn * 256 + wc * 64 + 8 * fq;
#pragma unroll
            for (int ai = 0; ai < 2; ++ai)
#pragma unroll
                for (int m = 0; m < 4; ++m) store_lines16(tile + (size_t)(ai * 128 + m * 16) * 1024, 1024, fr, pack8(acc[ai][0][m][0] * rs[ai][m], acc[ai][0][m][1] * rs[ai][m]), pack8(acc[ai][1][m][0] * rs[ai][m], acc[ai][1][m][1] * rs[ai][m]));
            return false;
        }
        const int cb = u.pn * 256 + wc * 64;
        if (cb >= 512 && cb < 1664) {
#pragma unroll
            for (int bj = 0; bj < 2; ++bj) {
                const int c = cb + bj * 32 + 8 * fq;
                const bool isq = cb < 1536; const int rel = isq ? c - 512 : c - 1536; const int hrel = rel & 63, d0 = hrel >> 1, hb = rel - hrel;
                const float sc = isq ? 0.125f : 1.f;
#pragma unroll
                for (int ai = 0; ai < 2; ++ai) {
                    f32x4 cs0[4], cs1[4];
#pragma unroll
                    for (int m = 0; m < 4; ++m) { const int row = row0 + ai * 128 + m * 16;
                        cs0[m] = *(const f32x4*)(rope + (size_t)row * 32 + d0); cs1[m] = *(const f32x4*)(rope + (size_t)row * 32 + d0 + 2); }
#pragma unroll
                    for (int m = 0; m < 4; ++m) { const int row = row0 + ai * 128 + m * 16;
                        const f32x4 v0 = acc[ai][bj][m][0] * rs[ai][m], v1 = acc[ai][bj][m][1] * rs[ai][m], a0 = cs0[m], a1 = cs1[m];
                        f32x4 o1, o2;
                        o1[0] = (v0[0] * a0[0] - v1[0] * a0[1]) * sc; o2[0] = (v1[0] * a0[0] + v0[0] * a0[1]) * sc;
                        o1[1] = (v0[1] * a0[2] - v1[1] * a0[3]) * sc; o2[1] = (v1[1] * a0[2] + v0[1] * a0[3]) * sc;
                        o1[2] = (v0[2] * a1[0] - v1[2] * a1[1]) * sc; o2[2] = (v1[2] * a1[0] + v0[2] * a1[1]) * sc;
                        o1[3] = (v0[3] * a1[2] - v1[3] * a1[3]) * sc; o2[3] = (v1[3] * a1[2] + v0[3] * a1[3]) * sc;
                        bf16_t* dst = isq ? qr + (size_t)row * 1024 + hb + d0 : kr + (size_t)row * 128 + hb + d0;
                        u32x2 w1, w2; w1.x = pk2(o1[0], o1[1]); w1.y = pk2(o1[2], o1[3]); w2.x = pk2(o2[0], o2[1]); w2.y = pk2(o2[2], o2[3]);
                        *(u32x2*)dst = w1; *(u32x2*)(dst + 32) = w2; }
                }
            }
        } else if (cb >= 2304) {
            unsigned char* tile = gates + (size_t)(u.pm * 256 + wr * 64) * 3072 + (cb - 2304) + 8 * fq;
#pragma unroll
            for (int ai = 0; ai < 2; ++ai)
#pragma unroll
                for (int m = 0; m < 4; ++m) {
                    u32x2 wq[2];
#pragma unroll
                    for (int bj = 0; bj < 2; ++bj) { const f32x4 v0 = acc[ai][bj][m][0] * rs[ai][m], v1 = acc[ai][bj][m][1] * rs[ai][m]; u32x2 w = {0u, 0u};
#pragma unroll
                        for (int e = 0; e < 4; ++e) {
                            const float t0 = __builtin_amdgcn_rcpf(__builtin_fmaf(__builtin_amdgcn_exp2f(-1.4426950408889634f * v0[e]), 1.f / 256.f, 1.f / 256.f));
                            const float t1 = __builtin_amdgcn_rcpf(__builtin_fmaf(__builtin_amdgcn_exp2f(-1.4426950408889634f * v1[e]), 1.f / 256.f, 1.f / 256.f));
                            w.x = __builtin_amdgcn_cvt_pk_u8_f32(__builtin_floorf(t0), e, w.x); w.y = __builtin_amdgcn_cvt_pk_u8_f32(__builtin_floorf(t1), e, w.y); }
                        wq[bj] = w; }
                    store_lines8(tile + (size_t)(ai * 128 + m * 16) * 3072, 3072, fr, wq[0], wq[1]);
                }
        } else {
            bf16_t* dstp; size_t ld;
            if (cb < 512) { dstp = upool + cb; ld = 512; } else if (cb < 1792) { dstp = vv + (cb - 1664); ld = 128; } else { dstp = qm + (cb - 1792); ld = 512; }
            bf16_t* tile = dstp + (size_t)(u.pm * 256 + wr * 64) * ld + 8 * fq;
#pragma unroll
            for (int ai = 0; ai < 2; ++ai)
#pragma unroll
                for (int m = 0; m < 4; ++m) store_lines16(tile + (size_t)(ai * 128 + m * 16) * ld, ld, fr, pack8(acc[ai][0][m][0] * rs[ai][m], acc[ai][0][m][1] * rs[ai][m]), pack8(acc[ai][1][m][0] * rs[ai][m], acc[ai][1][m][1] * rs[ai][m]));
        }
        return false;
    }
};
struct EpiGated {
    const unsigned char* gates; bf16_t* merged;
    static DI float gv(unsigned w, int e) { return ((float)((w >> (8 * e)) & 255u) + 0.5f) * (1.f / 256.f); }
    DI bool operator()(acc_t& acc, const pg8::Unit& u, int wr, int wc, int fr_, int fq_) const {
        int l_ = threadIdx.x; asm volatile("" : "+v"(l_)); const int fr = l_ & 15, fq = (l_ >> 4) & 3;
        const int row0 = u.pm * 256 + wr * 64 + fr, b = u.tag;
#pragma unroll
        for (int ai = 0; ai < 2; ++ai) {
            u32x2 gq[4][2], gnq[4][2];
#pragma unroll
            for (int m = 0; m < 4; ++m)
#pragma unroll
                for (int bj = 0; bj < 2; ++bj) { const unsigned char* gp = gates + (size_t)(row0 + ai * 128 + m * 16) * 3072 + b * 1024 + u.pn * 256 + wc * 64 + bj * 32 + 8 * fq;
                    gq[m][bj] = *(const u32x2*)gp; if (b < 2) gnq[m][bj] = *(const u32x2*)(gp + 1024); else gnq[m][bj] = gq[m][bj]; }
#pragma unroll
            for (int m = 0; m < 4; ++m) { const int row = row0 + ai * 128 + m * 16;
#pragma unroll
                for (int bj = 0; bj < 2; ++bj) { const int c = u.pn * 256 + wc * 64 + bj * 32 + 8 * fq;
                    const u32x2 g = gq[m][bj], gn = gnq[m][bj];
                    f32x4 s0, s1;
#pragma unroll
                    for (int e = 0; e < 4; ++e) { s0[e] = gv(g.x, e); s1[e] = gv(g.y, e); }
                    if (b < 2) {
#pragma unroll
                        for (int e = 0; e < 4; ++e) { s0[e] *= __builtin_amdgcn_rcpf(gv(gn.x, e)); s1[e] *= __builtin_amdgcn_rcpf(gv(gn.y, e)); }
                        acc[ai][bj][m][0] *= s0; acc[ai][bj][m][1] *= s1; }
                    else { acc[ai][bj][m][0] *= s0; acc[ai][bj][m][1] *= s1; } }
                if (b == 2) store_lines16(merged + (size_t)(u.pm * 256 + wr * 64 + ai * 128 + m * 16) * 1024 + u.pn * 256 + wc * 64 + 8 * fq, 1024, fr, pack8(acc[ai][0][m][0], acc[ai][0][m][1]), pack8(acc[ai][1][m][0], acc[ai][1][m][1])); }
        }
        return b < 2;
    }
};
struct EpiOut {
    const bf16_t* xb; bf16_t* x1b; float* ssq;
    DI bool operator()(const acc_t& acc, const pg8::Unit& u, int wr, int wc, int fr_, int fq_) const {
        int l_ = threadIdx.x; asm volatile("" : "+v"(l_)); const int fr = l_ & 15, fq = (l_ >> 4) & 3;
        const int row0 = u.pm * 256 + wr * 64 + fr;
#pragma unroll
        for (int ai = 0; ai < 2; ++ai) {
            u32x4 xq[4][2];
#pragma unroll
            for (int m = 0; m < 4; ++m)
#pragma unroll
                for (int bj = 0; bj < 2; ++bj) xq[m][bj] = *(const u32x4*)(xb + (size_t)(row0 + ai * 128 + m * 16) * D + u.pn * 256 + wc * 64 + bj * 32 + 8 * fq);
#pragma unroll
            for (int m = 0; m < 4; ++m) { const int row = row0 + ai * 128 + m * 16; float sq = 0.f; u32x4 pk[2];
#pragma unroll
                for (int bj = 0; bj < 2; ++bj) { const size_t o = (size_t)row * D + u.pn * 256 + wc * 64 + bj * 32 + 8 * fq;
                    const u32x4 xw = xq[m][bj];
                    f32x4 v0 = acc[ai][bj][m][0], v1 = acc[ai][bj][m][1];
                    v0[0] += bflo(xw.x); v0[1] += bfhi(xw.x); v0[2] += bflo(xw.y); v0[3] += bfhi(xw.y); v1[0] += bflo(xw.z); v1[1] += bfhi(xw.z); v1[2] += bflo(xw.w); v1[3] += bfhi(xw.w);
                    sq += (v0[0] * v0[0] + v0[1] * v0[1]) + (v0[2] * v0[2] + v0[3] * v0[3]) + (v1[0] * v1[0] + v1[1] * v1[1]) + (v1[2] * v1[2] + v1[3] * v1[3]);
                    pk[bj] = pack8(v0, v1); }
                store_lines16(x1b + (size_t)(u.pm * 256 + wr * 64 + ai * 128 + m * 16) * D + u.pn * 256 + wc * 64 + 8 * fq, D, fr, pk[0], pk[1]);
                sq += __shfl_xor(sq, 16); sq += __shfl_xor(sq, 32);
                if (fq == 0) atomicAdd(ssq + row, sq); }
        }
        return false;
    }
};
struct EpiBf16 {
    bf16_t* O; int ldo;
    DI bool operator()(const acc_t& acc, const pg8::Unit& u, int wr, int wc, int fr_, int fq_) const {
        int l_ = threadIdx.x; asm volatile("" : "+v"(l_)); const int fr = l_ & 15, fq = (l_ >> 4) & 3;
        bf16_t* tile = O + (size_t)(u.pm * 256 + wr * 64) * ldo + u.pn * 256 + wc * 64 + 8 * fq;
#pragma unroll
        for (int ai = 0; ai < 2; ++ai)
#pragma unroll
            for (int m = 0; m < 4; ++m) store_lines16(tile + (size_t)(ai * 128 + m * 16) * ldo, (size_t)ldo, fr, pack8(acc[ai][0][m][0], acc[ai][0][m][1]), pack8(acc[ai][1][m][0], acc[ai][1][m][1]));
        return false;
    }
};

DI void unpack8(const u32x4& w, float (&f)[8]) { f[0] = bflo(w.x); f[1] = bfhi(w.x); f[2] = bflo(w.y); f[3] = bfhi(w.y); f[4] = bflo(w.z); f[5] = bfhi(w.z); f[6] = bflo(w.w); f[7] = bfhi(w.w); }
DI void pooled_phase(const bf16_t* upool, bf16_t* pooled) {
    const int tid = opaque_tid(), lane = tid & 63, gw = blockIdx.x * NWAVES + (tid >> 6), NGW = gridDim.x * NWAVES;
    const int c = lane * 8, w = 2 << (lane >> 4);
    for (int task = gw; task < T / 16; task += NGW) {
        const int t0 = task * 16, s0 = t0 & (SEQ - 1);
        const bf16_t* up = upool + (size_t)t0 * 512 + c;
        u32x4 hw[15], nw[16], ow[16];
#pragma unroll
        for (int j = 1; j < 16; ++j) { const int jj = (s0 - j >= 0) ? j : 0; hw[j - 1] = *(const u32x4*)(up - (ptrdiff_t)jj * 512); }
#pragma unroll
        for (int i = 0; i < 16; ++i) { nw[i] = *(const u32x4*)(up + (size_t)i * 512); const int back = (s0 + i - (w - 1) >= 0) ? (w - 1) : 0; ow[i] = *(const u32x4*)(up + (ptrdiff_t)(i - back) * 512); }
        float win[8];
#pragma unroll
        for (int e = 0; e < 8; ++e) win[e] = 0.f;
#pragma unroll
        for (int j = 1; j < 16; ++j) { float f[8]; unpack8(hw[j - 1], f); const float mk = (j < w && s0 - j >= 0) ? 1.f : 0.f;
#pragma unroll
            for (int e = 0; e < 8; ++e) win[e] += mk * f[e]; }
#pragma unroll
        for (int i = 0; i < 16; ++i) {
            const int s = s0 + i;
            float un[8], uo[8];
            unpack8(nw[i], un); unpack8(ow[i], uo);
            const float mo = (s - (w - 1) >= 0) ? 1.f : 0.f;
            const int cnt = (s + 1 < w) ? s + 1 : w; const float ic = __builtin_amdgcn_rcpf((float)cnt);
            float o[8];
#pragma unroll
            for (int e = 0; e < 8; ++e) { const float tot = win[e] + un[e]; o[e] = tot * ic - un[e]; win[e] = tot - mo * uo[e]; }
            u32x4 ov; ov.x = pk2(o[0], o[1]); ov.y = pk2(o[2], o[3]); ov.z = pk2(o[4], o[5]); ov.w = pk2(o[6], o[7]);
            *(u32x4*)(pooled + (size_t)(t0 + i) * 2048 + c) = ov;
        }
    }
}
typedef __bf16 bf16x2_t __attribute__((ext_vector_type(2)));
typedef float f32x2_t __attribute__((ext_vector_type(2)));
DI unsigned cvtpk(float lo, float hi) { f32x2_t v = {lo, hi}; bf16x2_t b = __builtin_convertvector(v, bf16x2_t); return __builtin_bit_cast(unsigned, b); }
DI int crow(int i, int h) { return (i & 3) + 8 * (i >> 2) + 4 * h; }
#define MFMA32(a, b, c) __builtin_amdgcn_mfma_f32_32x32x16_bf16((a), (b), (c), 0, 0, 0)
DI bf16x8 mk8(unsigned a, unsigned b, unsigned c, unsigned d) { u32x4 w = {a, b, c, d}; return __builtin_bit_cast(bf16x8, w); }

constexpr int SWA_KLD = 72, SWA_VLD = 260, SWA_VT_OFF = 256 * SWA_KLD * 2;
DI void swa_phase(const bf16_t* qr, const bf16_t* kr, const bf16_t* vv, const float* sinks, bf16_t* ycat, unsigned char* lds) {
    const int tid = opaque_tid();
    const int lane = tid & 63, w = tid >> 6, r = lane & 31, h = lane >> 5;
    bf16_t* Ks = (bf16_t*)lds; bf16_t* Vt = (bf16_t*)(lds + SWA_VT_OFF);
    for (int unit = blockIdx.x; unit < 512; unit += gridDim.x) {
        const int kvh = unit & 1, nb = (unit >> 1) & 31, b = unit >> 6;
        const int tq0 = b * SEQ + nb * 128, tk0 = tq0 - 128;
        const int hq = kvh * 8 + w; const float sink = sinks[hq];
        bf16x8 qn[4];
        { const bf16_t* qp = qr + (size_t)(tq0 + r) * 1024 + hq * 64 + 8 * h;
#pragma unroll
          for (int s = 0; s < 4; ++s) qn[s] = *(const bf16x8*)(qp + 16 * s); }
        __syncthreads();
#pragma unroll
        for (int i = 0; i < 4; ++i) {
            const int c = tid + 512 * i, kb = c >> 3, dc = (c & 7) * 8;
            u32x4 kv = {0u, 0u, 0u, 0u}, vx = {0u, 0u, 0u, 0u};
            if (nb > 0 || kb >= 128) { kv = *(const u32x4*)(kr + (size_t)(tk0 + kb) * 128 + kvh * 64 + dc); vx = *(const u32x4*)(vv + (size_t)(tk0 + kb) * 128 + kvh * 64 + dc); }
            *(u32x4*)(Ks + kb * SWA_KLD + dc) = kv;
            bf16_t* vp = Vt + dc * SWA_VLD + kb;
            vp[0 * SWA_VLD] = (bf16_t)(vx.x & 0xffffu); vp[1 * SWA_VLD] = (bf16_t)(vx.x >> 16); vp[2 * SWA_VLD] = (bf16_t)(vx.y & 0xffffu); vp[3 * SWA_VLD] = (bf16_t)(vx.y >> 16);
            vp[4 * SWA_VLD] = (bf16_t)(vx.z & 0xffffu); vp[5 * SWA_VLD] = (bf16_t)(vx.z >> 16); vp[6 * SWA_VLD] = (bf16_t)(vx.w & 0xffffu); vp[7 * SWA_VLD] = (bf16_t)(vx.w >> 16);
        }
        __syncthreads();
        for (int qt = 0; qt < 4; ++qt) {
            bf16x8 qf[4];
#pragma unroll
            for (int s = 0; s < 4; ++s) qf[s] = qn[s];
            if (qt < 3) { const bf16_t* qp = qr + (size_t)(tq0 + 32 * (qt + 1) + r) * 1024 + hq * 64 + 8 * h;
#pragma unroll
                for (int s = 0; s < 4; ++s) qn[s] = *(const bf16x8*)(qp + 16 * s); }
            f32x16 sa[5];
#pragma unroll
            for (int c = 0; c < 5; ++c) {
#pragma unroll
                for (int i = 0; i < 16; ++i) sa[c][i] = 0.f;
#pragma unroll
                for (int s = 0; s < 4; ++s) { const bf16x8 kf = *(const bf16x8*)(Ks + (32 * (qt + c) + r) * SWA_KLD + 16 * s + 8 * h); sa[c] = MFMA32(kf, qf[s], sa[c]); }
            }
            float mx = sink;
#pragma unroll
            for (int c = 0; c < 5; ++c)
#pragma unroll
                for (int i = 0; i < 16; ++i) {
                    const int kk = 32 * c + crow(i, h);
                    bool vis = (c == 0) ? (kk > r) : ((c == 4) ? (kk - 128 <= r) : true);
                    if (nb == 0) vis = vis && (32 * qt + kk >= 128);
                    const float s = vis ? sa[c][i] : -1e30f; sa[c][i] = s; mx = fmaxf(mx, s);
                }
            mx = fmaxf(mx, __shfl_xor(mx, 32));
            float l = 0.f;
#pragma unroll
            for (int c = 0; c < 5; ++c)
#pragma unroll
                for (int i = 0; i < 16; ++i) { const float pz = __expf(sa[c][i] - mx); sa[c][i] = pz; l += pz; }
            l += __shfl_xor(l, 32); l += __expf(sink - mx);
            const float inv = 1.f / l;
            f32x16 oa[2];
#pragma unroll
            for (int i = 0; i < 16; ++i) { oa[0][i] = 0.f; oa[1][i] = 0.f; }
#pragma unroll
            for (int c = 0; c < 5; ++c)
#pragma unroll
                for (int s2 = 0; s2 < 2; ++s2) {
                    const bf16x8 pf = mk8(cvtpk(sa[c][8 * s2 + 0], sa[c][8 * s2 + 1]), cvtpk(sa[c][8 * s2 + 2], sa[c][8 * s2 + 3]), cvtpk(sa[c][8 * s2 + 4], sa[c][8 * s2 + 5]), cvtpk(sa[c][8 * s2 + 6], sa[c][8 * s2 + 7]));
#pragma unroll
                    for (int dt = 0; dt < 2; ++dt) {
                        const bf16_t* va = Vt + (32 * dt + r) * SWA_VLD + 32 * (qt + c) + 16 * s2 + 4 * h;
                        const u32x2 lo = *(const u32x2*)va, hi = *(const u32x2*)(va + 8);
                        oa[dt] = MFMA32(mk8(lo.x, lo.y, hi.x, hi.y), pf, oa[dt]);
                    }
                }
            bf16_t* yp = ycat + (size_t)(tq0 + 32 * qt + r) * 2048 + 512 + hq * 64 + 4 * h;
#pragma unroll
            for (int dt = 0; dt < 2; ++dt)
#pragma unroll
                for (int g4 = 0; g4 < 4; ++g4) { u32x2 o; o.x = cvtpk(oa[dt][4 * g4] * inv, oa[dt][4 * g4 + 1] * inv); o.y = cvtpk(oa[dt][4 * g4 + 2] * inv, oa[dt][4 * g4 + 3] * inv);
                    *(u32x2*)(yp + 32 * dt + 8 * g4) = o; }
        }
    }
}

constexpr int MEM_KLD = 136, MEM_VLD = 260, MEM_VT_OFF = 256 * MEM_KLD * 2;
DI void mem_phase(const bf16_t* qm, const bf16_t* kvm, bf16_t* ycat, unsigned char* lds) {
    const int tid = opaque_tid();
    const int lane = tid & 63, w = tid >> 6, r = lane & 31, h = lane >> 5;
    bf16_t* Ks = (bf16_t*)lds; bf16_t* Vt = (bf16_t*)(lds + MEM_VT_OFF);
    for (int unit = blockIdx.x; unit < 256; unit += gridDim.x) {
        const int qc = unit & 7, hm = (unit >> 3) & 3, b = unit >> 5;
        bf16x8 qn[8];
        { const bf16_t* qp = qm + (size_t)(b * SEQ + qc * 512 + (w * 2) * 32 + r) * 512 + hm * 128 + 8 * h;
#pragma unroll
          for (int s = 0; s < 8; ++s) qn[s] = *(const bf16x8*)(qp + 16 * s); }
        __syncthreads();
#pragma unroll
        for (int i = 0; i < 8; ++i) {
            const int c = tid + 512 * i, m = c >> 4, dc = (c & 15) * 8;
            const bf16_t* src = kvm + (size_t)(b * MEML + m) * 1024 + hm * 128 + dc;
            const u32x4 kv = *(const u32x4*)src, vx = *(const u32x4*)(src + 512);
            *(u32x4*)(Ks + m * MEM_KLD + dc) = kv;
            bf16_t* vp = Vt + dc * MEM_VLD + m;
            vp[0 * MEM_VLD] = (bf16_t)(vx.x & 0xffffu); vp[1 * MEM_VLD] = (bf16_t)(vx.x >> 16); vp[2 * MEM_VLD] = (bf16_t)(vx.y & 0xffffu); vp[3 * MEM_VLD] = (bf16_t)(vx.y >> 16);
            vp[4 * MEM_VLD] = (bf16_t)(vx.z & 0xffffu); vp[5 * MEM_VLD] = (bf16_t)(vx.z >> 16); vp[6 * MEM_VLD] = (bf16_t)(vx.w & 0xffffu); vp[7 * MEM_VLD] = (bf16_t)(vx.w >> 16);
        }
        __syncthreads();
        for (int qi = 0; qi < 2; ++qi) {
            const int t0 = b * SEQ + qc * 512 + (w * 2 + qi) * 32;
            bf16x8 qf[8];
#pragma unroll
            for (int s = 0; s < 8; ++s) qf[s] = qn[s];
            if (qi == 0) { const bf16_t* qp = qm + (size_t)(t0 + 32 + r) * 512 + hm * 128 + 8 * h;
#pragma unroll
                for (int s = 0; s < 8; ++s) qn[s] = *(const bf16x8*)(qp + 16 * s); }
            float mx = -3e38f;
#pragma unroll 1
            for (int c = 0; c < 8; ++c) {
                f32x16 sc;
#pragma unroll
                for (int i = 0; i < 16; ++i) sc[i] = 0.f;
#pragma unroll
                for (int s = 0; s < 8; ++s) { const bf16x8 kf = *(const bf16x8*)(Ks + (32 * c + r) * MEM_KLD + 16 * s + 8 * h); sc = MFMA32(kf, qf[s], sc); }
#pragma unroll
                for (int i = 0; i < 16; ++i) mx = fmaxf(mx, sc[i]);
            }
            mx = fmaxf(mx, __shfl_xor(mx, 32));
            constexpr float SC = 0.08838834764831845f * 1.4426950408889634f;
            float l = 0.f;
            f32x16 oa[4];
#pragma unroll
            for (int dt = 0; dt < 4; ++dt)
#pragma unroll
                for (int i = 0; i < 16; ++i) oa[dt][i] = 0.f;
#pragma unroll 1
            for (int c = 0; c < 8; ++c) {
                f32x16 sc;
#pragma unroll
                for (int i = 0; i < 16; ++i) sc[i] = 0.f;
#pragma unroll
                for (int s = 0; s < 8; ++s) { const bf16x8 kf = *(const bf16x8*)(Ks + (32 * c + r) * MEM_KLD + 16 * s + 8 * h); sc = MFMA32(kf, qf[s], sc); }
#pragma unroll
                for (int i = 0; i < 16; ++i) { const float pz = exp2f((sc[i] - mx) * SC); sc[i] = pz; l += pz; }
#pragma unroll
                for (int s2 = 0; s2 < 2; ++s2) {
                    const bf16x8 pf = mk8(cvtpk(sc[8 * s2 + 0], sc[8 * s2 + 1]), cvtpk(sc[8 * s2 + 2], sc[8 * s2 + 3]), cvtpk(sc[8 * s2 + 4], sc[8 * s2 + 5]), cvtpk(sc[8 * s2 + 6], sc[8 * s2 + 7]));
#pragma unroll
                    for (int dt = 0; dt < 4; ++dt) {
                        const bf16_t* va = Vt + (32 * dt + r) * MEM_VLD + 32 * c + 16 * s2 + 4 * h;
                        const u32x2 lo = *(const u32x2*)va, hi = *(const u32x2*)(va + 8);
                        oa[dt] = MFMA32(mk8(lo.x, lo.y, hi.x, hi.y), pf, oa[dt]);
                    }
                }
            }
            l += __shfl_xor(l, 32);
            const float inv = 1.f / l;
            bf16_t* yp = ycat + (size_t)(t0 + r) * 2048 + 1536 + hm * 128 + 4 * h;
#pragma unroll
            for (int dt = 0; dt < 4; ++dt)
#pragma unroll
                for (int g4 = 0; g4 < 4; ++g4) { u32x2 o; o.x = cvtpk(oa[dt][4 * g4] * inv, oa[dt][4 * g4 + 1] * inv); o.y = cvtpk(oa[dt][4 * g4 + 2] * inv, oa[dt][4 * g4 + 3] * inv);
                    *(u32x2*)(yp + 32 * dt + 8 * g4) = o; }
        }
    }
}

DI unsigned umax_(unsigned a, unsigned b) { return a > b ? a : b; }
DI unsigned umin_(unsigned a, unsigned b) { return a < b ? a : b; }
DI void cexd(unsigned& a, unsigned& b) { const unsigned mx = umax_(a, b), mn = umin_(a, b); a = mx; b = mn; }
DI void sort16_desc(unsigned (&v)[16]) {
#pragma unroll
    for (int k = 2; k <= 16; k <<= 1)
#pragma unroll
        for (int j = k >> 1; j > 0; j >>= 1)
#pragma unroll
            for (int i = 0; i < 16; ++i) { const int l = i ^ j; if (l > i) { if ((i & k) == 0) cexd(v[i], v[l]); else cexd(v[l], v[i]); } }
}
DI void merge16_desc(unsigned (&a)[16], const unsigned (&b)[16]) {
#pragma unroll
    for (int i = 0; i < 16; ++i) a[i] = umax_(a[i], b[15 - i]);
#pragma unroll
    for (int j = 8; j > 0; j >>= 1)
#pragma unroll
        for (int i = 0; i < 16; ++i) { const int l = i ^ j; if (l > i) cexd(a[i], a[l]); }
}
DI unsigned mono(float f) { const unsigned u = __builtin_bit_cast(unsigned, f); return u ^ ((unsigned)((int)u >> 31) | 0x80000000u); }
DI float demono(unsigned m) { const unsigned t = (unsigned)((int)m >> 31); return __builtin_bit_cast(float, m ^ (~t | 0x80000000u)); }
constexpr int TK_KLD = 136, TK_SCR_OFF = 2 * 128 * TK_KLD * 2;
DI void topk_phase(const bf16_t* qp, const bf16_t* keysb, const float* rstd2, unsigned short* ids, float* gts, unsigned char* lds) {
    const int tid = opaque_tid();
    const int lane = tid & 63, w = tid >> 6, r = lane & 31, h2 = lane >> 5;
    bf16_t* Kl = (bf16_t*)lds;
    unsigned char* scr = lds + TK_SCR_OFF + w * 2048 + lane * 32;
    int staged = -1;
    for (int unit = blockIdx.x; unit < 1024; unit += gridDim.x) {
        const int hd = unit & 7, tile = unit >> 3;
        if (hd != staged) {
            __syncthreads();
#pragma unroll
            for (int i = 0; i < 8; ++i) { const int c = tid + 512 * i, row = c >> 4, dc = (c & 15) * 8;
                *(u32x4*)(Kl + row * TK_KLD + dc) = *(const u32x4*)(keysb + ((size_t)hd * 256 + row) * 128 + dc); }
            __syncthreads();
            staged = hd;
        }
        const int t0 = tile * 256 + w * 32;
        unsigned K0[16], K1[16];
#pragma unroll
        for (int p = 0; p < 2; ++p) {
            const bf16_t* qrow = qp + (size_t)(t0 + r) * 2048 + hd * 256 + p * 128 + 8 * h2;
            bf16x8 qf[8];
#pragma unroll
            for (int s = 0; s < 8; ++s) qf[s] = *(const bf16x8*)(qrow + 16 * s);
            unsigned blk[4][16];
#pragma unroll
            for (int c = 0; c < 4; ++c) {
                f32x16 sc;
#pragma unroll
                for (int i = 0; i < 16; ++i) sc[i] = 0.f;
#pragma unroll
                for (int s = 0; s < 8; ++s) { const bf16x8 kf = *(const bf16x8*)(Kl + (p * 128 + 32 * c + r) * TK_KLD + 16 * s + 8 * h2); sc = MFMA32(kf, qf[s], sc); }
#pragma unroll
                for (int i = 0; i < 16; ++i) blk[c][i] = (mono(sc[i]) & ~0x7Fu) | (unsigned)(32 * c + crow(i, h2));
                sort16_desc(blk[c]);
            }
            merge16_desc(blk[0], blk[1]); merge16_desc(blk[2], blk[3]); merge16_desc(blk[0], blk[2]);
            unsigned oth[16];
#pragma unroll
            for (int i = 0; i < 16; ++i) oth[i] = (unsigned)__shfl_xor((int)blk[0][i], 32);
            merge16_desc(blk[0], oth);
#pragma unroll
            for (int i = 0; i < 16; ++i) { if (p == 0) K0[i] = blk[0][i]; else K1[i] = blk[0][i]; }
        }
#pragma unroll
        for (int q = 0; q < 4; ++q) {
            ((unsigned*)scr)[q] = (K0[4 * q] & 0x7Fu) | ((K0[4 * q + 1] & 0x7Fu) << 8) | ((K0[4 * q + 2] & 0x7Fu) << 16) | ((K0[4 * q + 3] & 0x7Fu) << 24);
            ((unsigned*)scr)[4 + q] = (K1[4 * q] & 0x7Fu) | ((K1[4 * q + 1] & 0x7Fu) << 8) | ((K1[4 * q + 2] & 0x7Fu) << 16) | ((K1[4 * q + 3] & 0x7Fu) << 24);
        }
        float sx[16], sy[16];
#pragma unroll
        for (int i = 0; i < 16; ++i) { const float s0 = demono(K0[i] & ~0x7Fu), s1 = demono(K1[i] & ~0x7Fu); sx[i] = h2 ? s1 : s0; sy[i] = h2 ? s0 : s1; }
        unsigned ca[16], cb[16];
#pragma unroll
        for (int i = 0; i < 16; ++i) { ca[i] = 0u; cb[i] = 0u; }
#define CAND(n, a, b) do { const unsigned key_ = (mono(sx[a] + sy[b]) & ~0xFFu) | (h2 ? (unsigned)(((b) << 4) | (a)) : (unsigned)(((a) << 4) | (b))); if ((n) < 16) ca[(n) & 15] = key_; else cb[(n) & 15] = key_; } while (0)
            CAND(0, 0, 1);
            CAND(1, 0, 2);
            CAND(2, 0, 3);
            CAND(3, 0, 4);
            CAND(4, 0, 5);
            CAND(5, 0, 6);
            CAND(6, 0, 7);
            CAND(7, 0, 8);
            CAND(8, 0, 9);
            CAND(9, 0, 10);
            CAND(10, 0, 11);
            CAND(11, 0, 12);
            CAND(12, 0, 13);
            CAND(13, 0, 14);
            CAND(14, 0, 15);
            CAND(15, 1, 2);
            CAND(16, 1, 3);
            CAND(17, 1, 4);
            CAND(18, 1, 5);
            CAND(19, 1, 6);
            CAND(20, 1, 7);
            CAND(21, 2, 3);
            CAND(22, 2, 4);
#undef CAND
#pragma unroll
        for (int d = 0; d < 4; ++d) { const unsigned key_ = (mono(sx[d] + sy[d]) & ~0xFFu) | (unsigned)((d << 4) | d); cb[7 + d] = h2 ? 0u : key_; }
        sort16_desc(ca); sort16_desc(cb); merge16_desc(ca, cb);
        unsigned fin[16], cpart[16];
#pragma unroll
        for (int i = 0; i < 16; ++i) cpart[i] = (unsigned)__shfl_xor((int)ca[i], 32);
#pragma unroll
        for (int i = 0; i < 16; ++i) fin[i] = umax_(ca[i], cpart[15 - i]);
        const float rs = 1.f / sqrtf(rstd2[t0 + r] * (1.f / D) + EPS);
        float sv[16], mxv = -3e38f;
#pragma unroll
        for (int i = 0; i < 16; ++i) { sv[i] = demono(fin[i] & ~0xFFu) * rs; mxv = fmaxf(mxv, sv[i]); }
        float den = 0.f;
#pragma unroll
        for (int i = 0; i < 16; ++i) { sv[i] = __expf(sv[i] - mxv); den += sv[i]; }
        const float rden = 1.f / den;
        int oid[8]; float og[8];
#pragma unroll
        for (int j = 0; j < 8; ++j) {
            const unsigned wk = fin[j]; og[j] = sv[j] * rden;
            const unsigned a0 = (wk >> 4) & 15u, a1 = wk & 15u;
            oid[j] = (int)scr[a0] * 128 + (int)scr[16 + a1];
        }
        unsigned short* ip = ids + (size_t)(t0 + r) * 128 + hd * 16 + 8 * h2; float* gp = gts + (size_t)(t0 + r) * 128 + hd * 16 + 8 * h2;
        *(u32x4*)ip = (u32x4){(unsigned)oid[0] | ((unsigned)oid[1] << 16), (unsigned)oid[2] | ((unsigned)oid[3] << 16), (unsigned)oid[4] | ((unsigned)oid[5] << 16), (unsigned)oid[6] | ((unsigned)oid[7] << 16)};
        *(f32x4*)gp = (f32x4){og[0], og[1], og[2], og[3]}; *(f32x4*)(gp + 4) = (f32x4){og[4], og[5], og[6], og[7]};
    }
}

typedef _Float16 h2_t __attribute__((ext_vector_type(2)));
template <int CTRL> DI float dpp_f(float v) { return __builtin_bit_cast(float, __builtin_amdgcn_update_dpp(0, __builtin_bit_cast(int, v), CTRL, 0xf, 0xf, true)); }
DI float row16_sum(float v) {
    v += dpp_f<0xB1>(v); v += dpp_f<0x4E>(v); v += dpp_f<0x141>(v); v += dpp_f<0x140>(v); return v; }
DI bf16x2_t as_b2(unsigned w) { return __builtin_bit_cast(bf16x2_t, w); }
DI float dot_row(const u32x4 (&xw)[4][2], const u32x4 (&ru)[4]) {
    float d0 = 0.f, d1 = 0.f;
#pragma unroll
    for (int i = 0; i < 4; ++i)
#pragma unroll
        for (int q = 0; q < 4; ++q) {
            const bf16x2_t z0 = __builtin_amdgcn_cvt_scalef32_pk_bf16_fp8((int)ru[i][q], 1.0f, false), z1 = __builtin_amdgcn_cvt_scalef32_pk_bf16_fp8((int)ru[i][q], 1.0f, true);
            d0 = __builtin_amdgcn_fdot2_f32_bf16(as_b2(xw[i][q >> 1][2 * (q & 1)]), z0, d0, false); d1 = __builtin_amdgcn_fdot2_f32_bf16(as_b2(xw[i][q >> 1][2 * (q & 1) + 1]), z1, d1, false);
        }
    return row16_sum(d0 + d1);
}
DI float swz_xor4(float v) { return __builtin_bit_cast(float, __builtin_amdgcn_ds_swizzle(__builtin_bit_cast(int, v), 0x101F)); }
DI bf16_t* partial_base(unsigned char* ws, int x) { return (bf16_t*)(ws + 42 * MiB + (size_t)x * 8 * MiB); }
template <int VAR>
DI void peer_u2_phase(const bf16_t* x1b, const unsigned char* u8, const unsigned short* ids, bf16_t* part, unsigned char* lds, int lbl, int rnk, int cnt) {
    const int tid = opaque_tid(), lane = tid & 63, wave = tid >> 6, g8 = lane >> 3, s8 = lane & 7;
    constexpr int LST = 132;
    int* lid = (int*)(lds + wave * (2 * 8 * LST * 4)); float* lpa = (float*)(lid + 8 * LST);
    const int stride = cnt * NWAVES * 8;
    const int sl = lbl & 3, hf = lbl >> 2;
    const unsigned char* ubase = u8 + sl * 128;
    const bool b4 = (s8 & 4) != 0, b2 = (s8 & 2) != 0, b1 = (s8 & 1) != 0;
    for (int t0 = hf * (T / 2) + (rnk * NWAVES + wave) * 8; t0 < (hf + 1) * (T / 2); t0 += stride) {
#pragma unroll
        for (int j = 0; j < 2; ++j) { const int f = lane * 8 + 512 * j, tk = f >> 7, k = f & 127; const u32x4 w = *(const u32x4*)(ids + (size_t)t0 * 128 + f);
            *(u32x4*)(lid + tk * LST + k) = (u32x4){w.x & 0xffffu, w.x >> 16, w.y & 0xffffu, w.y >> 16}; *(u32x4*)(lid + tk * LST + k + 4) = (u32x4){w.z & 0xffffu, w.z >> 16, w.w & 0xffffu, w.w >> 16}; }
        const size_t xo_ = (size_t)(t0 + g8) * D + sl * 256 + 32 * s8;
        u32x4 xr[4];
#pragma unroll
        for (int q = 0; q < 4; ++q) xr[q] = *(const u32x4*)(x1b + xo_ + 8 * q);
        float xm = 0.f;
#pragma unroll
        for (int q = 0; q < 4; ++q) { xm = fmaxf(fmaxf(xm, fmaxf(fabsf(bflo(xr[q].x)), fabsf(bfhi(xr[q].x)))), fmaxf(fabsf(bflo(xr[q].y)), fabsf(bfhi(xr[q].y))));
            xm = fmaxf(fmaxf(xm, fmaxf(fabsf(bflo(xr[q].z)), fabsf(bfhi(xr[q].z)))), fmaxf(fabsf(bflo(xr[q].w)), fabsf(bfhi(xr[q].w)))); }
        xm = fmaxf(xm, dpp_f<0xB1>(xm)); xm = fmaxf(xm, dpp_f<0x4E>(xm)); xm = fmaxf(xm, dpp_f<0x141>(xm));
        const float xinv = xm > 0.f ? 127.f / xm : 0.f, sx = xm * (1.f / 127.f);
        int xq[8];
#pragma unroll
        for (int q = 0; q < 4; ++q) {
            const int q0 = (int)__builtin_rintf(bflo(xr[q].x) * xinv), q1 = (int)__builtin_rintf(bfhi(xr[q].x) * xinv), q2 = (int)__builtin_rintf(bflo(xr[q].y) * xinv), q3 = (int)__builtin_rintf(bfhi(xr[q].y) * xinv);
            const int q4 = (int)__builtin_rintf(bflo(xr[q].z) * xinv), q5 = (int)__builtin_rintf(bfhi(xr[q].z) * xinv), q6 = (int)__builtin_rintf(bflo(xr[q].w) * xinv), q7 = (int)__builtin_rintf(bfhi(xr[q].w) * xinv);
            xq[2 * q] = (int)((unsigned)(q0 & 255) | ((unsigned)(q1 & 255) << 8) | ((unsigned)(q2 & 255) << 16) | ((unsigned)q3 << 24));
            xq[2 * q + 1] = (int)((unsigned)(q4 & 255) | ((unsigned)(q5 & 255) << 8) | ((unsigned)(q6 & 255) << 16) | ((unsigned)q7 << 24)); }
        int sxlo = 0, sxhi = 0;
#pragma unroll
        for (int q = 0; q < 4; ++q) { sxlo = __builtin_amdgcn_sdot4(xq[2 * q], 0x01010101, sxlo, false); sxhi = __builtin_amdgcn_sdot4(xq[2 * q + 1], 0x01010101, sxhi, false); }
        const int dh0 = 8 * sxhi - 120 * sxlo;
        const int* myid = lid + g8 * LST; float* mypa = lpa + g8 * LST;
        const unsigned loff = (unsigned)(s8 * 16);
#define U2_FETCH(K8, RW) do { const int kc_ = (K8) < 128 ? (K8) : 120; const u32x4 i0_ = *(const u32x4*)(myid + kc_), i1_ = *(const u32x4*)(myid + kc_ + 4); \
            _Pragma("unroll") for (int i = 0; i < 8; ++i) { const unsigned id_ = i < 4 ? i0_[i & 3] : i1_[i & 3]; \
                if (VAR & 1) RW[i] = (u32x4){id_, id_ * 3u, id_ * 5u, id_ * 7u}; else RW[i] = *(const u32x4*)(ubase + (id_ * 512u + loff)); } } while (0)
#define U2_REDUCE(K8, RW) do { int pp[8]; \
            _Pragma("unroll") for (int i = 0; i < 8; ++i) { \
                if (VAR & 2) { pp[i] = (int)((RW[i].x ^ RW[i].y ^ RW[i].z ^ RW[i].w ^ xr[0].x) & 0xffu); continue; } \
                int dl_ = 0, dh_ = dh0; \
                _Pragma("unroll") for (int q = 0; q < 4; ++q) { dl_ = __builtin_amdgcn_sdot4((int)(RW[i][q] & 0x0F0F0F0Fu), xq[2 * q], dl_, false); dh_ = __builtin_amdgcn_sdot4((int)(RW[i][q] & 0xF0F0F0F0u), xq[2 * q + 1], dh_, false); } \
                pp[i] = (dl_ << 4) + dh_; } \
            int q4[4], q2[2]; \
            _Pragma("unroll") for (int j = 0; j < 4; ++j) { const int keep = b4 ? pp[j + 4] : pp[j], send = b4 ? pp[j] : pp[j + 4]; q4[j] = keep + __builtin_amdgcn_ds_swizzle(send, 0x101F); } \
            _Pragma("unroll") for (int j = 0; j < 2; ++j) { const int keep = b2 ? q4[j + 2] : q4[j], send = b2 ? q4[j] : q4[j + 2]; q2[j] = keep + __builtin_amdgcn_update_dpp(0, send, 0x4E, 0xf, 0xf, true); } \
            const int keep1 = b1 ? q2[1] : q2[0], send1 = b1 ? q2[0] : q2[1]; \
            mypa[(K8) + s8] = (float)(keep1 + __builtin_amdgcn_update_dpp(0, send1, 0xB1, 0xf, 0xf, true)) * sx;     } while (0)
        u32x4 rwA[8], rwB[8];
        U2_FETCH(0, rwA);
#pragma unroll 1
        for (int k8 = 0; k8 < 128; k8 += 16) {
            U2_FETCH(k8 + 8, rwB);
            U2_REDUCE(k8, rwA);
            U2_FETCH(k8 + 16, rwA);
            U2_REDUCE(k8 + 8, rwB);
        }
#undef U2_FETCH
#undef U2_REDUCE
        bf16_t* pg = part + (size_t)t0 * 128;
#pragma unroll
        for (int j = 0; j < 4; ++j) { const int f = lane * 4 + 256 * j, tk = f >> 7, k = f & 127; const f32x4 v = *(const f32x4*)(lpa + tk * LST + k);
            u32x2 w; w.x = pk2(v.x, v.y); w.y = pk2(v.z, v.w); *(u32x2*)(pg + f) = w; }
    }
}
DI void peer_combine_phase(unsigned char* ws, const float* ssq2, const float* gts, const unsigned short* ids, const float* su, const float* sv, bf16_t* coef) {
    const size_t gt = (size_t)blockIdx.x * NTHREADS + opaque_tid(), NGT = (size_t)gridDim.x * NTHREADS;
    for (size_t i = gt; i < (size_t)T * 32; i += NGT) {
        const int t = (int)(i >> 5);
        f32x4 a = {0.f, 0.f, 0.f, 0.f};
#pragma unroll
        for (int x = 0; x < 4; ++x) { const u32x2 w = ((const u32x2*)partial_base(ws, x))[i]; a += (f32x4){bflo(w.x), bfhi(w.x), bflo(w.y), bfhi(w.y)}; }
        const float rs = __builtin_amdgcn_rsqf(ssq2[t] * (1.f / D) + EPS);
        const f32x4 g = ((const f32x4*)gts)[i]; const u32x2 idw = ((const u32x2*)ids)[i];
        const unsigned i0 = idw.x & 0xffffu, i1 = idw.x >> 16, i2 = idw.y & 0xffffu, i3 = idw.y >> 16;
        u32x2 w; w.x = pk2(g.x * gelu_tanh(a.x * rs * su[i0]) * sv[i0], g.y * gelu_tanh(a.y * rs * su[i1]) * sv[i1]); w.y = pk2(g.z * gelu_tanh(a.z * rs * su[i2]) * sv[i2], g.w * gelu_tanh(a.w * rs * su[i3]) * sv[i3]);
        ((u32x2*)coef)[i] = w;
    }
}
template <int VAR>
DI void peer_v_phase(const bf16_t* x1in, bf16_t* xout, const unsigned char* v8, const unsigned short* ids, const bf16_t* coef, float* ssqo, unsigned char* lds, int lbl, int rnk, int cnt) {
    const int tid = opaque_tid(), lane = tid & 63, wave = tid >> 6, g8 = lane >> 3, s8 = lane & 7;
    constexpr int LST = 132;
    int* lid = (int*)(lds + wave * (2 * 8 * LST * 4)); float* lco = (float*)(lid + 8 * LST);
    const int stride = cnt * NWAVES * 8;
    const int sl = lbl & 3, hf = lbl >> 2;
    const unsigned char* vbase = v8 + sl * 128;
    for (int t0 = hf * (T / 2) + (rnk * NWAVES + wave) * 8; t0 < (hf + 1) * (T / 2); t0 += stride) {
#pragma unroll
        for (int j = 0; j < 2; ++j) { const int f = lane * 8 + 512 * j, tk = f >> 7, k = f & 127;
            const u32x4 w = *(const u32x4*)(ids + (size_t)t0 * 128 + f), cw = *(const u32x4*)(coef + (size_t)t0 * 128 + f);
            *(u32x4*)(lid + tk * LST + k) = (u32x4){w.x & 0xffffu, w.x >> 16, w.y & 0xffffu, w.y >> 16}; *(u32x4*)(lid + tk * LST + k + 4) = (u32x4){w.z & 0xffffu, w.z >> 16, w.w & 0xffffu, w.w >> 16};
            *(f32x4*)(lco + tk * LST + k) = (f32x4){bflo(cw.x), bfhi(cw.x), bflo(cw.y), bfhi(cw.y)}; *(f32x4*)(lco + tk * LST + k + 4) = (f32x4){bflo(cw.z), bfhi(cw.z), bflo(cw.w), bfhi(cw.w)}; }
        h2_t acc[16];
#pragma unroll
        for (int j = 0; j < 16; ++j) acc[j] = (h2_t){(f16_t)0.f, (f16_t)0.f};
        const int* myid = lid + g8 * LST; const float* myco = lco + g8 * LST;
        const unsigned loff = (unsigned)(s8 * 16);
#define V_FETCH(K8, RW, CO) do { const int kc_ = (K8) < 128 ? (K8) : 120; const u32x4 i0_ = *(const u32x4*)(myid + kc_), i1_ = *(const u32x4*)(myid + kc_ + 4); \
            const f32x4 c0_ = *(const f32x4*)(myco + kc_), c1_ = *(const f32x4*)(myco + kc_ + 4); \
            _Pragma("unroll") for (int i = 0; i < 8; ++i) { const unsigned id_ = i < 4 ? i0_[i & 3] : i1_[i & 3]; CO[i] = i < 4 ? c0_[i & 3] : c1_[i & 3]; \
                if (VAR & 1) RW[i] = (u32x4){id_, id_ * 3u, id_ * 5u, id_ * 7u}; else RW[i] = *(const u32x4*)(vbase + (id_ * 512u + loff)); } } while (0)
#define V_ACCUM(RW, CO) do { _Pragma("unroll") for (int i = 0; i < 8; ++i) { const h2_t cc = {(f16_t)CO[i], (f16_t)CO[i]}; \
                if (VAR & 2) { acc[i].x += (f16_t)(__builtin_bit_cast(float, (RW[i].x ^ RW[i].y ^ RW[i].z ^ RW[i].w) & 0x3fffffffu) * CO[i]); continue; } \
                _Pragma("unroll") for (int q = 0; q < 4; ++q) { \
                    const h2_t a0 = __builtin_amdgcn_cvt_scalef32_pk_f16_fp4(RW[i][q], 1.0f, 0), a1 = __builtin_amdgcn_cvt_scalef32_pk_f16_fp4(RW[i][q], 1.0f, 1), a2 = __builtin_amdgcn_cvt_scalef32_pk_f16_fp4(RW[i][q], 1.0f, 2), a3 = __builtin_amdgcn_cvt_scalef32_pk_f16_fp4(RW[i][q], 1.0f, 3); \
                    acc[4 * q] = __builtin_elementwise_fma(a0, cc, acc[4 * q]); acc[4 * q + 1] = __builtin_elementwise_fma(a1, cc, acc[4 * q + 1]); acc[4 * q + 2] = __builtin_elementwise_fma(a2, cc, acc[4 * q + 2]); acc[4 * q + 3] = __builtin_elementwise_fma(a3, cc, acc[4 * q + 3]); } } } while (0)
        u32x4 rwA[8], rwB[8]; float coA[8], coB[8];
        V_FETCH(0, rwA, coA);
#pragma unroll 1
        for (int k8 = 0; k8 < 128; k8 += 16) {
            V_FETCH(k8 + 8, rwB, coB);
            V_ACCUM(rwA, coA);
            V_FETCH(k8 + 16, rwA, coA);
            V_ACCUM(rwB, coB);
        }
#undef V_FETCH
#undef V_ACCUM
        const size_t xo_ = (size_t)(t0 + g8) * D + sl * 256 + 32 * s8;
        u32x4 xr[4];
#pragma unroll
        for (int q = 0; q < 4; ++q) xr[q] = *(const u32x4*)(x1in + xo_ + 8 * q);
        float ss = 0.f;
        u32x4 wo[4];
#pragma unroll
        for (int q = 0; q < 4; ++q) {
            const float o0 = bflo(xr[q].x) + (float)acc[4 * q].x, o1 = bfhi(xr[q].x) + (float)acc[4 * q].y, o2 = bflo(xr[q].y) + (float)acc[4 * q + 1].x, o3 = bfhi(xr[q].y) + (float)acc[4 * q + 1].y;
            const float o4 = bflo(xr[q].z) + (float)acc[4 * q + 2].x, o5 = bfhi(xr[q].z) + (float)acc[4 * q + 2].y, o6 = bflo(xr[q].w) + (float)acc[4 * q + 3].x, o7 = bfhi(xr[q].w) + (float)acc[4 * q + 3].y;
            ss += o0 * o0 + o1 * o1 + o2 * o2 + o3 * o3 + o4 * o4 + o5 * o5 + o6 * o6 + o7 * o7;
            wo[q].x = pk2(o0, o1); wo[q].y = pk2(o2, o3); wo[q].z = pk2(o4, o5); wo[q].w = pk2(o6, o7); }
        ss += dpp_f<0xB1>(ss); ss += dpp_f<0x4E>(ss); ss += dpp_f<0x141>(ss);
        if (s8 == 0) atomicAdd(ssqo + t0 + g8, ss);
#pragma unroll
        for (int q = 0; q < 4; ++q) *(u32x4*)(xout + xo_ + 8 * q) = wo[q];
    }
}
DI void peer_final_phase(const bf16_t* xo, const float* ssqo, const float* gf, float* out) {
    const int tid = opaque_tid(), lane = tid & 63, gw = blockIdx.x * NWAVES + (tid >> 6), NGW = gridDim.x * NWAVES;
    f32x4 g[4];
#pragma unroll
    for (int q = 0; q < 4; ++q) g[q] = *(const f32x4*)(gf + lane * 16 + 4 * q);
    for (int t = gw; t < T; t += NGW) {
        const u32x4 w0 = *(const u32x4*)(xo + (size_t)t * D + lane * 16), w1 = *(const u32x4*)(xo + (size_t)t * D + lane * 16 + 8);
        const float rf = 1.f / sqrtf(ssqo[t] * (1.f / D) + EPS);
        f32x4* po = (f32x4*)(out + (size_t)t * D + lane * 16);
        po[0] = (f32x4){bflo(w0.x), bfhi(w0.x), bflo(w0.y), bfhi(w0.y)} * rf * g[0]; po[1] = (f32x4){bflo(w0.z), bfhi(w0.z), bflo(w0.w), bfhi(w0.w)} * rf * g[1];
        po[2] = (f32x4){bflo(w1.x), bfhi(w1.x), bflo(w1.y), bfhi(w1.y)} * rf * g[2]; po[3] = (f32x4){bflo(w1.z), bfhi(w1.z), bflo(w1.w), bfhi(w1.w)} * rf * g[3];
    }
}

#define LAS __attribute__((address_space(3)))
#define XB_TMO      128
#define XB_XCNT(j)  (256  + 64 * (j))
#define XB_XSUB(j)  (1280 + 64 * (j))
#define XB_XGEN(j)  (2304 + 64 * (j))
#define XB_TOP      3328
#define XB_TOPGEN   3392
#define XCD_BAR_WORDS 3456
#define XB_SPIN_CAP (1u << 18)
DI unsigned xb_ld(unsigned* p)              { return __hip_atomic_load(p, __ATOMIC_RELAXED, __HIP_MEMORY_SCOPE_AGENT); }
DI unsigned xb_add(unsigned* p, unsigned v) { return __hip_atomic_fetch_add(p, v, __ATOMIC_RELAXED, __HIP_MEMORY_SCOPE_AGENT); }
DI unsigned xb_xcc_id() { return (unsigned)__builtin_amdgcn_s_getreg((3 << 11) | 20) & 0xFu; }
#define XB_SPIN(cond, bar) do { unsigned _sp = 0; while (cond) { __builtin_amdgcn_s_sleep(1); \
    if ((++_sp & 255u) == 0u) { if (xb_ld(&(bar)[XB_TMO])) break; if (_sp > XB_SPIN_CAP) { atomicAdd(&(bar)[XB_TMO], 1u); break; } } } } while (0)
struct XcdBarrier { unsigned* bar; unsigned x; volatile LAS unsigned* st; };
DI XcdBarrier xcd_barrier_post(unsigned* bar, volatile LAS unsigned* st) {
    XcdBarrier b; b.bar = bar; b.x = xb_xcc_id(); b.st = st;
    if (threadIdx.x == 0) st[2] = xb_add(&bar[XB_XCNT(b.x)], 1u);
    return b;
}
DI void xcd_barrier_complete(unsigned* bar, unsigned x, unsigned& nloc, unsigned& nx) {
    const unsigned G = gridDim.x * gridDim.y * gridDim.z;
    unsigned sum, cnt, mine, sp = 0u;
    for (;;) {
        sum = 0u; cnt = 0u; mine = 0u;
#pragma unroll
        for (unsigned j = 0; j < 16; ++j) { const unsigned c = xb_ld(&bar[XB_XCNT(j)]); sum += c; cnt += (c > 0u) ? 1u : 0u; mine = (j == x) ? c : mine; }
        if (sum == G) break;
        __builtin_amdgcn_s_sleep(1);
        if ((++sp & 255u) == 0u) { if (xb_ld(&bar[XB_TMO])) break; if (sp > XB_SPIN_CAP) { atomicAdd(&bar[XB_TMO], 1u); break; } }
    }
    nloc = mine > 0u ? mine : 1u; nx = cnt > 0u ? cnt : 1u;
}
DI void xcd_barrier(const XcdBarrier& b) {
    asm volatile("s_waitcnt vmcnt(0)" ::: "memory");
    __syncthreads();
    if (threadIdx.x == 0) {
        unsigned* bar = b.bar;
        __builtin_amdgcn_s_waitcnt(0);
        unsigned nloc = b.st[0], nx = b.st[1];
        if (nloc == 0u) { xcd_barrier_complete(bar, b.x, nloc, nx); b.st[0] = nloc; b.st[1] = nx; }
        const unsigned old = xb_add(&bar[XB_XSUB(b.x)], 1u);
        const unsigned gen = old / nloc;
        if (old + 1u == (gen + 1u) * nloc) {
            __builtin_amdgcn_fence(__ATOMIC_RELEASE, "agent");
            asm volatile("s_waitcnt vmcnt(0)" ::: "memory");
            const unsigned og = xb_add(&bar[XB_TOP], 1u);
            const unsigned tg = og / nx;
            if (og + 1u == (tg + 1u) * nx) xb_add(&bar[XB_TOPGEN], 1u);
            else XB_SPIN(xb_ld(&bar[XB_TOPGEN]) == tg, bar);
            __builtin_amdgcn_fence(__ATOMIC_ACQUIRE, "agent");
            xb_add(&bar[XB_XGEN(b.x)], 1u);
            asm volatile("s_waitcnt vmcnt(0)" ::: "memory");
        } else {
            XB_SPIN(xb_ld(&bar[XB_XGEN(b.x)]) == gen, bar);
            __builtin_amdgcn_fence(__ATOMIC_ACQUIRE, "agent");
            asm volatile("s_waitcnt vmcnt(0)" ::: "memory");
        }
    }
    __syncthreads();
}


constexpr int LDS_BYTES = 147456;
__global__ void __launch_bounds__(NTHREADS, 2) fwd_kernel(Params p) {
    extern __shared__ __attribute__((aligned(16))) unsigned char lds[];
    cg::grid_group grid = cg::this_grid();
    volatile LAS unsigned* bst = (volatile LAS unsigned*)((LAS unsigned char*)lds + (LDS_BYTES - 64));
    if (threadIdx.x < 4) bst[threadIdx.x] = 0u;
    __syncthreads();
    const XcdBarrier xbar = xcd_barrier_post((unsigned*)p.ws, bst);
    const int NGW = gridDim.x * NWAVES, G = gridDim.x, cu = blockIdx.x;
    unsigned char* ws = p.ws;
    PG8_LAS unsigned char* ldsl = (PG8_LAS unsigned char*)lds;
    bf16_t* ycat = (bf16_t*)p.out;

    for (int rep_ = 0; rep_ < (DUP_PHASE == 0 ? 2 : 1); ++rep_) { phase0(p, (float*)lds);
    if (p.use_cg_sync) grid.sync(); else xcd_barrier(xbar); }
    for (int rep_ = 0; rep_ < (DUP_PHASE == 1 ? 2 : 1); ++rep_) {
        EpiZ E{(const float*)(ws + WS_RSTD1), (const float*)(ws + WS_RSTDM), (const float2*)(ws + WS_ROPE), (bf16_t*)(ws + WS_UPOOL), (bf16_t*)(ws + WS_QR), (bf16_t*)(ws + WS_KR), (bf16_t*)(ws + WS_VV), (bf16_t*)(ws + WS_QM), (unsigned char*)(ws + WS_GATES), (bf16_t*)(ws + WS_KVM)};
        SchedZ S{(const char*)(ws + WS_XB), (const char*)(ws + WS_WIN), (const char*)(ws + WS_MEMB), (const char*)(ws + WS_WMKV), G, cu};
        pg8::gemm_phase(ldsl, 1024, 1024, S, E);
    xcd_barrier(xbar); }
    if (DUP_PHASE == 20) pooled_phase((const bf16_t*)(ws + WS_UPOOL), ycat);
    if (DUP_PHASE == 21) swa_phase((const bf16_t*)(ws + WS_QR), (const bf16_t*)(ws + WS_KR), (const bf16_t*)(ws + WS_VV), p.sinks, ycat, lds);
    if (DUP_PHASE == 22) mem_phase((const bf16_t*)(ws + WS_QM), (const bf16_t*)(ws + WS_KVM), ycat, lds);
    pooled_phase((const bf16_t*)(ws + WS_UPOOL), ycat);
    swa_phase((const bf16_t*)(ws + WS_QR), (const bf16_t*)(ws + WS_KR), (const bf16_t*)(ws + WS_VV), p.sinks, ycat, lds);
    mem_phase((const bf16_t*)(ws + WS_QM), (const bf16_t*)(ws + WS_KVM), ycat, lds);
    xcd_barrier(xbar);
    for (int rep_ = 0; rep_ < (DUP_PHASE == 3 ? 2 : 1); ++rep_) {
        EpiGated E{(const unsigned char*)(ws + WS_GATES), (bf16_t*)(ws + WS_MERGED)};
        SchedGated S{(const char*)ycat, (const char*)(ws + WS_WBR), G, cu};
        pg8::gemm_phase(ldsl, 2048, 2048, S, E);
    xcd_barrier(xbar); }
    for (int rep_ = 0; rep_ < (DUP_PHASE == 4 ? 2 : 1); ++rep_) {
        EpiOut E{(const bf16_t*)(ws + WS_XB), (DUP_PHASE == 4 && rep_ == 0) ? (bf16_t*)(ws + WS_QP) : (bf16_t*)(ws + WS_X1B), (DUP_PHASE == 4 && rep_ == 0) ? (float*)(ws + WS_RSTD1) : (float*)(ws + WS_RSTD2)};
        SchedPlain S{(const char*)(ws + WS_MERGED), (const char*)(ws + WS_WOUT), 1024, 1024, 128, 4, 16, G, cu};
        pg8::gemm_phase(ldsl, 1024, 1024, S, E);
    xcd_barrier(xbar); }
    for (int rep_ = 0; rep_ < (DUP_PHASE == 5 ? 2 : 1); ++rep_) {
        EpiBf16 E{(bf16_t*)(ws + WS_QP), 2048};
        SchedPlain S{(const char*)(ws + WS_X1B), (const char*)(ws + WS_WQ), 1024, 1024, 128, 8, 16, G, cu};
        pg8::gemm_phase(ldsl, 1024, 1024, S, E);
    xcd_barrier(xbar); }
    for (int rep_ = 0; rep_ < (DUP_PHASE == 6 ? 2 : 1); ++rep_) {
    topk_phase((const bf16_t*)(ws + WS_QP), (const bf16_t*)(ws + WS_KEYS), (const float*)(ws + WS_RSTD2), (unsigned short*)(ws + WS_IDS), (float*)(ws + WS_GTS), lds);
    xcd_barrier(xbar); }
    int lbl, rnk, cnt;
    {
        unsigned* bar = (unsigned*)p.ws; unsigned sum = 0u, mine = 0u; bool ok = xbar.x < 8u;
#pragma unroll
        for (unsigned j = 0; j < 8; ++j) { const unsigned c = xb_ld(&bar[XB_XCNT(j)]); sum += c; ok = ok && (c > 0u); mine = (j == xbar.x) ? c : mine; }
        ok = ok && (sum == (unsigned)G);
        lbl = ok ? (int)xbar.x : (cu & 7); rnk = ok ? (int)bst[2] : (cu >> 3); cnt = ok ? (int)mine : ((G - (cu & 7) + 7) >> 3);
        lbl = __builtin_amdgcn_readfirstlane(lbl); rnk = __builtin_amdgcn_readfirstlane(rnk); cnt = __builtin_amdgcn_readfirstlane(cnt);
    }
    if (DUP_PHASE == 7) {
        peer_u2_phase<PROBE_VAR>((const bf16_t*)(ws + WS_X1B), (const unsigned char*)(ws + WS_U16), (const unsigned short*)(ws + WS_IDS), partial_base(ws, lbl & 3), lds, lbl, rnk, cnt);
        xcd_barrier(xbar); }
    peer_u2_phase<0>((const bf16_t*)(ws + WS_X1B), (const unsigned char*)(ws + WS_U16), (const unsigned short*)(ws + WS_IDS), partial_base(ws, lbl & 3), lds, lbl, rnk, cnt);
    xcd_barrier(xbar);
    peer_combine_phase(ws, (const float*)(ws + WS_RSTD2), (const float*)(ws + WS_GTS), (const unsigned short*)(ws + WS_IDS), (const float*)(ws + WS_SU), (const float*)(ws + WS_SV), (bf16_t*)(ws + WS_COEF));
    xcd_barrier(xbar);
    if (DUP_PHASE == 8) {
        peer_v_phase<PROBE_VAR>((const bf16_t*)(ws + WS_X1B), (bf16_t*)(ws + WS_MERGED), (const unsigned char*)(ws + WS_V16), (const unsigned short*)(ws + WS_IDS), (const bf16_t*)(ws + WS_COEF), (float*)(ws + WS_RSTD1), lds, lbl, rnk, cnt);
        xcd_barrier(xbar); }
    peer_v_phase<0>((const bf16_t*)(ws + WS_X1B), (bf16_t*)(ws + WS_X1B), (const unsigned char*)(ws + WS_V16), (const unsigned short*)(ws + WS_IDS), (const bf16_t*)(ws + WS_COEF), (float*)(ws + WS_SSQO), lds, lbl, rnk, cnt);
    xcd_barrier(xbar);
    for (int rep_ = 0; rep_ < (DUP_PHASE == 9 ? 2 : 1); ++rep_)
    peer_final_phase((const bf16_t*)(ws + WS_X1B), (const float*)(ws + WS_SSQO), p.final_g, p.out);
}

extern "C" void kernel_launch(void* const* d_in, const int* in_sizes, int n_in, void* d_out, int out_size, void* d_ws, size_t ws_size, hipStream_t stream) {
    static int grid_blocks = 0;
    if (grid_blocks == 0) {
        if (n_in != 20 || out_size != T * D || ws_size < WS_END) { fprintf(stderr, "kernel_launch: unexpected shapes: n_in %d out %d ws %zu\n", n_in, out_size, ws_size); grid_blocks = -1; return; }
        int dev = 0, cus = 0, per_cu = 0;
        (void)hipGetDevice(&dev);
        (void)hipDeviceGetAttribute(&cus, hipDeviceAttributeMultiprocessorCount, dev);
        if (hipFuncSetAttribute((const void*)fwd_kernel, hipFuncAttributeMaxDynamicSharedMemorySize, LDS_BYTES) != hipSuccess) { fprintf(stderr, "kernel_launch: hipFuncSetAttribute failed\n"); grid_blocks = -1; return; }
        (void)hipOccupancyMaxActiveBlocksPerMultiprocessor(&per_cu, (const void*)fwd_kernel, NTHREADS, LDS_BYTES);
        if (per_cu < 1) { fprintf(stderr, "kernel_launch: occupancy query says %d blocks per CU\n", per_cu); grid_blocks = -1; return; }
        grid_blocks = cus * per_cu;
        fprintf(stderr, "kernel_launch: cus %d per_cu %d grid %d ws %zu\n", cus, per_cu, grid_blocks, ws_size);
    }
    if (grid_blocks < 0) return;
    Params p{};
    p.x = (const float*)d_in[0]; p.mem = (const float*)d_in[1]; p.pos = (const int*)d_in[2]; p.norm1_g = (const float*)d_in[3]; p.mem_norm_g = (const float*)d_in[4];
    p.w_in = (const float*)d_in[5]; p.w_pool = (const float*)d_in[6]; p.pool_scale = (const float*)d_in[7]; p.sinks = (const float*)d_in[8]; p.w_mem_kv = (const float*)d_in[9];
    p.w_bpool = (const float*)d_in[10]; p.w_bswa = (const float*)d_in[11]; p.w_bmem = (const float*)d_in[12]; p.w_out = (const float*)d_in[13]; p.norm2_g = (const float*)d_in[14];
    p.w_q = (const float*)d_in[15]; p.sub_keys = (const float*)d_in[16]; p.peer_u = (const float*)d_in[17]; p.peer_v = (const float*)d_in[18]; p.final_g = (const float*)d_in[19];
    p.out = (float*)d_out; p.ws = (unsigned char*)d_ws;
    (void)hipMemsetAsync(d_ws, 0, 16384, stream);
    void* args[] = {&p};
    hipError_t e = hipLaunchCooperativeKernel((const void*)fwd_kernel, dim3(grid_blocks), dim3(NTHREADS), args, LDS_BYTES, stream);
    if (e != hipSuccess) fprintf(stderr, "cooperative launch failed: %s (grid %d)\n", hipGetErrorString(e), grid_blocks);
}
```
